# Optimizing an MI355X kernel written in HIP

```python
import jax, jax.numpy as jnp
from jax import lax
import numpy as np

D_MODEL = 1024
BATCH = 8
SEQ = 4096
DEPTH = 2
DEC_BATCH = 8
DEC_SEQ = 2048
PAST_LEN = 128

GRID_W = 64
NORM_EPS = 1e-6
GLA_HEADS = 4
GLA_DK = 64
GLA_DV = 128
GLA_RANK = 16
GLA_GATE_NORM = 16.0
GLA_CHUNK = 64
FNET_GROUPS = 4
FNET_GW = 128
ATTN_HEADS = 8
KV_HEADS = 2
HEAD_DIM = 128
ROPE_THETA = 10000.0
Q_BLOCK = 128
FFN_HIDDEN = -(-8 * D_MODEL // (3 * 256)) * 256
AB_IN = 2 * GLA_HEADS * GLA_DK + 2 * GLA_HEADS * GLA_DV + 2 * GLA_RANK + FNET_GROUPS * FNET_GW
AB_OUT = GLA_HEADS * GLA_DV + FNET_GROUPS * FNET_GW
C_IN = (ATTN_HEADS + 2 * KV_HEADS) * HEAD_DIM

kernel_name = 'hybrid_gla_fnet_axial_gqa_encoder'


def rms_norm(x, gain):
    xf = x.astype(jnp.float32)
    y = xf * lax.rsqrt(jnp.mean(xf * xf, axis=-1, keepdims=True) + NORM_EPS)
    return (y * gain.astype(jnp.float32)).astype(x.dtype)


def gla_direction(q, k, v, g):
    b_, s_, h_, dk = q.shape
    dv = v.shape[-1]
    n = s_ // GLA_CHUNK
    qc = q.reshape(b_, n, GLA_CHUNK, h_, dk)
    kc = k.reshape(b_, n, GLA_CHUNK, h_, dk)
    vc = v.reshape(b_, n, GLA_CHUNK, h_, dv)
    gc = g.reshape(b_, n, GLA_CHUNK, h_, dk)
    bcum = jnp.cumsum(gc, axis=2)
    q_in = qc * jnp.exp(bcum)
    k_in = kc * jnp.exp(-bcum)
    lower = jnp.tril(jnp.ones((GLA_CHUNK, GLA_CHUNK), dtype=bool))
    att = jnp.where(lower, jnp.einsum('bnihd,bnjhd->bnhij', q_in, k_in), 0.0)
    o_intra = jnp.einsum('bnhij,bnjhe->bnihe', att, vc)
    b_last = bcum[:, :, -1]
    d_state = jnp.einsum('bnjhd,bnjhe->bnhde', kc * jnp.exp(b_last[:, :, None] - bcum), vc)

    def step(state, inp):
        ds, dec = inp
        return dec[..., None] * state + ds, state

    init = jnp.zeros((b_, h_, dk, dv), jnp.float32)
    _, s_prev = lax.scan(step, init, (jnp.moveaxis(d_state, 1, 0), jnp.moveaxis(jnp.exp(b_last), 1, 0)))
    s_prev = jnp.moveaxis(s_prev, 0, 1)
    o_inter = jnp.einsum('bnihd,bnhde->bnihe', q_in, s_prev)
    return (o_intra + o_inter).reshape(b_, s_, h_, dv)


def ab_mixer(x, norm_g, w_in, up_f, bias_f, up_b, bias_b, out_g, w_out):
    b_, s_, _ = x.shape
    f32 = jnp.float32
    h = rms_norm(x, norm_g)
    sizes = [GLA_HEADS * GLA_DK, GLA_HEADS * GLA_DK, GLA_HEADS * GLA_DV, GLA_HEADS * GLA_DV, GLA_RANK, GLA_RANK]
    cuts = [int(c) for c in np.cumsum(sizes)]
    q, k, v, r, lf, lb, f = jnp.split(h @ w_in, cuts, axis=-1)
    q = q.astype(f32).reshape(b_, s_, GLA_HEADS, GLA_DK) * (GLA_DK ** -0.5)
    k = k.astype(f32).reshape(b_, s_, GLA_HEADS, GLA_DK)
    v = v.astype(f32).reshape(b_, s_, GLA_HEADS, GLA_DV)
    g_f = (jax.nn.log_sigmoid(lf.astype(f32) @ up_f.astype(f32) + bias_f.astype(f32)) / GLA_GATE_NORM).reshape(b_, s_, GLA_HEADS, GLA_DK)
    g_b = (jax.nn.log_sigmoid(lb.astype(f32) @ up_b.astype(f32) + bias_b.astype(f32)) / GLA_GATE_NORM).reshape(b_, s_, GLA_HEADS, GLA_DK)
    o_f = gla_direction(q, k, v, g_f)
    o_b = jnp.flip(gla_direction(jnp.flip(q, 1), jnp.flip(k, 1), jnp.flip(v, 1), jnp.flip(g_b, 1)), 1)
    o = rms_norm(o_f + o_b, out_g).reshape(b_, s_, GLA_HEADS * GLA_DV) * jax.nn.silu(r.astype(f32))
    fg = f.astype(f32).reshape(b_, s_, FNET_GROUPS, FNET_GW)
    fo = jnp.real(jnp.fft.fft2(fg, axes=(1, 3), norm='ortho')).reshape(b_, s_, FNET_GROUPS * FNET_GW)
    mixed = jnp.concatenate([o, fo], axis=-1).astype(x.dtype) @ w_out
    return x + mixed


def axial_angles(s_):
    rows = s_ // GRID_W
    row_idx = jnp.repeat(jnp.arange(rows), GRID_W).astype(jnp.float32)
    col_idx = jnp.tile(jnp.arange(GRID_W), rows).astype(jnp.float32)
    half = HEAD_DIM // 2
    inv = ROPE_THETA ** (-jnp.arange(0, half, 2, dtype=jnp.float32) / half)
    return row_idx[:, None] * inv[None, :], col_idx[:, None] * inv[None, :]


def rope_rotate(x, ang):
    m = ang.shape[-1]
    x1, x2 = x[..., :m], x[..., m:]
    c = jnp.cos(ang)[:, None, :]
    s = jnp.sin(ang)[:, None, :]
    return jnp.concatenate([x1 * c - x2 * s, x2 * c + x1 * s], axis=-1)


def apply_axial_rope(x, ang_row, ang_col):
    half = HEAD_DIM // 2
    xf = x.astype(jnp.float32)
    out = jnp.concatenate([rope_rotate(xf[..., :half], ang_row), rope_rotate(xf[..., half:], ang_col)], axis=-1)
    return out.astype(x.dtype)


def c_mixer(x, norm_g, w_in, qn_g, kn_g, w_out):
    b_, s_, _ = x.shape
    h = rms_norm(x, norm_g)
    q, k, v = jnp.split(h @ w_in, [ATTN_HEADS * HEAD_DIM, (ATTN_HEADS + KV_HEADS) * HEAD_DIM], axis=-1)
    q = rms_norm(q.reshape(b_, s_, ATTN_HEADS, HEAD_DIM), qn_g)
    k = rms_norm(k.reshape(b_, s_, KV_HEADS, HEAD_DIM), kn_g)
    v = v.reshape(b_, s_, KV_HEADS, HEAD_DIM)
    ang_row, ang_col = axial_angles(s_)
    q = apply_axial_rope(q, ang_row, ang_col)
    k = apply_axial_rope(k, ang_row, ang_col)
    group = ATTN_HEADS // KV_HEADS
    nblk = s_ // Q_BLOCK
    qb = jnp.moveaxis(q.reshape(b_, nblk, Q_BLOCK, KV_HEADS, group, HEAD_DIM), 1, 0)
    scale = HEAD_DIM ** -0.5

    def block(qblk):
        sc = jnp.einsum('bqkgd,bskd->bkgqs', qblk, k).astype(jnp.float32) * scale
        pr = jax.nn.softmax(sc, axis=-1).astype(v.dtype)
        return jnp.einsum('bkgqs,bskd->bqkgd', pr, v)

    o = lax.map(block, qb)
    o = jnp.moveaxis(o, 0, 1).reshape(b_, s_, ATTN_HEADS * HEAD_DIM)
    return x + o @ w_out


def swiglu_ffn(x, norm_g, w_gate, w_up, w_down):
    h = rms_norm(x, norm_g)
    return x + (jax.nn.silu(h @ w_gate) * (h @ w_up)) @ w_down


def trunk(x, ab_norm, ab_w_in, gla_up_f, gla_bias_f, gla_up_b, gla_bias_b, gla_out_norm, ab_w_out,
          c_norm, c_w_in, c_q_norm, c_k_norm, c_w_out, ffn_norm, ffn_w_gate, ffn_w_up, ffn_w_down):
    for i in range(DEPTH):
        j = i // 2
        if i % 2 == 0:
            x = ab_mixer(x, ab_norm[j], ab_w_in[j], gla_up_f[j], gla_bias_f[j], gla_up_b[j], gla_bias_b[j],
                         gla_out_norm[j], ab_w_out[j])
        else:
            x = c_mixer(x, c_norm[j], c_w_in[j], c_q_norm[j], c_k_norm[j], c_w_out[j])
        x = swiglu_ffn(x, ffn_norm[i], ffn_w_gate[i], ffn_w_up[i], ffn_w_down[i])
    return x


def setup_inputs(seed: int = 0) -> dict:
    key = jax.random.key(seed)
    ks = jax.random.split(key, 24)
    ne = (DEPTH + 1) // 2
    no = DEPTH // 2
    f32 = jnp.float32

    def nrm(k, shape, scale):
        return jax.random.normal(k, shape, f32) * scale

    def gain(k, shape):
        return 1.0 + 0.01 * jax.random.normal(k, shape, f32)

    return {
        'x_prompt': nrm(ks[0], (BATCH, SEQ, D_MODEL), 1.0),
        'x_sample': nrm(ks[1], (DEC_BATCH, DEC_SEQ, D_MODEL), 1.0),
        'ab_norm': gain(ks[2], (ne, D_MODEL)),
        'ab_w_in': nrm(ks[3], (ne, D_MODEL, AB_IN), D_MODEL ** -0.5),
        'gla_up_f': nrm(ks[4], (ne, GLA_RANK, GLA_HEADS * GLA_DK), GLA_RANK ** -0.5),
        'gla_bias_f': nrm(ks[5], (ne, GLA_HEADS * GLA_DK), 0.1),
        'gla_up_b': nrm(ks[6], (ne, GLA_RANK, GLA_HEADS * GLA_DK), GLA_RANK ** -0.5),
        'gla_bias_b': nrm(ks[7], (ne, GLA_HEADS * GLA_DK), 0.1),
        'gla_out_norm': gain(ks[8], (ne, GLA_DV)),
        'ab_w_out': nrm(ks[9], (ne, AB_OUT, D_MODEL), AB_OUT ** -0.5),
        'c_norm': gain(ks[10], (no, D_MODEL)),
        'c_w_in': nrm(ks[11], (no, D_MODEL, C_IN), D_MODEL ** -0.5),
        'c_q_norm': gain(ks[12], (no, HEAD_DIM)),
        'c_k_norm': gain(ks[13], (no, HEAD_DIM)),
        'c_w_out': nrm(ks[14], (no, ATTN_HEADS * HEAD_DIM, D_MODEL), (ATTN_HEADS * HEAD_DIM) ** -0.5),
        'ffn_norm': gain(ks[15], (DEPTH, D_MODEL)),
        'ffn_w_gate': nrm(ks[16], (DEPTH, D_MODEL, FFN_HIDDEN), D_MODEL ** -0.5),
        'ffn_w_up': nrm(ks[17], (DEPTH, D_MODEL, FFN_HIDDEN), D_MODEL ** -0.5),
        'ffn_w_down': nrm(ks[18], (DEPTH, FFN_HIDDEN, D_MODEL), FFN_HIDDEN ** -0.5),
    }


def reference(x_prompt, x_sample, ab_norm, ab_w_in, gla_up_f, gla_bias_f, gla_up_b, gla_bias_b, gla_out_norm,
              ab_w_out, c_norm, c_w_in, c_q_norm, c_k_norm, c_w_out, ffn_norm, ffn_w_gate, ffn_w_up, ffn_w_down):
    y_prompt = trunk(x_prompt, ab_norm, ab_w_in, gla_up_f, gla_bias_f, gla_up_b, gla_bias_b, gla_out_norm, ab_w_out,
                     c_norm, c_w_in, c_q_norm, c_k_norm, c_w_out, ffn_norm, ffn_w_gate, ffn_w_up, ffn_w_down)
    y_sample = trunk(x_sample, ab_norm, ab_w_in, gla_up_f, gla_bias_f, gla_up_b, gla_bias_b, gla_out_norm, ab_w_out,
                     c_norm, c_w_in, c_q_norm, c_k_norm, c_w_out, ffn_norm, ffn_w_gate, ffn_w_up, ffn_w_down)
    return (y_prompt, y_sample)
```

```cpp
#include <hip/hip_runtime.h>
#include <hip/hip_cooperative_groups.h>
#include <cstdio>
#include <cstdint>
namespace cg = cooperative_groups;
#define DEVI __device__ __forceinline__
namespace pg8 {
#define PG8_LAS __attribute__((address_space(3)))
typedef unsigned short bf16_t;
typedef short bf16x8 __attribute__((ext_vector_type(8)));
typedef float f32x4 __attribute__((ext_vector_type(4)));
typedef unsigned u32x4 __attribute__((ext_vector_type(4)));
constexpr int BM = 256, BK = 64, HALF = 128, HTB = HALF * BK * 2  , STAGE_BYTES = 8 * HTB, NXCD = 8, WGM = 8;

__host__ __device__ __forceinline__ int lds_byte(int r, int c) { const int st = (r >> 4) * 2 + (c >> 5), rr = r & 15, cc = c & 31, ob = rr * 64 + cc * 2; return st * 1024 + (ob ^ (((ob >> 9) & 1) << 5)); }
__host__ __device__ __forceinline__ void stage_rc(int b, int& R, int& C) { const int st = b / 1024, sb = b % 1024, swz = sb ^ (((sb >> 9) & 1) << 5); R = (st >> 1) * 16 + swz / 64; C = (st & 1) * 32 + (swz % 64) / 2; }
__host__ __device__ __forceinline__ int perm32(int rho) { const int n = rho >> 4, i = rho & 15; return 8 * (i >> 2) + 4 * n + (i & 3); }

struct Unit { int pm, pn; };
struct Gemm { const bf16_t* A; const bf16_t* Bt; int M, N, K; };

struct StaticOrder {
    int nM, nN, nwg, G, c;
    __host__ __device__ void init(int M, int N, int G_, int c_) { nM = M / BM; nN = N / BM; nwg = nM * nN; G = G_; c = c_; }
    __host__ __device__ bool next(int i, Unit& u) const {
        const long L = (long)i * G + c; if (L >= nwg) return false;
        int wgid = (int)L; { const int q = nwg / NXCD, r = nwg % NXCD, xcd = wgid % NXCD, off = wgid / NXCD; wgid = (xcd < r ? xcd * (q + 1) : r * (q + 1) + (xcd - r) * q) + off; }
        const int nig = WGM * nN, gid = wgid / nig, fm = gid * WGM, gsz = (nM - fm) < WGM ? (nM - fm) : WGM;
        u.pm = fm + ((wgid % nig) % gsz); u.pn = (wgid % nig) / gsz; return true;
    }
    __device__ __forceinline__ void a_ready(const Unit&) const {}
    __device__ __forceinline__ void done(const Unit&) const {}
};

__device__ __forceinline__ unsigned cvt_pk_bf16(float lo, float hi) { unsigned r; asm volatile("v_cvt_pk_bf16_f32 %0, %1, %2" : "=v"(r) : "v"(lo), "v"(hi)); return r; }
template <class Epi, class Sched, bool ALIGN_EPI = false, bool SP2 = false>
__device__ __forceinline__ void gemm_phase(PG8_LAS unsigned char* lds, const Gemm g, const Sched& S, const Epi& E) {
    int tid_ = threadIdx.x; asm volatile("" : "+v"(tid_));
    const int tid = tid_, wid = __builtin_amdgcn_readfirstlane(tid >> 6), lane = tid & 63, wr = wid >> 2, wc = wid & 3, fr = lane & 15, fq = lane >> 4;
    const int K = g.K, nt = K / BK;
    unsigned voffA[2], voffB[2];
#pragma unroll
    for (int i = 0; i < 2; ++i) { int R, C; stage_rc(tid * 16 + i * 8192, R, C); const int Rb = Epi::PERM ? ((R & ~31) + perm32(R & 31)) : R;
        voffA[i] = (unsigned)(R * K + C) * 2u; voffB[i] = (unsigned)(Rb * K + C) * 2u; }
    const size_t kstep = (size_t)(BK * 2);
    const size_t hstep = (size_t)HALF * K * 2;
    const size_t tstep = 2 * hstep;
    const unsigned ldsw = (unsigned)wid * 1024u;
    const int aoff = lds_byte(wr * 64 + fr, fq * 8), boff = lds_byte(wc * 32 + fr, fq * 8);
#define PG8_SA(b, h) (((b) * 2 + (h)) * HTB)
#define PG8_SB(b, h) ((4 + (b) * 2 + (h)) * HTB)
#define PG8_STAGE(bufoff, gbase, voff) do { _Pragma("unroll") for (int _i = 0; _i < 2; ++_i) \
        __builtin_amdgcn_global_load_lds((const unsigned*)((const char*)(gbase) + (voff)[_i]), (PG8_LAS unsigned*)(lds + (bufoff) + ldsw + _i * 8192), 16, 0, 0); } while (0)
#define PG8_LDA(dst, b, h) do { _Pragma("unroll") for (int m = 0; m < 4; ++m) _Pragma("unroll") for (int k = 0; k < 2; ++k) dst[m][k] = *(const PG8_LAS bf16x8*)(lds + PG8_SA(b, h) + aoff + m * 2048 + k * 1024); } while (0)
#define PG8_LDB(dst, b, h) do { _Pragma("unroll") for (int n = 0; n < 2; ++n) _Pragma("unroll") for (int k = 0; k < 2; ++k) dst[n][k] = *(const PG8_LAS bf16x8*)(lds + PG8_SB(b, h) + boff + n * 2048 + k * 1024); } while (0)
#define PG8_MMA(ai, bj, At, Bt) do { __builtin_amdgcn_s_setprio(1); _Pragma("unroll") for (int m = 0; m < 4; ++m) _Pragma("unroll") for (int n = 0; n < 2; ++n) _Pragma("unroll") for (int k = 0; k < 2; ++k) \
        acc[ai][bj][m][n] = __builtin_amdgcn_mfma_f32_16x16x32_bf16(Bt[n][k], At[m][k], acc[ai][bj][m][n], 0, 0, 0); __builtin_amdgcn_s_setprio(0); } while (0)
#define PG8_WAIT_V(n) asm volatile("s_waitcnt vmcnt(" #n ")" ::: "memory")
#define PG8_WAIT_L(n) asm volatile("s_waitcnt lgkmcnt(" #n ")" ::: "memory")
#define PG8_BAR __builtin_amdgcn_s_barrier()
#define PG8_SCHED __builtin_amdgcn_sched_barrier(0)
    Unit cur, nxt; int ui = 0;
    if (!S.next(0, cur)) return;
    f32x4 acc[2][2][4][2];
#pragma unroll
    for (int a = 0; a < 2; ++a)
#pragma unroll
        for (int b = 0; b < 2; ++b)
#pragma unroll
            for (int m = 0; m < 4; ++m)
#pragma unroll
                for (int n = 0; n < 2; ++n) acc[a][b][m][n] = (f32x4){0.f, 0.f, 0.f, 0.f};
    bf16x8 At[4][2], B0[2][2], B1[2][2];
    const char* cA = (const char*)g.A + (size_t)cur.pm * tstep; const char* cB = (const char*)g.Bt + (size_t)cur.pn * tstep;
    S.a_ready(cur);
    if constexpr (SP2) {
        PG8_STAGE(PG8_SB(0, 0), cB, voffB); PG8_STAGE(PG8_SB(0, 1), cB + hstep, voffB); PG8_STAGE(PG8_SA(0, 0), cA, voffA); PG8_STAGE(PG8_SA(0, 1), cA + hstep, voffA);
        if (wr == 1) PG8_BAR;
        PG8_WAIT_V(2); PG8_BAR;
        PG8_STAGE(PG8_SB(1, 0), cB + kstep, voffB); PG8_STAGE(PG8_SA(1, 0), cA + kstep, voffA); PG8_STAGE(PG8_SB(1, 1), cB + hstep + kstep, voffB);
        PG8_WAIT_V(6); PG8_BAR;
    } else {
        PG8_STAGE(PG8_SB(0, 0), cB, voffB); PG8_STAGE(PG8_SA(0, 0), cA, voffA); PG8_STAGE(PG8_SB(0, 1), cB + hstep, voffB); PG8_STAGE(PG8_SA(0, 1), cA + hstep, voffA);
        if (wr == 1) PG8_BAR;
        PG8_WAIT_V(4); PG8_BAR;
        PG8_STAGE(PG8_SB(1, 0), cB + kstep, voffB); PG8_STAGE(PG8_SA(1, 0), cA + kstep, voffA); PG8_STAGE(PG8_SB(1, 1), cB + hstep + kstep, voffB);
        PG8_WAIT_V(6); PG8_BAR;
    }
    for (;;) {
        const bool has_next = S.next(ui + 1, nxt);
        const char* nA = has_next ? (const char*)g.A + (size_t)nxt.pm * tstep : cA; const char* nB = has_next ? (const char*)g.Bt + (size_t)nxt.pn * tstep : cB;
        for (int t = 0; t < nt; t += 2) {
            const bool last = (t == nt - 2);
            const char* a1 = cA + (size_t)(t + 1) * kstep;
            const char* a2 = last ? nA : cA + (size_t)(t + 2) * kstep; const char* b2 = last ? nB : cB + (size_t)(t + 2) * kstep;
            const char* a3 = a2 + kstep; const char* b3 = b2 + kstep;
            if (last && has_next) S.a_ready(nxt);
            if constexpr (SP2) {
            PG8_LDB(B0, 0, 0); PG8_LDB(B1, 0, 1); PG8_SCHED; PG8_LDA(At, 0, 0); PG8_STAGE(PG8_SA(1, 1), a1 + hstep, voffA);
            PG8_WAIT_V(8); PG8_WAIT_L(0); PG8_BAR; PG8_MMA(0, 0, At, B0); PG8_MMA(0, 1, At, B1); PG8_BAR; PG8_SCHED;
            PG8_LDA(At, 0, 1); PG8_STAGE(PG8_SB(0, 0), b2, voffB); PG8_STAGE(PG8_SB(0, 1), b2 + hstep, voffB); PG8_STAGE(PG8_SA(0, 0), a2, voffA);
            PG8_WAIT_V(8); PG8_WAIT_L(0); PG8_BAR; PG8_MMA(1, 0, At, B0); PG8_MMA(1, 1, At, B1); PG8_BAR; PG8_SCHED;
            PG8_LDB(B0, 1, 0); PG8_LDB(B1, 1, 1); PG8_SCHED; PG8_LDA(At, 1, 0); PG8_STAGE(PG8_SA(0, 1), a2 + hstep, voffA);
            PG8_WAIT_V(8); PG8_WAIT_L(0); PG8_BAR; PG8_MMA(0, 0, At, B0); PG8_MMA(0, 1, At, B1); PG8_BAR; PG8_SCHED;
            PG8_LDA(At, 1, 1); PG8_STAGE(PG8_SB(1, 0), b3, voffB); PG8_STAGE(PG8_SB(1, 1), b3 + hstep, voffB); PG8_STAGE(PG8_SA(1, 0), a3, voffA);
            PG8_WAIT_V(8); PG8_WAIT_L(0); PG8_BAR; PG8_MMA(1, 0, At, B0); PG8_MMA(1, 1, At, B1); PG8_BAR; PG8_SCHED;
            } else {
            PG8_LDB(B0, 0, 0); PG8_SCHED; PG8_LDA(At, 0, 0); PG8_STAGE(PG8_SA(1, 1), a1 + hstep, voffA);
            PG8_WAIT_L(8); PG8_BAR; PG8_WAIT_L(0); PG8_MMA(0, 0, At, B0); PG8_BAR; PG8_SCHED;
            PG8_LDB(B1, 0, 1); PG8_STAGE(PG8_SB(0, 0), b2, voffB);
            PG8_BAR; PG8_WAIT_L(0); PG8_MMA(0, 1, At, B1); PG8_BAR;
            PG8_LDA(At, 0, 1); PG8_STAGE(PG8_SA(0, 0), a2, voffA);
            PG8_BAR; PG8_WAIT_L(0); PG8_MMA(1, 0, At, B0); PG8_BAR; PG8_SCHED;
            PG8_STAGE(PG8_SB(0, 1), b2 + hstep, voffB);
            PG8_WAIT_V(6); PG8_BAR; PG8_MMA(1, 1, At, B1); PG8_BAR;
            PG8_LDB(B0, 1, 0); PG8_SCHED; PG8_LDA(At, 1, 0); PG8_STAGE(PG8_SA(0, 1), a2 + hstep, voffA);
            PG8_WAIT_L(8); PG8_BAR; PG8_WAIT_L(0); PG8_MMA(0, 0, At, B0); PG8_BAR; PG8_SCHED;
            PG8_LDB(B1, 1, 1); PG8_STAGE(PG8_SB(1, 0), b3, voffB);
            PG8_BAR; PG8_WAIT_L(0); PG8_MMA(0, 1, At, B1); PG8_BAR;
            PG8_LDA(At, 1, 1); PG8_STAGE(PG8_SA(1, 0), a3, voffA);
            PG8_BAR; PG8_WAIT_L(0); PG8_MMA(1, 0, At, B0); PG8_BAR; PG8_SCHED;
            PG8_STAGE(PG8_SB(1, 1), b3 + hstep, voffB);
            PG8_WAIT_V(6); PG8_BAR; PG8_MMA(1, 1, At, B1); PG8_BAR;
            }
        }
        if constexpr (ALIGN_EPI) { if (wr == 0) PG8_BAR; }
        if constexpr (!Epi::AFTER_DRAIN) { E(acc, cur, wr, wc, fr, fq); S.done(cur); }
        if (!has_next) break;
#pragma unroll
        for (int a = 0; a < 2; ++a)
#pragma unroll
            for (int b = 0; b < 2; ++b)
#pragma unroll
                for (int m = 0; m < 4; ++m)
#pragma unroll
                    for (int n = 0; n < 2; ++n) acc[a][b][m][n] = (f32x4){0.f, 0.f, 0.f, 0.f};
        cur = nxt; cA = nA; cB = nB; ++ui;
        if constexpr (ALIGN_EPI) { if (wr == 1) PG8_BAR; }
    }
    PG8_WAIT_V(0);
    if constexpr (!ALIGN_EPI) { if (wr == 0) PG8_BAR; }
    PG8_BAR;
    if constexpr (Epi::AFTER_DRAIN) { E.fused(acc, cur, wr, wc, fr, fq, lds, wid, lane); S.done(cur); }
#undef PG8_SA
#undef PG8_SB
#undef PG8_STAGE
#undef PG8_LDA
#undef PG8_LDB
#undef PG8_MMA
#undef PG8_WAIT_V
#undef PG8_WAIT_L
#undef PG8_BAR
#undef PG8_SCHED
}
}

typedef unsigned short bf16_t;
typedef short bf16x8 __attribute__((ext_vector_type(8)));
typedef float f32x4 __attribute__((ext_vector_type(4)));
typedef float f32x16 __attribute__((ext_vector_type(16)));
typedef unsigned u32x4 __attribute__((ext_vector_type(4)));
typedef unsigned u32x2 __attribute__((ext_vector_type(2)));
typedef float f32x2_t __attribute__((ext_vector_type(2)));
typedef __bf16 bf16x2_t __attribute__((ext_vector_type(2)));

constexpr int TP = 32768, TS = 16384, TT = TP + TS, DM = 1024, FFH = 2816, SP = 4096, SS = 2048;
constexpr float EPS = 1e-6f;
constexpr size_t MiB = 1u << 20;
constexpr size_t WS_CTL = 0, CTL_BYTES = 64 * 1024;
constexpr size_t WS_ROPE = 1 * MiB;
constexpr size_t WS_W_AB1 = 2 * MiB;
constexpr size_t WS_W_FT = 6 * MiB;
constexpr size_t WS_W_ABO = 8 * MiB;
constexpr size_t WS_W_GU0 = 10 * MiB;
constexpr size_t WS_W_D0 = 21 * MiB;
constexpr size_t WS_W_QKV = 27 * MiB;
constexpr size_t WS_W_CO = 30 * MiB;
constexpr size_t WS_W_GU1 = 32 * MiB;
constexpr size_t WS_W_D1 = 43 * MiB;
constexpr size_t WS_DEC = 49 * MiB;
constexpr size_t WS_DS4 = 51 * MiB;
constexpr size_t WS_DS2 = 115 * MiB;
constexpr size_t WS_H = 131 * MiB;
constexpr size_t WS_BIG = 227 * MiB;
constexpr size_t WS_QKVR = WS_BIG;
constexpr size_t WS_G = WS_BIG + 144 * MiB;
constexpr size_t WS_FOLDF = WS_BIG;
constexpr size_t WS_FOLDG = WS_BIG + 4 * MiB;
constexpr size_t WS_ACT = WS_BIG;
constexpr size_t WS_Q = WS_BIG, WS_K = WS_BIG + 96 * MiB, WS_V = WS_BIG + 120 * MiB, WS_AO = WS_BIG + 144 * MiB;
constexpr size_t WS_END = WS_BIG + 264 * MiB;
constexpr size_t OUT_YTP = 0, OUT_YTS = 64 * MiB, OUT_DST = 96 * MiB;

DEVI float bf2f(bf16_t x) { return __uint_as_float(((unsigned)x) << 16); }
DEVI unsigned pk2(float lo, float hi) { f32x2_t v = {lo, hi}; bf16x2_t b = __builtin_convertvector(v, bf16x2_t); return __builtin_bit_cast(unsigned, b); }
DEVI bf16_t f2bf(float f) { return (bf16_t)(pk2(f, 0.f) & 0xffffu); }
DEVI u32x4 pk8(f32x4 a, f32x4 b) { u32x4 w; w.x = pk2(a[0], a[1]); w.y = pk2(a[2], a[3]); w.z = pk2(b[0], b[1]); w.w = pk2(b[2], b[3]); return w; }
DEVI float wave_sum(float v) {
#pragma unroll
    for (int o = 1; o < 64; o <<= 1) v += __shfl_xor(v, o);
    return v;
}
DEVI float logsig(float z) { return fminf(z, 0.f) - log1pf(__expf(-fabsf(z))); }
DEVI float silu(float z) { return z / (1.f + __expf(-z)); }

enum { EM_AB1, EM_AB1T, EM_FNETP, EM_FNETS, EM_RESIN, EM_RES, EM_GLU, EM_QKV };
template <int MODE> struct Epi {
    static constexpr bool PERM = true, AFTER_DRAIN = false;
    bf16_t* O0; bf16_t* O1; bf16_t* O2; float* F0; const float* X0; const float* X1; const float* B0; const float* B1;
    DEVI void operator()(const f32x4 (&acc)[2][2][4][2], const pg8::Unit& u, int wr, int wc, int fr, int fq) const {
        const int rbase = u.pm * 256 + wr * 64 + fr, cb = wc * 32 + 8 * fq;
#pragma unroll
        for (int ai = 0; ai < 2; ++ai)
#pragma unroll
            for (int m = 0; m < 4; ++m) {
                const int row = rbase + ai * 128 + m * 16;
                if constexpr (MODE == EM_GLU) {
                    const f32x4 g0 = acc[ai][0][m][0], g1 = acc[ai][0][m][1], u0 = acc[ai][1][m][0], u1 = acc[ai][1][m][1];
                    f32x4 a, b;
#pragma unroll
                    for (int j = 0; j < 4; ++j) { a[j] = silu(g0[j]) * u0[j]; b[j] = silu(g1[j]) * u1[j]; }
                    *(u32x4*)(O0 + (size_t)row * FFH + u.pn * 128 + cb) = pk8(a, b);
                } else {
#pragma unroll
                    for (int bj = 0; bj < 2; ++bj) {
                        const f32x4 v0 = acc[ai][bj][m][0], v1 = acc[ai][bj][m][1];
                        const int c = bj * 128 + cb;
                        if constexpr (MODE == EM_AB1) {
                            if (u.pn < 6) { *(u32x4*)(O0 + (size_t)row * 1536 + u.pn * 256 + c) = pk8(v0, v1); }
                            else { const int dir = u.pn - 6; const float* bias = dir ? B1 : B0;
                                const f32x4 b0 = *(const f32x4*)(bias + c), b1 = *(const f32x4*)(bias + c + 4);
                                f32x4 a, b;
#pragma unroll
                                for (int j = 0; j < 4; ++j) { a[j] = logsig(v0[j] + b0[j]) * 0.0625f; b[j] = logsig(v1[j] + b1[j]) * 0.0625f; }
                                float* gp = F0 + (size_t)row * 512 + dir * 256 + c; *(f32x4*)gp = a; *(f32x4*)(gp + 4) = b; }
                        } else if constexpr (MODE == EM_AB1T) {
                            const int cc = row, t0 = u.pn * 256;
                            bf16_t* dst;
                            if (t0 < TP) { const int b = t0 >> 12, s = (t0 & 4095) + c; dst = O0 + ((size_t)(b * 512 + (cc & 511)) * 8192 + (cc >> 9) * 4096 + s); }
                            else { const int tt = t0 - TP, b = tt >> 11, s = (tt & 2047) + c; dst = O1 + ((size_t)(b * 512 + (cc & 511)) * 4096 + (cc >> 9) * 2048 + s); }
                            *(u32x4*)dst = pk8(v0, v1);
                        } else if constexpr (MODE == EM_FNETP) {
                            const int tok = (u.pn >> 1) * 4096 + row;
                            *(u32x4*)(O0 + (size_t)tok * 1024 + 512 + (u.pn & 1) * 256 + c) = pk8(v0, v1);
                        } else if constexpr (MODE == EM_FNETS) {
                            const int tok = TP + (u.pn >> 1) * 2048 + row;
                            *(u32x4*)(O0 + (size_t)tok * 1024 + 512 + (u.pn & 1) * 256 + c) = pk8(v0, v1);
                        } else if constexpr (MODE == EM_RESIN) {
                            const float* xp = (row < TP ? X0 + (size_t)row * 1024 : X1 + (size_t)(row - TP) * 1024) + u.pn * 256 + c;
                            float* op = F0 + (size_t)row * 1024 + u.pn * 256 + c;
                            const f32x4 x0 = *(const f32x4*)xp, x1 = *(const f32x4*)(xp + 4);
                            *(f32x4*)op = x0 + v0; *(f32x4*)(op + 4) = x1 + v1;
                        } else if constexpr (MODE == EM_RES) {
                            float* op = F0 + (size_t)row * 1024 + u.pn * 256 + c;
                            const f32x4 x0 = *(const f32x4*)op, x1 = *(const f32x4*)(op + 4);
                            *(f32x4*)op = x0 + v0; *(f32x4*)(op + 4) = x1 + v1;
                        } else if constexpr (MODE == EM_QKV) {
                            bf16_t* dst;
                            if (u.pn < 4) dst = O0 + (size_t)row * 1024 + u.pn * 256 + c;
                            else if (u.pn == 4) dst = O1 + (size_t)row * 256 + c;
                            else dst = O2 + (size_t)row * 256 + c;
                            *(u32x4*)dst = pk8(v0, v1);
                        }
                    }
                }
            }
    }
};

DEVI void p_fold(const float* win, const float* upf, const float* upb, float* FF, float* FG, float* tab, int gw, int NGW, int lane) {
    if (threadIdx.x < 128) tab[threadIdx.x] = cospif((float)threadIdx.x * (1.f / 64.f));
    __syncthreads();
    for (int it = gw; it < 1024 * 16; it += NGW) {
        const int k = it >> 4, cb = it & 15, cc = cb * 64 + lane, part = cc >> 9, g = (cc >> 7) & 3, l = cc & 127;
        const float* wr = win + (size_t)k * 2080 + 1568 + g * 128;
        const int sh = part ? 96 : 0;
        float acc = 0.f;
#pragma unroll 8
        for (int w = 0; w < 128; ++w) acc += wr[w] * tab[(w * l + sh) & 127];
        FF[(size_t)k * 1024 + cc] = acc;
    }
    for (int it = gw; it < 1024 * 8; it += NGW) {
        const int k = it >> 3, nb = it & 7, n = nb * 64 + lane, dir = n >> 8, nn = n & 255;
        const float* wr = win + (size_t)k * 2080 + 1536 + dir * 16;
        const float* up = dir ? upb : upf;
        float acc = 0.f;
#pragma unroll
        for (int r = 0; r < 16; ++r) acc += wr[r] * up[r * 256 + nn];
        FG[(size_t)k * 512 + n] = acc;
    }
    __syncthreads();
}
DEVI void p_dft(bf16_t* DS, int S, int logS, int gt, int NGT) {
    const int lri = logS - 2;
    const long total = (long)S << lri;
    const float nrm = rsqrtf((float)S * 128.f), xs = 2.f / (float)S;
    for (long it = gt; it < total; it += NGT) {
        const int k = (int)(it >> lri), c8 = (int)(it & ((1 << lri) - 1)), col0 = c8 * 8, part = col0 >= S, s0 = col0 - part * S;
        float v[8];
#pragma unroll
        for (int j = 0; j < 8; ++j) { const int idx = (k * (s0 + j)) & (S - 1); const float x = (float)idx * xs; v[j] = (part ? -sinpif(x) : cospif(x)) * nrm; }
        u32x4 w; w.x = pk2(v[0], v[1]); w.y = pk2(v[2], v[3]); w.z = pk2(v[4], v[5]); w.w = pk2(v[6], v[7]);
        *(u32x4*)(DS + (size_t)k * (2 * S) + col0) = w;
    }
}
DEVI void p_norm(const float* src0, const float* src1, const float* gain, bf16_t* H, int gw, int NGW, int lane) {
    f32x4 gv[4];
#pragma unroll
    for (int j = 0; j < 4; ++j) gv[j] = *((const f32x4*)gain + lane + 64 * j);
    for (int m = gw; m < TT; m += NGW) {
        const f32x4* xr = (const f32x4*)(m < TP ? src0 + (size_t)m * DM : src1 + (size_t)(m - TP) * DM) + lane;
        f32x4 v[4]; float s = 0.f;
#pragma unroll
        for (int j = 0; j < 4; ++j) { v[j] = xr[64 * j]; s += (v[j].x * v[j].x + v[j].y * v[j].y) + (v[j].z * v[j].z + v[j].w * v[j].w); }
        const float rstd = rsqrtf(wave_sum(s) * (1.f / DM) + EPS);
        u32x2* o8 = (u32x2*)(H + (size_t)m * DM) + lane;
#pragma unroll
        for (int j = 0; j < 4; ++j) { u32x2 w; w.x = pk2(v[j].x * rstd * gv[j].x, v[j].y * rstd * gv[j].y); w.y = pk2(v[j].z * rstd * gv[j].z, v[j].w * rstd * gv[j].w); o8[64 * j] = w; }
    }
}
DEVI void tr_item(const float* W, int ld, int col0, bf16_t* WT, int Kd, int drow0, float scale, float* scr, int k0, int n0, int lane) {
#pragma unroll 8
    for (int i = 0; i < 32; ++i) { const int kk = 2 * i + (lane >> 5); scr[kk * 33 + (lane & 31)] = W[(size_t)(k0 + kk) * ld + col0 + n0 + (lane & 31)]; }
    asm volatile("s_waitcnt lgkmcnt(0)" ::: "memory");
    const int c = lane & 7;
#pragma unroll
    for (int j = 0; j < 4; ++j) { const int n = (lane >> 3) + 8 * j; const float* s = scr + (8 * c) * 33 + n;
        u32x4 o; o.x = pk2(s[0] * scale, s[33] * scale); o.y = pk2(s[66] * scale, s[99] * scale); o.z = pk2(s[132] * scale, s[165] * scale); o.w = pk2(s[198] * scale, s[231] * scale);
        *(u32x4*)(WT + (size_t)(drow0 + n) * Kd + k0 + 8 * c) = o; }
    asm volatile("s_waitcnt lgkmcnt(0)" ::: "memory");
}
template <int MAP> DEVI bool tr_mat(int& r, const float* W, int ld, int col0, int K, int ncols, bf16_t* WT, int drow, float scale, float* scr, int lane) {
    const int nblk = ncols >> 5, cnt = (K >> 6) * nblk;
    if (r >= cnt) { r -= cnt; return false; }
    const int kb = r / nblk, nb = r - kb * nblk, n0 = nb * 32;
    int d0 = drow + n0;
    if (MAP == 1) d0 = (n0 >> 7) * 256 + (n0 & 127);
    if (MAP == 2) d0 = (n0 >> 7) * 256 + 128 + (n0 & 127);
    tr_item(W, ld, col0, WT, K, d0, scale, scr, kb * 64, n0, lane);
    return true;
}

constexpr int GP = 144;
constexpr int L_QF = 0, L_QB = 9216, L_KF = 18432, L_KB = 27648, L_VT = 36864, L_ATF = 55296, L_ATB = 64512, L_SPF = 73728, L_SPB = 92160, L_SEG = 110592;
constexpr int L_KDF = 0, L_KDB = 9216;
DEVI int crow(int r, int hi) { return (r & 3) + 8 * (r >> 2) + 4 * hi; }
DEVI bf16x8 ldf(const unsigned char* base, int row, int ks, int hi) { return *(const bf16x8*)(base + row * GP + ks * 32 + hi * 16); }

DEVI void gla_prefix(const float* G, int tok0, int h, float* SEG, int tid, float (&bF)[8], float (&bB)[8], float& totF, float& totB) {
    const int d = tid & 63, sg = tid >> 6;
    float gf[8], gb[8];
#pragma unroll
    for (int i = 0; i < 8; ++i) { const float* p = G + (size_t)(tok0 + 8 * sg + i) * 512 + h * 64 + d; gf[i] = p[0]; gb[i] = p[256]; }
    bF[0] = gf[0];
#pragma unroll
    for (int i = 1; i < 8; ++i) bF[i] = bF[i - 1] + gf[i];
    bB[7] = gb[7];
#pragma unroll
    for (int i = 6; i >= 0; --i) bB[i] = bB[i + 1] + gb[i];
    SEG[sg * 64 + d] = bF[7]; SEG[512 + sg * 64 + d] = bB[0];
    __syncthreads();
    float offF = 0.f, offB = 0.f; totF = 0.f; totB = 0.f;
#pragma unroll
    for (int s = 0; s < 8; ++s) { const float a = SEG[s * 64 + d], b = SEG[512 + s * 64 + d]; totF += a; totB += b; if (s < sg) offF += a; if (s > sg) offB += b; }
#pragma unroll
    for (int i = 0; i < 8; ++i) { bF[i] += offF; bB[i] += offB; }
}
DEVI void gla_stage_vt(const bf16_t* QKVR, int tok0, int h, unsigned char* VT, int tid) {
    const int e = tid & 127, s4 = tid >> 7;
    unsigned w[8];
#pragma unroll
    for (int i = 0; i < 8; ++i) {
        const unsigned lo = QKVR[(size_t)(tok0 + 16 * s4 + 2 * i) * 1536 + 512 + h * 128 + e], hi = QKVR[(size_t)(tok0 + 16 * s4 + 2 * i + 1) * 1536 + 512 + h * 128 + e];
        w[i] = lo | (hi << 16); }
    u32x4 a = {w[0], w[1], w[2], w[3]}, b = {w[4], w[5], w[6], w[7]};
    *(u32x4*)(VT + e * GP + s4 * 32) = a; *(u32x4*)(VT + e * GP + s4 * 32 + 16) = b;
}
DEVI void gla_a_item(int item, const bf16_t* QKVR, const float* G, bf16_t* DST, float* DEC, unsigned char* lds, int tid, int wave, int lane) {
    const int n = item >> 2, h = item & 3, tok0 = n * 64, d = tid & 63, sg = tid >> 6;
    float bF[8], bB[8], totF, totB;
    gla_prefix(G, tok0, h, (float*)(lds + L_SEG), tid, bF, bB, totF, totB);
    float kf[8], kb[8];
#pragma unroll
    for (int i = 0; i < 8; ++i) { const float kk = bf2f(QKVR[(size_t)(tok0 + 8 * sg + i) * 1536 + 256 + h * 64 + d]); kf[i] = kk * __expf(totF - bF[i]); kb[i] = kk * __expf(totB - bB[i]); }
    { u32x4 a = {pk2(kf[0], kf[1]), pk2(kf[2], kf[3]), pk2(kf[4], kf[5]), pk2(kf[6], kf[7])}, b = {pk2(kb[0], kb[1]), pk2(kb[2], kb[3]), pk2(kb[4], kb[5]), pk2(kb[6], kb[7])};
      *(u32x4*)(lds + L_KDF + d * GP + sg * 16) = a; *(u32x4*)(lds + L_KDB + d * GP + sg * 16) = b; }
    if (sg == 0) { DEC[(size_t)(item * 2) * 64 + d] = __expf(totF); DEC[(size_t)(item * 2 + 1) * 64 + d] = __expf(totB); }
    gla_stage_vt(QKVR, tok0, h, lds + L_VT, tid);
    __syncthreads();
    { const int dir = wave >> 2, et = wave & 3, r32 = lane & 31, hi = lane >> 5;
      const unsigned char* KD = lds + (dir ? L_KDB : L_KDF);
      f32x16 c0 = {}, c1 = {};
#pragma unroll
      for (int ks = 0; ks < 4; ++ks) { const bf16x8 b = ldf(lds + L_VT, 32 * et + r32, ks, hi), a0 = ldf(KD, r32, ks, hi), a1 = ldf(KD, 32 + r32, ks, hi);
          c0 = __builtin_amdgcn_mfma_f32_32x32x16_bf16(a0, b, c0, 0, 0, 0); c1 = __builtin_amdgcn_mfma_f32_32x32x16_bf16(a1, b, c1, 0, 0, 0); }
      bf16_t* dst = DST + (size_t)(item * 2 + dir) * 8192 + (32 * et + r32) * 64 + 4 * hi;
#pragma unroll
      for (int q = 0; q < 4; ++q) { u32x2 w0 = {pk2(c0[4 * q], c0[4 * q + 1]), pk2(c0[4 * q + 2], c0[4 * q + 3])}, w1 = {pk2(c1[4 * q], c1[4 * q + 1]), pk2(c1[4 * q + 2], c1[4 * q + 3])};
          *(u32x2*)(dst + 8 * q) = w0; *(u32x2*)(dst + 32 + 8 * q) = w1; } }
    __syncthreads();
}
DEVI void p_scan(bf16_t* DST, const float* DEC, int gt) {
    const int combo = gt >> 10, el = gt & 1023, e = el >> 3, d0 = (el & 7) * 8;
    const int seq = combo >> 3, h = (combo >> 1) & 3, dir = combo & 1;
    const int nch = seq < 8 ? 64 : 32, n0 = seq < 8 ? seq * 64 : 512 + (seq - 8) * 32;
    float S[8];
#pragma unroll
    for (int j = 0; j < 8; ++j) S[j] = 0.f;
    for (int st0 = 0; st0 < nch; st0 += 4) {
        u32x4 ds[4]; f32x4 dc0[4], dc1[4];
#pragma unroll
        for (int u = 0; u < 4; ++u) { const int n = dir ? nch - 1 - (st0 + u) : st0 + u; const size_t item = (size_t)((n0 + n) * 4 + h) * 2 + dir;
            ds[u] = *(const u32x4*)(DST + item * 8192 + e * 64 + d0); dc0[u] = *(const f32x4*)(DEC + item * 64 + d0); dc1[u] = *(const f32x4*)(DEC + item * 64 + d0 + 4); }
#pragma unroll
        for (int u = 0; u < 4; ++u) { const int n = dir ? nch - 1 - (st0 + u) : st0 + u; const size_t item = (size_t)((n0 + n) * 4 + h) * 2 + dir;
            u32x4 w = {pk2(S[0], S[1]), pk2(S[2], S[3]), pk2(S[4], S[5]), pk2(S[6], S[7])};
            *(u32x4*)(DST + item * 8192 + e * 64 + d0) = w;
            S[0] = dc0[u][0] * S[0] + __uint_as_float(ds[u][0] << 16); S[1] = dc0[u][1] * S[1] + __uint_as_float(ds[u][0] & 0xffff0000u);
            S[2] = dc0[u][2] * S[2] + __uint_as_float(ds[u][1] << 16); S[3] = dc0[u][3] * S[3] + __uint_as_float(ds[u][1] & 0xffff0000u);
            S[4] = dc1[u][0] * S[4] + __uint_as_float(ds[u][2] << 16); S[5] = dc1[u][1] * S[5] + __uint_as_float(ds[u][2] & 0xffff0000u);
            S[6] = dc1[u][2] * S[6] + __uint_as_float(ds[u][3] << 16); S[7] = dc1[u][3] * S[7] + __uint_as_float(ds[u][3] & 0xffff0000u); }
    }
}
DEVI void gla_c_item(int item, const bf16_t* QKVR, const float* G, const bf16_t* DST, const float* outg, bf16_t* MIX, unsigned char* lds, int tid, int wave, int lane) {
    const int n = item >> 2, h = item & 3, tok0 = n * 64, d = tid & 63, sg = tid >> 6, r32 = lane & 31, hi = lane >> 5;
    float bF[8], bB[8], totF, totB;
    gla_prefix(G, tok0, h, (float*)(lds + L_SEG), tid, bF, bB, totF, totB);
    bf16_t* QF = (bf16_t*)(lds + L_QF); bf16_t* QB = (bf16_t*)(lds + L_QB); bf16_t* KF = (bf16_t*)(lds + L_KF); bf16_t* KB = (bf16_t*)(lds + L_KB);
#pragma unroll
    for (int i = 0; i < 8; ++i) { const bf16_t* tr = QKVR + (size_t)(tok0 + 8 * sg + i) * 1536 + h * 64 + d; const float qv = bf2f(tr[0]), kv = bf2f(tr[256]);
        const int o = (8 * sg + i) * (GP / 2) + d;
        QF[o] = f2bf(qv * __expf(bF[i])); KF[o] = f2bf(kv * __expf(-bF[i])); QB[o] = f2bf(qv * __expf(bB[i])); KB[o] = f2bf(kv * __expf(-bB[i])); }
    gla_stage_vt(QKVR, tok0, h, lds + L_VT, tid);
#pragma unroll
    for (int p = 0; p < 2; ++p) { const int row = (tid >> 3) + 64 * p, c = tid & 7;
        *(u32x4*)(lds + L_SPF + row * GP + c * 16) = *(const u32x4*)(DST + (size_t)(item * 2) * 8192 + row * 64 + c * 8);
        *(u32x4*)(lds + L_SPB + row * GP + c * 16) = *(const u32x4*)(DST + (size_t)(item * 2 + 1) * 8192 + row * 64 + c * 8); }
    __syncthreads();
    { const int dir = wave >> 2, it = (wave >> 1) & 1, jt = wave & 1;
      const unsigned char* Qd = lds + (dir ? L_QB : L_QF); const unsigned char* Kd = lds + (dir ? L_KB : L_KF);
      f32x16 c = {};
#pragma unroll
      for (int ks = 0; ks < 4; ++ks) c = __builtin_amdgcn_mfma_f32_32x32x16_bf16(ldf(Qd, 32 * it + r32, ks, hi), ldf(Kd, 32 * jt + r32, ks, hi), c, 0, 0, 0);
      bf16_t* AT = (bf16_t*)(lds + (dir ? L_ATB : L_ATF));
      const int j = 32 * jt + r32;
#pragma unroll
      for (int r = 0; r < 16; ++r) { const int i = 32 * it + crow(r, hi); const bool keep = dir ? (j >= i) : (j <= i); AT[i * (GP / 2) + j] = f2bf(keep ? c[r] : 0.f); } }
    __syncthreads();
    { const int it = wave >> 2, et = wave & 3;
      f32x16 o = {};
#pragma unroll
      for (int dir = 0; dir < 2; ++dir) {
          const unsigned char* AT = lds + (dir ? L_ATB : L_ATF); const unsigned char* Qd = lds + (dir ? L_QB : L_QF); const unsigned char* SPd = lds + (dir ? L_SPB : L_SPF);
#pragma unroll
          for (int ks = 0; ks < 4; ++ks) o = __builtin_amdgcn_mfma_f32_32x32x16_bf16(ldf(AT, 32 * it + r32, ks, hi), ldf(lds + L_VT, 32 * et + r32, ks, hi), o, 0, 0, 0);
#pragma unroll
          for (int ks = 0; ks < 4; ++ks) o = __builtin_amdgcn_mfma_f32_32x32x16_bf16(ldf(Qd, 32 * it + r32, ks, hi), ldf(SPd, 32 * et + r32, ks, hi), o, 0, 0, 0); }
      __syncthreads();
      float* OB = (float*)lds;
#pragma unroll
      for (int r = 0; r < 16; ++r) OB[(32 * it + crow(r, hi)) * 132 + 32 * et + r32] = o[r]; }
    __syncthreads();
    { const int i = tid >> 3, s8 = tid & 7; const float* OB = (const float*)lds + i * 132 + 16 * s8;
      f32x4 v[4]; float ss = 0.f;
#pragma unroll
      for (int q = 0; q < 4; ++q) { v[q] = *(const f32x4*)(OB + 4 * q); ss += (v[q].x * v[q].x + v[q].y * v[q].y) + (v[q].z * v[q].z + v[q].w * v[q].w); }
      ss += __shfl_xor(ss, 1); ss += __shfl_xor(ss, 2); ss += __shfl_xor(ss, 4);
      const float rstd = rsqrtf(ss * (1.f / 128.f) + EPS);
      const int tok = tok0 + i;
      const u32x4 r0 = *(const u32x4*)(QKVR + (size_t)tok * 1536 + 1024 + h * 128 + 16 * s8), r1 = *(const u32x4*)(QKVR + (size_t)tok * 1536 + 1024 + h * 128 + 16 * s8 + 8);
      float y[16];
#pragma unroll
      for (int q = 0; q < 4; ++q) { const f32x4 g = *(const f32x4*)(outg + 16 * s8 + 4 * q);
          const unsigned w0 = q < 2 ? r0[2 * q] : r1[2 * (q - 2)], w1 = q < 2 ? r0[2 * q + 1] : r1[2 * (q - 2) + 1];
          y[4 * q + 0] = v[q].x * rstd * g.x * silu(__uint_as_float(w0 << 16)); y[4 * q + 1] = v[q].y * rstd * g.y * silu(__uint_as_float(w0 & 0xffff0000u));
          y[4 * q + 2] = v[q].z * rstd * g.z * silu(__uint_as_float(w1 << 16)); y[4 * q + 3] = v[q].w * rstd * g.w * silu(__uint_as_float(w1 & 0xffff0000u)); }
      u32x4 a = {pk2(y[0], y[1]), pk2(y[2], y[3]), pk2(y[4], y[5]), pk2(y[6], y[7])}, b = {pk2(y[8], y[9]), pk2(y[10], y[11]), pk2(y[12], y[13]), pk2(y[14], y[15])};
      bf16_t* mp = MIX + (size_t)tok * 1024 + h * 128 + 16 * s8;
      *(u32x4*)mp = a; *(u32x4*)(mp + 8) = b; }
    __syncthreads();
}

DEVI void p_qkrope(bf16_t* Q, bf16_t* K, const float* qg, const float* kg, const float2* rope, int gw, int NGW, int lane) {
    const int i = lane & 31, hh = lane >> 5;
    float gq[4], gk[4];
#pragma unroll
    for (int j = 0; j < 4; ++j) { gq[j] = qg[32 * j + i]; gk[j] = kg[32 * j + i]; }
    for (int t = gw; t < TT; t += NGW) {
        const int s = t < TP ? (t & 4095) : ((t - TP) & 2047);
        const float2 rr = rope[(s >> 6) * 32 + i], rc = rope[(s & 63) * 32 + i];
#pragma unroll
        for (int p = 0; p < 5; ++p) {
            const int slot = 2 * p + hh;
            bf16_t* base = slot < 8 ? Q + (size_t)t * 1024 + slot * 128 : K + (size_t)t * 256 + (slot - 8) * 128;
            float x[4]; float ss = 0.f;
#pragma unroll
            for (int j = 0; j < 4; ++j) { x[j] = bf2f(base[32 * j + i]); ss += x[j] * x[j]; }
            ss += __shfl_xor(ss, 1); ss += __shfl_xor(ss, 2); ss += __shfl_xor(ss, 4); ss += __shfl_xor(ss, 8); ss += __shfl_xor(ss, 16);
            const float rstd = rsqrtf(ss * (1.f / 128.f) + EPS);
#pragma unroll
            for (int j = 0; j < 4; ++j) x[j] *= rstd * (slot < 8 ? gq[j] : gk[j]);
            base[i] = f2bf(x[0] * rr.x - x[1] * rr.y); base[32 + i] = f2bf(x[1] * rr.x + x[0] * rr.y);
            base[64 + i] = f2bf(x[2] * rc.x - x[3] * rc.y); base[96 + i] = f2bf(x[3] * rc.x + x[2] * rc.y);
        }
    }
}
namespace attn {
using bf16 = unsigned short;
constexpr int   D = 128, NW = 8, QBLK = 32, KVBLK = 64;
constexpr float SCALE = 0.088388347648318440f;
constexpr float THR = 8.f;
constexpr int SDEPTH = 2;
constexpr int LDQ = 1024, LDK = 256, LDO = 1024;
constexpr size_t SHM_V = KVBLK * D * 2, SHM_K = KVBLK * D * 2, SHM_ATTN = 2 * SHM_V + 2 * SHM_K + NW * 64 * 4;
using bf16x8 = __attribute__((ext_vector_type(8))) short;
using s16x4  = __attribute__((ext_vector_type(4))) short;
using f32x16 = __attribute__((ext_vector_type(16))) float;
using f32x8  = __attribute__((ext_vector_type(8))) float;
using u32x4  = __attribute__((ext_vector_type(4))) unsigned;
#define KSWZ(row, colB) ((row) * 256 + ((colB) ^ (((row) & 7) << 4)))
#define SBAR() __builtin_amdgcn_sched_barrier(0)
__device__ __forceinline__ int crow(int r, int hi) { return (r & 3) + 8 * (r >> 2) + 4 * hi; }
__device__ __forceinline__ unsigned cvtpk(float lo, float hi) {
  unsigned r; asm volatile("v_cvt_pk_bf16_f32 %0, %1, %2" : "=v"(r) : "v"(lo), "v"(hi)); return r;
}
template <typename TIn> struct Stage;
template <> struct Stage<bf16>  { using T = bf16x8;
  __device__ static __forceinline__ T ld8(const bf16* p) { return *reinterpret_cast<const bf16x8*>(p); }
  __device__ static __forceinline__ bf16x8 tobf(T x) { return x; } };
template <> struct Stage<float> { using T = f32x8;
  __device__ static __forceinline__ T ld8(const float* p) { return *reinterpret_cast<const f32x8*>(p); }
  __device__ static __forceinline__ bf16x8 tobf(T x) {
    u32x4 w = {cvtpk(x[0], x[1]), cvtpk(x[2], x[3]), cvtpk(x[4], x[5]), cvtpk(x[6], x[7])}; return *reinterpret_cast<bf16x8*>(&w); } };

__device__ __forceinline__ void partialSM(f32x16& p0, f32x16& p1, float& m_reg, float& mn, float& alpha) {
  constexpr float C = SCALE * 1.4426950408889634f;
  float pmax = p0[0]; for (int r = 1; r < 16; ++r) pmax = fmaxf(pmax, p0[r]); for (int r = 0; r < 16; ++r) pmax = fmaxf(pmax, p1[r]);
  { auto rr = __builtin_amdgcn_permlane32_swap(__float_as_uint(pmax), __float_as_uint(pmax), false, false);
    pmax = fmaxf(__uint_as_float(rr[0]), __uint_as_float(rr[1])); }
  if (__builtin_expect(__all(pmax - m_reg <= THR / SCALE), 1)) { mn = m_reg; alpha = 1.f; }
  else { mn = fmaxf(m_reg, pmax); alpha = __builtin_amdgcn_exp2f((m_reg - mn) * C); m_reg = mn; }
  float mnC = -mn * C;
  for (int r = 0; r < 16; ++r) p0[r] = fmaf(p0[r], C, mnC); for (int r = 0; r < 16; ++r) p1[r] = fmaf(p1[r], C, mnC);
  for (int r = 0; r < 16; ++r) p0[r] = __builtin_amdgcn_exp2f(p0[r]);
}
__device__ __forceinline__ void finishSM(f32x16& p0, f32x16& p1, float alpha, float& l_reg, bf16x8& pa0, bf16x8& pa1, bf16x8& pa2, bf16x8& pa3) {
  for (int r = 0; r < 16; ++r) p1[r] = __builtin_amdgcn_exp2f(p1[r]);
  float ps = 0; for (int r = 0; r < 16; ++r) ps += p0[r]; for (int r = 0; r < 16; ++r) ps += p1[r];
  { auto rr = __builtin_amdgcn_permlane32_swap(__float_as_uint(ps), __float_as_uint(ps), false, false);
    ps = __uint_as_float(rr[0]) + __uint_as_float(rr[1]); }
  l_reg = l_reg * alpha + ps;
#define PK4(P, BASE, OUT) do { unsigned a0 = cvtpk(P[BASE + 0], P[BASE + 1]), a1 = cvtpk(P[BASE + 2], P[BASE + 3]);   \
    unsigned b0 = cvtpk(P[BASE + 4], P[BASE + 5]), b1 = cvtpk(P[BASE + 6], P[BASE + 7]);                              \
    auto r0 = __builtin_amdgcn_permlane32_swap(a0, b0, false, false); auto r1 = __builtin_amdgcn_permlane32_swap(a1, b1, false, false); \
    u32x4 w = {r0[0], r1[0], r0[1], r1[1]}; OUT = *reinterpret_cast<bf16x8*>(&w); } while (0)
  PK4(p0, 0, pa0); PK4(p0, 8, pa1); PK4(p1, 0, pa2); PK4(p1, 8, pa3);
#undef PK4
}
__device__ __forceinline__ void qkt(f32x16& p0, f32x16& p1, const bf16* Ks, const bf16x8* qr, int r32, int hi) {
  p0 = f32x16{}; p1 = f32x16{};
  for (int d0 = 0; d0 < 8; ++d0) { int cb = (d0 * 16 + hi * 8) * 2;
    bf16x8 b0 = *reinterpret_cast<const bf16x8*>((const char*)Ks + KSWZ(r32, cb));
    bf16x8 b1 = *reinterpret_cast<const bf16x8*>((const char*)Ks + KSWZ(32 + r32, cb));
    p0 = __builtin_amdgcn_mfma_f32_32x32x16_bf16(b0, qr[d0], p0, 0, 0, 0);
    p1 = __builtin_amdgcn_mfma_f32_32x32x16_bf16(b1, qr[d0], p1, 0, 0, 0); }
}
__device__ __forceinline__ int v_st(int k, int c) { const int kk = (k & ~0xC) | ((k & 4) << 1) | ((k & 8) >> 1); return ((kk >> 3) * 4 + (c >> 5)) * 512 + ((kk & 7) * 32 + (c & 31)) * 2; }
__device__ __forceinline__ int v_rd_base(int lane) { return ((lane & 3) << 3) | (((lane >> 2) & 3) << 6) | (((lane >> 4) & 1) << 5) | (((lane >> 5) & 1) << 8); }
constexpr int v_rd_off(int d0, int ks, int half) { return d0 * 512 + ks * 4096 + half * 2048; }
template <int OFF> __device__ __forceinline__ s16x4 tr_read(int vb) {
  s16x4 r; asm volatile("ds_read_b64_tr_b16 %0, %1 offset:%2" : "=&v"(r) : "v"(vb), "i"(OFF) : "memory"); return r;
}
template <int D0> __device__ __forceinline__ void pv_one(f32x16& od, int vb, bf16x8 pa0, bf16x8 pa1, bf16x8 pa2, bf16x8 pa3) {
  const s16x4 l0 = tr_read<v_rd_off(D0, 0, 0)>(vb), h0 = tr_read<v_rd_off(D0, 0, 1)>(vb), l1 = tr_read<v_rd_off(D0, 1, 0)>(vb), h1 = tr_read<v_rd_off(D0, 1, 1)>(vb);
  const s16x4 l2 = tr_read<v_rd_off(D0, 2, 0)>(vb), h2 = tr_read<v_rd_off(D0, 2, 1)>(vb), l3 = tr_read<v_rd_off(D0, 3, 0)>(vb), h3 = tr_read<v_rd_off(D0, 3, 1)>(vb);
  asm volatile("s_waitcnt lgkmcnt(0)" ::: "memory"); SBAR();
#define PK(L, H) (bf16x8){L[0], L[1], L[2], L[3], H[0], H[1], H[2], H[3]}
  od = __builtin_amdgcn_mfma_f32_32x32x16_bf16(pa0, PK(l0, h0), od, 0, 0, 0);
  od = __builtin_amdgcn_mfma_f32_32x32x16_bf16(pa1, PK(l1, h1), od, 0, 0, 0);
  od = __builtin_amdgcn_mfma_f32_32x32x16_bf16(pa2, PK(l2, h2), od, 0, 0, 0);
  od = __builtin_amdgcn_mfma_f32_32x32x16_bf16(pa3, PK(l3, h3), od, 0, 0, 0);
#undef PK
}
__device__ __forceinline__ void pv_d0(f32x16* o, int vb, bf16x8 pa0, bf16x8 pa1, bf16x8 pa2, bf16x8 pa3) {
  pv_one<0>(o[0], vb, pa0, pa1, pa2, pa3); pv_one<1>(o[1], vb, pa0, pa1, pa2, pa3); pv_one<2>(o[2], vb, pa0, pa1, pa2, pa3); pv_one<3>(o[3], vb, pa0, pa1, pa2, pa3);
}

template <typename TQ>
__device__ __forceinline__ void attn_dense_body(const TQ* __restrict__ Qb, const bf16* __restrict__ Kh, const bf16* __restrict__ Vh,
                                                bf16* __restrict__ Ob, int seq, char* lds) {
  using St = Stage<bf16>; using SQ = Stage<TQ>;
  const int tid = threadIdx.x, wid = __builtin_amdgcn_readfirstlane(tid >> 6), lane = tid & 63, r32 = lane & 31, hi = lane >> 5;
  bf16* V_lds = (bf16*)lds; bf16* K_lds = (bf16*)(lds + 2 * SHM_V);
  float* ws = (float*)(lds + 2 * SHM_V + 2 * SHM_K) + wid * 64; float* li_l = ws; float* al_l = ws + 32;
  float m_reg = -1e30f, l_reg = 0; f32x16 o[4] = {}; bf16x8 qr[8];
  const TQ* Qw = Qb + (long)(wid * QBLK + r32) * LDQ + hi * 8;
#pragma unroll
  for (int d0 = 0; d0 < 8; ++d0) qr[d0] = SQ::tobf(SQ::ld8(Qw + d0 * 16));
  const int sr = tid >> 4, sc = (tid & 15) * 8, vst0 = v_st(sr, sc), vst1 = v_st(32 + sr, sc);
  const int vb0 = (int)(uintptr_t)V_lds + v_rd_base(lane);
  struct { typename St::T vs0, vs1, ks0, ks1; } sr_[SDEPTH];
#define SLOAD(i, k0) do { sr_[i].vs0 = St::ld8(&Vh[(long)((k0) + sr) * LDK + sc]); sr_[i].vs1 = St::ld8(&Vh[(long)((k0) + 32 + sr) * LDK + sc]); \
    sr_[i].ks0 = St::ld8(&Kh[(long)((k0) + sr) * LDK + sc]); sr_[i].ks1 = St::ld8(&Kh[(long)((k0) + 32 + sr) * LDK + sc]); } while (0)
#define SWRITE(b, i) do { *(bf16x8*)((char*)V_lds + (b) * SHM_V + vst0) = St::tobf(sr_[i].vs0);          \
    *(bf16x8*)((char*)V_lds + (b) * SHM_V + vst1) = St::tobf(sr_[i].vs1); int kc = sc * 2;               \
    *(bf16x8*)((char*)K_lds + (b) * SHM_K + KSWZ(sr, kc)) = St::tobf(sr_[i].ks0);                       \
    *(bf16x8*)((char*)K_lds + (b) * SHM_K + KSWZ(32 + sr, kc)) = St::tobf(sr_[i].ks1); } while (0)
#define SWAIT() do { if constexpr (SDEPTH == 2) asm volatile("s_waitcnt vmcnt(4)" ::: "memory"); else asm volatile("s_waitcnt vmcnt(0)" ::: "memory"); } while (0)
#define RESC(a) do { if (__any((a) < 1.f)) { if (hi == 0) al_l[r32] = (a); asm volatile("s_waitcnt lgkmcnt(0)" ::: "memory"); \
    for (int d = 0; d < 4; ++d) for (int r = 0; r < 16; ++r) o[d][r] *= al_l[crow(r, hi)]; } } while (0)
  f32x16 pA0, pA1, pB0, pB1; float mnA, mnB, alA, alB; bf16x8 pa0, pa1, pa2, pa3; const int NT = seq / KVBLK;
  constexpr int SE = 0, SO = SDEPTH - 1;
  SLOAD(SE, 0); asm volatile("s_waitcnt vmcnt(0)" ::: "memory"); SWRITE(0, SE); __syncthreads();
  qkt(pA0, pA1, K_lds, qr, r32, hi); partialSM(pA0, pA1, m_reg, mnA, alA);
  SLOAD(SO, KVBLK); if constexpr (SDEPTH == 2) { if (2 < NT) SLOAD(SE, 2 * KVBLK); }
  SWAIT(); SWRITE(1, SO); __syncthreads();
  for (int j = 1; j + 1 < NT; j += 2) {
    SBAR(); qkt(pB0, pB1, (bf16*)((char*)K_lds + SHM_K), qr, r32, hi);
    finishSM(pA0, pA1, alA, l_reg, pa0, pa1, pa2, pa3); SBAR();
    SLOAD(SO, (j + SDEPTH) * KVBLK); SBAR();
    pv_d0(o, vb0, pa0, pa1, pa2, pa3); partialSM(pB0, pB1, m_reg, mnB, alB);
    __syncthreads(); SWAIT(); SWRITE(0, SE);
    RESC(alB); __syncthreads();
    SBAR(); qkt(pA0, pA1, K_lds, qr, r32, hi);
    finishSM(pB0, pB1, alB, l_reg, pa0, pa1, pa2, pa3); SBAR();
    if (SDEPTH == 1 || j + 3 < NT) SLOAD(SE, (j + 1 + SDEPTH) * KVBLK); SBAR();
    pv_d0(o, vb0 + (int)SHM_V, pa0, pa1, pa2, pa3); partialSM(pA0, pA1, m_reg, mnA, alA);
    __syncthreads(); SWAIT(); SWRITE(1, SO);
    RESC(alA); __syncthreads();
  }
  SBAR(); qkt(pB0, pB1, (bf16*)((char*)K_lds + SHM_K), qr, r32, hi);
  finishSM(pA0, pA1, alA, l_reg, pa0, pa1, pa2, pa3); SBAR();
  pv_d0(o, vb0, pa0, pa1, pa2, pa3); partialSM(pB0, pB1, m_reg, mnB, alB);
  __syncthreads(); RESC(alB);
  finishSM(pB0, pB1, alB, l_reg, pa0, pa1, pa2, pa3); SBAR();
  pv_d0(o, vb0 + (int)SHM_V, pa0, pa1, pa2, pa3);
  if (hi == 0) li_l[r32] = l_reg; asm volatile("s_waitcnt lgkmcnt(0)" ::: "memory");
  float rli[16];
#pragma unroll
  for (int r = 0; r < 16; ++r) rli[r] = __builtin_amdgcn_rcpf(li_l[crow(r, hi)]);
  bf16* Ow = Ob + (long)(wid * QBLK) * LDO;
#pragma unroll
  for (int r = 0; r < 16; ++r) { int orow = crow(r, hi);
    for (int d0 = 0; d0 < 4; ++d0) Ow[(long)orow * LDO + d0 * 32 + r32] = (bf16)(cvtpk(o[d0][r] * rli[r], 0.f) & 0xffffu); }
#undef SLOAD
#undef SWRITE
#undef SWAIT
#undef RESC
}

#undef KSWZ
#undef SBAR
}

constexpr int LDS_BYTES = 135168;
struct Args { const float* in[19]; float* out; unsigned char* ws; };
#define LAS3 __attribute__((address_space(3)))

typedef const __attribute__((address_space(4))) Args* CArgsP;
#ifndef PHM
#define PHM 0xFFFFFFu
#endif
#define PH(b) ((PHM >> (b)) & 1u)
#define PHASE_VARS \
    CArgsP ap = (CArgsP)__builtin_amdgcn_kernarg_segment_ptr(); asm volatile("" : "+s"(ap)); \
    int tid = threadIdx.x; asm volatile("" : "+v"(tid)); \
    const int lane = tid & 63, wave = __builtin_amdgcn_readfirstlane(tid >> 6); \
    const int G = gridDim.x, bx = blockIdx.x, gw = bx * 8 + wave, NGW = G * 8, gt = bx * 512 + tid, NGT = G * 512; \
    unsigned char* ws = ap->ws; float* out = ap->out; bf16_t* H = (bf16_t*)(ws + WS_H); \
    (void)lane; (void)gw; (void)NGW; (void)gt; (void)NGT; (void)out; (void)H; (void)bx; (void)G;
#define GRID_SYNC() cg::this_grid().sync()

template <int LAYER> DEVI void ffn_block(LAS3 unsigned char* lds3) {
    { PHASE_VARS
      if (PH(17)) p_norm(out, out + (size_t)TP * DM, ap->in[15] + LAYER * 1024, H, gw, NGW, lane); }
    GRID_SYNC();
    { PHASE_VARS
      if (PH(18)) { pg8::Gemm g{H, (const bf16_t*)(ws + (LAYER ? WS_W_GU1 : WS_W_GU0)), TT, 2 * FFH, 1024}; pg8::StaticOrder S; S.init(TT, 2 * FFH, G, bx);
        Epi<EM_GLU> E{(bf16_t*)(ws + WS_ACT), nullptr, nullptr, nullptr, nullptr, nullptr, nullptr, nullptr};
        pg8::gemm_phase<Epi<EM_GLU>, pg8::StaticOrder, true, true>(lds3, g, S, E); } }
    GRID_SYNC();
    { PHASE_VARS
      if (PH(19)) { pg8::Gemm g{(const bf16_t*)(ws + WS_ACT), (const bf16_t*)(ws + (LAYER ? WS_W_D1 : WS_W_D0)), TT, 1024, FFH}; pg8::StaticOrder S; S.init(TT, 1024, G, bx);
        Epi<EM_RES> E{nullptr, nullptr, nullptr, out, nullptr, nullptr, nullptr, nullptr};
        pg8::gemm_phase<Epi<EM_RES>, pg8::StaticOrder, true, true>(lds3, g, S, E); } }
}

__global__ void __launch_bounds__(512, 2) mega_fwd(Args a_unused) {
    extern __shared__ __attribute__((aligned(16))) unsigned char lds[];
    LAS3 unsigned char* lds3 = (LAS3 unsigned char*)lds;
    { PHASE_VARS
      if (PH(0)) p_fold(ap->in[3], ap->in[4], ap->in[6], (float*)(ws + WS_FOLDF), (float*)(ws + WS_FOLDG), (float*)lds, gw, NGW, lane);
      if (PH(1)) { p_dft((bf16_t*)(ws + WS_DS4), 4096, 12, gt, NGT); p_dft((bf16_t*)(ws + WS_DS2), 2048, 11, gt, NGT); }
      if (gt < 2048) { const int idx = gt >> 5, i = gt & 31; const float inv = powf(10000.f, -(float)(2 * i) * (1.f / 64.f)); const float ang = (float)idx * inv;
          ((float2*)(ws + WS_ROPE))[gt] = make_float2((float)cos((double)ang), (float)sin((double)ang)); }
      if (PH(2)) p_norm(ap->in[0], ap->in[1], ap->in[2], H, gw, NGW, lane); }
    GRID_SYNC();
    { PHASE_VARS
      if (PH(3)) { float* scr = (float*)(lds + wave * 16384);
      const float* win = ap->in[3];
      for (int it = gw; it < 11776; it += NGW) { int r = it;
          if (tr_mat<0>(r, win, 2080, 0, 1024, 256, (bf16_t*)(ws + WS_W_AB1), 0, 0.125f, scr, lane)) continue;
          if (tr_mat<0>(r, win, 2080, 256, 1024, 1280, (bf16_t*)(ws + WS_W_AB1), 256, 1.f, scr, lane)) continue;
          if (tr_mat<0>(r, (const float*)(ws + WS_FOLDG), 512, 0, 1024, 512, (bf16_t*)(ws + WS_W_AB1), 1536, 1.f, scr, lane)) continue;
          if (tr_mat<0>(r, (const float*)(ws + WS_FOLDF), 1024, 0, 1024, 1024, (bf16_t*)(ws + WS_W_FT), 0, 1.f, scr, lane)) continue;
          if (tr_mat<0>(r, ap->in[9], 1024, 0, 1024, 1024, (bf16_t*)(ws + WS_W_ABO), 0, 1.f, scr, lane)) continue;
          if (tr_mat<1>(r, ap->in[16], FFH, 0, 1024, FFH, (bf16_t*)(ws + WS_W_GU0), 0, 1.f, scr, lane)) continue;
          if (tr_mat<2>(r, ap->in[17], FFH, 0, 1024, FFH, (bf16_t*)(ws + WS_W_GU0), 0, 1.f, scr, lane)) continue;
          if (tr_mat<0>(r, ap->in[18], 1024, 0, FFH, 1024, (bf16_t*)(ws + WS_W_D0), 0, 1.f, scr, lane)) continue;
          if (tr_mat<0>(r, ap->in[11], 1536, 0, 1024, 1536, (bf16_t*)(ws + WS_W_QKV), 0, 1.f, scr, lane)) continue;
          if (tr_mat<0>(r, ap->in[14], 1024, 0, 1024, 1024, (bf16_t*)(ws + WS_W_CO), 0, 1.f, scr, lane)) continue;
          if (tr_mat<1>(r, ap->in[16] + (size_t)1024 * FFH, FFH, 0, 1024, FFH, (bf16_t*)(ws + WS_W_GU1), 0, 1.f, scr, lane)) continue;
          if (tr_mat<2>(r, ap->in[17] + (size_t)1024 * FFH, FFH, 0, 1024, FFH, (bf16_t*)(ws + WS_W_GU1), 0, 1.f, scr, lane)) continue;
          if (tr_mat<0>(r, ap->in[18] + (size_t)1024 * FFH, 1024, 0, FFH, 1024, (bf16_t*)(ws + WS_W_D1), 0, 1.f, scr, lane)) continue;
      } } }
    GRID_SYNC();
    { PHASE_VARS
      if (PH(4)) { pg8::Gemm g{H, (const bf16_t*)(ws + WS_W_AB1), TT, 2048, 1024}; pg8::StaticOrder S; S.init(TT, 2048, G, bx);
        Epi<EM_AB1> E{(bf16_t*)(ws + WS_QKVR), nullptr, nullptr, (float*)(ws + WS_G), nullptr, nullptr, ap->in[5], ap->in[7]};
        pg8::gemm_phase<Epi<EM_AB1>, pg8::StaticOrder, true, true>(lds3, g, S, E); } }
    { PHASE_VARS
      if (PH(5)) { pg8::Gemm g{(const bf16_t*)(ws + WS_W_FT), H, 1024, TT, 1024}; pg8::StaticOrder S; S.init(1024, TT, G, bx);
        Epi<EM_AB1T> E{(bf16_t*)((unsigned char*)out + OUT_YTP), (bf16_t*)((unsigned char*)out + OUT_YTS), nullptr, nullptr, nullptr, nullptr, nullptr, nullptr};
        pg8::gemm_phase<Epi<EM_AB1T>, pg8::StaticOrder, true, true>(lds3, g, S, E); } }
    GRID_SYNC();
    { PHASE_VARS
      if (PH(6)) { pg8::Gemm g{(const bf16_t*)(ws + WS_DS4), (const bf16_t*)((unsigned char*)out + OUT_YTP), 4096, 4096, 8192}; pg8::StaticOrder S; S.init(4096, 4096, G, bx);
        Epi<EM_FNETP> E{H, nullptr, nullptr, nullptr, nullptr, nullptr, nullptr, nullptr};
        pg8::gemm_phase<Epi<EM_FNETP>, pg8::StaticOrder, true, true>(lds3, g, S, E); } }
    { PHASE_VARS
      if (PH(7)) { pg8::Gemm g{(const bf16_t*)(ws + WS_DS2), (const bf16_t*)((unsigned char*)out + OUT_YTS), 2048, 4096, 4096}; pg8::StaticOrder S; S.init(2048, 4096, G, (bx + G / 2) % G);
        Epi<EM_FNETS> E{H, nullptr, nullptr, nullptr, nullptr, nullptr, nullptr, nullptr};
        pg8::gemm_phase<Epi<EM_FNETS>, pg8::StaticOrder, true, true>(lds3, g, S, E); } }
    { PHASE_VARS
      if (PH(8)) if (bx < G / 2) for (int item = bx; item < 3072; item += G / 2)
          gla_a_item(item, (const bf16_t*)(ws + WS_QKVR), (const float*)(ws + WS_G), (bf16_t*)((unsigned char*)out + OUT_DST), (float*)(ws + WS_DEC), lds, tid, wave, lane); }
    GRID_SYNC();
    { PHASE_VARS
      if (PH(9)) for (int g2 = gt; g2 < 131072; g2 += NGT) p_scan((bf16_t*)((unsigned char*)out + OUT_DST), (const float*)(ws + WS_DEC), g2); }
    GRID_SYNC();
    { PHASE_VARS
      if (PH(10)) for (int item = bx; item < 3072; item += G)
          gla_c_item(item, (const bf16_t*)(ws + WS_QKVR), (const float*)(ws + WS_G), (const bf16_t*)((unsigned char*)out + OUT_DST), ap->in[8], H, lds, tid, wave, lane); }
    GRID_SYNC();
    { PHASE_VARS
      if (PH(11)) { pg8::Gemm g{H, (const bf16_t*)(ws + WS_W_ABO), TT, 1024, 1024}; pg8::StaticOrder S; S.init(TT, 1024, G, bx);
        Epi<EM_RESIN> E{nullptr, nullptr, nullptr, out, ap->in[0], ap->in[1], nullptr, nullptr};
        pg8::gemm_phase<Epi<EM_RESIN>, pg8::StaticOrder, true, true>(lds3, g, S, E); } }
    GRID_SYNC();
    ffn_block<0>(lds3);
    GRID_SYNC();
    { PHASE_VARS
      if (PH(12)) p_norm(out, out + (size_t)TP * DM, ap->in[10], H, gw, NGW, lane); }
    GRID_SYNC();
    { PHASE_VARS
      if (PH(13)) { pg8::Gemm g{H, (const bf16_t*)(ws + WS_W_QKV), TT, 1536, 1024}; pg8::StaticOrder S; S.init(TT, 1536, G, bx);
        Epi<EM_QKV> E{(bf16_t*)(ws + WS_Q), (bf16_t*)(ws + WS_K), (bf16_t*)(ws + WS_V), nullptr, nullptr, nullptr, nullptr, nullptr};
        pg8::gemm_phase<Epi<EM_QKV>, pg8::StaticOrder, true, true>(lds3, g, S, E); } }
    GRID_SYNC();
    { PHASE_VARS
      if (PH(14)) p_qkrope((bf16_t*)(ws + WS_Q), (bf16_t*)(ws + WS_K), ap->in[12], ap->in[13], (const float2*)(ws + WS_ROPE), gw, NGW, lane); }
    GRID_SYNC();
    { PHASE_VARS
      if (PH(15)) { const int vx = bx & 7, vi = bx >> 3;
        bf16_t* Qb = (bf16_t*)(ws + WS_Q); bf16_t* Kb = (bf16_t*)(ws + WS_K); bf16_t* Vb = (bf16_t*)(ws + WS_V); bf16_t* AO = (bf16_t*)(ws + WS_AO);
        for (int i = 0; i < 6; ++i) {
            int b, kvh, hq, qb, row0, seq;
            if (i < 4) { const int combo = vx * 2 + (i >> 1), u = (i & 1) * 32 + vi; b = combo >> 1; kvh = combo & 1; hq = kvh * 4 + (u >> 4); qb = u & 15; row0 = b * 4096; seq = 4096; }
            else { const int combo = vx * 2 + (i - 4), u = vi; b = combo >> 1; kvh = combo & 1; hq = kvh * 4 + (u >> 3); qb = u & 7; row0 = TP + b * 2048; seq = 2048; }
            attn::attn_dense_body<attn::bf16>(Qb + (size_t)(row0 + qb * 256) * 1024 + hq * 128, Kb + (size_t)row0 * 256 + kvh * 128, Vb + (size_t)row0 * 256 + kvh * 128,
                                              AO + (size_t)(row0 + qb * 256) * 1024 + hq * 128, seq, (char*)lds);
            __syncthreads();
        } } }
    GRID_SYNC();
    { PHASE_VARS
      if (PH(16)) { pg8::Gemm g{(const bf16_t*)(ws + WS_AO), (const bf16_t*)(ws + WS_W_CO), TT, 1024, 1024}; pg8::StaticOrder S; S.init(TT, 1024, G, bx);
        Epi<EM_RES> E{nullptr, nullptr, nullptr, out, nullptr, nullptr, nullptr, nullptr};
        pg8::gemm_phase<Epi<EM_RES>, pg8::StaticOrder, true, true>(lds3, g, S, E); } }
    GRID_SYNC();
    ffn_block<1>(lds3);
}

extern "C" void kernel_launch(void* const* d_in, const int* in_sizes, int n_in, void* d_out, int out_size, void* d_ws, size_t ws_size, hipStream_t stream) {
    static int grid = 0;
    if (grid == 0) {
        int dev = 0, cus = 0, per_cu = 0;
        if (n_in != 19 || out_size != TT * DM || ws_size < WS_END) { fprintf(stderr, "kernel_launch: unexpected shapes: n_in %d out %d ws %zu (need %zu)\n", n_in, out_size, ws_size, (size_t)WS_END); grid = -1; return; }
        if (hipGetDevice(&dev) != hipSuccess || hipDeviceGetAttribute(&cus, hipDeviceAttributeMultiprocessorCount, dev) != hipSuccess) { fprintf(stderr, "kernel_launch: device query failed\n"); grid = -1; return; }
        if (hipFuncSetAttribute((const void*)mega_fwd, hipFuncAttributeMaxDynamicSharedMemorySize, LDS_BYTES) != hipSuccess) { fprintf(stderr, "kernel_launch: hipFuncSetAttribute failed\n"); grid = -1; return; }
        if (hipOccupancyMaxActiveBlocksPerMultiprocessor(&per_cu, (const void*)mega_fwd, 512, LDS_BYTES) != hipSuccess || per_cu < 1) fprintf(stderr, "kernel_launch: occupancy query reports %d blocks per CU\n", per_cu);
        (void)hipGetLastError();
        if (cus != 256) { fprintf(stderr, "kernel_launch: built for a 256-CU device, found %d\n", cus); grid = -1; return; }
        grid = 256;
    }
    if (grid < 0) return;
    Args a{};
    for (int i = 0; i < 19; ++i) a.in[i] = (const float*)d_in[i];
    a.out = (float*)d_out; a.ws = (unsigned char*)d_ws;
    void* args[] = {&a};
    const hipError_t e = hipLaunchCooperativeKernel((const void*)mega_fwd, dim3(grid), dim3(512), args, LDS_BYTES, stream);
    if (e != hipSuccess) fprintf(stderr, "kernel_launch: cooperative launch failed: %s\n", hipGetErrorString(e));
}
```

```cpp
#include <hip/hip_runtime.h>
#include <hip/hip_cooperative_groups.h>
#include <cstdio>
#include <cstdint>
namespace cg = cooperative_groups;
#define DEVI __device__ __forceinline__
namespace pg8 {
#define PG8_LAS __attribute__((address_space(3)))
typedef unsigned short bf16_t;
typedef short bf16x8 __attribute__((ext_vector_type(8)));
typedef float f32x4 __attribute__((ext_vector_type(4)));
typedef unsigned u32x4 __attribute__((ext_vector_type(4)));
constexpr int BM = 256, BK = 64, HALF = 128, HTB = HALF * BK * 2  , STAGE_BYTES = 8 * HTB, NXCD = 8, WGM = 8;

__host__ __device__ __forceinline__ int lds_byte(int r, int c) { const int st = (r >> 4) * 2 + (c >> 5), rr = r & 15, cc = c & 31, ob = rr * 64 + cc * 2; return st * 1024 + (ob ^ (((ob >> 9) & 1) << 5)); }
__host__ __device__ __forceinline__ void stage_rc(int b, int& R, int& C) { const int st = b / 1024, sb = b % 1024, swz = sb ^ (((sb >> 9) & 1) << 5); R = (st >> 1) * 16 + swz / 64; C = (st & 1) * 32 + (swz % 64) / 2; }
__host__ __device__ __forceinline__ int perm32(int rho) { const int n = rho >> 4, i = rho & 15; return 8 * (i >> 2) + 4 * n + (i & 3); }

struct Unit { int pm, pn; };
struct Gemm { const bf16_t* A; const bf16_t* Bt; int M, N, K; };

struct StaticOrder {
    int nM, nN, nwg, G, c;
    __host__ __device__ void init(int M, int N, int G_, int c_) { nM = M / BM; nN = N / BM; nwg = nM * nN; G = G_; c = c_; }
    __host__ __device__ bool next(int i, Unit& u) const {
        const long L = (long)i * G + c; if (L >= nwg) return false;
        int wgid = (int)L; { const int q = nwg / NXCD, r = nwg % NXCD, xcd = wgid % NXCD, off = wgid / NXCD; wgid = (xcd < r ? xcd * (q + 1) : r * (q + 1) + (xcd - r) * q) + off; }
        const int nig = WGM * nN, gid = wgid / nig, fm = gid * WGM, gsz = (nM - fm) < WGM ? (nM - fm) : WGM;
        u.pm = fm + ((wgid % nig) % gsz); u.pn = (wgid % nig) / gsz; return true;
    }
    __device__ __forceinline__ void a_ready(const Unit&) const {}
    __device__ __forceinline__ void done(const Unit&) const {}
};

__device__ __forceinline__ unsigned cvt_pk_bf16(float lo, float hi) { unsigned r; asm volatile("v_cvt_pk_bf16_f32 %0, %1, %2" : "=v"(r) : "v"(lo), "v"(hi)); return r; }
template <class Epi, class Sched, bool ALIGN_EPI = false, bool SP2 = false>
__device__ __forceinline__ void gemm_phase(PG8_LAS unsigned char* lds, const Gemm g, const Sched& S, const Epi& E) {
    int tid_ = threadIdx.x; asm volatile("" : "+v"(tid_));
    const int tid = tid_, wid = __builtin_amdgcn_readfirstlane(tid >> 6), lane = tid & 63, wr = wid >> 2, wc = wid & 3, fr = lane & 15, fq = lane >> 4;
    const int K = g.K, nt = K / BK;
    unsigned voffA[2], voffB[2];
#pragma unroll
    for (int i = 0; i < 2; ++i) { int R, C; stage_rc(tid * 16 + i * 8192, R, C); const int Rb = Epi::PERM ? ((R & ~31) + perm32(R & 31)) : R;
        voffA[i] = (unsigned)(R * K + C) * 2u; voffB[i] = (unsigned)(Rb * K + C) * 2u; }
    const size_t kstep = (size_t)(BK * 2);
    const size_t hstep = (size_t)HALF * K * 2;
    const size_t tstep = 2 * hstep;
    const unsigned ldsw = (unsigned)wid * 1024u;
    const int aoff = lds_byte(wr * 64 + fr, fq * 8), boff = lds_byte(wc * 32 + fr, fq * 8);
#define PG8_SA(b, h) (((b) * 2 + (h)) * HTB)
#define PG8_SB(b, h) ((4 + (b) * 2 + (h)) * HTB)
#define PG8_STAGE(bufoff, gbase, voff) do { _Pragma("unroll") for (int _i = 0; _i < 2; ++_i) \
        __builtin_amdgcn_global_load_lds((const unsigned*)((const char*)(gbase) + (voff)[_i]), (PG8_LAS unsigned*)(lds + (bufoff) + ldsw + _i * 8192), 16, 0, 0); } while (0)
#define PG8_LDA(dst, b, h) do { _Pragma("unroll") for (int m = 0; m < 4; ++m) _Pragma("unroll") for (int k = 0; k < 2; ++k) dst[m][k] = *(const PG8_LAS bf16x8*)(lds + PG8_SA(b, h) + aoff + m * 2048 + k * 1024); } while (0)
#define PG8_LDB(dst, b, h) do { _Pragma("unroll") for (int n = 0; n < 2; ++n) _Pragma("unroll") for (int k = 0; k < 2; ++k) dst[n][k] = *(const PG8_LAS bf16x8*)(lds + PG8_SB(b, h) + boff + n * 2048 + k * 1024); } while (0)
#define PG8_MMA(ai, bj, At, Bt) do { __builtin_amdgcn_s_setprio(1); _Pragma("unroll") for (int m = 0; m < 4; ++m) _Pragma("unroll") for (int n = 0; n < 2; ++n) _Pragma("unroll") for (int k = 0; k < 2; ++k) \
        acc[ai][bj][m][n] = __builtin_amdgcn_mfma_f32_16x16x32_bf16(Bt[n][k], At[m][k], acc[ai][bj][m][n], 0, 0, 0); __builtin_amdgcn_s_setprio(0); } while (0)
#define PG8_WAIT_V(n) asm volatile("s_waitcnt vmcnt(" #n ")" ::: "memory")
#define PG8_WAIT_L(n) asm volatile("s_waitcnt lgkmcnt(" #n ")" ::: "memory")
#define PG8_BAR __builtin_amdgcn_s_barrier()
#define PG8_SCHED __builtin_amdgcn_sched_barrier(0)
    Unit cur, nxt; int ui = 0;
    if (!S.next(0, cur)) return;
    f32x4 acc[2][2][4][2];
#pragma unroll
    for (int a = 0; a < 2; ++a)
#pragma unroll
        for (int b = 0; b < 2; ++b)
#pragma unroll
            for (int m = 0; m < 4; ++m)
#pragma unroll
                for (int n = 0; n < 2; ++n) acc[a][b][m][n] = (f32x4){0.f, 0.f, 0.f, 0.f};
    bf16x8 At[4][2], B0[2][2], B1[2][2];
    const char* cA = (const char*)g.A + (size_t)cur.pm * tstep; const char* cB = (const char*)g.Bt + (size_t)cur.pn * tstep;
    S.a_ready(cur);
    if constexpr (SP2) {
        PG8_STAGE(PG8_SB(0, 0), cB, voffB); PG8_STAGE(PG8_SB(0, 1), cB + hstep, voffB); PG8_STAGE(PG8_SA(0, 0), cA, voffA); PG8_STAGE(PG8_SA(0, 1), cA + hstep, voffA);
        if (wr == 1) PG8_BAR;
        PG8_WAIT_V(2); PG8_BAR;
        PG8_STAGE(PG8_SB(1, 0), cB + kstep, voffB); PG8_STAGE(PG8_SA(1, 0), cA + kstep, voffA); PG8_STAGE(PG8_SB(1, 1), cB + hstep + kstep, voffB);
        PG8_WAIT_V(6); PG8_BAR;
    } else {
        PG8_STAGE(PG8_SB(0, 0), cB, voffB); PG8_STAGE(PG8_SA(0, 0), cA, voffA); PG8_STAGE(PG8_SB(0, 1), cB + hstep, voffB); PG8_STAGE(PG8_SA(0, 1), cA + hstep, voffA);
        if (wr == 1) PG8_BAR;
        PG8_WAIT_V(4); PG8_BAR;
        PG8_STAGE(PG8_SB(1, 0), cB + kstep, voffB); PG8_STAGE(PG8_SA(1, 0), cA + kstep, voffA); PG8_STAGE(PG8_SB(1, 1), cB + hstep + kstep, voffB);
        PG8_WAIT_V(6); PG8_BAR;
    }
    for (;;) {
        const bool has_next = S.next(ui + 1, nxt);
        const char* nA = has_next ? (const char*)g.A + (size_t)nxt.pm * tstep : cA; const char* nB = has_next ? (const char*)g.Bt + (size_t)nxt.pn * tstep : cB;
        for (int t = 0; t < nt; t += 2) {
            const bool last = (t == nt - 2);
            const char* a1 = cA + (size_t)(t + 1) * kstep;
            const char* a2 = last ? nA : cA + (size_t)(t + 2) * kstep; const char* b2 = last ? nB : cB + (size_t)(t + 2) * kstep;
            const char* a3 = a2 + kstep; const char* b3 = b2 + kstep;
            if (last && has_next) S.a_ready(nxt);
            if constexpr (SP2) {
            PG8_LDB(B0, 0, 0); PG8_LDB(B1, 0, 1); PG8_SCHED; PG8_LDA(At, 0, 0); PG8_STAGE(PG8_SA(1, 1), a1 + hstep, voffA);
            PG8_WAIT_V(8); PG8_WAIT_L(0); PG8_BAR; PG8_MMA(0, 0, At, B0); PG8_MMA(0, 1, At, B1); PG8_BAR; PG8_SCHED;
            PG8_LDA(At, 0, 1); PG8_STAGE(PG8_SB(0, 0), b2, voffB); PG8_STAGE(PG8_SB(0, 1), b2 + hstep, voffB); PG8_STAGE(PG8_SA(0, 0), a2, voffA);
            PG8_WAIT_V(8); PG8_WAIT_L(0); PG8_BAR; PG8_MMA(1, 0, At, B0); PG8_MMA(1, 1, At, B1); PG8_BAR; PG8_SCHED;
            PG8_LDB(B0, 1, 0); PG8_LDB(B1, 1, 1); PG8_SCHED; PG8_LDA(At, 1, 0); PG8_STAGE(PG8_SA(0, 1), a2 + hstep, voffA);
            PG8_WAIT_V(8); PG8_WAIT_L(0); PG8_BAR; PG8_MMA(0, 0, At, B0); PG8_MMA(0, 1, At, B1); PG8_BAR; PG8_SCHED;
            PG8_LDA(At, 1, 1); PG8_STAGE(PG8_SB(1, 0), b3, voffB); PG8_STAGE(PG8_SB(1, 1), b3 + hstep, voffB); PG8_STAGE(PG8_SA(1, 0), a3, voffA);
            PG8_WAIT_V(8); PG8_WAIT_L(0); PG8_BAR; PG8_MMA(1, 0, At, B0); PG8_MMA(1, 1, At, B1); PG8_BAR; PG8_SCHED;
            } else {
            PG8_LDB(B0, 0, 0); PG8_SCHED; PG8_LDA(At, 0, 0); PG8_STAGE(PG8_SA(1, 1), a1 + hstep, voffA);
            PG8_WAIT_L(8); PG8_BAR; PG8_WAIT_L(0); PG8_MMA(0, 0, At, B0); PG8_BAR; PG8_SCHED;
            PG8_LDB(B1, 0, 1); PG8_STAGE(PG8_SB(0, 0), b2, voffB);
            PG8_BAR; PG8_WAIT_L(0); PG8_MMA(0, 1, At, B1); PG8_BAR;
            PG8_LDA(At, 0, 1); PG8_STAGE(PG8_SA(0, 0), a2, voffA);
            PG8_BAR; PG8_WAIT_L(0); PG8_MMA(1, 0, At, B0); PG8_BAR; PG8_SCHED;
            PG8_STAGE(PG8_SB(0, 1), b2 + hstep, voffB);
            PG8_WAIT_V(6); PG8_BAR; PG8_MMA(1, 1, At, B1); PG8_BAR;
            PG8_LDB(B0, 1, 0); PG8_SCHED; PG8_LDA(At, 1, 0); PG8_STAGE(PG8_SA(0, 1), a2 + hstep, voffA);
            PG8_WAIT_L(8); PG8_BAR; PG8_WAIT_L(0); PG8_MMA(0, 0, At, B0); PG8_BAR; PG8_SCHED;
            PG8_LDB(B1, 1, 1); PG8_STAGE(PG8_SB(1, 0), b3, voffB);
            PG8_BAR; PG8_WAIT_L(0); PG8_MMA(0, 1, At, B1); PG8_BAR;
            PG8_LDA(At, 1, 1); PG8_STAGE(PG8_SA(1, 0), a3, voffA);
            PG8_BAR; PG8_WAIT_L(0); PG8_MMA(1, 0, At, B0); PG8_BAR; PG8_SCHED;
            PG8_STAGE(PG8_SB(1, 1), b3 + hstep, voffB);
            PG8_WAIT_V(6); PG8_BAR; PG8_MMA(1, 1, At, B1); PG8_BAR;
            }
        }
        if constexpr (ALIGN_EPI) { if (wr == 0) PG8_BAR; }
        if constexpr (!Epi::AFTER_DRAIN) { E(acc, cur, wr, wc, fr, fq); S.done(cur); }
        if (!has_next) break;
#pragma unroll
        for (int a = 0; a < 2; ++a)
#pragma unroll
            for (int b = 0; b < 2; ++b)
#pragma unroll
                for (int m = 0; m < 4; ++m)
#pragma unroll
                    for (int n = 0; n < 2; ++n) acc[a][b][m][n] = (f32x4){0.f, 0.f, 0.f, 0.f};
        cur = nxt; cA = nA; cB = nB; ++ui;
        if constexpr (ALIGN_EPI) { if (wr == 1) PG8_BAR; }
    }
    PG8_WAIT_V(0);
    if constexpr (!ALIGN_EPI) { if (wr == 0) PG8_BAR; }
    PG8_BAR;
    if constexpr (Epi::AFTER_DRAIN) { E.fused(acc, cur, wr, wc, fr, fq, lds, wid, lane); S.done(cur); }
#undef PG8_SA
#undef PG8_SB
#undef PG8_STAGE
#undef PG8_LDA
#undef PG8_LDB
#undef PG8_MMA
#undef PG8_WAIT_V
#undef PG8_WAIT_L
#undef PG8_BAR
#undef PG8_SCHED
}
}

typedef unsigned short bf16_t;
typedef short bf16x8 __attribute__((ext_vector_type(8)));
typedef float f32x4 __attribute__((ext_vector_type(4)));
typedef float f32x16 __attribute__((ext_vector_type(16)));
typedef unsigned u32x4 __attribute__((ext_vector_type(4)));
typedef unsigned u32x2 __attribute__((ext_vector_type(2)));
typedef float f32x2_t __attribute__((ext_vector_type(2)));
typedef __bf16 bf16x2_t __attribute__((ext_vector_type(2)));

constexpr int TP = 32768, TS = 16384, TT = TP + TS, DM = 1024, FFH = 2816, SP = 4096, SS = 2048;
constexpr float EPS = 1e-6f;
constexpr size_t MiB = 1u << 20;
constexpr size_t WS_CTL = 0, CTL_BYTES = 64 * 1024;
constexpr size_t WS_ROPE = 1 * MiB;
constexpr size_t WS_W_AB1 = 2 * MiB;
constexpr size_t WS_W_FT = 6 * MiB;
constexpr size_t WS_W_ABO = 8 * MiB;
constexpr size_t WS_W_GU0 = 10 * MiB;
constexpr size_t WS_W_D0 = 21 * MiB;
constexpr size_t WS_W_QKV = 27 * MiB;
constexpr size_t WS_W_CO = 30 * MiB;
constexpr size_t WS_W_GU1 = 32 * MiB;
constexpr size_t WS_W_D1 = 43 * MiB;
constexpr size_t WS_DEC = 49 * MiB;
constexpr size_t WS_DS4 = 51 * MiB;
constexpr size_t WS_DS2 = 115 * MiB;
constexpr size_t WS_H = 131 * MiB;
constexpr size_t WS_BIG = 227 * MiB;
constexpr size_t WS_QKVR = WS_BIG;
constexpr size_t WS_G = WS_BIG + 144 * MiB;
constexpr size_t WS_FOLDF = WS_BIG;
constexpr size_t WS_FOLDG = WS_BIG + 4 * MiB;
constexpr size_t WS_ACT = WS_BIG;
constexpr size_t WS_Q = WS_BIG, WS_K = WS_BIG + 96 * MiB, WS_V = WS_BIG + 120 * MiB, WS_AO = WS_BIG + 144 * MiB;
constexpr size_t WS_END = WS_BIG + 264 * MiB;
constexpr size_t OUT_YTP = 0, OUT_YTS = 64 * MiB, OUT_DST = 96 * MiB;

DEVI float bf2f(bf16_t x) { return __uint_as_float(((unsigned)x) << 16); }
DEVI unsigned pk2(float lo, float hi) { f32x2_t v = {lo, hi}; bf16x2_t b = __builtin_convertvector(v, bf16x2_t); return __builtin_bit_cast(unsigned, b); }
DEVI bf16_t f2bf(float f) { return (bf16_t)(pk2(f, 0.f) & 0xffffu); }
DEVI u32x4 pk8(f32x4 a, f32x4 b) { u32x4 w; w.x = pk2(a[0], a[1]); w.y = pk2(a[2], a[3]); w.z = pk2(b[0], b[1]); w.w = pk2(b[2], b[3]); return w; }
DEVI float wave_sum(float v) {
#pragma unroll
    for (int o = 1; o < 64; o <<= 1) v += __shfl_xor(v, o);
    return v;
}
DEVI float logsig(float z) { return fminf(z, 0.f) - log1pf(__expf(-fabsf(z))); }
DEVI float silu(float z) { return z / (1.f + __expf(-z)); }

enum { EM_AB1, EM_AB1T, EM_FNETP, EM_FNETS, EM_RESIN, EM_RES, EM_GLU, EM_QKV };
template <int MODE> struct Epi {
    static constexpr bool PERM = true, AFTER_DRAIN = false;
    bf16_t* O0; bf16_t* O1; bf16_t* O2; float* F0; const float* X0; const float* X1; const float* B0; const float* B1;
    DEVI void operator()(const f32x4 (&acc)[2][2][4][2], const pg8::Unit& u, int wr, int wc, int fr, int fq) const {
        const int rbase = u.pm * 256 + wr * 64 + fr, cb = wc * 32 + 8 * fq;
#pragma unroll
        for (int ai = 0; ai < 2; ++ai)
#pragma unroll
            for (int m = 0; m < 4; ++m) {
                const int row = rbase + ai * 128 + m * 16;
                if constexpr (MODE == EM_GLU) {
                    const f32x4 g0 = acc[ai][0][m][0], g1 = acc[ai][0][m][1], u0 = acc[ai][1][m][0], u1 = acc[ai][1][m][1];
                    f32x4 a, b;
#pragma unroll
                    for (int j = 0; j < 4; ++j) { a[j] = silu(g0[j]) * u0[j]; b[j] = silu(g1[j]) * u1[j]; }
                    *(u32x4*)(O0 + (size_t)row * FFH + u.pn * 128 + cb) = pk8(a, b);
                } else {
#pragma unroll
                    for (int bj = 0; bj < 2; ++bj) {
                        const f32x4 v0 = acc[ai][bj][m][0], v1 = acc[ai][bj][m][1];
                        const int c = bj * 128 + cb;
                        if constexpr (MODE == EM_AB1) {
                            if (u.pn < 6) { *(u32x4*)(O0 + (size_t)row * 1536 + u.pn * 256 + c) = pk8(v0, v1); }
                            else { const int dir = u.pn - 6; const float* bias = dir ? B1 : B0;
                                const f32x4 b0 = *(const f32x4*)(bias + c), b1 = *(const f32x4*)(bias + c + 4);
                                f32x4 a, b;
#pragma unroll
                                for (int j = 0; j < 4; ++j) { a[j] = logsig(v0[j] + b0[j]) * 0.0625f; b[j] = logsig(v1[j] + b1[j]) * 0.0625f; }
                                float* gp = F0 + (size_t)row * 512 + dir * 256 + c; *(f32x4*)gp = a; *(f32x4*)(gp + 4) = b; }
                        } else if constexpr (MODE == EM_AB1T) {
                            const int cc = row, t0 = u.pn * 256;
                            bf16_t* dst;
                            if (t0 < TP) { const int b = t0 >> 12, s = (t0 & 4095) + c; dst = O0 + ((size_t)(b * 512 + (cc & 511)) * 8192 + (cc >> 9) * 4096 + s); }
                            else { const int tt = t0 - TP, b = tt >> 11, s = (tt & 2047) + c; dst = O1 + ((size_t)(b * 512 + (cc & 511)) * 4096 + (cc >> 9) * 2048 + s); }
                            *(u32x4*)dst = pk8(v0, v1);
                        } else if constexpr (MODE == EM_FNETP) {
                            const int tok = (u.pn >> 1) * 4096 + row;
                            *(u32x4*)(O0 + (size_t)tok * 1024 + 512 + (u.pn & 1) * 256 + c) = pk8(v0, v1);
                        } else if constexpr (MODE == EM_FNETS) {
                            const int tok = TP + (u.pn >> 1) * 2048 + row;
                            *(u32x4*)(O0 + (size_t)tok * 1024 + 512 + (u.pn & 1) * 256 + c) = pk8(v0, v1);
                        } else if constexpr (MODE == EM_RESIN) {
                            const float* xp = (row < TP ? X0 + (size_t)row * 1024 : X1 + (size_t)(row - TP) * 1024) + u.pn * 256 + c;
                            float* op = F0 + (size_t)row * 1024 + u.pn * 256 + c;
                            const f32x4 x0 = *(const f32x4*)xp, x1 = *(const f32x4*)(xp + 4);
                            *(f32x4*)op = x0 + v0; *(f32x4*)(op + 4) = x1 + v1;
                        } else if constexpr (MODE == EM_RES) {
                            float* op = F0 + (size_t)row * 1024 + u.pn * 256 + c;
                            const f32x4 x0 = *(const f32x4*)op, x1 = *(const f32x4*)(op + 4);
                            *(f32x4*)op = x0 + v0; *(f32x4*)(op + 4) = x1 + v1;
                        } else if constexpr (MODE == EM_QKV) {
                            bf16_t* dst;
                            if (u.pn < 4) dst = O0 + (size_t)row * 1024 + u.pn * 256 + c;
                            else if (u.pn == 4) dst = O1 + (size_t)row * 256 + c;
                            else dst = O2 + (size_t)row * 256 + c;
                            *(u32x4*)dst = pk8(v0, v1);
                        }
                    }
                }
            }
    }
};

DEVI void p_fold(const float* win, const float* upf, const float* upb, float* FF, float* FG, float* tab, int gw, int NGW, int lane) {
    if (threadIdx.x < 128) tab[threadIdx.x] = cospif((float)threadIdx.x * (1.f / 64.f));
    __syncthreads();
    for (int it = gw; it < 1024 * 16; it += NGW) {
        const int k = it >> 4, cb = it & 15, cc = cb * 64 + lane, part = cc >> 9, g = (cc >> 7) & 3, l = cc & 127;
        const float* wr = win + (size_t)k * 2080 + 1568 + g * 128;
        const int sh = part ? 96 : 0;
        float acc = 0.f;
#pragma unroll 8
        for (int w = 0; w < 128; ++w) acc += wr[w] * tab[(w * l + sh) & 127];
        FF[(size_t)k * 1024 + cc] = acc;
    }
    for (int it = gw; it < 1024 * 8; it += NGW) {
        const int k = it >> 3, nb = it & 7, n = nb * 64 + lane, dir = n >> 8, nn = n & 255;
        const float* wr = win + (size_t)k * 2080 + 1536 + dir * 16;
        const float* up = dir ? upb : upf;
        float acc = 0.f;
#pragma unroll
        for (int r = 0; r < 16; ++r) acc += wr[r] * up[r * 256 + nn];
        FG[(size_t)k * 512 + n] = acc;
    }
    __syncthreads();
}
DEVI void p_dft(bf16_t* DS, int S, int logS, int gt, int NGT) {
    const int lri = logS - 2;
    const long total = (long)S << lri;
    const float nrm = rsqrtf((float)S * 128.f), xs = 2.f / (float)S;
    for (long it = gt; it < total; it += NGT) {
        const int k = (int)(it >> lri), c8 = (int)(it & ((1 << lri) - 1)), col0 = c8 * 8, part = col0 >= S, s0 = col0 - part * S;
        float v[8];
#pragma unroll
        for (int j = 0; j < 8; ++j) { const int idx = (k * (s0 + j)) & (S - 1); const float x = (float)idx * xs; v[j] = (part ? -sinpif(x) : cospif(x)) * nrm; }
        u32x4 w; w.x = pk2(v[0], v[1]); w.y = pk2(v[2], v[3]); w.z = pk2(v[4], v[5]); w.w = pk2(v[6], v[7]);
        *(u32x4*)(DS + (size_t)k * (2 * S) + col0) = w;
    }
}
DEVI void p_norm(const float* src0, const float* src1, const float* gain, bf16_t* H, int gw, int NGW, int lane) {
    f32x4 gv[4];
#pragma unroll
    for (int j = 0; j < 4; ++j) gv[j] = *((const f32x4*)gain + lane + 64 * j);
    for (int m = gw; m < TT; m += NGW) {
        const f32x4* xr = (const f32x4*)(m < TP ? src0 + (size_t)m * DM : src1 + (size_t)(m - TP) * DM) + lane;
        f32x4 v[4]; float s = 0.f;
#pragma unroll
        for (int j = 0; j < 4; ++j) { v[j] = xr[64 * j]; s += (v[j].x * v[j].x + v[j].y * v[j].y) + (v[j].z * v[j].z + v[j].w * v[j].w); }
        const float rstd = rsqrtf(wave_sum(s) * (1.f / DM) + EPS);
        u32x2* o8 = (u32x2*)(H + (size_t)m * DM) + lane;
#pragma unroll
        for (int j = 0; j < 4; ++j) { u32x2 w; w.x = pk2(v[j].x * rstd * gv[j].x, v[j].y * rstd * gv[j].y); w.y = pk2(v[j].z * rstd * gv[j].z, v[j].w * rstd * gv[j].w); o8[64 * j] = w; }
    }
}
DEVI void tr_item(const float* W, int ld, int col0, bf16_t* WT, int Kd, int drow0, float scale, float* scr, int k0, int n0, int lane) {
#pragma unroll 8
    for (int i = 0; i < 32; ++i) { const int kk = 2 * i + (lane >> 5); scr[kk * 33 + (lane & 31)] = W[(size_t)(k0 + kk) * ld + col0 + n0 + (lane & 31)]; }
    asm volatile("s_waitcnt lgkmcnt(0)" ::: "memory");
    const int c = lane & 7;
#pragma unroll
    for (int j = 0; j < 4; ++j) { const int n = (lane >> 3) + 8 * j; const float* s = scr + (8 * c) * 33 + n;
        u32x4 o; o.x = pk2(s[0] * scale, s[33] * scale); o.y = pk2(s[66] * scale, s[99] * scale); o.z = pk2(s[132] * scale, s[165] * scale); o.w = pk2(s[198] * scale, s[231] * scale);
        *(u32x4*)(WT + (size_t)(drow0 + n) * Kd + k0 + 8 * c) = o; }
    asm volatile("s_waitcnt lgkmcnt(0)" ::: "memory");
}
template <int MAP> DEVI bool tr_mat(int& r, const float* W, int ld, int col0, int K, int ncols, bf16_t* WT, int drow, float scale, float* scr, int lane) {
    const int nblk = ncols >> 5, cnt = (K >> 6) * nblk;
    if (r >= cnt) { r -= cnt; return false; }
    const int kb = r / nblk, nb = r - kb * nblk, n0 = nb * 32;
    int d0 = drow + n0;
    if (MAP == 1) d0 = (n0 >> 7) * 256 + (n0 & 127);
    if (MAP == 2) d0 = (n0 >> 7) * 256 + 128 + (n0 & 127);
    tr_item(W, ld, col0, WT, K, d0, scale, scr, kb * 64, n0, lane);
    return true;
}

constexpr int GP = 144;
constexpr int L_QF = 0, L_QB = 9216, L_KF = 18432, L_KB = 27648, L_VT = 36864, L_ATF = 55296, L_ATB = 64512, L_SPF = 73728, L_SPB = 92160, L_SEG = 110592;
constexpr int L_KDF = 0, L_KDB = 9216;
DEVI int crow(int r, int hi) { return (r & 3) + 8 * (r >> 2) + 4 * hi; }
DEVI bf16x8 ldf(const unsigned char* base, int row, int ks, int hi) { return *(const bf16x8*)(base + row * GP + ks * 32 + hi * 16); }

DEVI void gla_prefix(const float* G, int tok0, int h, float* SEG, int tid, float (&bF)[8], float (&bB)[8], float& totF, float& totB) {
    const int d = tid & 63, sg = tid >> 6;
    float gf[8], gb[8];
#pragma unroll
    for (int i = 0; i < 8; ++i) { const float* p = G + (size_t)(tok0 + 8 * sg + i) * 512 + h * 64 + d; gf[i] = p[0]; gb[i] = p[256]; }
    bF[0] = gf[0];
#pragma unroll
    for (int i = 1; i < 8; ++i) bF[i] = bF[i - 1] + gf[i];
    bB[7] = gb[7];
#pragma unroll
    for (int i = 6; i >= 0; --i) bB[i] = bB[i + 1] + gb[i];
    SEG[sg * 64 + d] = bF[7]; SEG[512 + sg * 64 + d] = bB[0];
    __syncthreads();
    float offF = 0.f, offB = 0.f; totF = 0.f; totB = 0.f;
#pragma unroll
    for (int s = 0; s < 8; ++s) { const float a = SEG[s * 64 + d], b = SEG[512 + s * 64 + d]; totF += a; totB += b; if (s < sg) offF += a; if (s > sg) offB += b; }
#pragma unroll
    for (int i = 0; i < 8; ++i) { bF[i] += offF; bB[i] += offB; }
}
DEVI void gla_stage_vt(const bf16_t* QKVR, int tok0, int h, unsigned char* VT, int tid) {
    const int e = tid & 127, s4 = tid >> 7;
    unsigned w[8];
#pragma unroll
    for (int i = 0; i < 8; ++i) {
        const unsigned lo = QKVR[(size_t)(tok0 + 16 * s4 + 2 * i) * 1536 + 512 + h * 128 + e], hi = QKVR[(size_t)(tok0 + 16 * s4 + 2 * i + 1) * 1536 + 512 + h * 128 + e];
        w[i] = lo | (hi << 16); }
    u32x4 a = {w[0], w[1], w[2], w[3]}, b = {w[4], w[5], w[6], w[7]};
    *(u32x4*)(VT + e * GP + s4 * 32) = a; *(u32x4*)(VT + e * GP + s4 * 32 + 16) = b;
}
DEVI void gla_a_item(int item, const bf16_t* QKVR, const float* G, bf16_t* DST, float* DEC, unsigned char* lds, int tid, int wave, int lane) {
    const int n = item >> 2, h = item & 3, tok0 = n * 64, d = tid & 63, sg = tid >> 6;
    float bF[8], bB[8], totF, totB;
    gla_prefix(G, tok0, h, (float*)(lds + L_SEG), tid, bF, bB, totF, totB);
    float kf[8], kb[8];
#pragma unroll
    for (int i = 0; i < 8; ++i) { const float kk = bf2f(QKVR[(size_t)(tok0 + 8 * sg + i) * 1536 + 256 + h * 64 + d]); kf[i] = kk * __expf(totF - bF[i]); kb[i] = kk * __expf(totB - bB[i]); }
    { u32x4 a = {pk2(kf[0], kf[1]), pk2(kf[2], kf[3]), pk2(kf[4], kf[5]), pk2(kf[6], kf[7])}, b = {pk2(kb[0], kb[1]), pk2(kb[2], kb[3]), pk2(kb[4], kb[5]), pk2(kb[6], kb[7])};
      *(u32x4*)(lds + L_KDF + d * GP + sg * 16) = a; *(u32x4*)(lds + L_KDB + d * GP + sg * 16) = b; }
    if (sg == 0) { DEC[(size_t)(item * 2) * 64 + d] = __expf(totF); DEC[(size_t)(item * 2 + 1) * 64 + d] = __expf(totB); }
    gla_stage_vt(QKVR, tok0, h, lds + L_VT, tid);
    __syncthreads();
    { const int dir = wave >> 2, et = wave & 3, r32 = lane & 31, hi = lane >> 5;
      const unsigned char* KD = lds + (dir ? L_KDB : L_KDF);
      f32x16 c0 = {}, c1 = {};
#pragma unroll
      for (int ks = 0; ks < 4; ++ks) { const bf16x8 b = ldf(lds + L_VT, 32 * et + r32, ks, hi), a0 = ldf(KD, r32, ks, hi), a1 = ldf(KD, 32 + r32, ks, hi);
          c0 = __builtin_amdgcn_mfma_f32_32x32x16_bf16(a0, b, c0, 0, 0, 0); c1 = __builtin_amdgcn_mfma_f32_32x32x16_bf16(a1, b, c1, 0, 0, 0); }
      bf16_t* dst = DST + (size_t)(item * 2 + dir) * 8192 + (32 * et + r32) * 64 + 4 * hi;
#pragma unroll
      for (int q = 0; q < 4; ++q) { u32x2 w0 = {pk2(c0[4 * q], c0[4 * q + 1]), pk2(c0[4 * q + 2], c0[4 * q + 3])}, w1 = {pk2(c1[4 * q], c1[4 * q + 1]), pk2(c1[4 * q + 2], c1[4 * q + 3])};
          *(u32x2*)(dst + 8 * q) = w0; *(u32x2*)(dst + 32 + 8 * q) = w1; } }
    __syncthreads();
}
DEVI void p_scan(bf16_t* DST, const float* DEC, int gt) {
    const int combo = gt >> 10, el = gt & 1023, e = el >> 3, d0 = (el & 7) * 8;
    const int seq = combo >> 3, h = (combo >> 1) & 3, dir = combo & 1;
    const int nch = seq < 8 ? 64 : 32, n0 = seq < 8 ? seq * 64 : 512 + (seq - 8) * 32;
    float S[8];
#pragma unroll
    for (int j = 0; j < 8; ++j) S[j] = 0.f;
    for (int st0 = 0; st0 < nch; st0 += 4) {
        u32x4 ds[4]; f32x4 dc0[4], dc1[4];
#pragma unroll
        for (int u = 0; u < 4; ++u) { const int n = dir ? nch - 1 - (st0 + u) : st0 + u; const size_t item = (size_t)((n0 + n) * 4 + h) * 2 + dir;
            ds[u] = *(const u32x4*)(DST + item * 8192 + e * 64 + d0); dc0[u] = *(const f32x4*)(DEC + item * 64 + d0); dc1[u] = *(const f32x4*)(DEC + item * 64 + d0 + 4); }
#pragma unroll
        for (int u = 0; u < 4; ++u) { const int n = dir ? nch - 1 - (st0 + u) : st0 + u; const size_t item = (size_t)((n0 + n) * 4 + h) * 2 + dir;
            u32x4 w = {pk2(S[0], S[1]), pk2(S[2], S[3]), pk2(S[4], S[5]), pk2(S[6], S[7])};
            *(u32x4*)(DST + item * 8192 + e * 64 + d0) = w;
            S[0] = dc0[u][0] * S[0] + __uint_as_float(ds[u][0] << 16); S[1] = dc0[u][1] * S[1] + __uint_as_float(ds[u][0] & 0xffff0000u);
            S[2] = dc0[u][2] * S[2] + __uint_as_float(ds[u][1] << 16); S[3] = dc0[u][3] * S[3] + __uint_as_float(ds[u][1] & 0xffff0000u);
            S[4] = dc1[u][0] * S[4] + __uint_as_float(ds[u][2] << 16); S[5] = dc1[u][1] * S[5] + __uint_as_float(ds[u][2] & 0xffff0000u);
            S[6] = dc1[u][2] * S[6] + __uint_as_float(ds[u][3] << 16); S[7] = dc1[u][3] * S[7] + __uint_as_float(ds[u][3] & 0xffff0000u); }
    }
}
DEVI void gla_c_item(int item, const bf16_t* QKVR, const float* G, const bf16_t* DST, const float* outg, bf16_t* MIX, unsigned char* lds, int tid, int wave, int lane) {
    const int n = item >> 2, h = item & 3, tok0 = n * 64, d = tid & 63, sg = tid >> 6, r32 = lane & 31, hi = lane >> 5;
    float bF[8], bB[8], totF, totB;
    gla_prefix(G, tok0, h, (float*)(lds + L_SEG), tid, bF, bB, totF, totB);
    bf16_t* QF = (bf16_t*)(lds + L_QF); bf16_t* QB = (bf16_t*)(lds + L_QB); bf16_t* KF = (bf16_t*)(lds + L_KF); bf16_t* KB = (bf16_t*)(lds + L_KB);
#pragma unroll
    for (int i = 0; i < 8; ++i) { const bf16_t* tr = QKVR + (size_t)(tok0 + 8 * sg + i) * 1536 + h * 64 + d; const float qv = bf2f(tr[0]), kv = bf2f(tr[256]);
        const int o = (8 * sg + i) * (GP / 2) + d;
        QF[o] = f2bf(qv * __expf(bF[i])); KF[o] = f2bf(kv * __expf(-bF[i])); QB[o] = f2bf(qv * __expf(bB[i])); KB[o] = f2bf(kv * __expf(-bB[i])); }
    gla_stage_vt(QKVR, tok0, h, lds + L_VT, tid);
#pragma unroll
    for (int p = 0; p < 2; ++p) { const int row = (tid >> 3) + 64 * p, c = tid & 7;
        *(u32x4*)(lds + L_SPF + row * GP + c * 16) = *(const u32x4*)(DST + (size_t)(item * 2) * 8192 + row * 64 + c * 8);
        *(u32x4*)(lds + L_SPB + row * GP + c * 16) = *(const u32x4*)(DST + (size_t)(item * 2 + 1) * 8192 + row * 64 + c * 8); }
    __syncthreads();
    { const int dir = wave >> 2, it = (wave >> 1) & 1, jt = wave & 1;
      const unsigned char* Qd = lds + (dir ? L_QB : L_QF); const unsigned char* Kd = lds + (dir ? L_KB : L_KF);
      f32x16 c = {};
#pragma unroll
      for (int ks = 0; ks < 4; ++ks) c = __builtin_amdgcn_mfma_f32_32x32x16_bf16(ldf(Qd, 32 * it + r32, ks, hi), ldf(Kd, 32 * jt + r32, ks, hi), c, 0, 0, 0);
      bf16_t* AT = (bf16_t*)(lds + (dir ? L_ATB : L_ATF));
      const int j = 32 * jt + r32;
#pragma unroll
      for (int r = 0; r < 16; ++r) { const int i = 32 * it + crow(r, hi); const bool keep = dir ? (j >= i) : (j <= i); AT[i * (GP / 2) + j] = f2bf(keep ? c[r] : 0.f); } }
    __syncthreads();
    { const int it = wave >> 2, et = wave & 3;
      f32x16 o = {};
#pragma unroll
      for (int dir = 0; dir < 2; ++dir) {
          const unsigned char* AT = lds + (dir ? L_ATB : L_ATF); const unsigned char* Qd = lds + (dir ? L_QB : L_QF); const unsigned char* SPd = lds + (dir ? L_SPB : L_SPF);
#pragma unroll
          for (int ks = 0; ks < 4; ++ks) o = __builtin_amdgcn_mfma_f32_32x32x16_bf16(ldf(AT, 32 * it + r32, ks, hi), ldf(lds + L_VT, 32 * et + r32, ks, hi), o, 0, 0, 0);
#pragma unroll
          for (int ks = 0; ks < 4; ++ks) o = __builtin_amdgcn_mfma_f32_32x32x16_bf16(ldf(Qd, 32 * it + r32, ks, hi), ldf(SPd, 32 * et + r32, ks, hi), o, 0, 0, 0); }
      __syncthreads();
      float* OB = (float*)lds;
#pragma unroll
      for (int r = 0; r < 16; ++r) OB[(32 * it + crow(r, hi)) * 132 + 32 * et + r32] = o[r]; }
    __syncthreads();
    { const int i = tid >> 3, s8 = tid & 7; const float* OB = (const float*)lds + i * 132 + 16 * s8;
      f32x4 v[4]; float ss = 0.f;
#pragma unroll
      for (int q = 0; q < 4; ++q) { v[q] = *(const f32x4*)(OB + 4 * q); ss += (v[q].x * v[q].x + v[q].y * v[q].y) + (v[q].z * v[q].z + v[q].w * v[q].w); }
      ss += __shfl_xor(ss, 1); ss += __shfl_xor(ss, 2); ss += __shfl_xor(ss, 4);
      const float rstd = rsqrtf(ss * (1.f / 128.f) + EPS);
      const int tok = tok0 + i;
      const u32x4 r0 = *(const u32x4*)(QKVR + (size_t)tok * 1536 + 1024 + h * 128 + 16 * s8), r1 = *(const u32x4*)(QKVR + (size_t)tok * 1536 + 1024 + h * 128 + 16 * s8 + 8);
      float y[16];
#pragma unroll
      for (int q = 0; q < 4; ++q) { const f32x4 g = *(const f32x4*)(outg + 16 * s8 + 4 * q);
          const unsigned w0 = q < 2 ? r0[2 * q] : r1[2 * (q - 2)], w1 = q < 2 ? r0[2 * q + 1] : r1[2 * (q - 2) + 1];
          y[4 * q + 0] = v[q].x * rstd * g.x * silu(__uint_as_float(w0 << 16)); y[4 * q + 1] = v[q].y * rstd * g.y * silu(__uint_as_float(w0 & 0xffff0000u));
          y[4 * q + 2] = v[q].z * rstd * g.z * silu(__uint_as_float(w1 << 16)); y[4 * q + 3] = v[q].w * rstd * g.w * silu(__uint_as_float(w1 & 0xffff0000u)); }
      u32x4 a = {pk2(y[0], y[1]), pk2(y[2], y[3]), pk2(y[4], y[5]), pk2(y[6], y[7])}, b = {pk2(y[8], y[9]), pk2(y[10], y[11]), pk2(y[12], y[13]), pk2(y[14], y[15])};
      bf16_t* mp = MIX + (size_t)tok * 1024 + h * 128 + 16 * s8;
      *(u32x4*)mp = a; *(u32x4*)(mp + 8) = b; }
    __syncthreads();
}

DEVI void p_qkrope(bf16_t* Q, bf16_t* K, const float* qg, const float* kg, const float2* rope, int gw, int NGW, int lane) {
    const int i = lane & 31, hh = lane >> 5;
    float gq[4], gk[4];
#pragma unroll
    for (int j = 0; j < 4; ++j) { gq[j] = qg[32 * j + i]; gk[j] = kg[32 * j + i]; }
    for (int t = gw; t < TT; t += NGW) {
        const int s = t < TP ? (t & 4095) : ((t - TP) & 2047);
        const float2 rr = rope[(s >> 6) * 32 + i], rc = rope[(s & 63) * 32 + i];
#pragma unroll
        for (int p = 0; p < 5; ++p) {
            const int slot = 2 * p + hh;
            bf16_t* base = slot < 8 ? Q + (size_t)t * 1024 + slot * 128 : K + (size_t)t * 256 + (slot - 8) * 128;
            float x[4]; float ss = 0.f;
#pragma unroll
            for (int j = 0; j < 4; ++j) { x[j] = bf2f(base[32 * j + i]); ss += x[j] * x[j]; }
            ss += __shfl_xor(ss, 1); ss += __shfl_xor(ss, 2); ss += __shfl_xor(ss, 4); ss += __shfl_xor(ss, 8); ss += __shfl_xor(ss, 16);
            const float rstd = rsqrtf(ss * (1.f / 128.f) + EPS);
#pragma unroll
            for (int j = 0; j < 4; ++j) x[j] *= rstd * (slot < 8 ? gq[j] : gk[j]);
            base[i] = f2bf(x[0] * rr.x - x[1] * rr.y); base[32 + i] = f2bf(x[1] * rr.x + x[0] * rr.y);
            base[64 + i] = f2bf(x[2] * rc.x - x[3] * rc.y); base[96 + i] = f2bf(x[3] * rc.x + x[2] * rc.y);
        }
    }
}
namespace attn {
using bf16 = unsigned short;
constexpr int   D = 128, NW = 8, QBLK = 32, KVBLK = 64;
constexpr float SCALE = 0.088388347648318440f;
constexpr float THR = 8.f;
constexpr int SDEPTH = 2;
constexpr int LDQ = 1024, LDK = 256, LDO = 1024;
constexpr size_t SHM_V = KVBLK * D * 2, SHM_K = KVBLK * D * 2, SHM_ATTN = 2 * SHM_V + 2 * SHM_K + NW * 64 * 4;
using bf16x8 = __attribute__((ext_vector_type(8))) short;
using s16x4  = __attribute__((ext_vector_type(4))) short;
using f32x16 = __attribute__((ext_vector_type(16))) float;
using f32x8  = __attribute__((ext_vector_type(8))) float;
using u32x4  = __attribute__((ext_vector_type(4))) unsigned;
#define KSWZ(row, colB) ((row) * 256 + ((colB) ^ (((row) & 7) << 4)))
#define SBAR() __builtin_amdgcn_sched_barrier(0)
__device__ __forceinline__ int crow(int r, int hi) { return (r & 3) + 8 * (r >> 2) + 4 * hi; }
__device__ __forceinline__ unsigned cvtpk(float lo, float hi) {
  unsigned r; asm volatile("v_cvt_pk_bf16_f32 %0, %1, %2" : "=v"(r) : "v"(lo), "v"(hi)); return r;
}
template <typename TIn> struct Stage;
template <> struct Stage<bf16>  { using T = bf16x8;
  __device__ static __forceinline__ T ld8(const bf16* p) { return *reinterpret_cast<const bf16x8*>(p); }
  __device__ static __forceinline__ bf16x8 tobf(T x) { return x; } };
template <> struct Stage<float> { using T = f32x8;
  __device__ static __forceinline__ T ld8(const float* p) { return *reinterpret_cast<const f32x8*>(p); }
  __device__ static __forceinline__ bf16x8 tobf(T x) {
    u32x4 w = {cvtpk(x[0], x[1]), cvtpk(x[2], x[3]), cvtpk(x[4], x[5]), cvtpk(x[6], x[7])}; return *reinterpret_cast<bf16x8*>(&w); } };

__device__ __forceinline__ void partialSM(f32x16& p0, f32x16& p1, float& m_reg, float& mn, float& alpha) {
  constexpr float C = SCALE * 1.4426950408889634f;
  float pmax = p0[0]; for (int r = 1; r < 16; ++r) pmax = fmaxf(pmax, p0[r]); for (int r = 0; r < 16; ++r) pmax = fmaxf(pmax, p1[r]);
  { auto rr = __builtin_amdgcn_permlane32_swap(__float_as_uint(pmax), __float_as_uint(pmax), false, false);
    pmax = fmaxf(__uint_as_float(rr[0]), __uint_as_float(rr[1])); }
  if (__builtin_expect(__all(pmax - m_reg <= THR / SCALE), 1)) { mn = m_reg; alpha = 1.f; }
  else { mn = fmaxf(m_reg, pmax); alpha = __builtin_amdgcn_exp2f((m_reg - mn) * C); m_reg = mn; }
  float mnC = -mn * C;
  for (int r = 0; r < 16; ++r) p0[r] = fmaf(p0[r], C, mnC); for (int r = 0; r < 16; ++r) p1[r] = fmaf(p1[r], C, mnC);
  for (int r = 0; r < 16; ++r) p0[r] = __builtin_amdgcn_exp2f(p0[r]);
}
__device__ __forceinline__ void finishSM(f32x16& p0, f32x16& p1, float alpha, float& l_reg, bf16x8& pa0, bf16x8& pa1, bf16x8& pa2, bf16x8& pa3) {
  for (int r = 0; r < 16; ++r) p1[r] = __builtin_amdgcn_exp2f(p1[r]);
  float ps = 0; for (int r = 0; r < 16; ++r) ps += p0[r]; for (int r = 0; r < 16; ++r) ps += p1[r];
  { auto rr = __builtin_amdgcn_permlane32_swap(__float_as_uint(ps), __float_as_uint(ps), false, false);
    ps = __uint_as_float(rr[0]) + __uint_as_float(rr[1]); }
  l_reg = l_reg * alpha + ps;
#define PK4(P, BASE, OUT) do { unsigned a0 = cvtpk(P[BASE + 0], P[BASE + 1]), a1 = cvtpk(P[BASE + 2], P[BASE + 3]);   \
    unsigned b0 = cvtpk(P[BASE + 4], P[BASE + 5]), b1 = cvtpk(P[BASE + 6], P[BASE + 7]);                              \
    auto r0 = __builtin_amdgcn_permlane32_swap(a0, b0, false, false); auto r1 = __builtin_amdgcn_permlane32_swap(a1, b1, false, false); \
    u32x4 w = {r0[0], r1[0], r0[1], r1[1]}; OUT = *reinterpret_cast<bf16x8*>(&w); } while (0)
  PK4(p0, 0, pa0); PK4(p0, 8, pa1); PK4(p1, 0, pa2); PK4(p1, 8, pa3);
#undef PK4
}
__device__ __forceinline__ void qkt(f32x16& p0, f32x16& p1, const bf16* Ks, const bf16x8* qr, int r32, int hi) {
  p0 = f32x16{}; p1 = f32x16{};
  for (int d0 = 0; d0 < 8; ++d0) { int cb = (d0 * 16 + hi * 8) * 2;
    bf16x8 b0 = *reinterpret_cast<const bf16x8*>((const char*)Ks + KSWZ(r32, cb));
    bf16x8 b1 = *reinterpret_cast<const bf16x8*>((const char*)Ks + KSWZ(32 + r32, cb));
    p0 = __builtin_amdgcn_mfma_f32_32x32x16_bf16(b0, qr[d0], p0, 0, 0, 0);
    p1 = __builtin_amdgcn_mfma_f32_32x32x16_bf16(b1, qr[d0], p1, 0, 0, 0); }
}
__device__ __forceinline__ int v_st(int k, int c) { const int kk = (k & ~0xC) | ((k & 4) << 1) | ((k & 8) >> 1); return ((kk >> 3) * 4 + (c >> 5)) * 512 + ((kk & 7) * 32 + (c & 31)) * 2; }
__device__ __forceinline__ int v_rd_base(int lane) { return ((lane & 3) << 3) | (((lane >> 2) & 3) << 6) | (((lane >> 4) & 1) << 5) | (((lane >> 5) & 1) << 8); }
constexpr int v_rd_off(int d0, int ks, int half) { return d0 * 512 + ks * 4096 + half * 2048; }
template <int OFF> __device__ __forceinline__ s16x4 tr_read(int vb) {
  s16x4 r; asm volatile("ds_read_b64_tr_b16 %0, %1 offset:%2" : "=&v"(r) : "v"(vb), "i"(OFF) : "memory"); return r;
}
template <int D0> __device__ __forceinline__ void pv_one(f32x16& od, int vb, bf16x8 pa0, bf16x8 pa1, bf16x8 pa2, bf16x8 pa3) {
  const s16x4 l0 = tr_read<v_rd_off(D0, 0, 0)>(vb), h0 = tr_read<v_rd_off(D0, 0, 1)>(vb), l1 = tr_read<v_rd_off(D0, 1, 0)>(vb), h1 = tr_read<v_rd_off(D0, 1, 1)>(vb);
  const s16x4 l2 = tr_read<v_rd_off(D0, 2, 0)>(vb), h2 = tr_read<v_rd_off(D0, 2, 1)>(vb), l3 = tr_read<v_rd_off(D0, 3, 0)>(vb), h3 = tr_read<v_rd_off(D0, 3, 1)>(vb);
  asm volatile("s_waitcnt lgkmcnt(0)" ::: "memory"); SBAR();
#define PK(L, H) (bf16x8){L[0], L[1], L[2], L[3], H[0], H[1], H[2], H[3]}
  od = __builtin_amdgcn_mfma_f32_32x32x16_bf16(pa0, PK(l0, h0), od, 0, 0, 0);
  od = __builtin_amdgcn_mfma_f32_32x32x16_bf16(pa1, PK(l1, h1), od, 0, 0, 0);
  od = __builtin_amdgcn_mfma_f32_32x32x16_bf16(pa2, PK(l2, h2), od, 0, 0, 0);
  od = __builtin_amdgcn_mfma_f32_32x32x16_bf16(pa3, PK(l3, h3), od, 0, 0, 0);
#undef PK
}
__device__ __forceinline__ void pv_d0(f32x16* o, int vb, bf16x8 pa0, bf16x8 pa1, bf16x8 pa2, bf16x8 pa3) {
  pv_one<0>(o[0], vb, pa0, pa1, pa2, pa3); pv_one<1>(o[1], vb, pa0, pa1, pa2, pa3); pv_one<2>(o[2], vb, pa0, pa1, pa2, pa3); pv_one<3>(o[3], vb, pa0, pa1, pa2, pa3);
}

template <typename TQ>
__device__ __forceinline__ void attn_dense_body(const TQ* __restrict__ Qb, const bf16* __restrict__ Kh, const bf16* __restrict__ Vh,
                                                bf16* __restrict__ Ob, int seq, char* lds) {
  using St = Stage<bf16>; using SQ = Stage<TQ>;
  const int tid = threadIdx.x, wid = __builtin_amdgcn_readfirstlane(tid >> 6), lane = tid & 63, r32 = lane & 31, hi = lane >> 5;
  bf16* V_lds = (bf16*)lds; bf16* K_lds = (bf16*)(lds + 2 * SHM_V);
  float* ws = (float*)(lds + 2 * SHM_V + 2 * SHM_K) + wid * 64; float* li_l = ws; float* al_l = ws + 32;
  float m_reg = -1e30f, l_reg = 0; f32x16 o[4] = {}; bf16x8 qr[8];
  const TQ* Qw = Qb + (long)(wid * QBLK + r32) * LDQ + hi * 8;
#pragma unroll
  for (int d0 = 0; d0 < 8; ++d0) qr[d0] = SQ::tobf(SQ::ld8(Qw + d0 * 16));
  const int sr = tid >> 4, sc = (tid & 15) * 8, vst0 = v_st(sr, sc), vst1 = v_st(32 + sr, sc);
  const int vb0 = (int)(uintptr_t)V_lds + v_rd_base(lane);
  struct { typename St::T vs0, vs1, ks0, ks1; } sr_[SDEPTH];
#define SLOAD(i, k0) do { sr_[i].vs0 = St::ld8(&Vh[(long)((k0) + sr) * LDK + sc]); sr_[i].vs1 = St::ld8(&Vh[(long)((k0) + 32 + sr) * LDK + sc]); \
    sr_[i].ks0 = St::ld8(&Kh[(long)((k0) + sr) * LDK + sc]); sr_[i].ks1 = St::ld8(&Kh[(long)((k0) + 32 + sr) * LDK + sc]); } while (0)
#define SWRITE(b, i) do { *(bf16x8*)((char*)V_lds + (b) * SHM_V + vst0) = St::tobf(sr_[i].vs0);          \
    *(bf16x8*)((char*)V_lds + (b) * SHM_V + vst1) = St::tobf(sr_[i].vs1); int kc = sc * 2;               \
    *(bf16x8*)((char*)K_lds + (b) * SHM_K + KSWZ(sr, kc)) = St::tobf(sr_[i].ks0);                       \
    *(bf16x8*)((char*)K_lds + (b) * SHM_K + KSWZ(32 + sr, kc)) = St::tobf(sr_[i].ks1); } while (0)
#define SWAIT() do { if constexpr (SDEPTH == 2) asm volatile("s_waitcnt vmcnt(4)" ::: "memory"); else asm volatile("s_waitcnt vmcnt(0)" ::: "memory"); } while (0)
#define RESC(a) do { if (__any((a) < 1.f)) { if (hi == 0) al_l[r32] = (a); asm volatile("s_waitcnt lgkmcnt(0)" ::: "memory"); \
    for (int d = 0; d < 4; ++d) for (int r = 0; r < 16; ++r) o[d][r] *= al_l[crow(r, hi)]; } } while (0)
  f32x16 pA0, pA1, pB0, pB1; float mnA, mnB, alA, alB; bf16x8 pa0, pa1, pa2, pa3; const int NT = seq / KVBLK;
  constexpr int SE = 0, SO = SDEPTH - 1;
  SLOAD(SE, 0); asm volatile("s_waitcnt vmcnt(0)" ::: "memory"); SWRITE(0, SE); __syncthreads();
  qkt(pA0, pA1, K_lds, qr, r32, hi); partialSM(pA0, pA1, m_reg, mnA, alA);
  SLOAD(SO, KVBLK); if constexpr (SDEPTH == 2) { if (2 < NT) SLOAD(SE, 2 * KVBLK); }
  SWAIT(); SWRITE(1, SO); __syncthreads();
  for (int j = 1; j + 1 < NT; j += 2) {
    SBAR(); qkt(pB0, pB1, (bf16*)((char*)K_lds + SHM_K), qr, r32, hi);
    finishSM(pA0, pA1, alA, l_reg, pa0, pa1, pa2, pa3); SBAR();
    SLOAD(SO, (j + SDEPTH) * KVBLK); SBAR();
    pv_d0(o, vb0, pa0, pa1, pa2, pa3); partialSM(pB0, pB1, m_reg, mnB, alB);
    __syncthreads(); SWAIT(); SWRITE(0, SE);
    RESC(alB); __syncthreads();
    SBAR(); qkt(pA0, pA1, K_lds, qr, r32, hi);
    finishSM(pB0, pB1, alB, l_reg, pa0, pa1, pa2, pa3); SBAR();
    if (SDEPTH == 1 || j + 3 < NT) SLOAD(SE, (j + 1 + SDEPTH) * KVBLK); SBAR();
    pv_d0(o, vb0 + (int)SHM_V, pa0, pa1, pa2, pa3); partialSM(pA0, pA1, m_reg, mnA, alA);
    __syncthreads(); SWAIT(); SWRITE(1, SO);
    RESC(alA); __syncthreads();
  }
  SBAR(); qkt(pB0, pB1, (bf16*)((char*)K_lds + SHM_K), qr, r32, hi);
  finishSM(pA0, pA1, alA, l_reg, pa0, pa1, pa2, pa3); SBAR();
  pv_d0(o, vb0, pa0, pa1, pa2, pa3); partialSM(pB0, pB1, m_reg, mnB, alB);
  __syncthreads(); RESC(alB);
  finishSM(pB0, pB1, alB, l_reg, pa0, pa1, pa2, pa3); SBAR();
  pv_d0(o, vb0 + (int)SHM_V, pa0, pa1, pa2, pa3);
  if (hi == 0) li_l[r32] = l_reg; asm volatile("s_waitcnt lgkmcnt(0)" ::: "memory");
  float rli[16];
#pragma unroll
  for (int r = 0; r < 16; ++r) rli[r] = __builtin_amdgcn_rcpf(li_l[crow(r, hi)]);
  bf16* Ow = Ob + (long)(wid * QBLK) * LDO;
#pragma unroll
  for (int r = 0; r < 16; ++r) { int orow = crow(r, hi);
    for (int d0 = 0; d0 < 4; ++d0) Ow[(long)orow * LDO + d0 * 32 + r32] = (bf16)(cvtpk(o[d0][r] * rli[r], 0.f) & 0xffffu); }
#undef SLOAD
#undef SWRITE
#undef SWAIT
#undef RESC
}

#undef KSWZ
#undef SBAR
}

constexpr int LDS_BYTES = 135168;
struct Args { const float* in[19]; float* out; unsigned char* ws; };
#define LAS3 __attribute__((address_space(3)))

#define RLX_AGENT __ATOMIC_RELAXED, __HIP_MEMORY_SCOPE_AGENT
#define XB_TMO      128
#define XB_XCNT(j)  (256  + 64 * (j))
#define XB_XSUB(j)  (1280 + 64 * (j))
#define XB_XGEN(j)  (2304 + 64 * (j))
#define XB_TOP      3328
#define XB_TOPGEN   3392
#define XCD_BAR_WORDS 3456
#define XB_SPIN_CAP (1u << 18)

__device__ __forceinline__ unsigned xb_ld(unsigned* p)              { return __hip_atomic_load(p, __ATOMIC_RELAXED, __HIP_MEMORY_SCOPE_AGENT); }
__device__ __forceinline__ unsigned xb_add(unsigned* p, unsigned v) { return __hip_atomic_fetch_add(p, v, __ATOMIC_RELAXED, __HIP_MEMORY_SCOPE_AGENT); }
__device__ __forceinline__ unsigned xb_xcc_id() { return (unsigned)__builtin_amdgcn_s_getreg((3 << 11) | 20) & 0xFu; }
#define XB_SPIN(cond, bar) do { unsigned _sp = 0; while (cond) { __builtin_amdgcn_s_sleep(1); \
    if ((++_sp & 255u) == 0u) { if (xb_ld(&(bar)[XB_TMO])) break; if (_sp > XB_SPIN_CAP) { atomicAdd(&(bar)[XB_TMO], 1u); break; } } } } while (0)

struct XcdBarrier {
    unsigned* bar; unsigned x;
    volatile LAS3 unsigned* st;
};

__device__ __forceinline__ XcdBarrier xcd_barrier_post(unsigned* bar, volatile LAS3 unsigned* st) {
    XcdBarrier b; b.bar = bar; b.x = xb_xcc_id(); b.st = st;
    if (threadIdx.x == 0) (void)xb_add(&bar[XB_XCNT(b.x)], 1u);
    return b;
}
__device__ __forceinline__ void xcd_barrier_complete(unsigned* bar, unsigned x, unsigned& nloc, unsigned& nx) {
    const unsigned G = gridDim.x * gridDim.y * gridDim.z;
    unsigned sum, cnt, mine, sp = 0u;
    for (;;) {
        sum = 0u; cnt = 0u; mine = 0u;
#pragma unroll
        for (unsigned j = 0; j < 16; ++j) { const unsigned c = xb_ld(&bar[XB_XCNT(j)]); sum += c; cnt += (c > 0u) ? 1u : 0u; mine = (j == x) ? c : mine; }
        if (sum == G) break;
        __builtin_amdgcn_s_sleep(1);
        if ((++sp & 255u) == 0u) { if (xb_ld(&bar[XB_TMO])) break; if (sp > XB_SPIN_CAP) { atomicAdd(&bar[XB_TMO], 1u); break; } }
    }
    nloc = mine > 0u ? mine : 1u; nx = cnt > 0u ? cnt : 1u;
}

__device__ __forceinline__ void xcd_barrier(const XcdBarrier& b) {
    asm volatile("s_waitcnt vmcnt(0)" ::: "memory");
    __syncthreads();
    if (threadIdx.x == 0) {
        unsigned* bar = b.bar;
        __builtin_amdgcn_s_waitcnt(0);
        unsigned nloc = b.st[0], nx = b.st[1];
        if (nloc == 0u) { xcd_barrier_complete(bar, b.x, nloc, nx); b.st[0] = nloc; b.st[1] = nx; }
        const unsigned old = xb_add(&bar[XB_XSUB(b.x)], 1u);
        const unsigned gen = old / nloc;
        if (old + 1u == (gen + 1u) * nloc) {
            __builtin_amdgcn_fence(__ATOMIC_RELEASE, "agent");
            asm volatile("s_waitcnt vmcnt(0)" ::: "memory");
            const unsigned og = xb_add(&bar[XB_TOP], 1u);
            const unsigned tg = og / nx;
            if (og + 1u == (tg + 1u) * nx) xb_add(&bar[XB_TOPGEN], 1u);
            else XB_SPIN(xb_ld(&bar[XB_TOPGEN]) == tg, bar);
            __builtin_amdgcn_fence(__ATOMIC_ACQUIRE, "agent");
            xb_add(&bar[XB_XGEN(b.x)], 1u);
            asm volatile("s_waitcnt vmcnt(0)" ::: "memory");
        } else {
            XB_SPIN(xb_ld(&bar[XB_XGEN(b.x)]) == gen, bar);
            __builtin_amdgcn_fence(__ATOMIC_ACQUIRE, "agent");
            asm volatile("s_waitcnt vmcnt(0)" ::: "memory");
        }
    }
    __syncthreads();
}

constexpr int MISC_OFF = 131072;
constexpr int CW_BAR = 4096;
typedef const __attribute__((address_space(4))) Args* CArgsP;
#ifndef PHM
#define PHM 0xFFFFFFu
#endif
#ifndef PROBE_GLU
#define PROBE_GLU 0
#endif
#ifndef PROBE_ATTN
#define PROBE_ATTN 0
#endif
#define PH(b) ((PHM >> (b)) & 1u)
#define PHASE_VARS \
    CArgsP ap = (CArgsP)__builtin_amdgcn_kernarg_segment_ptr(); asm volatile("" : "+s"(ap)); \
    int tid = threadIdx.x; asm volatile("" : "+v"(tid)); \
    const int lane = tid & 63, wave = __builtin_amdgcn_readfirstlane(tid >> 6); \
    const int G = gridDim.x, bx = blockIdx.x, gw = bx * 8 + wave, NGW = G * 8, gt = bx * 512 + tid, NGT = G * 512; \
    unsigned char* ws = ap->ws; float* out = ap->out; bf16_t* H = (bf16_t*)(ws + WS_H); \
    (void)lane; (void)gw; (void)NGW; (void)gt; (void)NGT; (void)out; (void)H; (void)bx; (void)G;
#define GRID_SYNC_CG() cg::this_grid().sync()
#define GRID_SYNC() do { CArgsP ap_ = (CArgsP)__builtin_amdgcn_kernarg_segment_ptr(); asm volatile("" : "+s"(ap_)); \
    XcdBarrier b_; b_.bar = (unsigned*)(ap_->ws + WS_CTL) + CW_BAR; b_.x = xb_xcc_id(); b_.st = (volatile LAS3 unsigned*)(lds3 + MISC_OFF); xcd_barrier(b_); } while (0)

template <int LAYER> DEVI void ffn_block(LAS3 unsigned char* lds3) {
    { PHASE_VARS
      if (PH(17)) p_norm(out, out + (size_t)TP * DM, ap->in[15] + LAYER * 1024, H, gw, NGW, lane); }
    GRID_SYNC();
    { PHASE_VARS
      for (int rep_ = 0; rep_ < (PROBE_GLU ? 2 : 1); ++rep_) if (PH(18)) { pg8::Gemm g{H, (const bf16_t*)(ws + (LAYER ? WS_W_GU1 : WS_W_GU0)), TT, 2 * FFH, 1024}; pg8::StaticOrder S; S.init(TT, 2 * FFH, G, bx);
        Epi<EM_GLU> E{(bf16_t*)(ws + WS_ACT), nullptr, nullptr, nullptr, nullptr, nullptr, nullptr, nullptr};
        pg8::gemm_phase<Epi<EM_GLU>, pg8::StaticOrder, true, true>(lds3, g, S, E); } }
    GRID_SYNC();
    { PHASE_VARS
      if (PH(19)) { pg8::Gemm g{(const bf16_t*)(ws + WS_ACT), (const bf16_t*)(ws + (LAYER ? WS_W_D1 : WS_W_D0)), TT, 1024, FFH}; pg8::StaticOrder S; S.init(TT, 1024, G, bx);
        Epi<EM_RES> E{nullptr, nullptr, nullptr, out, nullptr, nullptr, nullptr, nullptr};
        pg8::gemm_phase<Epi<EM_RES>, pg8::StaticOrder, true, true>(lds3, g, S, E); } }
}

__global__ void __launch_bounds__(512, 2) mega_fwd(Args a_unused) {
    extern __shared__ __attribute__((aligned(16))) unsigned char lds[];
    LAS3 unsigned char* lds3 = (LAS3 unsigned char*)lds;
    { if (threadIdx.x < 32) ((LAS3 unsigned*)(lds3 + MISC_OFF))[threadIdx.x] = 0u;
      __syncthreads();
      CArgsP ap0 = (CArgsP)__builtin_amdgcn_kernarg_segment_ptr();
      (void)xcd_barrier_post((unsigned*)(ap0->ws + WS_CTL) + CW_BAR, (volatile LAS3 unsigned*)(lds3 + MISC_OFF)); }
    { PHASE_VARS
      if (PH(0)) p_fold(ap->in[3], ap->in[4], ap->in[6], (float*)(ws + WS_FOLDF), (float*)(ws + WS_FOLDG), (float*)lds, gw, NGW, lane);
      if (PH(1)) { p_dft((bf16_t*)(ws + WS_DS4), 4096, 12, gt, NGT); p_dft((bf16_t*)(ws + WS_DS2), 2048, 11, gt, NGT); }
      if (gt < 2048) { const int idx = gt >> 5, i = gt & 31; const float inv = powf(10000.f, -(float)(2 * i) * (1.f / 64.f)); const float ang = (float)idx * inv;
          ((float2*)(ws + WS_ROPE))[gt] = make_float2((float)cos((double)ang), (float)sin((double)ang)); }
      if (PH(2)) p_norm(ap->in[0], ap->in[1], ap->in[2], H, gw, NGW, lane); }
    GRID_SYNC_CG();
    { PHASE_VARS
      if (PH(3)) { float* scr = (float*)(lds + wave * 16384);
      const float* win = ap->in[3];
      for (int it = gw; it < 11776; it += NGW) { int r = it;
          if (tr_mat<0>(r, win, 2080, 0, 1024, 256, (bf16_t*)(ws + WS_W_AB1), 0, 0.125f, scr, lane)) continue;
          if (tr_mat<0>(r, win, 2080, 256, 1024, 1280, (bf16_t*)(ws + WS_W_AB1), 256, 1.f, scr, lane)) continue;
          if (tr_mat<0>(r, (const float*)(ws + WS_FOLDG), 512, 0, 1024, 512, (bf16_t*)(ws + WS_W_AB1), 1536, 1.f, scr, lane)) continue;
          if (tr_mat<0>(r, (const float*)(ws + WS_FOLDF), 1024, 0, 1024, 1024, (bf16_t*)(ws + WS_W_FT), 0, 1.f, scr, lane)) continue;
          if (tr_mat<0>(r, ap->in[9], 1024, 0, 1024, 1024, (bf16_t*)(ws + WS_W_ABO), 0, 1.f, scr, lane)) continue;
          if (tr_mat<1>(r, ap->in[16], FFH, 0, 1024, FFH, (bf16_t*)(ws + WS_W_GU0), 0, 1.f, scr, lane)) continue;
          if (tr_mat<2>(r, ap->in[17], FFH, 0, 1024, FFH, (bf16_t*)(ws + WS_W_GU0), 0, 1.f, scr, lane)) continue;
          if (tr_mat<0>(r, ap->in[18], 1024, 0, FFH, 1024, (bf16_t*)(ws + WS_W_D0), 0, 1.f, scr, lane)) continue;
          if (tr_mat<0>(r, ap->in[11], 1536, 0, 1024, 1536, (bf16_t*)(ws + WS_W_QKV), 0, 1.f, scr, lane)) continue;
          if (tr_mat<0>(r, ap->in[14], 1024, 0, 1024, 1024, (bf16_t*)(ws + WS_W_CO), 0, 1.f, scr, lane)) continue;
          if (tr_mat<1>(r, ap->in[16] + (size_t)1024 * FFH, FFH, 0, 1024, FFH, (bf16_t*)(ws + WS_W_GU1), 0, 1.f, scr, lane)) continue;
          if (tr_mat<2>(r, ap->in[17] + (size_t)1024 * FFH, FFH, 0, 1024, FFH, (bf16_t*)(ws + WS_W_GU1), 0, 1.f, scr, lane)) continue;
          if (tr_mat<0>(r, ap->in[18] + (size_t)1024 * FFH, 1024, 0, FFH, 1024, (bf16_t*)(ws + WS_W_D1), 0, 1.f, scr, lane)) continue;
      } } }
    GRID_SYNC();
    { PHASE_VARS
      if (PH(4)) { pg8::Gemm g{H, (const bf16_t*)(ws + WS_W_AB1), TT, 2048, 1024}; pg8::StaticOrder S; S.init(TT, 2048, G, bx);
        Epi<EM_AB1> E{(bf16_t*)(ws + WS_QKVR), nullptr, nullptr, (float*)(ws + WS_G), nullptr, nullptr, ap->in[5], ap->in[7]};
        pg8::gemm_phase<Epi<EM_AB1>, pg8::StaticOrder, true, true>(lds3, g, S, E); } }
    { PHASE_VARS
      if (PH(5)) { pg8::Gemm g{(const bf16_t*)(ws + WS_W_FT), H, 1024, TT, 1024}; pg8::StaticOrder S; S.init(1024, TT, G, bx);
        Epi<EM_AB1T> E{(bf16_t*)((unsigned char*)out + OUT_YTP), (bf16_t*)((unsigned char*)out + OUT_YTS), nullptr, nullptr, nullptr, nullptr, nullptr, nullptr};
        pg8::gemm_phase<Epi<EM_AB1T>, pg8::StaticOrder, true, true>(lds3, g, S, E); } }
    GRID_SYNC();
    { PHASE_VARS
      if (PH(6)) { pg8::Gemm g{(const bf16_t*)(ws + WS_DS4), (const bf16_t*)((unsigned char*)out + OUT_YTP), 4096, 4096, 8192}; pg8::StaticOrder S; S.init(4096, 4096, G, bx);
        Epi<EM_FNETP> E{H, nullptr, nullptr, nullptr, nullptr, nullptr, nullptr, nullptr};
        pg8::gemm_phase<Epi<EM_FNETP>, pg8::StaticOrder, true, true>(lds3, g, S, E); } }
    { PHASE_VARS
      if (PH(7)) { pg8::Gemm g{(const bf16_t*)(ws + WS_DS2), (const bf16_t*)((unsigned char*)out + OUT_YTS), 2048, 4096, 4096}; pg8::StaticOrder S; S.init(2048, 4096, G, (bx + G / 2) % G);
        Epi<EM_FNETS> E{H, nullptr, nullptr, nullptr, nullptr, nullptr, nullptr, nullptr};
        pg8::gemm_phase<Epi<EM_FNETS>, pg8::StaticOrder, true, true>(lds3, g, S, E); } }
    { PHASE_VARS
      if (PH(8)) if (bx < G / 2) for (int item = bx; item < 3072; item += G / 2)
          gla_a_item(item, (const bf16_t*)(ws + WS_QKVR), (const float*)(ws + WS_G), (bf16_t*)((unsigned char*)out + OUT_DST), (float*)(ws + WS_DEC), lds, tid, wave, lane); }
    GRID_SYNC();
    { PHASE_VARS
      if (PH(9)) for (int g2 = gt; g2 < 131072; g2 += NGT) p_scan((bf16_t*)((unsigned char*)out + OUT_DST), (const float*)(ws + WS_DEC), g2); }
    GRID_SYNC();
    { PHASE_VARS
      if (PH(10)) for (int item = bx; item < 3072; item += G)
          gla_c_item(item, (const bf16_t*)(ws + WS_QKVR), (const float*)(ws + WS_G), (const bf16_t*)((unsigned char*)out + OUT_DST), ap->in[8], H, lds, tid, wave, lane); }
    GRID_SYNC();
    { PHASE_VARS
      if (PH(11)) { pg8::Gemm g{H, (const bf16_t*)(ws + WS_W_ABO), TT, 1024, 1024}; pg8::StaticOrder S; S.init(TT, 1024, G, bx);
        Epi<EM_RESIN> E{nullptr, nullptr, nullptr, out, ap->in[0], ap->in[1], nullptr, nullptr};
        pg8::gemm_phase<Epi<EM_RESIN>, pg8::StaticOrder, true, true>(lds3, g, S, E); } }
    GRID_SYNC();
    ffn_block<0>(lds3);
    GRID_SYNC();
    { PHASE_VARS
      if (PH(12)) p_norm(out, out + (size_t)TP * DM, ap->in[10], H, gw, NGW, lane); }
    GRID_SYNC();
    { PHASE_VARS
      if (PH(13)) { pg8::Gemm g{H, (const bf16_t*)(ws + WS_W_QKV), TT, 1536, 1024}; pg8::StaticOrder S; S.init(TT, 1536, G, bx);
        Epi<EM_QKV> E{(bf16_t*)(ws + WS_Q), (bf16_t*)(ws + WS_K), (bf16_t*)(ws + WS_V), nullptr, nullptr, nullptr, nullptr, nullptr};
        pg8::gemm_phase<Epi<EM_QKV>, pg8::StaticOrder, true, true>(lds3, g, S, E); } }
    GRID_SYNC();
    { PHASE_VARS
      if (PH(14)) p_qkrope((bf16_t*)(ws + WS_Q), (bf16_t*)(ws + WS_K), ap->in[12], ap->in[13], (const float2*)(ws + WS_ROPE), gw, NGW, lane); }
    GRID_SYNC();
    { PHASE_VARS
      if (PH(15)) { const int vx = bx & 7, vi = bx >> 3;
        bf16_t* Qb = (bf16_t*)(ws + WS_Q); bf16_t* Kb = (bf16_t*)(ws + WS_K); bf16_t* Vb = (bf16_t*)(ws + WS_V); bf16_t* AO = (bf16_t*)(ws + WS_AO);
        for (int i6 = 0; i6 < (PROBE_ATTN ? 12 : 6); ++i6) { const int i = i6 % 6;
            int b, kvh, hq, qb, row0, seq;
            if (i < 4) { const int combo = vx * 2 + (i >> 1), u = (i & 1) * 32 + vi; b = combo >> 1; kvh = combo & 1; hq = kvh * 4 + (u >> 4); qb = u & 15; row0 = b * 4096; seq = 4096; }
            else { const int combo = vx * 2 + (i - 4), u = vi; b = combo >> 1; kvh = combo & 1; hq = kvh * 4 + (u >> 3); qb = u & 7; row0 = TP + b * 2048; seq = 2048; }
            attn::attn_dense_body<attn::bf16>(Qb + (size_t)(row0 + qb * 256) * 1024 + hq * 128, Kb + (size_t)row0 * 256 + kvh * 128, Vb + (size_t)row0 * 256 + kvh * 128,
                                              AO + (size_t)(row0 + qb * 256) * 1024 + hq * 128, seq, (char*)lds);
            __syncthreads();
        } } }
    GRID_SYNC();
    { PHASE_VARS
      if (PH(16)) { pg8::Gemm g{(const bf16_t*)(ws + WS_AO), (const bf16_t*)(ws + WS_W_CO), TT, 1024, 1024}; pg8::StaticOrder S; S.init(TT, 1024, G, bx);
        Epi<EM_RES> E{nullptr, nullptr, nullptr, out, nullptr, nullptr, nullptr, nullptr};
        pg8::gemm_phase<Epi<EM_RES>, pg8::StaticOrder, true, true>(lds3, g, S, E); } }
    GRID_SYNC();
    ffn_block<1>(lds3);
}

extern "C" void kernel_launch(void* const* d_in, const int* in_sizes, int n_in, void* d_out, int out_size, void* d_ws, size_t ws_size, hipStream_t stream) {
    static int grid = 0;
    if (grid == 0) {
        int dev = 0, cus = 0, per_cu = 0;
        if (n_in != 19 || out_size != TT * DM || ws_size < WS_END) { fprintf(stderr, "kernel_launch: unexpected shapes: n_in %d out %d ws %zu (need %zu)\n", n_in, out_size, ws_size, (size_t)WS_END); grid = -1; return; }
        if (hipGetDevice(&dev) != hipSuccess || hipDeviceGetAttribute(&cus, hipDeviceAttributeMultiprocessorCount, dev) != hipSuccess) { fprintf(stderr, "kernel_launch: device query failed\n"); grid = -1; return; }
        if (hipFuncSetAttribute((const void*)mega_fwd, hipFuncAttributeMaxDynamicSharedMemorySize, LDS_BYTES) != hipSuccess) { fprintf(stderr, "kernel_launch: hipFuncSetAttribute failed\n"); grid = -1; return; }
        if (hipOccupancyMaxActiveBlocksPerMultiprocessor(&per_cu, (const void*)mega_fwd, 512, LDS_BYTES) != hipSuccess || per_cu < 1) fprintf(stderr, "kernel_launch: occupancy query reports %d blocks per CU\n", per_cu);
        (void)hipGetLastError();
        if (cus != 256) { fprintf(stderr, "kernel_launch: built for a 256-CU device, found %d\n", cus); grid = -1; return; }
        grid = 256;
    }
    if (grid < 0) return;
    if (hipMemsetAsync((char*)d_ws + WS_CTL, 0, CTL_BYTES, stream) != hipSuccess) { fprintf(stderr, "kernel_launch: memset failed\n"); return; }
    Args a{};
    for (int i = 0; i < 19; ++i) a.in[i] = (const float*)d_in[i];
    a.out = (float*)d_out; a.ws = (unsigned char*)d_ws;
    void* args[] = {&a};
    const hipError_t e = hipLaunchCooperativeKernel((const void*)mega_fwd, dim3(grid), dim3(512), args, LDS_BYTES, stream);
    if (e != hipSuccess) fprintf(stderr, "kernel_launch: cooperative launch failed: %s\n", hipGetErrorString(e));
}
```

```cpp
#include <hip/hip_runtime.h>
#include <hip/hip_cooperative_groups.h>
#include <cstdio>
#include <cstdint>
namespace cg = cooperative_groups;
#define DEVI __device__ __forceinline__
namespace pg8 {
#define PG8_LAS __attribute__((address_space(3)))
typedef unsigned short bf16_t;
typedef short bf16x8 __attribute__((ext_vector_type(8)));
typedef float f32x4 __attribute__((ext_vector_type(4)));
typedef unsigned u32x4 __attribute__((ext_vector_type(4)));
constexpr int BM = 256, BK = 64, HALF = 128, HTB = HALF * BK * 2  , STAGE_BYTES = 8 * HTB, NXCD = 8, WGM = 8;

__host__ __device__ __forceinline__ int lds_byte(int r, int c) { const int st = (r >> 4) * 2 + (c >> 5), rr = r & 15, cc = c & 31, ob = rr * 64 + cc * 2; return st * 1024 + (ob ^ (((ob >> 9) & 1) << 5)); }
__host__ __device__ __forceinline__ void stage_rc(int b, int& R, int& C) { const int st = b / 1024, sb = b % 1024, swz = sb ^ (((sb >> 9) & 1) << 5); R = (st >> 1) * 16 + swz / 64; C = (st & 1) * 32 + (swz % 64) / 2; }
__host__ __device__ __forceinline__ int perm32(int rho) { const int n = rho >> 4, i = rho & 15; return 8 * (i >> 2) + 4 * n + (i & 3); }

struct Unit { int pm, pn; };
struct Gemm { const bf16_t* A; const bf16_t* Bt; int M, N, K; };

struct StaticOrder {
    int nM, nN, nwg, G, c;
    __host__ __device__ void init(int M, int N, int G_, int c_) { nM = M / BM; nN = N / BM; nwg = nM * nN; G = G_; c = c_; }
    __host__ __device__ bool next(int i, Unit& u) const {
        const long L = (long)i * G + c; if (L >= nwg) return false;
        int wgid = (int)L; { const int q = nwg / NXCD, r = nwg % NXCD, xcd = wgid % NXCD, off = wgid / NXCD; wgid = (xcd < r ? xcd * (q + 1) : r * (q + 1) + (xcd - r) * q) + off; }
        const int nig = WGM * nN, gid = wgid / nig, fm = gid * WGM, gsz = (nM - fm) < WGM ? (nM - fm) : WGM;
        u.pm = fm + ((wgid % nig) % gsz); u.pn = (wgid % nig) / gsz; return true;
    }
    __device__ __forceinline__ void a_ready(const Unit&) const {}
    __device__ __forceinline__ void done(const Unit&) const {}
};

__device__ __forceinline__ unsigned cvt_pk_bf16(float lo, float hi) { unsigned r; asm volatile("v_cvt_pk_bf16_f32 %0, %1, %2" : "=v"(r) : "v"(lo), "v"(hi)); return r; }
template <class Epi, class Sched, bool ALIGN_EPI = false, bool SP2 = false>
__device__ __forceinline__ void gemm_phase(PG8_LAS unsigned char* lds, const Gemm g, const Sched& S, const Epi& E) {
    int tid_ = threadIdx.x; asm volatile("" : "+v"(tid_));
    const int tid = tid_, wid = __builtin_amdgcn_readfirstlane(tid >> 6), lane = tid & 63, wr = wid >> 2, wc = wid & 3, fr = lane & 15, fq = lane >> 4;
    const int K = g.K, nt = K / BK;
    unsigned voffA[2], voffB[2];
#pragma unroll
    for (int i = 0; i < 2; ++i) { int R, C; stage_rc(tid * 16 + i * 8192, R, C); const int Rb = Epi::PERM ? ((R & ~31) + perm32(R & 31)) : R;
        voffA[i] = (unsigned)(R * K + C) * 2u; voffB[i] = (unsigned)(Rb * K + C) * 2u; }
    const size_t kstep = (size_t)(BK * 2);
    const size_t hstep = (size_t)HALF * K * 2;
    const size_t tstep = 2 * hstep;
    const unsigned ldsw = (unsigned)wid * 1024u;
    const int aoff = lds_byte(wr * 64 + fr, fq * 8), boff = lds_byte(wc * 32 + fr, fq * 8);
#define PG8_SA(b, h) (((b) * 2 + (h)) * HTB)
#define PG8_SB(b, h) ((4 + (b) * 2 + (h)) * HTB)
#define PG8_STAGE(bufoff, gbase, voff) do { _Pragma("unroll") for (int _i = 0; _i < 2; ++_i) \
        __builtin_amdgcn_global_load_lds((const unsigned*)((const char*)(gbase) + (voff)[_i]), (PG8_LAS unsigned*)(lds + (bufoff) + ldsw + _i * 8192), 16, 0, 0); } while (0)
#define PG8_LDA(dst, b, h) do { _Pragma("unroll") for (int m = 0; m < 4; ++m) _Pragma("unroll") for (int k = 0; k < 2; ++k) dst[m][k] = *(const PG8_LAS bf16x8*)(lds + PG8_SA(b, h) + aoff + m * 2048 + k * 1024); } while (0)
#define PG8_LDB(dst, b, h) do { _Pragma("unroll") for (int n = 0; n < 2; ++n) _Pragma("unroll") for (int k = 0; k < 2; ++k) dst[n][k] = *(const PG8_LAS bf16x8*)(lds + PG8_SB(b, h) + boff + n * 2048 + k * 1024); } while (0)
#define PG8_MMA(ai, bj, At, Bt) do { __builtin_amdgcn_s_setprio(1); _Pragma("unroll") for (int m = 0; m < 4; ++m) _Pragma("unroll") for (int n = 0; n < 2; ++n) _Pragma("unroll") for (int k = 0; k < 2; ++k) \
        acc[ai][bj][m][n] = __builtin_amdgcn_mfma_f32_16x16x32_bf16(Bt[n][k], At[m][k], acc[ai][bj][m][n], 0, 0, 0); __builtin_amdgcn_s_setprio(0); } while (0)
#define PG8_WAIT_V(n) asm volatile("s_waitcnt vmcnt(" #n ")" ::: "memory")
#define PG8_WAIT_L(n) asm volatile("s_waitcnt lgkmcnt(" #n ")" ::: "memory")
#define PG8_BAR __builtin_amdgcn_s_barrier()
#define PG8_SCHED __builtin_amdgcn_sched_barrier(0)
    Unit cur, nxt; int ui = 0;
    if (!S.next(0, cur)) return;
    f32x4 acc[2][2][4][2];
#pragma unroll
    for (int a = 0; a < 2; ++a)
#pragma unroll
        for (int b = 0; b < 2; ++b)
#pragma unroll
            for (int m = 0; m < 4; ++m)
#pragma unroll
                for (int n = 0; n < 2; ++n) acc[a][b][m][n] = (f32x4){0.f, 0.f, 0.f, 0.f};
    bf16x8 At[4][2], B0[2][2], B1[2][2];
    const char* cA = (const char*)g.A + (size_t)cur.pm * tstep; const char* cB = (const char*)g.Bt + (size_t)cur.pn * tstep;
    S.a_ready(cur);
    if constexpr (SP2) {
        PG8_STAGE(PG8_SB(0, 0), cB, voffB); PG8_STAGE(PG8_SB(0, 1), cB + hstep, voffB); PG8_STAGE(PG8_SA(0, 0), cA, voffA); PG8_STAGE(PG8_SA(0, 1), cA + hstep, voffA);
        if (wr == 1) PG8_BAR;
        PG8_WAIT_V(2); PG8_BAR;
        PG8_STAGE(PG8_SB(1, 0), cB + kstep, voffB); PG8_STAGE(PG8_SA(1, 0), cA + kstep, voffA); PG8_STAGE(PG8_SB(1, 1), cB + hstep + kstep, voffB);
        PG8_WAIT_V(6); PG8_BAR;
    } else {
        PG8_STAGE(PG8_SB(0, 0), cB, voffB); PG8_STAGE(PG8_SA(0, 0), cA, voffA); PG8_STAGE(PG8_SB(0, 1), cB + hstep, voffB); PG8_STAGE(PG8_SA(0, 1), cA + hstep, voffA);
        if (wr == 1) PG8_BAR;
        PG8_WAIT_V(4); PG8_BAR;
        PG8_STAGE(PG8_SB(1, 0), cB + kstep, voffB); PG8_STAGE(PG8_SA(1, 0), cA + kstep, voffA); PG8_STAGE(PG8_SB(1, 1), cB + hstep + kstep, voffB);
        PG8_WAIT_V(6); PG8_BAR;
    }
    for (;;) {
        const bool has_next = S.next(ui + 1, nxt);
        const char* nA = has_next ? (const char*)g.A + (size_t)nxt.pm * tstep : cA; const char* nB = has_next ? (const char*)g.Bt + (size_t)nxt.pn * tstep : cB;
        for (int t = 0; t < nt; t += 2) {
            const bool last = (t == nt - 2);
            const char* a1 = cA + (size_t)(t + 1) * kstep;
            const char* a2 = last ? nA : cA + (size_t)(t + 2) * kstep; const char* b2 = last ? nB : cB + (size_t)(t + 2) * kstep;
            const char* a3 = a2 + kstep; const char* b3 = b2 + kstep;
            if (last && has_next) S.a_ready(nxt);
            if constexpr (SP2) {
            PG8_LDB(B0, 0, 0); PG8_LDB(B1, 0, 1); PG8_SCHED; PG8_LDA(At, 0, 0); PG8_STAGE(PG8_SA(1, 1), a1 + hstep, voffA);
            PG8_WAIT_V(8); PG8_WAIT_L(0); PG8_BAR; PG8_MMA(0, 0, At, B0); PG8_MMA(0, 1, At, B1); PG8_BAR; PG8_SCHED;
            PG8_LDA(At, 0, 1); PG8_STAGE(PG8_SB(0, 0), b2, voffB); PG8_STAGE(PG8_SB(0, 1), b2 + hstep, voffB); PG8_STAGE(PG8_SA(0, 0), a2, voffA);
            PG8_WAIT_V(8); PG8_WAIT_L(0); PG8_BAR; PG8_MMA(1, 0, At, B0); PG8_MMA(1, 1, At, B1); PG8_BAR; PG8_SCHED;
            PG8_LDB(B0, 1, 0); PG8_LDB(B1, 1, 1); PG8_SCHED; PG8_LDA(At, 1, 0); PG8_STAGE(PG8_SA(0, 1), a2 + hstep, voffA);
            PG8_WAIT_V(8); PG8_WAIT_L(0); PG8_BAR; PG8_MMA(0, 0, At, B0); PG8_MMA(0, 1, At, B1); PG8_BAR; PG8_SCHED;
            PG8_LDA(At, 1, 1); PG8_STAGE(PG8_SB(1, 0), b3, voffB); PG8_STAGE(PG8_SB(1, 1), b3 + hstep, voffB); PG8_STAGE(PG8_SA(1, 0), a3, voffA);
            PG8_WAIT_V(8); PG8_WAIT_L(0); PG8_BAR; PG8_MMA(1, 0, At, B0); PG8_MMA(1, 1, At, B1); PG8_BAR; PG8_SCHED;
            } else {
            PG8_LDB(B0, 0, 0); PG8_SCHED; PG8_LDA(At, 0, 0); PG8_STAGE(PG8_SA(1, 1), a1 + hstep, voffA);
            PG8_WAIT_L(8); PG8_BAR; PG8_WAIT_L(0); PG8_MMA(0, 0, At, B0); PG8_BAR; PG8_SCHED;
            PG8_LDB(B1, 0, 1); PG8_STAGE(PG8_SB(0, 0), b2, voffB);
            PG8_BAR; PG8_WAIT_L(0); PG8_MMA(0, 1, At, B1); PG8_BAR;
            PG8_LDA(At, 0, 1); PG8_STAGE(PG8_SA(0, 0), a2, voffA);
            PG8_BAR; PG8_WAIT_L(0); PG8_MMA(1, 0, At, B0); PG8_BAR; PG8_SCHED;
            PG8_STAGE(PG8_SB(0, 1), b2 + hstep, voffB);
            PG8_WAIT_V(6); PG8_BAR; PG8_MMA(1, 1, At, B1); PG8_BAR;
            PG8_LDB(B0, 1, 0); PG8_SCHED; PG8_LDA(At, 1, 0); PG8_STAGE(PG8_SA(0, 1), a2 + hstep, voffA);
            PG8_WAIT_L(8); PG8_BAR; PG8_WAIT_L(0); PG8_MMA(0, 0, At, B0); PG8_BAR; PG8_SCHED;
            PG8_LDB(B1, 1, 1); PG8_STAGE(PG8_SB(1, 0), b3, voffB);
            PG8_BAR; PG8_WAIT_L(0); PG8_MMA(0, 1, At, B1); PG8_BAR;
            PG8_LDA(At, 1, 1); PG8_STAGE(PG8_SA(1, 0), a3, voffA);
            PG8_BAR; PG8_WAIT_L(0); PG8_MMA(1, 0, At, B0); PG8_BAR; PG8_SCHED;
            PG8_STAGE(PG8_SB(1, 1), b3 + hstep, voffB);
            PG8_WAIT_V(6); PG8_BAR; PG8_MMA(1, 1, At, B1); PG8_BAR;
            }
        }
        if constexpr (ALIGN_EPI) { if (wr == 0) PG8_BAR; }
        if constexpr (!Epi::AFTER_DRAIN) { E(acc, cur, wr, wc, fr, fq); S.done(cur); }
        if (!has_next) break;
#pragma unroll
        for (int a = 0; a < 2; ++a)
#pragma unroll
            for (int b = 0; b < 2; ++b)
#pragma unroll
                for (int m = 0; m < 4; ++m)
#pragma unroll
                    for (int n = 0; n < 2; ++n) acc[a][b][m][n] = (f32x4){0.f, 0.f, 0.f, 0.f};
        cur = nxt; cA = nA; cB = nB; ++ui;
        if constexpr (ALIGN_EPI) { if (wr == 1) PG8_BAR; }
    }
    PG8_WAIT_V(0);
    if constexpr (!ALIGN_EPI) { if (wr == 0) PG8_BAR; }
    PG8_BAR;
    if constexpr (Epi::AFTER_DRAIN) { E.fused(acc, cur, wr, wc, fr, fq, lds, wid, lane); S.done(cur); }
#undef PG8_SA
#undef PG8_SB
#undef PG8_STAGE
#undef PG8_LDA
#undef PG8_LDB
#undef PG8_MMA
#undef PG8_WAIT_V
#undef PG8_WAIT_L
#undef PG8_BAR
#undef PG8_SCHED
}
}

typedef unsigned short bf16_t;
typedef short bf16x8 __attribute__((ext_vector_type(8)));
typedef float f32x4 __attribute__((ext_vector_type(4)));
typedef float f32x16 __attribute__((ext_vector_type(16)));
typedef unsigned u32x4 __attribute__((ext_vector_type(4)));
typedef unsigned u32x2 __attribute__((ext_vector_type(2)));
typedef float f32x2_t __attribute__((ext_vector_type(2)));
typedef __bf16 bf16x2_t __attribute__((ext_vector_type(2)));

constexpr int TP = 32768, TS = 16384, TT = TP + TS, DM = 1024, FFH = 2816, SP = 4096, SS = 2048;
constexpr float EPS = 1e-6f;
constexpr size_t MiB = 1u << 20;
constexpr size_t WS_CTL = 0, CTL_BYTES = 64 * 1024;
constexpr size_t WS_ROPE = 1 * MiB;
constexpr size_t WS_W_AB1 = 2 * MiB;
constexpr size_t WS_W_FT = 6 * MiB;
constexpr size_t WS_W_ABO = 8 * MiB;
constexpr size_t WS_W_GU0 = 10 * MiB;
constexpr size_t WS_W_D0 = 21 * MiB;
constexpr size_t WS_W_QKV = 27 * MiB;
constexpr size_t WS_W_CO = 30 * MiB;
constexpr size_t WS_W_GU1 = 32 * MiB;
constexpr size_t WS_W_D1 = 43 * MiB;
constexpr size_t WS_DEC = 49 * MiB;
constexpr size_t WS_C4 = 51 * MiB, WS_S4 = 67 * MiB;
constexpr size_t WS_C2 = 83 * MiB, WS_S2 = 87 * MiB;
constexpr size_t WS_PCP = 91 * MiB, WS_PSP = 107 * MiB;
constexpr size_t WS_PCS = 123 * MiB, WS_PSS = 131 * MiB;
constexpr size_t WS_SSQ = 1 * MiB + 256 * 1024;
constexpr size_t WS_XBA = 51 * MiB;
constexpr size_t WS_XBB = 147 * MiB;
constexpr size_t WS_H = WS_XBB;
constexpr size_t WS_BIG = 243 * MiB;
constexpr size_t WS_QKVR = WS_BIG;
constexpr size_t WS_G = WS_BIG + 144 * MiB;
constexpr size_t WS_FOLDF = WS_BIG;
constexpr size_t WS_FOLDG = WS_BIG + 4 * MiB;
constexpr size_t WS_ACT = WS_BIG;
constexpr size_t WS_Q = WS_BIG, WS_K = WS_BIG + 96 * MiB, WS_V = WS_BIG + 120 * MiB, WS_AO = WS_BIG + 144 * MiB;
constexpr size_t WS_END = WS_BIG + 264 * MiB;
constexpr size_t OUT_YTPC = 0, OUT_YTPS = 32 * MiB, OUT_YTSC = 64 * MiB, OUT_YTSS = 80 * MiB, OUT_DST = 96 * MiB;

DEVI float bf2f(bf16_t x) { return __uint_as_float(((unsigned)x) << 16); }
DEVI unsigned pk2(float lo, float hi) { f32x2_t v = {lo, hi}; bf16x2_t b = __builtin_convertvector(v, bf16x2_t); return __builtin_bit_cast(unsigned, b); }
DEVI bf16_t f2bf(float f) { return (bf16_t)(pk2(f, 0.f) & 0xffffu); }
DEVI u32x4 pk8(f32x4 a, f32x4 b) { u32x4 w; w.x = pk2(a[0], a[1]); w.y = pk2(a[2], a[3]); w.z = pk2(b[0], b[1]); w.w = pk2(b[2], b[3]); return w; }
DEVI float wave_sum(float v) {
#pragma unroll
    for (int o = 1; o < 64; o <<= 1) v += __shfl_xor(v, o);
    return v;
}
DEVI float logsig(float z) { return fminf(z, 0.f) - log1pf(__expf(-fabsf(z))); }
DEVI float silu(float z) { return z / (1.f + __expf(-z)); }

enum { EM_AB1, EM_AB1T, EM_FNETP, EM_FNETS, EM_RESIN, EM_RES, EM_GLU, EM_QKV };
template <int MODE, bool NEXT = false> struct Epi {
    static constexpr bool PERM = true, AFTER_DRAIN = false;
    bf16_t* O0; bf16_t* O1; bf16_t* O2; float* F0; const float* X0; const float* X1; const float* B0; const float* B1;
    const float* SQI; float* SQO; bf16_t* XBN; const float* GN;
    DEVI float rstd_of(int row) const { return rsqrtf(SQI[row] * (1.f / 1024.f) + EPS); }
    DEVI void operator()(const f32x4 (&acc)[2][2][4][2], const pg8::Unit& u, int wr, int wc, int fr, int fq) const {
        const int rbase = u.pm * 256 + wr * 64 + fr, cb = wc * 32 + 8 * fq;
        f32x4 ga[2][2];
        if constexpr (NEXT) {
#pragma unroll
            for (int bj = 0; bj < 2; ++bj) { ga[bj][0] = *(const f32x4*)(GN + u.pn * 256 + bj * 128 + cb); ga[bj][1] = *(const f32x4*)(GN + u.pn * 256 + bj * 128 + cb + 4); } }
        if constexpr (MODE == EM_AB1T) {
#pragma unroll
            for (int bj = 0; bj < 2; ++bj) { const f32x4 s0 = *(const f32x4*)(SQI + u.pn * 256 + bj * 128 + cb), s1 = *(const f32x4*)(SQI + u.pn * 256 + bj * 128 + cb + 4);
#pragma unroll
                for (int j = 0; j < 4; ++j) { ga[bj][0][j] = rsqrtf(s0[j] * (1.f / 1024.f) + EPS); ga[bj][1][j] = rsqrtf(s1[j] * (1.f / 1024.f) + EPS); } } }
        float rsv[2][4];
        if constexpr (MODE == EM_AB1 || MODE == EM_GLU || MODE == EM_QKV) {
#pragma unroll
            for (int ai = 0; ai < 2; ++ai)
#pragma unroll
                for (int m = 0; m < 4; ++m) rsv[ai][m] = SQI[rbase + ai * 128 + m * 16];
#pragma unroll
            for (int ai = 0; ai < 2; ++ai)
#pragma unroll
                for (int m = 0; m < 4; ++m) rsv[ai][m] = rsqrtf(rsv[ai][m] * (1.f / 1024.f) + EPS);
        }
#pragma unroll
        for (int ai = 0; ai < 2; ++ai)
#pragma unroll
            for (int m = 0; m < 4; ++m) {
                const int row = rbase + ai * 128 + m * 16;
                float rs = 1.f, ssq = 0.f;
                if constexpr (MODE == EM_AB1 || MODE == EM_GLU || MODE == EM_QKV) rs = rsv[ai][m];
                if constexpr (MODE == EM_GLU) {
                    const f32x4 g0 = acc[ai][0][m][0] * rs, g1 = acc[ai][0][m][1] * rs, u0 = acc[ai][1][m][0] * rs, u1 = acc[ai][1][m][1] * rs;
                    f32x4 a, b;
#pragma unroll
                    for (int j = 0; j < 4; ++j) { a[j] = silu(g0[j]) * u0[j]; b[j] = silu(g1[j]) * u1[j]; }
                    *(u32x4*)(O0 + (size_t)row * FFH + u.pn * 128 + cb) = pk8(a, b);
                } else {
#pragma unroll
                    for (int bj = 0; bj < 2; ++bj) {
                        f32x4 v0 = acc[ai][bj][m][0] * rs, v1 = acc[ai][bj][m][1] * rs;
                        const int c = bj * 128 + cb;
                        if constexpr (MODE == EM_AB1T) { v0 = v0 * ga[bj][0]; v1 = v1 * ga[bj][1]; }
                        if constexpr (MODE == EM_AB1) {
                            if (u.pn < 6) { *(u32x4*)(O0 + (size_t)row * 1536 + u.pn * 256 + c) = pk8(v0, v1); }
                            else { const int dir = u.pn - 6; const float* bias = dir ? B1 : B0;
                                const f32x4 b0 = *(const f32x4*)(bias + c), b1 = *(const f32x4*)(bias + c + 4);
                                f32x4 a, b;
#pragma unroll
                                for (int j = 0; j < 4; ++j) { a[j] = logsig(v0[j] + b0[j]) * 0.0625f; b[j] = logsig(v1[j] + b1[j]) * 0.0625f; }
                                float* gp = F0 + (size_t)row * 512 + dir * 256 + c; *(f32x4*)gp = a; *(f32x4*)(gp + 4) = b; }
                        } else if constexpr (MODE == EM_AB1T) {
                            const int cc = row, t0 = u.pn * 256;
                            bf16_t* dst;
                            if (t0 < TP) { const int b = t0 >> 12, s = (t0 & 4095) + c; dst = O0 + (size_t)(cc >> 9) * (4096 * 4096) + (size_t)(b * 512 + (cc & 511)) * 4096 + s; }
                            else { const int tt = t0 - TP, b = tt >> 11, s = (tt & 2047) + c; dst = O1 + (size_t)(cc >> 9) * (4096 * 2048) + (size_t)(b * 512 + (cc & 511)) * 2048 + s; }
                            *(u32x4*)dst = pk8(v0, v1);
                        } else if constexpr (MODE == EM_FNETP) {
                            *(u32x4*)(O0 + ((size_t)(u.pn >> 1) * 2048 + row) * 512 + (u.pn & 1) * 256 + c) = pk8(v0, v1);
                        } else if constexpr (MODE == EM_FNETS) {
                            *(u32x4*)(O0 + ((size_t)(u.pn >> 1) * 1024 + row) * 512 + (u.pn & 1) * 256 + c) = pk8(v0, v1);
                        } else if constexpr (MODE == EM_RESIN) {
                            const float* xp = (row < TP ? X0 + (size_t)row * 1024 : X1 + (size_t)(row - TP) * 1024) + u.pn * 256 + c;
                            float* op = F0 + (size_t)row * 1024 + u.pn * 256 + c;
                            const f32x4 x0 = *(const f32x4*)xp + v0, x1 = *(const f32x4*)(xp + 4) + v1;
                            *(f32x4*)op = x0; *(f32x4*)(op + 4) = x1;
                            if constexpr (NEXT) { ssq += (x0[0] * x0[0] + x0[1] * x0[1]) + (x0[2] * x0[2] + x0[3] * x0[3]) + (x1[0] * x1[0] + x1[1] * x1[1]) + (x1[2] * x1[2] + x1[3] * x1[3]);
                                *(u32x4*)(XBN + (size_t)row * 1024 + u.pn * 256 + c) = pk8(x0 * ga[bj][0], x1 * ga[bj][1]); }
                        } else if constexpr (MODE == EM_RES) {
                            float* op = F0 + (size_t)row * 1024 + u.pn * 256 + c;
                            const f32x4 x0 = *(const f32x4*)op + v0, x1 = *(const f32x4*)(op + 4) + v1;
                            *(f32x4*)op = x0; *(f32x4*)(op + 4) = x1;
                            if constexpr (NEXT) { ssq += (x0[0] * x0[0] + x0[1] * x0[1]) + (x0[2] * x0[2] + x0[3] * x0[3]) + (x1[0] * x1[0] + x1[1] * x1[1]) + (x1[2] * x1[2] + x1[3] * x1[3]);
                                *(u32x4*)(XBN + (size_t)row * 1024 + u.pn * 256 + c) = pk8(x0 * ga[bj][0], x1 * ga[bj][1]); }
                        } else if constexpr (MODE == EM_QKV) {
                            bf16_t* dst;
                            if (u.pn < 4) dst = O0 + (size_t)row * 1024 + u.pn * 256 + c;
                            else if (u.pn == 4) dst = O1 + (size_t)row * 256 + c;
                            else dst = O2 + (size_t)row * 256 + c;
                            *(u32x4*)dst = pk8(v0, v1);
                        }
                    }
                    if constexpr (NEXT) { ssq += __shfl_xor(ssq, 16); ssq += __shfl_xor(ssq, 32); if (fq == 0) atomicAdd(SQO + row, ssq); }
                }
            }
    }
};

DEVI void p_fold(const float* win, const float* upf, const float* upb, float* FF, float* FG, float* tab, int gw, int NGW, int lane) {
    if (threadIdx.x < 128) tab[threadIdx.x] = cospif((float)threadIdx.x * (1.f / 64.f));
    __syncthreads();
    for (int it = gw; it < 1024 * 16; it += NGW) {
        const int k = it >> 4, cb = it & 15, cc = cb * 64 + lane, part = cc >> 9, g = (cc >> 7) & 3, l = cc & 127;
        const float* wr = win + (size_t)k * 2080 + 1568 + g * 128;
        const int sh = part ? 96 : 0;
        float acc = 0.f;
#pragma unroll 8
        for (int w = 0; w < 128; ++w) acc += wr[w] * tab[(w * l + sh) & 127];
        FF[(size_t)k * 1024 + cc] = acc;
    }
    for (int it = gw; it < 1024 * 8; it += NGW) {
        const int k = it >> 3, nb = it & 7, n = nb * 64 + lane, dir = n >> 8, nn = n & 255;
        const float* wr = win + (size_t)k * 2080 + 1536 + dir * 16;
        const float* up = dir ? upb : upf;
        float acc = 0.f;
#pragma unroll
        for (int r = 0; r < 16; ++r) acc += wr[r] * up[r * 256 + nn];
        FG[(size_t)k * 512 + n] = acc;
    }
    __syncthreads();
}
DEVI void p_dft(bf16_t* C, bf16_t* Sn, int S, int logS, int gt, int NGT) {
    const int lri = logS - 3;
    const long total = (long)(S / 2) << lri;
    const float nrm = rsqrtf((float)S * 128.f), xs = 2.f / (float)S;
    for (long it = gt; it < 2 * total; it += NGT) {
        const int part = it >= total; const long i2 = part ? it - total : it;
        const int k = (int)(i2 >> lri), s0 = (int)(i2 & ((1 << lri) - 1)) * 8;
        float v[8];
#pragma unroll
        for (int j = 0; j < 8; ++j) { const int idx = (k * (s0 + j)) & (S - 1); const float x = (float)idx * xs; v[j] = (part ? sinpif(x) : cospif(x)) * nrm; }
        u32x4 w; w.x = pk2(v[0], v[1]); w.y = pk2(v[2], v[3]); w.z = pk2(v[4], v[5]); w.w = pk2(v[6], v[7]);
        *(u32x4*)((part ? Sn : C) + (size_t)k * S + s0) = w;
    }
}
DEVI void p_fcombine(const bf16_t* PC, const bf16_t* PS, bf16_t* MIX, int tokbase, int S, int logSH, int gt, int NGT) {
    const int total = 8 << (logSH + 6);
    for (int it = gt; it < total; it += NGT) {
        const int ch = it & 63, k = (it >> 6) & ((1 << logSH) - 1), b = it >> (6 + logSH);
        const u32x4 pc = *(const u32x4*)(PC + ((size_t)(b << logSH) + k) * 512 + ch * 8), ps = *(const u32x4*)(PS + ((size_t)(b << logSH) + k) * 512 + ch * 8);
        u32x4 lo, hi;
#pragma unroll
        for (int j = 0; j < 4; ++j) { const float c0 = __uint_as_float(pc[j] << 16), c1 = __uint_as_float(pc[j] & 0xffff0000u), s0 = __uint_as_float(ps[j] << 16), s1 = __uint_as_float(ps[j] & 0xffff0000u);
            lo[j] = pk2(c0 - s0, c1 - s1); hi[j] = pk2(c0 + s0, c1 + s1); }
        *(u32x4*)(MIX + (size_t)(tokbase + b * S + k) * 1024 + 512 + ch * 8) = lo;
        if (k) *(u32x4*)(MIX + (size_t)(tokbase + b * S + S - k) * 1024 + 512 + ch * 8) = hi;
    }
}
DEVI void p_fmid(const bf16_t* YC, bf16_t* MIX, int tokbase, int S, int gw, int NGW, int lane) {
    const float nrm = rsqrtf((float)S * 128.f);
    for (int r = gw; r < 4096; r += NGW) {
        const bf16_t* row = YC + (size_t)r * S; float acc = 0.f;
        for (int s0 = lane * 8; s0 < S; s0 += 512) { const u32x4 w = *(const u32x4*)(row + s0);
#pragma unroll
            for (int j = 0; j < 4; ++j) acc += __uint_as_float(w[j] << 16) - __uint_as_float(w[j] & 0xffff0000u); }
        acc = wave_sum(acc);
        if (lane == 0) MIX[(size_t)(tokbase + (r >> 9) * S + S / 2) * 1024 + 512 + (r & 511)] = f2bf(acc * nrm);
    }
}
DEVI void p_norm(const float* src0, const float* src1, const float* gain, bf16_t* H, float* SQ, int gw, int NGW, int lane) {
    f32x4 gv[4];
#pragma unroll
    for (int j = 0; j < 4; ++j) gv[j] = *((const f32x4*)gain + lane + 64 * j);
    for (int m = gw; m < TT; m += NGW) {
        const f32x4* xr = (const f32x4*)(m < TP ? src0 + (size_t)m * DM : src1 + (size_t)(m - TP) * DM) + lane;
        f32x4 v[4]; float s = 0.f;
#pragma unroll
        for (int j = 0; j < 4; ++j) { v[j] = xr[64 * j]; s += (v[j].x * v[j].x + v[j].y * v[j].y) + (v[j].z * v[j].z + v[j].w * v[j].w); }
        const float rstd = 1.f; { const float tot = wave_sum(s); if (lane == 0) SQ[m] = tot; }
        u32x2* o8 = (u32x2*)(H + (size_t)m * DM) + lane;
#pragma unroll
        for (int j = 0; j < 4; ++j) { u32x2 w; w.x = pk2(v[j].x * rstd * gv[j].x, v[j].y * rstd * gv[j].y); w.y = pk2(v[j].z * rstd * gv[j].z, v[j].w * rstd * gv[j].w); o8[64 * j] = w; }
    }
}
DEVI void tr_item(const float* W, int ld, int col0, bf16_t* WT, int Kd, int drow0, float scale, float* scr, int k0, int n0, int lane) {
#pragma unroll 8
    for (int i = 0; i < 32; ++i) { const int kk = 2 * i + (lane >> 5); scr[kk * 33 + (lane & 31)] = W[(size_t)(k0 + kk) * ld + col0 + n0 + (lane & 31)]; }
    asm volatile("s_waitcnt lgkmcnt(0)" ::: "memory");
    const int c = lane & 7;
#pragma unroll
    for (int j = 0; j < 4; ++j) { const int n = (lane >> 3) + 8 * j; const float* s = scr + (8 * c) * 33 + n;
        u32x4 o; o.x = pk2(s[0] * scale, s[33] * scale); o.y = pk2(s[66] * scale, s[99] * scale); o.z = pk2(s[132] * scale, s[165] * scale); o.w = pk2(s[198] * scale, s[231] * scale);
        *(u32x4*)(WT + (size_t)(drow0 + n) * Kd + k0 + 8 * c) = o; }
    asm volatile("s_waitcnt lgkmcnt(0)" ::: "memory");
}
template <int MAP> DEVI bool tr_mat(int& r, const float* W, int ld, int col0, int K, int ncols, bf16_t* WT, int drow, float scale, float* scr, int lane) {
    const int nblk = ncols >> 5, cnt = (K >> 6) * nblk;
    if (r >= cnt) { r -= cnt; return false; }
    const int kb = r / nblk, nb = r - kb * nblk, n0 = nb * 32;
    int d0 = drow + n0;
    if (MAP == 1) d0 = (n0 >> 7) * 256 + (n0 & 127);
    if (MAP == 2) d0 = (n0 >> 7) * 256 + 128 + (n0 & 127);
    tr_item(W, ld, col0, WT, K, d0, scale, scr, kb * 64, n0, lane);
    return true;
}

constexpr int GP = 144;
constexpr int L_QF = 0, L_QB = 9216, L_KF = 18432, L_KB = 27648, L_VT = 36864, L_ATF = 55296, L_ATB = 64512, L_SPF = 73728, L_SPB = 92160, L_SEG = 110592;
constexpr int L_KDF = 0, L_KDB = 9216;
DEVI int crow(int r, int hi) { return (r & 3) + 8 * (r >> 2) + 4 * hi; }
DEVI bf16x8 ldf(const unsigned char* base, int row, int ks, int hi) { return *(const bf16x8*)(base + row * GP + ks * 32 + hi * 16); }

DEVI void gla_prefix(const float* G, int tok0, int h, float* SEG, int tid, float (&bF)[8], float (&bB)[8], float& totF, float& totB) {
    const int d = tid & 63, sg = tid >> 6;
    float gf[8], gb[8];
#pragma unroll
    for (int i = 0; i < 8; ++i) { const float* p = G + (size_t)(tok0 + 8 * sg + i) * 512 + h * 64 + d; gf[i] = p[0]; gb[i] = p[256]; }
    bF[0] = gf[0];
#pragma unroll
    for (int i = 1; i < 8; ++i) bF[i] = bF[i - 1] + gf[i];
    bB[7] = gb[7];
#pragma unroll
    for (int i = 6; i >= 0; --i) bB[i] = bB[i + 1] + gb[i];
    SEG[sg * 64 + d] = bF[7]; SEG[512 + sg * 64 + d] = bB[0];
    __syncthreads();
    float offF = 0.f, offB = 0.f; totF = 0.f; totB = 0.f;
#pragma unroll
    for (int s = 0; s < 8; ++s) { const float a = SEG[s * 64 + d], b = SEG[512 + s * 64 + d]; totF += a; totB += b; if (s < sg) offF += a; if (s > sg) offB += b; }
#pragma unroll
    for (int i = 0; i < 8; ++i) { bF[i] += offF; bB[i] += offB; }
}
DEVI void gla_stage_vt(const bf16_t* QKVR, int tok0, int h, unsigned char* VT, int tid) {
    const int e = tid & 127, s4 = tid >> 7;
    unsigned w[8];
#pragma unroll
    for (int i = 0; i < 8; ++i) {
        const unsigned lo = QKVR[(size_t)(tok0 + 16 * s4 + 2 * i) * 1536 + 512 + h * 128 + e], hi = QKVR[(size_t)(tok0 + 16 * s4 + 2 * i + 1) * 1536 + 512 + h * 128 + e];
        w[i] = lo | (hi << 16); }
    u32x4 a = {w[0], w[1], w[2], w[3]}, b = {w[4], w[5], w[6], w[7]};
    *(u32x4*)(VT + e * GP + s4 * 32) = a; *(u32x4*)(VT + e * GP + s4 * 32 + 16) = b;
}
DEVI void gla_a_item(int item, const bf16_t* QKVR, const float* G, bf16_t* DST, float* DEC, unsigned char* lds, int tid, int wave, int lane) {
    const int n = item >> 2, h = item & 3, tok0 = n * 64, d = tid & 63, sg = tid >> 6;
    float bF[8], bB[8], totF, totB;
    gla_prefix(G, tok0, h, (float*)(lds + L_SEG), tid, bF, bB, totF, totB);
    float kf[8], kb[8];
#pragma unroll
    for (int i = 0; i < 8; ++i) { const float kk = bf2f(QKVR[(size_t)(tok0 + 8 * sg + i) * 1536 + 256 + h * 64 + d]); kf[i] = kk * __expf(totF - bF[i]); kb[i] = kk * __expf(totB - bB[i]); }
    { u32x4 a = {pk2(kf[0], kf[1]), pk2(kf[2], kf[3]), pk2(kf[4], kf[5]), pk2(kf[6], kf[7])}, b = {pk2(kb[0], kb[1]), pk2(kb[2], kb[3]), pk2(kb[4], kb[5]), pk2(kb[6], kb[7])};
      *(u32x4*)(lds + L_KDF + d * GP + sg * 16) = a; *(u32x4*)(lds + L_KDB + d * GP + sg * 16) = b; }
    if (sg == 0) { DEC[(size_t)(item * 2) * 64 + d] = __expf(totF); DEC[(size_t)(item * 2 + 1) * 64 + d] = __expf(totB); }
    gla_stage_vt(QKVR, tok0, h, lds + L_VT, tid);
    __syncthreads();
    { const int dir = wave >> 2, et = wave & 3, r32 = lane & 31, hi = lane >> 5;
      const unsigned char* KD = lds + (dir ? L_KDB : L_KDF);
      f32x16 c0 = {}, c1 = {};
#pragma unroll
      for (int ks = 0; ks < 4; ++ks) { const bf16x8 b = ldf(lds + L_VT, 32 * et + r32, ks, hi), a0 = ldf(KD, r32, ks, hi), a1 = ldf(KD, 32 + r32, ks, hi);
          c0 = __builtin_amdgcn_mfma_f32_32x32x16_bf16(a0, b, c0, 0, 0, 0); c1 = __builtin_amdgcn_mfma_f32_32x32x16_bf16(a1, b, c1, 0, 0, 0); }
      bf16_t* dst = DST + (size_t)(item * 2 + dir) * 8192 + (32 * et + r32) * 64 + 4 * hi;
#pragma unroll
      for (int q = 0; q < 4; ++q) { u32x2 w0 = {pk2(c0[4 * q], c0[4 * q + 1]), pk2(c0[4 * q + 2], c0[4 * q + 3])}, w1 = {pk2(c1[4 * q], c1[4 * q + 1]), pk2(c1[4 * q + 2], c1[4 * q + 3])};
          *(u32x2*)(dst + 8 * q) = w0; *(u32x2*)(dst + 32 + 8 * q) = w1; } }
    __syncthreads();
}
DEVI void p_scan(bf16_t* DST, const float* DEC, int gt) {
    const int combo = gt >> 10, el = gt & 1023, e = el >> 3, d0 = (el & 7) * 8;
    const int seq = combo >> 3, h = (combo >> 1) & 3, dir = combo & 1;
    const int nch = seq < 8 ? 64 : 32, n0 = seq < 8 ? seq * 64 : 512 + (seq - 8) * 32;
    float S[8];
#pragma unroll
    for (int j = 0; j < 8; ++j) S[j] = 0.f;
    for (int st0 = 0; st0 < nch; st0 += 4) {
        u32x4 ds[4]; f32x4 dc0[4], dc1[4];
#pragma unroll
        for (int u = 0; u < 4; ++u) { const int n = dir ? nch - 1 - (st0 + u) : st0 + u; const size_t item = (size_t)((n0 + n) * 4 + h) * 2 + dir;
            ds[u] = *(const u32x4*)(DST + item * 8192 + e * 64 + d0); dc0[u] = *(const f32x4*)(DEC + item * 64 + d0); dc1[u] = *(const f32x4*)(DEC + item * 64 + d0 + 4); }
#pragma unroll
        for (int u = 0; u < 4; ++u) { const int n = dir ? nch - 1 - (st0 + u) : st0 + u; const size_t item = (size_t)((n0 + n) * 4 + h) * 2 + dir;
            u32x4 w = {pk2(S[0], S[1]), pk2(S[2], S[3]), pk2(S[4], S[5]), pk2(S[6], S[7])};
            *(u32x4*)(DST + item * 8192 + e * 64 + d0) = w;
            S[0] = dc0[u][0] * S[0] + __uint_as_float(ds[u][0] << 16); S[1] = dc0[u][1] * S[1] + __uint_as_float(ds[u][0] & 0xffff0000u);
            S[2] = dc0[u][2] * S[2] + __uint_as_float(ds[u][1] << 16); S[3] = dc0[u][3] * S[3] + __uint_as_float(ds[u][1] & 0xffff0000u);
            S[4] = dc1[u][0] * S[4] + __uint_as_float(ds[u][2] << 16); S[5] = dc1[u][1] * S[5] + __uint_as_float(ds[u][2] & 0xffff0000u);
            S[6] = dc1[u][2] * S[6] + __uint_as_float(ds[u][3] << 16); S[7] = dc1[u][3] * S[7] + __uint_as_float(ds[u][3] & 0xffff0000u); }
    }
}
DEVI void gla_c_item(int item, const bf16_t* QKVR, const float* G, const bf16_t* DST, const float* outg, bf16_t* MIX, unsigned char* lds, int tid, int wave, int lane) {
    const int n = item >> 2, h = item & 3, tok0 = n * 64, d = tid & 63, sg = tid >> 6, r32 = lane & 31, hi = lane >> 5;
    float bF[8], bB[8], totF, totB;
    gla_prefix(G, tok0, h, (float*)(lds + L_SEG), tid, bF, bB, totF, totB);
    bf16_t* QF = (bf16_t*)(lds + L_QF); bf16_t* QB = (bf16_t*)(lds + L_QB); bf16_t* KF = (bf16_t*)(lds + L_KF); bf16_t* KB = (bf16_t*)(lds + L_KB);
#pragma unroll
    for (int i = 0; i < 8; ++i) { const bf16_t* tr = QKVR + (size_t)(tok0 + 8 * sg + i) * 1536 + h * 64 + d; const float qv = bf2f(tr[0]), kv = bf2f(tr[256]);
        const int o = (8 * sg + i) * (GP / 2) + d;
        QF[o] = f2bf(qv * __expf(bF[i])); KF[o] = f2bf(kv * __expf(-bF[i])); QB[o] = f2bf(qv * __expf(bB[i])); KB[o] = f2bf(kv * __expf(-bB[i])); }
    gla_stage_vt(QKVR, tok0, h, lds + L_VT, tid);
#pragma unroll
    for (int p = 0; p < 2; ++p) { const int row = (tid >> 3) + 64 * p, c = tid & 7;
        *(u32x4*)(lds + L_SPF + row * GP + c * 16) = *(const u32x4*)(DST + (size_t)(item * 2) * 8192 + row * 64 + c * 8);
        *(u32x4*)(lds + L_SPB + row * GP + c * 16) = *(const u32x4*)(DST + (size_t)(item * 2 + 1) * 8192 + row * 64 + c * 8); }
    __syncthreads();
    { const int dir = wave >> 2, it = (wave >> 1) & 1, jt = wave & 1;
      const unsigned char* Qd = lds + (dir ? L_QB : L_QF); const unsigned char* Kd = lds + (dir ? L_KB : L_KF);
      f32x16 c = {};
#pragma unroll
      for (int ks = 0; ks < 4; ++ks) c = __builtin_amdgcn_mfma_f32_32x32x16_bf16(ldf(Qd, 32 * it + r32, ks, hi), ldf(Kd, 32 * jt + r32, ks, hi), c, 0, 0, 0);
      bf16_t* AT = (bf16_t*)(lds + (dir ? L_ATB : L_ATF));
      const int j = 32 * jt + r32;
#pragma unroll
      for (int r = 0; r < 16; ++r) { const int i = 32 * it + crow(r, hi); const bool keep = dir ? (j >= i) : (j <= i); AT[i * (GP / 2) + j] = f2bf(keep ? c[r] : 0.f); } }
    __syncthreads();
    { const int it = wave >> 2, et = wave & 3;
      f32x16 o = {};
#pragma unroll
      for (int dir = 0; dir < 2; ++dir) {
          const unsigned char* AT = lds + (dir ? L_ATB : L_ATF); const unsigned char* Qd = lds + (dir ? L_QB : L_QF); const unsigned char* SPd = lds + (dir ? L_SPB : L_SPF);
#pragma unroll
          for (int ks = 0; ks < 4; ++ks) o = __builtin_amdgcn_mfma_f32_32x32x16_bf16(ldf(AT, 32 * it + r32, ks, hi), ldf(lds + L_VT, 32 * et + r32, ks, hi), o, 0, 0, 0);
#pragma unroll
          for (int ks = 0; ks < 4; ++ks) o = __builtin_amdgcn_mfma_f32_32x32x16_bf16(ldf(Qd, 32 * it + r32, ks, hi), ldf(SPd, 32 * et + r32, ks, hi), o, 0, 0, 0); }
      __syncthreads();
      float* OB = (float*)lds;
#pragma unroll
      for (int r = 0; r < 16; ++r) OB[(32 * it + crow(r, hi)) * 132 + 32 * et + r32] = o[r]; }
    __syncthreads();
    { const int i = tid >> 3, s8 = tid & 7; const float* OB = (const float*)lds + i * 132 + 16 * s8;
      f32x4 v[4]; float ss = 0.f;
#pragma unroll
      for (int q = 0; q < 4; ++q) { v[q] = *(const f32x4*)(OB + 4 * q); ss += (v[q].x * v[q].x + v[q].y * v[q].y) + (v[q].z * v[q].z + v[q].w * v[q].w); }
      ss += __shfl_xor(ss, 1); ss += __shfl_xor(ss, 2); ss += __shfl_xor(ss, 4);
      const float rstd = rsqrtf(ss * (1.f / 128.f) + EPS);
      const int tok = tok0 + i;
      const u32x4 r0 = *(const u32x4*)(QKVR + (size_t)tok * 1536 + 1024 + h * 128 + 16 * s8), r1 = *(const u32x4*)(QKVR + (size_t)tok * 1536 + 1024 + h * 128 + 16 * s8 + 8);
      float y[16];
#pragma unroll
      for (int q = 0; q < 4; ++q) { const f32x4 g = *(const f32x4*)(outg + 16 * s8 + 4 * q);
          const unsigned w0 = q < 2 ? r0[2 * q] : r1[2 * (q - 2)], w1 = q < 2 ? r0[2 * q + 1] : r1[2 * (q - 2) + 1];
          y[4 * q + 0] = v[q].x * rstd * g.x * silu(__uint_as_float(w0 << 16)); y[4 * q + 1] = v[q].y * rstd * g.y * silu(__uint_as_float(w0 & 0xffff0000u));
          y[4 * q + 2] = v[q].z * rstd * g.z * silu(__uint_as_float(w1 << 16)); y[4 * q + 3] = v[q].w * rstd * g.w * silu(__uint_as_float(w1 & 0xffff0000u)); }
      u32x4 a = {pk2(y[0], y[1]), pk2(y[2], y[3]), pk2(y[4], y[5]), pk2(y[6], y[7])}, b = {pk2(y[8], y[9]), pk2(y[10], y[11]), pk2(y[12], y[13]), pk2(y[14], y[15])};
      bf16_t* mp = MIX + (size_t)tok * 1024 + h * 128 + 16 * s8;
      *(u32x4*)mp = a; *(u32x4*)(mp + 8) = b; }
    __syncthreads();
}

DEVI void p_qkrope(bf16_t* Q, bf16_t* K, const float* qg, const float* kg, const float2* rope, int gw, int NGW, int lane) {
    const int i = lane & 31, hh = lane >> 5;
    float gq[4], gk[4];
#pragma unroll
    for (int j = 0; j < 4; ++j) { gq[j] = qg[32 * j + i]; gk[j] = kg[32 * j + i]; }
    for (int t = gw; t < TT; t += NGW) {
        const int s = t < TP ? (t & 4095) : ((t - TP) & 2047);
        const float2 rr = rope[(s >> 6) * 32 + i], rc = rope[(s & 63) * 32 + i];
#pragma unroll
        for (int p = 0; p < 5; ++p) {
            const int slot = 2 * p + hh;
            bf16_t* base = slot < 8 ? Q + (size_t)t * 1024 + slot * 128 : K + (size_t)t * 256 + (slot - 8) * 128;
            float x[4]; float ss = 0.f;
#pragma unroll
            for (int j = 0; j < 4; ++j) { x[j] = bf2f(base[32 * j + i]); ss += x[j] * x[j]; }
            ss += __shfl_xor(ss, 1); ss += __shfl_xor(ss, 2); ss += __shfl_xor(ss, 4); ss += __shfl_xor(ss, 8); ss += __shfl_xor(ss, 16);
            const float rstd = rsqrtf(ss * (1.f / 128.f) + EPS);
#pragma unroll
            for (int j = 0; j < 4; ++j) x[j] *= rstd * (slot < 8 ? gq[j] : gk[j]);
            base[i] = f2bf(x[0] * rr.x - x[1] * rr.y); base[32 + i] = f2bf(x[1] * rr.x + x[0] * rr.y);
            base[64 + i] = f2bf(x[2] * rc.x - x[3] * rc.y); base[96 + i] = f2bf(x[3] * rc.x + x[2] * rc.y);
        }
    }
}
namespace attn {
using bf16 = unsigned short;
constexpr int   D = 128, NW = 8, QBLK = 32, KVBLK = 64;
constexpr float SCALE = 0.088388347648318440f;
constexpr float THR = 8.f;
constexpr int SDEPTH = 2;
constexpr int LDQ = 1024, LDK = 256, LDO = 1024;
constexpr size_t SHM_V = KVBLK * D * 2, SHM_K = KVBLK * D * 2, SHM_ATTN = 2 * SHM_V + 2 * SHM_K + NW * 64 * 4;
using bf16x8 = __attribute__((ext_vector_type(8))) short;
using s16x4  = __attribute__((ext_vector_type(4))) short;
using f32x16 = __attribute__((ext_vector_type(16))) float;
using f32x8  = __attribute__((ext_vector_type(8))) float;
using u32x4  = __attribute__((ext_vector_type(4))) unsigned;
#define KSWZ(row, colB) ((row) * 256 + ((colB) ^ (((row) & 7) << 4)))
#define SBAR() __builtin_amdgcn_sched_barrier(0)
__device__ __forceinline__ int crow(int r, int hi) { return (r & 3) + 8 * (r >> 2) + 4 * hi; }
__device__ __forceinline__ unsigned cvtpk(float lo, float hi) {
  unsigned r; asm volatile("v_cvt_pk_bf16_f32 %0, %1, %2" : "=v"(r) : "v"(lo), "v"(hi)); return r;
}
template <typename TIn> struct Stage;
template <> struct Stage<bf16>  { using T = bf16x8;
  __device__ static __forceinline__ T ld8(const bf16* p) { return *reinterpret_cast<const bf16x8*>(p); }
  __device__ static __forceinline__ bf16x8 tobf(T x) { return x; } };
template <> struct Stage<float> { using T = f32x8;
  __device__ static __forceinline__ T ld8(const float* p) { return *reinterpret_cast<const f32x8*>(p); }
  __device__ static __forceinline__ bf16x8 tobf(T x) {
    u32x4 w = {cvtpk(x[0], x[1]), cvtpk(x[2], x[3]), cvtpk(x[4], x[5]), cvtpk(x[6], x[7])}; return *reinterpret_cast<bf16x8*>(&w); } };

__device__ __forceinline__ void partialSM(f32x16& p0, f32x16& p1, float& m_reg, float& mn, float& alpha) {
  constexpr float C = SCALE * 1.4426950408889634f;
  float pmax = p0[0]; for (int r = 1; r < 16; ++r) pmax = fmaxf(pmax, p0[r]); for (int r = 0; r < 16; ++r) pmax = fmaxf(pmax, p1[r]);
  { auto rr = __builtin_amdgcn_permlane32_swap(__float_as_uint(pmax), __float_as_uint(pmax), false, false);
    pmax = fmaxf(__uint_as_float(rr[0]), __uint_as_float(rr[1])); }
  if (__builtin_expect(__all(pmax - m_reg <= THR / SCALE), 1)) { mn = m_reg; alpha = 1.f; }
  else { mn = fmaxf(m_reg, pmax); alpha = __builtin_amdgcn_exp2f((m_reg - mn) * C); m_reg = mn; }
  float mnC = -mn * C;
  for (int r = 0; r < 16; ++r) p0[r] = fmaf(p0[r], C, mnC); for (int r = 0; r < 16; ++r) p1[r] = fmaf(p1[r], C, mnC);
  for (int r = 0; r < 16; ++r) p0[r] = __builtin_amdgcn_exp2f(p0[r]);
}
__device__ __forceinline__ void finishSM(f32x16& p0, f32x16& p1, float alpha, float& l_reg, bf16x8& pa0, bf16x8& pa1, bf16x8& pa2, bf16x8& pa3) {
  for (int r = 0; r < 16; ++r) p1[r] = __builtin_amdgcn_exp2f(p1[r]);
  float ps = 0; for (int r = 0; r < 16; ++r) ps += p0[r]; for (int r = 0; r < 16; ++r) ps += p1[r];
  { auto rr = __builtin_amdgcn_permlane32_swap(__float_as_uint(ps), __float_as_uint(ps), false, false);
    ps = __uint_as_float(rr[0]) + __uint_as_float(rr[1]); }
  l_reg = l_reg * alpha + ps;
#define PK4(P, BASE, OUT) do { unsigned a0 = cvtpk(P[BASE + 0], P[BASE + 1]), a1 = cvtpk(P[BASE + 2], P[BASE + 3]);   \
    unsigned b0 = cvtpk(P[BASE + 4], P[BASE + 5]), b1 = cvtpk(P[BASE + 6], P[BASE + 7]);                              \
    auto r0 = __builtin_amdgcn_permlane32_swap(a0, b0, false, false); auto r1 = __builtin_amdgcn_permlane32_swap(a1, b1, false, false); \
    u32x4 w = {r0[0], r1[0], r0[1], r1[1]}; OUT = *reinterpret_cast<bf16x8*>(&w); } while (0)
  PK4(p0, 0, pa0); PK4(p0, 8, pa1); PK4(p1, 0, pa2); PK4(p1, 8, pa3);
#undef PK4
}
__device__ __forceinline__ void qkt(f32x16& p0, f32x16& p1, const bf16* Ks, const bf16x8* qr, int r32, int hi) {
  p0 = f32x16{}; p1 = f32x16{};
  for (int d0 = 0; d0 < 8; ++d0) { int cb = (d0 * 16 + hi * 8) * 2;
    bf16x8 b0 = *reinterpret_cast<const bf16x8*>((const char*)Ks + KSWZ(r32, cb));
    bf16x8 b1 = *reinterpret_cast<const bf16x8*>((const char*)Ks + KSWZ(32 + r32, cb));
    p0 = __builtin_amdgcn_mfma_f32_32x32x16_bf16(b0, qr[d0], p0, 0, 0, 0);
    p1 = __builtin_amdgcn_mfma_f32_32x32x16_bf16(b1, qr[d0], p1, 0, 0, 0); }
}
__device__ __forceinline__ int v_st(int k, int c) { const int kk = (k & ~0xC) | ((k & 4) << 1) | ((k & 8) >> 1); return ((kk >> 3) * 4 + (c >> 5)) * 512 + ((kk & 7) * 32 + (c & 31)) * 2; }
__device__ __forceinline__ int v_rd_base(int lane) { return ((lane & 3) << 3) | (((lane >> 2) & 3) << 6) | (((lane >> 4) & 1) << 5) | (((lane >> 5) & 1) << 8); }
constexpr int v_rd_off(int d0, int ks, int half) { return d0 * 512 + ks * 4096 + half * 2048; }
template <int OFF> __device__ __forceinline__ s16x4 tr_read(int vb) {
  s16x4 r; asm volatile("ds_read_b64_tr_b16 %0, %1 offset:%2" : "=&v"(r) : "v"(vb), "i"(OFF) : "memory"); return r;
}
template <int D0> __device__ __forceinline__ void pv_one(f32x16& od, int vb, bf16x8 pa0, bf16x8 pa1, bf16x8 pa2, bf16x8 pa3) {
  const s16x4 l0 = tr_read<v_rd_off(D0, 0, 0)>(vb), h0 = tr_read<v_rd_off(D0, 0, 1)>(vb), l1 = tr_read<v_rd_off(D0, 1, 0)>(vb), h1 = tr_read<v_rd_off(D0, 1, 1)>(vb);
  const s16x4 l2 = tr_read<v_rd_off(D0, 2, 0)>(vb), h2 = tr_read<v_rd_off(D0, 2, 1)>(vb), l3 = tr_read<v_rd_off(D0, 3, 0)>(vb), h3 = tr_read<v_rd_off(D0, 3, 1)>(vb);
  asm volatile("s_waitcnt lgkmcnt(0)" ::: "memory"); SBAR();
#define PK(L, H) (bf16x8){L[0], L[1], L[2], L[3], H[0], H[1], H[2], H[3]}
  od = __builtin_amdgcn_mfma_f32_32x32x16_bf16(pa0, PK(l0, h0), od, 0, 0, 0);
  od = __builtin_amdgcn_mfma_f32_32x32x16_bf16(pa1, PK(l1, h1), od, 0, 0, 0);
  od = __builtin_amdgcn_mfma_f32_32x32x16_bf16(pa2, PK(l2, h2), od, 0, 0, 0);
  od = __builtin_amdgcn_mfma_f32_32x32x16_bf16(pa3, PK(l3, h3), od, 0, 0, 0);
#undef PK
}
__device__ __forceinline__ void pv_d0(f32x16* o, int vb, bf16x8 pa0, bf16x8 pa1, bf16x8 pa2, bf16x8 pa3) {
  pv_one<0>(o[0], vb, pa0, pa1, pa2, pa3); pv_one<1>(o[1], vb, pa0, pa1, pa2, pa3); pv_one<2>(o[2], vb, pa0, pa1, pa2, pa3); pv_one<3>(o[3], vb, pa0, pa1, pa2, pa3);
}

template <typename TQ>
__device__ __forceinline__ void attn_dense_body(const TQ* __restrict__ Qb, const bf16* __restrict__ Kh, const bf16* __restrict__ Vh,
                                                bf16* __restrict__ Ob, int seq, char* lds) {
  using St = Stage<bf16>; using SQ = Stage<TQ>;
  const int tid = threadIdx.x, wid = __builtin_amdgcn_readfirstlane(tid >> 6), lane = tid & 63, r32 = lane & 31, hi = lane >> 5;
  bf16* V_lds = (bf16*)lds; bf16* K_lds = (bf16*)(lds + 2 * SHM_V);
  float* ws = (float*)(lds + 2 * SHM_V + 2 * SHM_K) + wid * 64; float* li_l = ws; float* al_l = ws + 32;
  float m_reg = -1e30f, l_reg = 0; f32x16 o[4] = {}; bf16x8 qr[8];
  const TQ* Qw = Qb + (long)(wid * QBLK + r32) * LDQ + hi * 8;
#pragma unroll
  for (int d0 = 0; d0 < 8; ++d0) qr[d0] = SQ::tobf(SQ::ld8(Qw + d0 * 16));
  const int sr = tid >> 4, sc = (tid & 15) * 8, vst0 = v_st(sr, sc), vst1 = v_st(32 + sr, sc);
  const int vb0 = (int)(uintptr_t)V_lds + v_rd_base(lane);
  struct { typename St::T vs0, vs1, ks0, ks1; } sr_[SDEPTH];
#define SLOAD(i, k0) do { sr_[i].vs0 = St::ld8(&Vh[(long)((k0) + sr) * LDK + sc]); sr_[i].vs1 = St::ld8(&Vh[(long)((k0) + 32 + sr) * LDK + sc]); \
    sr_[i].ks0 = St::ld8(&Kh[(long)((k0) + sr) * LDK + sc]); sr_[i].ks1 = St::ld8(&Kh[(long)((k0) + 32 + sr) * LDK + sc]); } while (0)
#define SWRITE(b, i) do { *(bf16x8*)((char*)V_lds + (b) * SHM_V + vst0) = St::tobf(sr_[i].vs0);          \
    *(bf16x8*)((char*)V_lds + (b) * SHM_V + vst1) = St::tobf(sr_[i].vs1); int kc = sc * 2;               \
    *(bf16x8*)((char*)K_lds + (b) * SHM_K + KSWZ(sr, kc)) = St::tobf(sr_[i].ks0);                       \
    *(bf16x8*)((char*)K_lds + (b) * SHM_K + KSWZ(32 + sr, kc)) = St::tobf(sr_[i].ks1); } while (0)
#define SWAIT() do { if constexpr (SDEPTH == 2) asm volatile("s_waitcnt vmcnt(4)" ::: "memory"); else asm volatile("s_waitcnt vmcnt(0)" ::: "memory"); } while (0)
#define RESC(a) do { if (__any((a) < 1.f)) { if (hi == 0) al_l[r32] = (a); asm volatile("s_waitcnt lgkmcnt(0)" ::: "memory"); \
    for (int d = 0; d < 4; ++d) for (int r = 0; r < 16; ++r) o[d][r] *= al_l[crow(r, hi)]; } } while (0)
  f32x16 pA0, pA1, pB0, pB1; float mnA, mnB, alA, alB; bf16x8 pa0, pa1, pa2, pa3; const int NT = seq / KVBLK;
  constexpr int SE = 0, SO = SDEPTH - 1;
  SLOAD(SE, 0); asm volatile("s_waitcnt vmcnt(0)" ::: "memory"); SWRITE(0, SE); __syncthreads();
  qkt(pA0, pA1, K_lds, qr, r32, hi); partialSM(pA0, pA1, m_reg, mnA, alA);
  SLOAD(SO, KVBLK); if constexpr (SDEPTH == 2) { if (2 < NT) SLOAD(SE, 2 * KVBLK); }
  SWAIT(); SWRITE(1, SO); __syncthreads();
  for (int j = 1; j + 1 < NT; j += 2) {
    SBAR(); qkt(pB0, pB1, (bf16*)((char*)K_lds + SHM_K), qr, r32, hi);
    finishSM(pA0, pA1, alA, l_reg, pa0, pa1, pa2, pa3); SBAR();
    SLOAD(SO, (j + SDEPTH) * KVBLK); SBAR();
    pv_d0(o, vb0, pa0, pa1, pa2, pa3); partialSM(pB0, pB1, m_reg, mnB, alB);
    __syncthreads(); SWAIT(); SWRITE(0, SE);
    RESC(alB); __syncthreads();
    SBAR(); qkt(pA0, pA1, K_lds, qr, r32, hi);
    finishSM(pB0, pB1, alB, l_reg, pa0, pa1, pa2, pa3); SBAR();
    if (SDEPTH == 1 || j + 3 < NT) SLOAD(SE, (j + 1 + SDEPTH) * KVBLK); SBAR();
    pv_d0(o, vb0 + (int)SHM_V, pa0, pa1, pa2, pa3); partialSM(pA0, pA1, m_reg, mnA, alA);
    __syncthreads(); SWAIT(); SWRITE(1, SO);
    RESC(alA); __syncthreads();
  }
  SBAR(); qkt(pB0, pB1, (bf16*)((char*)K_lds + SHM_K), qr, r32, hi);
  finishSM(pA0, pA1, alA, l_reg, pa0, pa1, pa2, pa3); SBAR();
  pv_d0(o, vb0, pa0, pa1, pa2, pa3); partialSM(pB0, pB1, m_reg, mnB, alB);
  __syncthreads(); RESC(alB);
  finishSM(pB0, pB1, alB, l_reg, pa0, pa1, pa2, pa3); SBAR();
  pv_d0(o, vb0 + (int)SHM_V, pa0, pa1, pa2, pa3);
  if (hi == 0) li_l[r32] = l_reg; asm volatile("s_waitcnt lgkmcnt(0)" ::: "memory");
  float rli[16];
#pragma unroll
  for (int r = 0; r < 16; ++r) rli[r] = __builtin_amdgcn_rcpf(li_l[crow(r, hi)]);
  bf16* Ow = Ob + (long)(wid * QBLK) * LDO;
#pragma unroll
  for (int r = 0; r < 16; ++r) { int orow = crow(r, hi);
    for (int d0 = 0; d0 < 4; ++d0) Ow[(long)orow * LDO + d0 * 32 + r32] = (bf16)(cvtpk(o[d0][r] * rli[r], 0.f) & 0xffffu); }
#undef SLOAD
#undef SWRITE
#undef SWAIT
#undef RESC
}

#undef KSWZ
#undef SBAR
}

constexpr int LDS_BYTES = 135168;
struct Args { const float* in[19]; float* out; unsigned char* ws; };
#define LAS3 __attribute__((address_space(3)))

#define RLX_AGENT __ATOMIC_RELAXED, __HIP_MEMORY_SCOPE_AGENT
#define XB_TMO      128
#define XB_XCNT(j)  (256  + 64 * (j))
#define XB_XSUB(j)  (1280 + 64 * (j))
#define XB_XGEN(j)  (2304 + 64 * (j))
#define XB_TOP      3328
#define XB_TOPGEN   3392
#define XCD_BAR_WORDS 3456
#define XB_SPIN_CAP (1u << 18)

__device__ __forceinline__ unsigned xb_ld(unsigned* p)              { return __hip_atomic_load(p, __ATOMIC_RELAXED, __HIP_MEMORY_SCOPE_AGENT); }
__device__ __forceinline__ unsigned xb_add(unsigned* p, unsigned v) { return __hip_atomic_fetch_add(p, v, __ATOMIC_RELAXED, __HIP_MEMORY_SCOPE_AGENT); }
__device__ __forceinline__ unsigned xb_xcc_id() { return (unsigned)__builtin_amdgcn_s_getreg((3 << 11) | 20) & 0xFu; }
#define XB_SPIN(cond, bar) do { unsigned _sp = 0; while (cond) { __builtin_amdgcn_s_sleep(1); \
    if ((++_sp & 255u) == 0u) { if (xb_ld(&(bar)[XB_TMO])) break; if (_sp > XB_SPIN_CAP) { atomicAdd(&(bar)[XB_TMO], 1u); break; } } } } while (0)

struct XcdBarrier {
    unsigned* bar; unsigned x;
    volatile LAS3 unsigned* st;
};

__device__ __forceinline__ XcdBarrier xcd_barrier_post(unsigned* bar, volatile LAS3 unsigned* st) {
    XcdBarrier b; b.bar = bar; b.x = xb_xcc_id(); b.st = st;
    if (threadIdx.x == 0) (void)xb_add(&bar[XB_XCNT(b.x)], 1u);
    return b;
}
__device__ __forceinline__ void xcd_barrier_complete(unsigned* bar, unsigned x, unsigned& nloc, unsigned& nx) {
    const unsigned G = gridDim.x * gridDim.y * gridDim.z;
    unsigned sum, cnt, mine, sp = 0u;
    for (;;) {
        sum = 0u; cnt = 0u; mine = 0u;
#pragma unroll
        for (unsigned j = 0; j < 16; ++j) { const unsigned c = xb_ld(&bar[XB_XCNT(j)]); sum += c; cnt += (c > 0u) ? 1u : 0u; mine = (j == x) ? c : mine; }
        if (sum == G) break;
        __builtin_amdgcn_s_sleep(1);
        if ((++sp & 255u) == 0u) { if (xb_ld(&bar[XB_TMO])) break; if (sp > XB_SPIN_CAP) { atomicAdd(&bar[XB_TMO], 1u); break; } }
    }
    nloc = mine > 0u ? mine : 1u; nx = cnt > 0u ? cnt : 1u;
}

__device__ __forceinline__ void xcd_barrier(const XcdBarrier& b) {
    asm volatile("s_waitcnt vmcnt(0)" ::: "memory");
    __syncthreads();
    if (threadIdx.x == 0) {
        unsigned* bar = b.bar;
        __builtin_amdgcn_s_waitcnt(0);
        unsigned nloc = b.st[0], nx = b.st[1];
        if (nloc == 0u) { xcd_barrier_complete(bar, b.x, nloc, nx); b.st[0] = nloc; b.st[1] = nx; }
        const unsigned old = xb_add(&bar[XB_XSUB(b.x)], 1u);
        const unsigned gen = old / nloc;
        if (old + 1u == (gen + 1u) * nloc) {
            __builtin_amdgcn_fence(__ATOMIC_RELEASE, "agent");
            asm volatile("s_waitcnt vmcnt(0)" ::: "memory");
            const unsigned og = xb_add(&bar[XB_TOP], 1u);
            const unsigned tg = og / nx;
            if (og + 1u == (tg + 1u) * nx) xb_add(&bar[XB_TOPGEN], 1u);
            else XB_SPIN(xb_ld(&bar[XB_TOPGEN]) == tg, bar);
            __builtin_amdgcn_fence(__ATOMIC_ACQUIRE, "agent");
            xb_add(&bar[XB_XGEN(b.x)], 1u);
            asm volatile("s_waitcnt vmcnt(0)" ::: "memory");
        } else {
            XB_SPIN(xb_ld(&bar[XB_XGEN(b.x)]) == gen, bar);
            __builtin_amdgcn_fence(__ATOMIC_ACQUIRE, "agent");
            asm volatile("s_waitcnt vmcnt(0)" ::: "memory");
        }
    }
    __syncthreads();
}

constexpr int MISC_OFF = 131072;
constexpr int CW_BAR = 4096;
typedef const __attribute__((address_space(4))) Args* CArgsP;
#ifndef PHM
#define PHM 0xFFFFFFu
#endif
#ifndef PROBE_GLU
#define PROBE_GLU 0
#endif
#ifndef PROBE_ATTN
#define PROBE_ATTN 0
#endif
#define PH(b) ((PHM >> (b)) & 1u)
#define PHASE_VARS \
    CArgsP ap = (CArgsP)__builtin_amdgcn_kernarg_segment_ptr(); asm volatile("" : "+s"(ap)); \
    int tid = threadIdx.x; asm volatile("" : "+v"(tid)); \
    const int lane = tid & 63, wave = __builtin_amdgcn_readfirstlane(tid >> 6); \
    const int G = gridDim.x, bx = blockIdx.x, gw = bx * 8 + wave, NGW = G * 8, gt = bx * 512 + tid, NGT = G * 512; \
    unsigned char* ws = ap->ws; float* out = ap->out; bf16_t* H = (bf16_t*)(ws + WS_H); \
    (void)lane; (void)gw; (void)NGW; (void)gt; (void)NGT; (void)out; (void)H; (void)bx; (void)G;
#define GRID_SYNC_CG() cg::this_grid().sync()
#define GRID_SYNC() do { CArgsP ap_ = (CArgsP)__builtin_amdgcn_kernarg_segment_ptr(); asm volatile("" : "+s"(ap_)); \
    XcdBarrier b_; b_.bar = (unsigned*)(ap_->ws + WS_CTL) + CW_BAR; b_.x = xb_xcc_id(); b_.st = (volatile LAS3 unsigned*)(lds3 + MISC_OFF); xcd_barrier(b_); } while (0)

#define SSQP(k) ((float*)(ws + WS_SSQ) + (size_t)(k) * TT)
template <int LAYER> DEVI void ffn_block(LAS3 unsigned char* lds3) {
    { PHASE_VARS
      for (int rep_ = 0; rep_ < (PROBE_GLU ? 2 : 1); ++rep_) if (PH(18)) { pg8::Gemm g{(const bf16_t*)(ws + WS_XBA), (const bf16_t*)(ws + (LAYER ? WS_W_GU1 : WS_W_GU0)), TT, 2 * FFH, 1024}; pg8::StaticOrder S; S.init(TT, 2 * FFH, G, bx);
        Epi<EM_GLU> E{(bf16_t*)(ws + WS_ACT), nullptr, nullptr, nullptr, nullptr, nullptr, nullptr, nullptr, SSQP(LAYER ? 3 : 1), nullptr, nullptr, nullptr};
        pg8::gemm_phase<Epi<EM_GLU>, pg8::StaticOrder, true, true>(lds3, g, S, E); } }
    GRID_SYNC();
    { PHASE_VARS
      if (PH(19)) { pg8::Gemm g{(const bf16_t*)(ws + WS_ACT), (const bf16_t*)(ws + (LAYER ? WS_W_D1 : WS_W_D0)), TT, 1024, FFH}; pg8::StaticOrder S; S.init(TT, 1024, G, bx);
        if constexpr (LAYER == 0) {
            Epi<EM_RES, true> E{nullptr, nullptr, nullptr, out, nullptr, nullptr, nullptr, nullptr, nullptr, SSQP(2), (bf16_t*)(ws + WS_XBB), ap->in[10]};
            pg8::gemm_phase<Epi<EM_RES, true>, pg8::StaticOrder, true, true>(lds3, g, S, E);
        } else {
            Epi<EM_RES> E{nullptr, nullptr, nullptr, out, nullptr, nullptr, nullptr, nullptr, nullptr, nullptr, nullptr, nullptr};
            pg8::gemm_phase<Epi<EM_RES>, pg8::StaticOrder, true, true>(lds3, g, S, E); } } }
}

__global__ void __launch_bounds__(512, 2) mega_fwd(Args a_unused) {
    extern __shared__ __attribute__((aligned(16))) unsigned char lds[];
    LAS3 unsigned char* lds3 = (LAS3 unsigned char*)lds;
    { if (threadIdx.x < 32) ((LAS3 unsigned*)(lds3 + MISC_OFF))[threadIdx.x] = 0u;
      __syncthreads();
      CArgsP ap0 = (CArgsP)__builtin_amdgcn_kernarg_segment_ptr();
      (void)xcd_barrier_post((unsigned*)(ap0->ws + WS_CTL) + CW_BAR, (volatile LAS3 unsigned*)(lds3 + MISC_OFF)); }
    { PHASE_VARS
      if (PH(0)) p_fold(ap->in[3], ap->in[4], ap->in[6], (float*)(ws + WS_FOLDF), (float*)(ws + WS_FOLDG), (float*)lds, gw, NGW, lane);
      if (PH(1)) { p_dft((bf16_t*)(ws + WS_C4), (bf16_t*)(ws + WS_S4), 4096, 12, gt, NGT); p_dft((bf16_t*)(ws + WS_C2), (bf16_t*)(ws + WS_S2), 2048, 11, gt, NGT); }
      if (gt < 2048) { const int idx = gt >> 5, i = gt & 31; const float inv = powf(10000.f, -(float)(2 * i) * (1.f / 64.f)); const float ang = (float)idx * inv;
          ((float2*)(ws + WS_ROPE))[gt] = make_float2((float)cos((double)ang), (float)sin((double)ang)); }
      for (int i = gt; i < 3 * TT; i += NGT) SSQP(1)[i] = 0.f;
      if (PH(2)) p_norm(ap->in[0], ap->in[1], ap->in[2], (bf16_t*)(ws + WS_XBB), SSQP(0), gw, NGW, lane); }
    GRID_SYNC_CG();
    { PHASE_VARS
      if (PH(3)) { float* scr = (float*)(lds + wave * 16384);
      const float* win = ap->in[3];
      for (int it = gw; it < 11776; it += NGW) { int r = it;
          if (tr_mat<0>(r, win, 2080, 0, 1024, 256, (bf16_t*)(ws + WS_W_AB1), 0, 0.125f, scr, lane)) continue;
          if (tr_mat<0>(r, win, 2080, 256, 1024, 1280, (bf16_t*)(ws + WS_W_AB1), 256, 1.f, scr, lane)) continue;
          if (tr_mat<0>(r, (const float*)(ws + WS_FOLDG), 512, 0, 1024, 512, (bf16_t*)(ws + WS_W_AB1), 1536, 1.f, scr, lane)) continue;
          if (tr_mat<0>(r, (const float*)(ws + WS_FOLDF), 1024, 0, 1024, 1024, (bf16_t*)(ws + WS_W_FT), 0, 1.f, scr, lane)) continue;
          if (tr_mat<0>(r, ap->in[9], 1024, 0, 1024, 1024, (bf16_t*)(ws + WS_W_ABO), 0, 1.f, scr, lane)) continue;
          if (tr_mat<1>(r, ap->in[16], FFH, 0, 1024, FFH, (bf16_t*)(ws + WS_W_GU0), 0, 1.f, scr, lane)) continue;
          if (tr_mat<2>(r, ap->in[17], FFH, 0, 1024, FFH, (bf16_t*)(ws + WS_W_GU0), 0, 1.f, scr, lane)) continue;
          if (tr_mat<0>(r, ap->in[18], 1024, 0, FFH, 1024, (bf16_t*)(ws + WS_W_D0), 0, 1.f, scr, lane)) continue;
          if (tr_mat<0>(r, ap->in[11], 1536, 0, 1024, 1536, (bf16_t*)(ws + WS_W_QKV), 0, 1.f, scr, lane)) continue;
          if (tr_mat<0>(r, ap->in[14], 1024, 0, 1024, 1024, (bf16_t*)(ws + WS_W_CO), 0, 1.f, scr, lane)) continue;
          if (tr_mat<1>(r, ap->in[16] + (size_t)1024 * FFH, FFH, 0, 1024, FFH, (bf16_t*)(ws + WS_W_GU1), 0, 1.f, scr, lane)) continue;
          if (tr_mat<2>(r, ap->in[17] + (size_t)1024 * FFH, FFH, 0, 1024, FFH, (bf16_t*)(ws + WS_W_GU1), 0, 1.f, scr, lane)) continue;
          if (tr_mat<0>(r, ap->in[18] + (size_t)1024 * FFH, 1024, 0, FFH, 1024, (bf16_t*)(ws + WS_W_D1), 0, 1.f, scr, lane)) continue;
      } } }
    GRID_SYNC();
    { PHASE_VARS
      if (PH(4)) { pg8::Gemm g{(const bf16_t*)(ws + WS_XBB), (const bf16_t*)(ws + WS_W_AB1), TT, 2048, 1024}; pg8::StaticOrder S; S.init(TT, 2048, G, bx);
        Epi<EM_AB1> E{(bf16_t*)(ws + WS_QKVR), nullptr, nullptr, (float*)(ws + WS_G), nullptr, nullptr, ap->in[5], ap->in[7], SSQP(0), nullptr, nullptr, nullptr};
        pg8::gemm_phase<Epi<EM_AB1>, pg8::StaticOrder, true, true>(lds3, g, S, E); } }
    { PHASE_VARS
      if (PH(5)) { pg8::Gemm g{(const bf16_t*)(ws + WS_W_FT), (const bf16_t*)(ws + WS_XBB), 1024, TT, 1024}; pg8::StaticOrder S; S.init(1024, TT, G, bx);
        Epi<EM_AB1T> E{(bf16_t*)((unsigned char*)out + OUT_YTPC), (bf16_t*)((unsigned char*)out + OUT_YTSC), nullptr, nullptr, nullptr, nullptr, nullptr, nullptr, SSQP(0), nullptr, nullptr, nullptr};
        pg8::gemm_phase<Epi<EM_AB1T>, pg8::StaticOrder, true, true>(lds3, g, S, E); } }
    GRID_SYNC();
    { PHASE_VARS
      if (PH(6)) { pg8::Gemm g{(const bf16_t*)(ws + WS_C4), (const bf16_t*)((unsigned char*)out + OUT_YTPC), 2048, 4096, 4096}; pg8::StaticOrder S; S.init(2048, 4096, G, bx);
        Epi<EM_FNETP> E{(bf16_t*)(ws + WS_PCP), nullptr, nullptr, nullptr, nullptr, nullptr, nullptr, nullptr, nullptr, nullptr, nullptr, nullptr};
        pg8::gemm_phase<Epi<EM_FNETP>, pg8::StaticOrder, true, true>(lds3, g, S, E); } }
    { PHASE_VARS
      if (PH(6)) { pg8::Gemm g{(const bf16_t*)(ws + WS_S4), (const bf16_t*)((unsigned char*)out + OUT_YTPS), 2048, 4096, 4096}; pg8::StaticOrder S; S.init(2048, 4096, G, (bx + G / 2) % G);
        Epi<EM_FNETP> E{(bf16_t*)(ws + WS_PSP), nullptr, nullptr, nullptr, nullptr, nullptr, nullptr, nullptr, nullptr, nullptr, nullptr, nullptr};
        pg8::gemm_phase<Epi<EM_FNETP>, pg8::StaticOrder, true, true>(lds3, g, S, E); } }
    { PHASE_VARS
      if (PH(7)) { pg8::Gemm g{(const bf16_t*)(ws + WS_C2), (const bf16_t*)((unsigned char*)out + OUT_YTSC), 1024, 4096, 2048}; pg8::StaticOrder S; S.init(1024, 4096, G, (bx + G / 2) % G);
        Epi<EM_FNETS> E{(bf16_t*)(ws + WS_PCS), nullptr, nullptr, nullptr, nullptr, nullptr, nullptr, nullptr, nullptr, nullptr, nullptr, nullptr};
        pg8::gemm_phase<Epi<EM_FNETS>, pg8::StaticOrder, true, true>(lds3, g, S, E); } }
    { PHASE_VARS
      if (PH(7)) { pg8::Gemm g{(const bf16_t*)(ws + WS_S2), (const bf16_t*)((unsigned char*)out + OUT_YTSS), 1024, 4096, 2048}; pg8::StaticOrder S; S.init(1024, 4096, G, (bx + G / 4) % G);
        Epi<EM_FNETS> E{(bf16_t*)(ws + WS_PSS), nullptr, nullptr, nullptr, nullptr, nullptr, nullptr, nullptr, nullptr, nullptr, nullptr, nullptr};
        pg8::gemm_phase<Epi<EM_FNETS>, pg8::StaticOrder, true, true>(lds3, g, S, E); } }
    { PHASE_VARS
      if (PH(8)) { const int half = G / 2;
        if (bx < half) { for (int item = bx; item < 2048; item += half) gla_a_item(item, (const bf16_t*)(ws + WS_QKVR), (const float*)(ws + WS_G), (bf16_t*)((unsigned char*)out + OUT_DST), (float*)(ws + WS_DEC), lds, tid, wave, lane); }
        else { for (int item = 2048 + bx - half; item < 3072; item += half) gla_a_item(item, (const bf16_t*)(ws + WS_QKVR), (const float*)(ws + WS_G), (bf16_t*)((unsigned char*)out + OUT_DST), (float*)(ws + WS_DEC), lds, tid, wave, lane); } } }
    GRID_SYNC();
    { PHASE_VARS
      if (PH(9)) for (int g2 = gt; g2 < 131072; g2 += NGT) p_scan((bf16_t*)((unsigned char*)out + OUT_DST), (const float*)(ws + WS_DEC), g2);
      p_fcombine((const bf16_t*)(ws + WS_PCP), (const bf16_t*)(ws + WS_PSP), H, 0, 4096, 11, gt, NGT);
      p_fcombine((const bf16_t*)(ws + WS_PCS), (const bf16_t*)(ws + WS_PSS), H, TP, 2048, 10, gt, NGT);
      p_fmid((const bf16_t*)((unsigned char*)out + OUT_YTPC), H, 0, 4096, gw, NGW, lane);
      p_fmid((const bf16_t*)((unsigned char*)out + OUT_YTSC), H, TP, 2048, gw, NGW, lane); }
    GRID_SYNC();
    { PHASE_VARS
      if (PH(10)) for (int item = bx; item < 3072; item += G)
          gla_c_item(item, (const bf16_t*)(ws + WS_QKVR), (const float*)(ws + WS_G), (const bf16_t*)((unsigned char*)out + OUT_DST), ap->in[8], H, lds, tid, wave, lane); }
    GRID_SYNC();
    { PHASE_VARS
      if (PH(11)) { pg8::Gemm g{H, (const bf16_t*)(ws + WS_W_ABO), TT, 1024, 1024}; pg8::StaticOrder S; S.init(TT, 1024, G, bx);
        Epi<EM_RESIN, true> E{nullptr, nullptr, nullptr, out, ap->in[0], ap->in[1], nullptr, nullptr, nullptr, SSQP(1), (bf16_t*)(ws + WS_XBA), ap->in[15]};
        pg8::gemm_phase<Epi<EM_RESIN, true>, pg8::StaticOrder, true, true>(lds3, g, S, E); } }
    GRID_SYNC();
    ffn_block<0>(lds3);
    GRID_SYNC();
    { PHASE_VARS
      if (PH(13)) { pg8::Gemm g{(const bf16_t*)(ws + WS_XBB), (const bf16_t*)(ws + WS_W_QKV), TT, 1536, 1024}; pg8::StaticOrder S; S.init(TT, 1536, G, bx);
        Epi<EM_QKV> E{(bf16_t*)(ws + WS_Q), (bf16_t*)(ws + WS_K), (bf16_t*)(ws + WS_V), nullptr, nullptr, nullptr, nullptr, nullptr, SSQP(2), nullptr, nullptr, nullptr};
        pg8::gemm_phase<Epi<EM_QKV>, pg8::StaticOrder, true, true>(lds3, g, S, E); } }
    GRID_SYNC();
    { PHASE_VARS
      if (PH(14)) p_qkrope((bf16_t*)(ws + WS_Q), (bf16_t*)(ws + WS_K), ap->in[12], ap->in[13], (const float2*)(ws + WS_ROPE), gw, NGW, lane); }
    GRID_SYNC();
    { PHASE_VARS
      if (PH(15)) { const int vx = bx & 7, vi = bx >> 3;
        bf16_t* Qb = (bf16_t*)(ws + WS_Q); bf16_t* Kb = (bf16_t*)(ws + WS_K); bf16_t* Vb = (bf16_t*)(ws + WS_V); bf16_t* AO = (bf16_t*)(ws + WS_AO);
        for (int i6 = 0; i6 < (PROBE_ATTN ? 12 : 6); ++i6) { const int i = i6 % 6;
            int b, kvh, hq, qb, row0, seq;
            if (i < 4) { const int combo = vx * 2 + (i >> 1), u = (i & 1) * 32 + vi; b = combo >> 1; kvh = combo & 1; hq = kvh * 4 + (u >> 4); qb = u & 15; row0 = b * 4096; seq = 4096; }
            else { const int combo = vx * 2 + (i - 4), u = vi; b = combo >> 1; kvh = combo & 1; hq = kvh * 4 + (u >> 3); qb = u & 7; row0 = TP + b * 2048; seq = 2048; }
            attn::attn_dense_body<attn::bf16>(Qb + (size_t)(row0 + qb * 256) * 1024 + hq * 128, Kb + (size_t)row0 * 256 + kvh * 128, Vb + (size_t)row0 * 256 + kvh * 128,
                                              AO + (size_t)(row0 + qb * 256) * 1024 + hq * 128, seq, (char*)lds);
            __syncthreads();
        } } }
    GRID_SYNC();
    { PHASE_VARS
      if (PH(16)) { pg8::Gemm g{(const bf16_t*)(ws + WS_AO), (const bf16_t*)(ws + WS_W_CO), TT, 1024, 1024}; pg8::StaticOrder S; S.init(TT, 1024, G, bx);
        Epi<EM_RES, true> E{nullptr, nullptr, nullptr, out, nullptr, nullptr, nullptr, nullptr, nullptr, SSQP(3), (bf16_t*)(ws + WS_XBA), ap->in[15] + 1024};
        pg8::gemm_phase<Epi<EM_RES, true>, pg8::StaticOrder, true, true>(lds3, g, S, E); } }
    GRID_SYNC();
    ffn_block<1>(lds3);
}

extern "C" void kernel_launch(void* const* d_in, const int* in_sizes, int n_in, void* d_out, int out_size, void* d_ws, size_t ws_size, hipStream_t stream) {
    static int grid = 0;
    if (grid == 0) {
        int dev = 0, cus = 0, per_cu = 0;
        if (n_in != 19 || out_size != TT * DM || ws_size < WS_END) { fprintf(stderr, "kernel_launch: unexpected shapes: n_in %d out %d ws %zu (need %zu)\n", n_in, out_size, ws_size, (size_t)WS_END); grid = -1; return; }
        if (hipGetDevice(&dev) != hipSuccess || hipDeviceGetAttribute(&cus, hipDeviceAttributeMultiprocessorCount, dev) != hipSuccess) { fprintf(stderr, "kernel_launch: device query failed\n"); grid = -1; return; }
        if (hipFuncSetAttribute((const void*)mega_fwd, hipFuncAttributeMaxDynamicSharedMemorySize, LDS_BYTES) != hipSuccess) { fprintf(stderr, "kernel_launch: hipFuncSetAttribute failed\n"); grid = -1; return; }
        if (hipOccupancyMaxActiveBlocksPerMultiprocessor(&per_cu, (const void*)mega_fwd, 512, LDS_BYTES) != hipSuccess || per_cu < 1) fprintf(stderr, "kernel_launch: occupancy query reports %d blocks per CU\n", per_cu);
        (void)hipGetLastError();
        if (cus != 256) { fprintf(stderr, "kernel_launch: built for a 256-CU device, found %d\n", cus); grid = -1; return; }
        grid = 256;
    }
    if (grid < 0) return;
    if (hipMemsetAsync((char*)d_ws + WS_CTL, 0, CTL_BYTES, stream) != hipSuccess) { fprintf(stderr, "kernel_launch: memset failed\n"); return; }
    Args a{};
    for (int i = 0; i < 19; ++i) a.in[i] = (const float*)d_in[i];
    a.out = (float*)d_out; a.ws = (unsigned char*)d_ws;
    void* args[] = {&a};
    const hipError_t e = hipLaunchCooperativeKernel((const void*)mega_fwd, dim3(grid), dim3(512), args, LDS_BYTES, stream);
    if (e != hipSuccess) fprintf(stderr, "kernel_launch: cooperative launch failed: %s\n", hipGetErrorString(e));
}
```

```cpp
#include <hip/hip_runtime.h>
#include <hip/hip_cooperative_groups.h>
#include <cstdio>
#include <cstdint>
namespace cg = cooperative_groups;
#define DEVI __device__ __forceinline__
namespace pg8 {
#define PG8_LAS __attribute__((address_space(3)))
typedef unsigned short bf16_t;
typedef short bf16x8 __attribute__((ext_vector_type(8)));
typedef float f32x4 __attribute__((ext_vector_type(4)));
typedef unsigned u32x4 __attribute__((ext_vector_type(4)));
constexpr int BM = 256, BK = 64, HALF = 128, HTB = HALF * BK * 2  , STAGE_BYTES = 8 * HTB, NXCD = 8, WGM = 8;

__host__ __device__ __forceinline__ int lds_byte(int r, int c) { const int st = (r >> 4) * 2 + (c >> 5), rr = r & 15, cc = c & 31, ob = rr * 64 + cc * 2; return st * 1024 + (ob ^ (((ob >> 9) & 1) << 5)); }
__host__ __device__ __forceinline__ void stage_rc(int b, int& R, int& C) { const int st = b / 1024, sb = b % 1024, swz = sb ^ (((sb >> 9) & 1) << 5); R = (st >> 1) * 16 + swz / 64; C = (st & 1) * 32 + (swz % 64) / 2; }
__host__ __device__ __forceinline__ int perm32(int rho) { const int n = rho >> 4, i = rho & 15; return 8 * (i >> 2) + 4 * n + (i & 3); }

struct Unit { int pm, pn; };
struct Gemm { const bf16_t* A; const bf16_t* Bt; int M, N, K; };

struct StaticOrder {
    int nM, nN, nwg, G, c;
    __host__ __device__ void init(int M, int N, int G_, int c_) { nM = M / BM; nN = N / BM; nwg = nM * nN; G = G_; c = c_; }
    __host__ __device__ bool next(int i, Unit& u) const {
        const long L = (long)i * G + c; if (L >= nwg) return false;
        int wgid = (int)L; { const int q = nwg / NXCD, r = nwg % NXCD, xcd = wgid % NXCD, off = wgid / NXCD; wgid = (xcd < r ? xcd * (q + 1) : r * (q + 1) + (xcd - r) * q) + off; }
        const int nig = WGM * nN, gid = wgid / nig, fm = gid * WGM, gsz = (nM - fm) < WGM ? (nM - fm) : WGM;
        u.pm = fm + ((wgid % nig) % gsz); u.pn = (wgid % nig) / gsz; return true;
    }
    __device__ __forceinline__ void a_ready(const Unit&) const {}
    __device__ __forceinline__ void done(const Unit&) const {}
};

__device__ __forceinline__ unsigned cvt_pk_bf16(float lo, float hi) { unsigned r; asm volatile("v_cvt_pk_bf16_f32 %0, %1, %2" : "=v"(r) : "v"(lo), "v"(hi)); return r; }
template <class Epi, class Sched, bool ALIGN_EPI = false, bool SP2 = false>
__device__ __forceinline__ void gemm_phase(PG8_LAS unsigned char* lds, const Gemm g, const Sched& S, const Epi& E) {
    int tid_ = threadIdx.x; asm volatile("" : "+v"(tid_));
    const int tid = tid_, wid = __builtin_amdgcn_readfirstlane(tid >> 6), lane = tid & 63, wr = wid >> 2, wc = wid & 3, fr = lane & 15, fq = lane >> 4;
    const int K = g.K, nt = K / BK;
    unsigned voffA[2], voffB[2];
#pragma unroll
    for (int i = 0; i < 2; ++i) { int R, C; stage_rc(tid * 16 + i * 8192, R, C); const int Rb = Epi::PERM ? ((R & ~31) + perm32(R & 31)) : R;
        voffA[i] = (unsigned)(R * K + C) * 2u; voffB[i] = (unsigned)(Rb * K + C) * 2u; }
    const size_t kstep = (size_t)(BK * 2);
    const size_t hstep = (size_t)HALF * K * 2;
    const size_t tstep = 2 * hstep;
    const unsigned ldsw = (unsigned)wid * 1024u;
    const int aoff = lds_byte(wr * 64 + fr, fq * 8), boff = lds_byte(wc * 32 + fr, fq * 8);
#define PG8_SA(b, h) (((b) * 2 + (h)) * HTB)
#define PG8_SB(b, h) ((4 + (b) * 2 + (h)) * HTB)
#define PG8_STAGE(bufoff, gbase, voff) do { _Pragma("unroll") for (int _i = 0; _i < 2; ++_i) \
        __builtin_amdgcn_global_load_lds((const unsigned*)((const char*)(gbase) + (voff)[_i]), (PG8_LAS unsigned*)(lds + (bufoff) + ldsw + _i * 8192), 16, 0, 0); } while (0)
#define PG8_LDA(dst, b, h) do { _Pragma("unroll") for (int m = 0; m < 4; ++m) _Pragma("unroll") for (int k = 0; k < 2; ++k) dst[m][k] = *(const PG8_LAS bf16x8*)(lds + PG8_SA(b, h) + aoff + m * 2048 + k * 1024); } while (0)
#define PG8_LDB(dst, b, h) do { _Pragma("unroll") for (int n = 0; n < 2; ++n) _Pragma("unroll") for (int k = 0; k < 2; ++k) dst[n][k] = *(const PG8_LAS bf16x8*)(lds + PG8_SB(b, h) + boff + n * 2048 + k * 1024); } while (0)
#define PG8_MMA(ai, bj, At, Bt) do { __builtin_amdgcn_s_setprio(1); _Pragma("unroll") for (int m = 0; m < 4; ++m) _Pragma("unroll") for (int n = 0; n < 2; ++n) _Pragma("unroll") for (int k = 0; k < 2; ++k) \
        acc[ai][bj][m][n] = __builtin_amdgcn_mfma_f32_16x16x32_bf16(Bt[n][k], At[m][k], acc[ai][bj][m][n], 0, 0, 0); __builtin_amdgcn_s_setprio(0); } while (0)
#define PG8_WAIT_V(n) asm volatile("s_waitcnt vmcnt(" #n ")" ::: "memory")
#define PG8_WAIT_L(n) asm volatile("s_waitcnt lgkmcnt(" #n ")" ::: "memory")
#define PG8_BAR __builtin_amdgcn_s_barrier()
#define PG8_SCHED __builtin_amdgcn_sched_barrier(0)
    Unit cur, nxt; int ui = 0;
    if (!S.next(0, cur)) return;
    f32x4 acc[2][2][4][2];
#pragma unroll
    for (int a = 0; a < 2; ++a)
#pragma unroll
        for (int b = 0; b < 2; ++b)
#pragma unroll
            for (int m = 0; m < 4; ++m)
#pragma unroll
                for (int n = 0; n < 2; ++n) acc[a][b][m][n] = (f32x4){0.f, 0.f, 0.f, 0.f};
    bf16x8 At[4][2], B0[2][2], B1[2][2];
    const char* cA = (const char*)g.A + (size_t)cur.pm * tstep; const char* cB = (const char*)g.Bt + (size_t)cur.pn * tstep;
    S.a_ready(cur);
    if constexpr (SP2) {
        PG8_STAGE(PG8_SB(0, 0), cB, voffB); PG8_STAGE(PG8_SB(0, 1), cB + hstep, voffB); PG8_STAGE(PG8_SA(0, 0), cA, voffA); PG8_STAGE(PG8_SA(0, 1), cA + hstep, voffA);
        if (wr == 1) PG8_BAR;
        PG8_WAIT_V(2); PG8_BAR;
        PG8_STAGE(PG8_SB(1, 0), cB + kstep, voffB); PG8_STAGE(PG8_SA(1, 0), cA + kstep, voffA); PG8_STAGE(PG8_SB(1, 1), cB + hstep + kstep, voffB);
        PG8_WAIT_V(6); PG8_BAR;
    } else {
        PG8_STAGE(PG8_SB(0, 0), cB, voffB); PG8_STAGE(PG8_SA(0, 0), cA, voffA); PG8_STAGE(PG8_SB(0, 1), cB + hstep, voffB); PG8_STAGE(PG8_SA(0, 1), cA + hstep, voffA);
        if (wr == 1) PG8_BAR;
        PG8_WAIT_V(4); PG8_BAR;
        PG8_STAGE(PG8_SB(1, 0), cB + kstep, voffB); PG8_STAGE(PG8_SA(1, 0), cA + kstep, voffA); PG8_STAGE(PG8_SB(1, 1), cB + hstep + kstep, voffB);
        PG8_WAIT_V(6); PG8_BAR;
    }
    for (;;) {
        const bool has_next = S.next(ui + 1, nxt);
        const char* nA = has_next ? (const char*)g.A + (size_t)nxt.pm * tstep : cA; const char* nB = has_next ? (const char*)g.Bt + (size_t)nxt.pn * tstep : cB;
        for (int t = 0; t < nt; t += 2) {
            const bool last = (t == nt - 2);
            const char* a1 = cA + (size_t)(t + 1) * kstep;
            const char* a2 = last ? nA : cA + (size_t)(t + 2) * kstep; const char* b2 = last ? nB : cB + (size_t)(t + 2) * kstep;
            const char* a3 = a2 + kstep; const char* b3 = b2 + kstep;
            if (last && has_next) S.a_ready(nxt);
            if constexpr (SP2) {
            PG8_LDB(B0, 0, 0); PG8_LDB(B1, 0, 1); PG8_SCHED; PG8_LDA(At, 0, 0); PG8_STAGE(PG8_SA(1, 1), a1 + hstep, voffA);
            PG8_WAIT_V(8); PG8_WAIT_L(0); PG8_BAR; PG8_MMA(0, 0, At, B0); PG8_MMA(0, 1, At, B1); PG8_BAR; PG8_SCHED;
            PG8_LDA(At, 0, 1); PG8_STAGE(PG8_SB(0, 0), b2, voffB); PG8_STAGE(PG8_SB(0, 1), b2 + hstep, voffB); PG8_STAGE(PG8_SA(0, 0), a2, voffA);
            PG8_WAIT_V(8); PG8_WAIT_L(0); PG8_BAR; PG8_MMA(1, 0, At, B0); PG8_MMA(1, 1, At, B1); PG8_BAR; PG8_SCHED;
            PG8_LDB(B0, 1, 0); PG8_LDB(B1, 1, 1); PG8_SCHED; PG8_LDA(At, 1, 0); PG8_STAGE(PG8_SA(0, 1), a2 + hstep, voffA);
            PG8_WAIT_V(8); PG8_WAIT_L(0); PG8_BAR; PG8_MMA(0, 0, At, B0); PG8_MMA(0, 1, At, B1); PG8_BAR; PG8_SCHED;
            PG8_LDA(At, 1, 1); PG8_STAGE(PG8_SB(1, 0), b3, voffB); PG8_STAGE(PG8_SB(1, 1), b3 + hstep, voffB); PG8_STAGE(PG8_SA(1, 0), a3, voffA);
            PG8_WAIT_V(8); PG8_WAIT_L(0); PG8_BAR; PG8_MMA(1, 0, At, B0); PG8_MMA(1, 1, At, B1); PG8_BAR; PG8_SCHED;
            } else {
            PG8_LDB(B0, 0, 0); PG8_SCHED; PG8_LDA(At, 0, 0); PG8_STAGE(PG8_SA(1, 1), a1 + hstep, voffA);
            PG8_WAIT_L(8); PG8_BAR; PG8_WAIT_L(0); PG8_MMA(0, 0, At, B0); PG8_BAR; PG8_SCHED;
            PG8_LDB(B1, 0, 1); PG8_STAGE(PG8_SB(0, 0), b2, voffB);
            PG8_BAR; PG8_WAIT_L(0); PG8_MMA(0, 1, At, B1); PG8_BAR;
            PG8_LDA(At, 0, 1); PG8_STAGE(PG8_SA(0, 0), a2, voffA);
            PG8_BAR; PG8_WAIT_L(0); PG8_MMA(1, 0, At, B0); PG8_BAR; PG8_SCHED;
            PG8_STAGE(PG8_SB(0, 1), b2 + hstep, voffB);
            PG8_WAIT_V(6); PG8_BAR; PG8_MMA(1, 1, At, B1); PG8_BAR;
            PG8_LDB(B0, 1, 0); PG8_SCHED; PG8_LDA(At, 1, 0); PG8_STAGE(PG8_SA(0, 1), a2 + hstep, voffA);
            PG8_WAIT_L(8); PG8_BAR; PG8_WAIT_L(0); PG8_MMA(0, 0, At, B0); PG8_BAR; PG8_SCHED;
            PG8_LDB(B1, 1, 1); PG8_STAGE(PG8_SB(1, 0), b3, voffB);
            PG8_BAR; PG8_WAIT_L(0); PG8_MMA(0, 1, At, B1); PG8_BAR;
            PG8_LDA(At, 1, 1); PG8_STAGE(PG8_SA(1, 0), a3, voffA);
            PG8_BAR; PG8_WAIT_L(0); PG8_MMA(1, 0, At, B0); PG8_BAR; PG8_SCHED;
            PG8_STAGE(PG8_SB(1, 1), b3 + hstep, voffB);
            PG8_WAIT_V(6); PG8_BAR; PG8_MMA(1, 1, At, B1); PG8_BAR;
            }
        }
        if constexpr (ALIGN_EPI) { if (wr == 0) PG8_BAR; }
        if constexpr (!Epi::AFTER_DRAIN) { E(acc, cur, wr, wc, fr, fq); S.done(cur); }
        if (!has_next) break;
#pragma unroll
        for (int a = 0; a < 2; ++a)
#pragma unroll
            for (int b = 0; b < 2; ++b)
#pragma unroll
                for (int m = 0; m < 4; ++m)
#pragma unroll
                    for (int n = 0; n < 2; ++n) acc[a][b][m][n] = (f32x4){0.f, 0.f, 0.f, 0.f};
        cur = nxt; cA = nA; cB = nB; ++ui;
        if constexpr (ALIGN_EPI) { if (wr == 1) PG8_BAR; }
    }
    PG8_WAIT_V(0);
    if constexpr (!ALIGN_EPI) { if (wr == 0) PG8_BAR; }
    PG8_BAR;
    if constexpr (Epi::AFTER_DRAIN) { E.fused(acc, cur, wr, wc, fr, fq, lds, wid, lane); S.done(cur); }
#undef PG8_SA
#undef PG8_SB
#undef PG8_STAGE
#undef PG8_LDA
#undef PG8_LDB
#undef PG8_MMA
#undef PG8_WAIT_V
#undef PG8_WAIT_L
#undef PG8_BAR
#undef PG8_SCHED
}
}

typedef unsigned short bf16_t;
typedef short bf16x8 __attribute__((ext_vector_type(8)));
typedef float f32x4 __attribute__((ext_vector_type(4)));
typedef float f32x16 __attribute__((ext_vector_type(16)));
typedef unsigned u32x4 __attribute__((ext_vector_type(4)));
typedef unsigned u32x2 __attribute__((ext_vector_type(2)));
typedef float f32x2_t __attribute__((ext_vector_type(2)));
typedef __bf16 bf16x2_t __attribute__((ext_vector_type(2)));

constexpr int TP = 32768, TS = 16384, TT = TP + TS, DM = 1024, FFH = 2816, SP = 4096, SS = 2048;
constexpr float EPS = 1e-6f;
constexpr size_t MiB = 1u << 20;
constexpr size_t WS_CTL = 0, CTL_BYTES = 64 * 1024;
constexpr size_t WS_ROPE = 1 * MiB;
constexpr size_t WS_W_AB1 = 2 * MiB;
constexpr size_t WS_W_FT = 6 * MiB;
constexpr size_t WS_W_ABO = 8 * MiB;
constexpr size_t WS_W_GU0 = 10 * MiB;
constexpr size_t WS_W_D0 = 21 * MiB;
constexpr size_t WS_W_QKV = 27 * MiB;
constexpr size_t WS_W_CO = 30 * MiB;
constexpr size_t WS_W_GU1 = 32 * MiB;
constexpr size_t WS_W_D1 = 43 * MiB;
constexpr size_t WS_DEC = 49 * MiB;
constexpr size_t WS_C4 = 51 * MiB, WS_S4 = 67 * MiB;
constexpr size_t WS_C2 = 83 * MiB, WS_S2 = 87 * MiB;
constexpr size_t WS_PCP = 91 * MiB, WS_PSP = 107 * MiB;
constexpr size_t WS_PCS = 123 * MiB, WS_PSS = 131 * MiB;
constexpr size_t WS_SSQ = 1 * MiB + 256 * 1024;
constexpr size_t WS_XBA = 51 * MiB;
constexpr size_t WS_XBB = 147 * MiB;
constexpr size_t WS_H = WS_XBB;
constexpr size_t WS_BIG = 243 * MiB;
constexpr size_t WS_QKVR = WS_BIG;
constexpr size_t WS_G = WS_BIG + 144 * MiB;
constexpr size_t WS_FOLDF = WS_BIG;
constexpr size_t WS_FOLDG = WS_BIG + 4 * MiB;
constexpr size_t WS_ACT = WS_BIG;
constexpr size_t WS_Q = WS_BIG, WS_K = WS_BIG + 96 * MiB, WS_V = WS_BIG + 120 * MiB, WS_AO = WS_BIG + 144 * MiB;
constexpr size_t WS_END = WS_BIG + 264 * MiB;
constexpr size_t OUT_YTPC = 0, OUT_YTPS = 32 * MiB, OUT_YTSC = 64 * MiB, OUT_YTSS = 80 * MiB, OUT_DST = 96 * MiB;

DEVI float bf2f(bf16_t x) { return __uint_as_float(((unsigned)x) << 16); }
DEVI unsigned pk2(float lo, float hi) { f32x2_t v = {lo, hi}; bf16x2_t b = __builtin_convertvector(v, bf16x2_t); return __builtin_bit_cast(unsigned, b); }
DEVI bf16_t f2bf(float f) { return (bf16_t)(pk2(f, 0.f) & 0xffffu); }
DEVI u32x4 pk8(f32x4 a, f32x4 b) { u32x4 w; w.x = pk2(a[0], a[1]); w.y = pk2(a[2], a[3]); w.z = pk2(b[0], b[1]); w.w = pk2(b[2], b[3]); return w; }
DEVI float wave_sum(float v) {
#pragma unroll
    for (int o = 1; o < 64; o <<= 1) v += __shfl_xor(v, o);
    return v;
}
DEVI float logsig(float z) { return fminf(z, 0.f) - __logf(1.f + __expf(-fabsf(z))); }
DEVI float silu(float z) { return z * __builtin_amdgcn_rcpf(1.f + __expf(-z)); }

enum { EM_AB1, EM_AB1T, EM_FNETP, EM_FNETS, EM_RESIN, EM_RES, EM_GLU, EM_QKV };
template <int MODE, bool NEXT = false> struct Epi {
    static constexpr bool PERM = true, AFTER_DRAIN = false;
    bf16_t* O0; bf16_t* O1; bf16_t* O2; float* F0; const float* X0; const float* X1; const float* B0; const float* B1;
    const float* SQI; float* SQO; bf16_t* XBN; const float* GN;
    DEVI float rstd_of(int row) const { return rsqrtf(SQI[row] * (1.f / 1024.f) + EPS); }
    DEVI void operator()(const f32x4 (&acc)[2][2][4][2], const pg8::Unit& u, int wr, int wc, int fr, int fq) const {
        const int rbase = u.pm * 256 + wr * 64 + fr, cb = wc * 32 + 8 * fq;
        f32x4 ga[2][2];
        if constexpr (NEXT) {
#pragma unroll
            for (int bj = 0; bj < 2; ++bj) { ga[bj][0] = *(const f32x4*)(GN + u.pn * 256 + bj * 128 + cb); ga[bj][1] = *(const f32x4*)(GN + u.pn * 256 + bj * 128 + cb + 4); } }
        if constexpr (MODE == EM_AB1T) {
#pragma unroll
            for (int bj = 0; bj < 2; ++bj) { const f32x4 s0 = *(const f32x4*)(SQI + u.pn * 256 + bj * 128 + cb), s1 = *(const f32x4*)(SQI + u.pn * 256 + bj * 128 + cb + 4);
#pragma unroll
                for (int j = 0; j < 4; ++j) { ga[bj][0][j] = rsqrtf(s0[j] * (1.f / 1024.f) + EPS); ga[bj][1][j] = rsqrtf(s1[j] * (1.f / 1024.f) + EPS); } } }
        float rsv[2][4];
        if constexpr (MODE == EM_AB1 || MODE == EM_GLU || MODE == EM_QKV) {
#pragma unroll
            for (int ai = 0; ai < 2; ++ai)
#pragma unroll
                for (int m = 0; m < 4; ++m) rsv[ai][m] = SQI[rbase + ai * 128 + m * 16];
#pragma unroll
            for (int ai = 0; ai < 2; ++ai)
#pragma unroll
                for (int m = 0; m < 4; ++m) rsv[ai][m] = rsqrtf(rsv[ai][m] * (1.f / 1024.f) + EPS);
        }
#pragma unroll
        for (int ai = 0; ai < 2; ++ai)
#pragma unroll
            for (int m = 0; m < 4; ++m) {
                const int row = rbase + ai * 128 + m * 16;
                float rs = 1.f, ssq = 0.f;
                if constexpr (MODE == EM_AB1 || MODE == EM_GLU || MODE == EM_QKV) rs = rsv[ai][m];
                if constexpr (MODE == EM_GLU) {
                    const f32x4 g0 = acc[ai][0][m][0] * rs, g1 = acc[ai][0][m][1] * rs, u0 = acc[ai][1][m][0] * rs, u1 = acc[ai][1][m][1] * rs;
                    f32x4 a, b;
#pragma unroll
                    for (int j = 0; j < 4; ++j) { a[j] = silu(g0[j]) * u0[j]; b[j] = silu(g1[j]) * u1[j]; }
                    *(u32x4*)(O0 + (size_t)row * FFH + u.pn * 128 + cb) = pk8(a, b);
                } else {
#pragma unroll
                    for (int bj = 0; bj < 2; ++bj) {
                        f32x4 v0 = acc[ai][bj][m][0] * rs, v1 = acc[ai][bj][m][1] * rs;
                        const int c = bj * 128 + cb;
                        if constexpr (MODE == EM_AB1T) { v0 = v0 * ga[bj][0]; v1 = v1 * ga[bj][1]; }
                        if constexpr (MODE == EM_AB1) {
                            if (u.pn < 6) { *(u32x4*)(O0 + (size_t)row * 1536 + u.pn * 256 + c) = pk8(v0, v1); }
                            else { const int dir = u.pn - 6; const float* bias = dir ? B1 : B0;
                                const f32x4 b0 = *(const f32x4*)(bias + c), b1 = *(const f32x4*)(bias + c + 4);
                                f32x4 a, b;
#pragma unroll
                                for (int j = 0; j < 4; ++j) { a[j] = logsig(v0[j] + b0[j]) * 0.0625f; b[j] = logsig(v1[j] + b1[j]) * 0.0625f; }
                                float* gp = F0 + (size_t)row * 512 + dir * 256 + c; *(f32x4*)gp = a; *(f32x4*)(gp + 4) = b; }
                        } else if constexpr (MODE == EM_AB1T) {
                            const int cc = row, t0 = u.pn * 256;
                            bf16_t* dst;
                            if (t0 < TP) { const int b = t0 >> 12, s = (t0 & 4095) + c; dst = O0 + (size_t)(cc >> 9) * (4096 * 4096) + (size_t)(b * 512 + (cc & 511)) * 4096 + s; }
                            else { const int tt = t0 - TP, b = tt >> 11, s = (tt & 2047) + c; dst = O1 + (size_t)(cc >> 9) * (4096 * 2048) + (size_t)(b * 512 + (cc & 511)) * 2048 + s; }
                            *(u32x4*)dst = pk8(v0, v1);
                        } else if constexpr (MODE == EM_FNETP) {
                            *(u32x4*)(O0 + ((size_t)(u.pn >> 1) * 2048 + row) * 512 + (u.pn & 1) * 256 + c) = pk8(v0, v1);
                        } else if constexpr (MODE == EM_FNETS) {
                            *(u32x4*)(O0 + ((size_t)(u.pn >> 1) * 1024 + row) * 512 + (u.pn & 1) * 256 + c) = pk8(v0, v1);
                        } else if constexpr (MODE == EM_RESIN) {
                            const float* xp = (row < TP ? X0 + (size_t)row * 1024 : X1 + (size_t)(row - TP) * 1024) + u.pn * 256 + c;
                            float* op = F0 + (size_t)row * 1024 + u.pn * 256 + c;
                            const f32x4 x0 = *(const f32x4*)xp + v0, x1 = *(const f32x4*)(xp + 4) + v1;
                            *(f32x4*)op = x0; *(f32x4*)(op + 4) = x1;
                            if constexpr (NEXT) { ssq += (x0[0] * x0[0] + x0[1] * x0[1]) + (x0[2] * x0[2] + x0[3] * x0[3]) + (x1[0] * x1[0] + x1[1] * x1[1]) + (x1[2] * x1[2] + x1[3] * x1[3]);
                                *(u32x4*)(XBN + (size_t)row * 1024 + u.pn * 256 + c) = pk8(x0 * ga[bj][0], x1 * ga[bj][1]); }
                        } else if constexpr (MODE == EM_RES) {
                            float* op = F0 + (size_t)row * 1024 + u.pn * 256 + c;
                            const f32x4 x0 = *(const f32x4*)op + v0, x1 = *(const f32x4*)(op + 4) + v1;
                            *(f32x4*)op = x0; *(f32x4*)(op + 4) = x1;
                            if constexpr (NEXT) { ssq += (x0[0] * x0[0] + x0[1] * x0[1]) + (x0[2] * x0[2] + x0[3] * x0[3]) + (x1[0] * x1[0] + x1[1] * x1[1]) + (x1[2] * x1[2] + x1[3] * x1[3]);
                                *(u32x4*)(XBN + (size_t)row * 1024 + u.pn * 256 + c) = pk8(x0 * ga[bj][0], x1 * ga[bj][1]); }
                        } else if constexpr (MODE == EM_QKV) {
                            bf16_t* dst;
                            if (u.pn < 4) dst = O0 + (size_t)row * 1024 + u.pn * 256 + c;
                            else if (u.pn == 4) dst = O1 + (size_t)row * 256 + c;
                            else dst = O2 + (size_t)row * 256 + c;
                            *(u32x4*)dst = pk8(v0, v1);
                        }
                    }
                    if constexpr (NEXT) { ssq += __shfl_xor(ssq, 16); ssq += __shfl_xor(ssq, 32); if (fq == 0) atomicAdd(SQO + row, ssq); }
                }
            }
    }
};

DEVI void p_fold(const float* win, const float* upf, const float* upb, float* FF, float* FG, float* tab, int gw, int NGW, int lane) {
    if (threadIdx.x < 128) tab[threadIdx.x] = cospif((float)threadIdx.x * (1.f / 64.f));
    __syncthreads();
    for (int it = gw; it < 1024 * 16; it += NGW) {
        const int k = it >> 4, cb = it & 15, cc = cb * 64 + lane, part = cc >> 9, g = (cc >> 7) & 3, l = cc & 127;
        const float* wr = win + (size_t)k * 2080 + 1568 + g * 128;
        const int sh = part ? 96 : 0;
        float acc = 0.f;
#pragma unroll 8
        for (int w = 0; w < 128; ++w) acc += wr[w] * tab[(w * l + sh) & 127];
        FF[(size_t)k * 1024 + cc] = acc;
    }
    for (int it = gw; it < 1024 * 8; it += NGW) {
        const int k = it >> 3, nb = it & 7, n = nb * 64 + lane, dir = n >> 8, nn = n & 255;
        const float* wr = win + (size_t)k * 2080 + 1536 + dir * 16;
        const float* up = dir ? upb : upf;
        float acc = 0.f;
#pragma unroll
        for (int r = 0; r < 16; ++r) acc += wr[r] * up[r * 256 + nn];
        FG[(size_t)k * 512 + n] = acc;
    }
    __syncthreads();
}
DEVI void p_dft(bf16_t* C, bf16_t* Sn, int S, int logS, int gt, int NGT) {
    const int lri = logS - 3;
    const long total = (long)(S / 2) << lri;
    const float nrm = rsqrtf((float)S * 128.f), xs = 2.f / (float)S;
    for (long it = gt; it < 2 * total; it += NGT) {
        const int part = it >= total; const long i2 = part ? it - total : it;
        const int k = (int)(i2 >> lri), s0 = (int)(i2 & ((1 << lri) - 1)) * 8;
        float v[8];
#pragma unroll
        for (int j = 0; j < 8; ++j) { const int idx = (k * (s0 + j)) & (S - 1); const float x = (float)idx * xs; v[j] = (part ? sinpif(x) : cospif(x)) * nrm; }
        u32x4 w; w.x = pk2(v[0], v[1]); w.y = pk2(v[2], v[3]); w.z = pk2(v[4], v[5]); w.w = pk2(v[6], v[7]);
        *(u32x4*)((part ? Sn : C) + (size_t)k * S + s0) = w;
    }
}
DEVI void p_fcombine(const bf16_t* PC, const bf16_t* PS, bf16_t* MIX, int tokbase, int S, int logSH, int gt, int NGT) {
    const int total = 8 << (logSH + 6);
    for (int it = gt; it < total; it += NGT) {
        const int ch = it & 63, k = (it >> 6) & ((1 << logSH) - 1), b = it >> (6 + logSH);
        const u32x4 pc = *(const u32x4*)(PC + ((size_t)(b << logSH) + k) * 512 + ch * 8), ps = *(const u32x4*)(PS + ((size_t)(b << logSH) + k) * 512 + ch * 8);
        u32x4 lo, hi;
#pragma unroll
        for (int j = 0; j < 4; ++j) { const float c0 = __uint_as_float(pc[j] << 16), c1 = __uint_as_float(pc[j] & 0xffff0000u), s0 = __uint_as_float(ps[j] << 16), s1 = __uint_as_float(ps[j] & 0xffff0000u);
            lo[j] = pk2(c0 - s0, c1 - s1); hi[j] = pk2(c0 + s0, c1 + s1); }
        *(u32x4*)(MIX + (size_t)(tokbase + b * S + k) * 1024 + 512 + ch * 8) = lo;
        if (k) *(u32x4*)(MIX + (size_t)(tokbase + b * S + S - k) * 1024 + 512 + ch * 8) = hi;
    }
}
DEVI void p_fmid(const bf16_t* YC, bf16_t* MIX, int tokbase, int S, int gw, int NGW, int lane) {
    const float nrm = rsqrtf((float)S * 128.f);
    for (int r = gw; r < 4096; r += NGW) {
        const bf16_t* row = YC + (size_t)r * S; float acc = 0.f;
        for (int s0 = lane * 8; s0 < S; s0 += 512) { const u32x4 w = *(const u32x4*)(row + s0);
#pragma unroll
            for (int j = 0; j < 4; ++j) acc += __uint_as_float(w[j] << 16) - __uint_as_float(w[j] & 0xffff0000u); }
        acc = wave_sum(acc);
        if (lane == 0) MIX[(size_t)(tokbase + (r >> 9) * S + S / 2) * 1024 + 512 + (r & 511)] = f2bf(acc * nrm);
    }
}
DEVI void p_norm(const float* src0, const float* src1, const float* gain, bf16_t* H, float* SQ, int gw, int NGW, int lane) {
    f32x4 gv[4];
#pragma unroll
    for (int j = 0; j < 4; ++j) gv[j] = *((const f32x4*)gain + lane + 64 * j);
    for (int m = gw; m < TT; m += NGW) {
        const f32x4* xr = (const f32x4*)(m < TP ? src0 + (size_t)m * DM : src1 + (size_t)(m - TP) * DM) + lane;
        f32x4 v[4]; float s = 0.f;
#pragma unroll
        for (int j = 0; j < 4; ++j) { v[j] = xr[64 * j]; s += (v[j].x * v[j].x + v[j].y * v[j].y) + (v[j].z * v[j].z + v[j].w * v[j].w); }
        const float rstd = 1.f; { const float tot = wave_sum(s); if (lane == 0) SQ[m] = tot; }
        u32x2* o8 = (u32x2*)(H + (size_t)m * DM) + lane;
#pragma unroll
        for (int j = 0; j < 4; ++j) { u32x2 w; w.x = pk2(v[j].x * rstd * gv[j].x, v[j].y * rstd * gv[j].y); w.y = pk2(v[j].z * rstd * gv[j].z, v[j].w * rstd * gv[j].w); o8[64 * j] = w; }
    }
}
DEVI void tr_item(const float* W, int ld, int col0, bf16_t* WT, int Kd, int drow0, float scale, float* scr, int k0, int n0, int lane) {
#pragma unroll 8
    for (int i = 0; i < 32; ++i) { const int kk = 2 * i + (lane >> 5); scr[kk * 33 + (lane & 31)] = W[(size_t)(k0 + kk) * ld + col0 + n0 + (lane & 31)]; }
    asm volatile("s_waitcnt lgkmcnt(0)" ::: "memory");
    const int c = lane & 7;
#pragma unroll
    for (int j = 0; j < 4; ++j) { const int n = (lane >> 3) + 8 * j; const float* s = scr + (8 * c) * 33 + n;
        u32x4 o; o.x = pk2(s[0] * scale, s[33] * scale); o.y = pk2(s[66] * scale, s[99] * scale); o.z = pk2(s[132] * scale, s[165] * scale); o.w = pk2(s[198] * scale, s[231] * scale);
        *(u32x4*)(WT + (size_t)(drow0 + n) * Kd + k0 + 8 * c) = o; }
    asm volatile("s_waitcnt lgkmcnt(0)" ::: "memory");
}
template <int MAP> DEVI bool tr_mat(int& r, const float* W, int ld, int col0, int K, int ncols, bf16_t* WT, int drow, float scale, float* scr, int lane) {
    const int nblk = ncols >> 5, cnt = (K >> 6) * nblk;
    if (r >= cnt) { r -= cnt; return false; }
    const int kb = r / nblk, nb = r - kb * nblk, n0 = nb * 32;
    int d0 = drow + n0;
    if (MAP == 1) d0 = (n0 >> 7) * 256 + (n0 & 127);
    if (MAP == 2) d0 = (n0 >> 7) * 256 + 128 + (n0 & 127);
    tr_item(W, ld, col0, WT, K, d0, scale, scr, kb * 64, n0, lane);
    return true;
}

constexpr int GP = 144;
constexpr int L_QF = 0, L_QB = 9216, L_KF = 18432, L_KB = 27648, L_VT = 36864, L_ATF = 55296, L_ATB = 64512, L_SPF = 73728, L_SPB = 92160, L_SEG = 110592;
constexpr int L_KDF = 0, L_KDB = 9216;
DEVI int crow(int r, int hi) { return (r & 3) + 8 * (r >> 2) + 4 * hi; }
DEVI bf16x8 ldf(const unsigned char* base, int row, int ks, int hi) { return *(const bf16x8*)(base + row * GP + ks * 32 + hi * 16); }

#define LBAR() do { asm volatile("s_waitcnt lgkmcnt(0)" ::: "memory"); __builtin_amdgcn_s_barrier(); asm volatile("" ::: "memory"); } while (0)
struct GlaLd { float gf[8], gb[8]; bf16_t qh[8], kh[8], vh[16]; u32x4 sp[4]; u32x4 r0, r1; };
template <bool FULL> DEVI void gla_load(GlaLd& L, int item, const bf16_t* QKVR, const float* G, const bf16_t* DST, int tid) {
    const int n = item >> 2, h = item & 3, tok0 = n * 64, d = tid & 63, sg = tid >> 6, e = tid & 127, s4 = tid >> 7;
#pragma unroll
    for (int i = 0; i < 8; ++i) { const float* p = G + (size_t)(tok0 + 8 * sg + i) * 512 + h * 64 + d; L.gf[i] = p[0]; L.gb[i] = p[256]; }
#pragma unroll
    for (int i = 0; i < 8; ++i) { const bf16_t* tr = QKVR + (size_t)(tok0 + 8 * sg + i) * 1536 + h * 64 + d; if (FULL) L.qh[i] = tr[0]; L.kh[i] = tr[256]; }
#pragma unroll
    for (int i = 0; i < 16; ++i) L.vh[i] = QKVR[(size_t)(tok0 + 16 * s4 + i) * 1536 + 512 + h * 128 + e];
    if (FULL) {
#pragma unroll
        for (int p = 0; p < 2; ++p) { const int row = (tid >> 3) + 64 * p, c = tid & 7;
            L.sp[2 * p] = *(const u32x4*)(DST + (size_t)(item * 2) * 8192 + row * 64 + c * 8); L.sp[2 * p + 1] = *(const u32x4*)(DST + (size_t)(item * 2 + 1) * 8192 + row * 64 + c * 8); }
        const int i = tid >> 3, s8 = tid & 7; const bf16_t* rp = QKVR + (size_t)(tok0 + i) * 1536 + 1024 + h * 128 + 16 * s8;
        L.r0 = *(const u32x4*)rp; L.r1 = *(const u32x4*)(rp + 8);
    }
}
DEVI void gla_prefix(const GlaLd& L, float* SEG, int tid, float (&bF)[8], float (&bB)[8], float& totF, float& totB) {
    const int d = tid & 63, sg = tid >> 6;
    bF[0] = L.gf[0];
#pragma unroll
    for (int i = 1; i < 8; ++i) bF[i] = bF[i - 1] + L.gf[i];
    bB[7] = L.gb[7];
#pragma unroll
    for (int i = 6; i >= 0; --i) bB[i] = bB[i + 1] + L.gb[i];
    SEG[sg * 64 + d] = bF[7]; SEG[512 + sg * 64 + d] = bB[0];
    LBAR();
    float offF = 0.f, offB = 0.f; totF = 0.f; totB = 0.f;
#pragma unroll
    for (int s = 0; s < 8; ++s) { const float a = SEG[s * 64 + d], b = SEG[512 + s * 64 + d]; totF += a; totB += b; if (s < sg) offF += a; if (s > sg) offB += b; }
#pragma unroll
    for (int i = 0; i < 8; ++i) { bF[i] += offF; bB[i] += offB; }
}
DEVI void gla_stage_vt(const GlaLd& L, unsigned char* VT, int tid) {
    const int e = tid & 127, s4 = tid >> 7;
    unsigned w[8];
#pragma unroll
    for (int i = 0; i < 8; ++i) w[i] = (unsigned)L.vh[2 * i] | ((unsigned)L.vh[2 * i + 1] << 16);
    u32x4 a = {w[0], w[1], w[2], w[3]}, b = {w[4], w[5], w[6], w[7]};
    *(u32x4*)(VT + e * GP + s4 * 32) = a; *(u32x4*)(VT + e * GP + s4 * 32 + 16) = b;
}
DEVI void gla_a_item(const GlaLd& L, int item, bf16_t* DST, float* DEC, unsigned char* lds, int tid, int wave, int lane) {
    const int d = tid & 63, sg = tid >> 6;
    float bF[8], bB[8], totF, totB;
    gla_prefix(L, (float*)(lds + L_SEG), tid, bF, bB, totF, totB);
    float kf[8], kb[8];
#pragma unroll
    for (int i = 0; i < 8; ++i) { const float kk = bf2f(L.kh[i]); kf[i] = kk * __expf(totF - bF[i]); kb[i] = kk * __expf(totB - bB[i]); }
    { u32x4 a = {pk2(kf[0], kf[1]), pk2(kf[2], kf[3]), pk2(kf[4], kf[5]), pk2(kf[6], kf[7])}, b = {pk2(kb[0], kb[1]), pk2(kb[2], kb[3]), pk2(kb[4], kb[5]), pk2(kb[6], kb[7])};
      *(u32x4*)(lds + L_KDF + d * GP + sg * 16) = a; *(u32x4*)(lds + L_KDB + d * GP + sg * 16) = b; }
    if (sg == 0) { DEC[(size_t)(item * 2) * 64 + d] = __expf(totF); DEC[(size_t)(item * 2 + 1) * 64 + d] = __expf(totB); }
    gla_stage_vt(L, lds + L_VT, tid);
    LBAR();
    { const int dir = wave >> 2, et = wave & 3, r32 = lane & 31, hi = lane >> 5;
      const unsigned char* KD = lds + (dir ? L_KDB : L_KDF);
      f32x16 c0 = {}, c1 = {};
#pragma unroll
      for (int ks = 0; ks < 4; ++ks) { const bf16x8 b = ldf(lds + L_VT, 32 * et + r32, ks, hi), a0 = ldf(KD, r32, ks, hi), a1 = ldf(KD, 32 + r32, ks, hi);
          c0 = __builtin_amdgcn_mfma_f32_32x32x16_bf16(a0, b, c0, 0, 0, 0); c1 = __builtin_amdgcn_mfma_f32_32x32x16_bf16(a1, b, c1, 0, 0, 0); }
      bf16_t* dst = DST + (size_t)(item * 2 + dir) * 8192 + (32 * et + r32) * 64 + 4 * hi;
#pragma unroll
      for (int q = 0; q < 4; ++q) { u32x2 w0 = {pk2(c0[4 * q], c0[4 * q + 1]), pk2(c0[4 * q + 2], c0[4 * q + 3])}, w1 = {pk2(c1[4 * q], c1[4 * q + 1]), pk2(c1[4 * q + 2], c1[4 * q + 3])};
          *(u32x2*)(dst + 8 * q) = w0; *(u32x2*)(dst + 32 + 8 * q) = w1; } }
    LBAR();
}
DEVI void p_scan(bf16_t* DST, const float* DEC, int gt) {
    const int combo = gt >> 10, el = gt & 1023, e = el >> 3, d0 = (el & 7) * 8;
    const int seq = combo >> 3, h = (combo >> 1) & 3, dir = combo & 1;
    const int nch = seq < 8 ? 64 : 32, n0 = seq < 8 ? seq * 64 : 512 + (seq - 8) * 32;
    float S[8];
#pragma unroll
    for (int j = 0; j < 8; ++j) S[j] = 0.f;
    for (int st0 = 0; st0 < nch; st0 += 4) {
        u32x4 ds[4]; f32x4 dc0[4], dc1[4];
#pragma unroll
        for (int u = 0; u < 4; ++u) { const int n = dir ? nch - 1 - (st0 + u) : st0 + u; const size_t item = (size_t)((n0 + n) * 4 + h) * 2 + dir;
            ds[u] = *(const u32x4*)(DST + item * 8192 + e * 64 + d0); dc0[u] = *(const f32x4*)(DEC + item * 64 + d0); dc1[u] = *(const f32x4*)(DEC + item * 64 + d0 + 4); }
#pragma unroll
        for (int u = 0; u < 4; ++u) { const int n = dir ? nch - 1 - (st0 + u) : st0 + u; const size_t item = (size_t)((n0 + n) * 4 + h) * 2 + dir;
            u32x4 w = {pk2(S[0], S[1]), pk2(S[2], S[3]), pk2(S[4], S[5]), pk2(S[6], S[7])};
            *(u32x4*)(DST + item * 8192 + e * 64 + d0) = w;
            S[0] = dc0[u][0] * S[0] + __uint_as_float(ds[u][0] << 16); S[1] = dc0[u][1] * S[1] + __uint_as_float(ds[u][0] & 0xffff0000u);
            S[2] = dc0[u][2] * S[2] + __uint_as_float(ds[u][1] << 16); S[3] = dc0[u][3] * S[3] + __uint_as_float(ds[u][1] & 0xffff0000u);
            S[4] = dc1[u][0] * S[4] + __uint_as_float(ds[u][2] << 16); S[5] = dc1[u][1] * S[5] + __uint_as_float(ds[u][2] & 0xffff0000u);
            S[6] = dc1[u][2] * S[6] + __uint_as_float(ds[u][3] << 16); S[7] = dc1[u][3] * S[7] + __uint_as_float(ds[u][3] & 0xffff0000u); }
    }
}
DEVI void gla_c_item(const GlaLd& L, int item, const float* outg, bf16_t* MIX, unsigned char* lds, int tid, int wave, int lane) {
    const int n = item >> 2, h = item & 3, tok0 = n * 64, d = tid & 63, sg = tid >> 6, r32 = lane & 31, hi = lane >> 5;
    float bF[8], bB[8], totF, totB;
    gla_prefix(L, (float*)(lds + L_SEG), tid, bF, bB, totF, totB);
    bf16_t* QF = (bf16_t*)(lds + L_QF); bf16_t* QB = (bf16_t*)(lds + L_QB); bf16_t* KF = (bf16_t*)(lds + L_KF); bf16_t* KB = (bf16_t*)(lds + L_KB);
#pragma unroll
    for (int i = 0; i < 8; ++i) { const float qv = bf2f(L.qh[i]), kv = bf2f(L.kh[i]);
        const int o = (8 * sg + i) * (GP / 2) + d;
        QF[o] = f2bf(qv * __expf(bF[i])); KF[o] = f2bf(kv * __expf(-bF[i])); QB[o] = f2bf(qv * __expf(bB[i])); KB[o] = f2bf(kv * __expf(-bB[i])); }
    gla_stage_vt(L, lds + L_VT, tid);
#pragma unroll
    for (int p = 0; p < 2; ++p) { const int row = (tid >> 3) + 64 * p, c = tid & 7;
        *(u32x4*)(lds + L_SPF + row * GP + c * 16) = L.sp[2 * p]; *(u32x4*)(lds + L_SPB + row * GP + c * 16) = L.sp[2 * p + 1]; }
    LBAR();
    { const int dir = wave >> 2, it = (wave >> 1) & 1, jt = wave & 1;
      const unsigned char* Qd = lds + (dir ? L_QB : L_QF); const unsigned char* Kd = lds + (dir ? L_KB : L_KF);
      f32x16 c = {};
#pragma unroll
      for (int ks = 0; ks < 4; ++ks) c = __builtin_amdgcn_mfma_f32_32x32x16_bf16(ldf(Qd, 32 * it + r32, ks, hi), ldf(Kd, 32 * jt + r32, ks, hi), c, 0, 0, 0);
      bf16_t* AT = (bf16_t*)(lds + (dir ? L_ATB : L_ATF));
      const int j = 32 * jt + r32;
#pragma unroll
      for (int r = 0; r < 16; ++r) { const int i = 32 * it + crow(r, hi); const bool keep = dir ? (j >= i) : (j <= i); AT[i * (GP / 2) + j] = f2bf(keep ? c[r] : 0.f); } }
    LBAR();
    { const int it = wave >> 2, et = wave & 3;
      f32x16 o = {};
#pragma unroll
      for (int dir = 0; dir < 2; ++dir) {
          const unsigned char* AT = lds + (dir ? L_ATB : L_ATF); const unsigned char* Qd = lds + (dir ? L_QB : L_QF); const unsigned char* SPd = lds + (dir ? L_SPB : L_SPF);
#pragma unroll
          for (int ks = 0; ks < 4; ++ks) o = __builtin_amdgcn_mfma_f32_32x32x16_bf16(ldf(AT, 32 * it + r32, ks, hi), ldf(lds + L_VT, 32 * et + r32, ks, hi), o, 0, 0, 0);
#pragma unroll
          for (int ks = 0; ks < 4; ++ks) o = __builtin_amdgcn_mfma_f32_32x32x16_bf16(ldf(Qd, 32 * it + r32, ks, hi), ldf(SPd, 32 * et + r32, ks, hi), o, 0, 0, 0); }
      LBAR();
      float* OB = (float*)lds;
#pragma unroll
      for (int r = 0; r < 16; ++r) OB[(32 * it + crow(r, hi)) * 132 + 32 * et + r32] = o[r]; }
    LBAR();
    { const int i = tid >> 3, s8 = tid & 7; const float* OB = (const float*)lds + i * 132 + 16 * s8;
      f32x4 v[4]; float ss = 0.f;
#pragma unroll
      for (int q = 0; q < 4; ++q) { v[q] = *(const f32x4*)(OB + 4 * q); ss += (v[q].x * v[q].x + v[q].y * v[q].y) + (v[q].z * v[q].z + v[q].w * v[q].w); }
      ss += __shfl_xor(ss, 1); ss += __shfl_xor(ss, 2); ss += __shfl_xor(ss, 4);
      const float rstd = rsqrtf(ss * (1.f / 128.f) + EPS);
      const int tok = tok0 + i;
      const u32x4 r0 = L.r0, r1 = L.r1;
      float y[16];
#pragma unroll
      for (int q = 0; q < 4; ++q) { const f32x4 g = *(const f32x4*)(outg + 16 * s8 + 4 * q);
          const unsigned w0 = q < 2 ? r0[2 * q] : r1[2 * (q - 2)], w1 = q < 2 ? r0[2 * q + 1] : r1[2 * (q - 2) + 1];
          y[4 * q + 0] = v[q].x * rstd * g.x * silu(__uint_as_float(w0 << 16)); y[4 * q + 1] = v[q].y * rstd * g.y * silu(__uint_as_float(w0 & 0xffff0000u));
          y[4 * q + 2] = v[q].z * rstd * g.z * silu(__uint_as_float(w1 << 16)); y[4 * q + 3] = v[q].w * rstd * g.w * silu(__uint_as_float(w1 & 0xffff0000u)); }
      u32x4 a = {pk2(y[0], y[1]), pk2(y[2], y[3]), pk2(y[4], y[5]), pk2(y[6], y[7])}, b = {pk2(y[8], y[9]), pk2(y[10], y[11]), pk2(y[12], y[13]), pk2(y[14], y[15])};
      bf16_t* mp = MIX + (size_t)tok * 1024 + h * 128 + 16 * s8;
      *(u32x4*)mp = a; *(u32x4*)(mp + 8) = b; }
    LBAR();
}

DEVI void p_qkrope(bf16_t* Q, bf16_t* K, const float* qg, const float* kg, const float2* rope, int gw, int NGW, int lane) {
    const int i = lane & 31, hh = lane >> 5;
    float gq[4], gk[4];
#pragma unroll
    for (int j = 0; j < 4; ++j) { gq[j] = qg[32 * j + i]; gk[j] = kg[32 * j + i]; }
    for (int t = gw; t < TT; t += NGW) {
        const int s = t < TP ? (t & 4095) : ((t - TP) & 2047);
        const float2 rr = rope[(s >> 6) * 32 + i], rc = rope[(s & 63) * 32 + i];
#pragma unroll
        for (int p = 0; p < 5; ++p) {
            const int slot = 2 * p + hh;
            bf16_t* base = slot < 8 ? Q + (size_t)t * 1024 + slot * 128 : K + (size_t)t * 256 + (slot - 8) * 128;
            float x[4]; float ss = 0.f;
#pragma unroll
            for (int j = 0; j < 4; ++j) { x[j] = bf2f(base[32 * j + i]); ss += x[j] * x[j]; }
            ss += __shfl_xor(ss, 1); ss += __shfl_xor(ss, 2); ss += __shfl_xor(ss, 4); ss += __shfl_xor(ss, 8); ss += __shfl_xor(ss, 16);
            const float rstd = rsqrtf(ss * (1.f / 128.f) + EPS);
#pragma unroll
            for (int j = 0; j < 4; ++j) x[j] *= rstd * (slot < 8 ? gq[j] : gk[j]);
            base[i] = f2bf(x[0] * rr.x - x[1] * rr.y); base[32 + i] = f2bf(x[1] * rr.x + x[0] * rr.y);
            base[64 + i] = f2bf(x[2] * rc.x - x[3] * rc.y); base[96 + i] = f2bf(x[3] * rc.x + x[2] * rc.y);
        }
    }
}
namespace attn {
using bf16 = unsigned short;
constexpr int   D = 128, NW = 8, QBLK = 32, KVBLK = 64;
constexpr float SCALE = 0.088388347648318440f;
constexpr float THR = 8.f;
constexpr int SDEPTH = 2;
constexpr int LDQ = 1024, LDK = 256, LDO = 1024;
constexpr size_t SHM_V = KVBLK * D * 2, SHM_K = KVBLK * D * 2, SHM_ATTN = 2 * SHM_V + 2 * SHM_K + NW * 64 * 4;
using bf16x8 = __attribute__((ext_vector_type(8))) short;
using s16x4  = __attribute__((ext_vector_type(4))) short;
using f32x16 = __attribute__((ext_vector_type(16))) float;
using f32x8  = __attribute__((ext_vector_type(8))) float;
using u32x4  = __attribute__((ext_vector_type(4))) unsigned;
#define KSWZ(row, colB) ((row) * 256 + ((colB) ^ (((row) & 7) << 4)))
#define SBAR() __builtin_amdgcn_sched_barrier(0)
__device__ __forceinline__ int crow(int r, int hi) { return (r & 3) + 8 * (r >> 2) + 4 * hi; }
__device__ __forceinline__ unsigned cvtpk(float lo, float hi) {
  unsigned r; asm volatile("v_cvt_pk_bf16_f32 %0, %1, %2" : "=v"(r) : "v"(lo), "v"(hi)); return r;
}
template <typename TIn> struct Stage;
template <> struct Stage<bf16>  { using T = bf16x8;
  __device__ static __forceinline__ T ld8(const bf16* p) { return *reinterpret_cast<const bf16x8*>(p); }
  __device__ static __forceinline__ bf16x8 tobf(T x) { return x; } };
template <> struct Stage<float> { using T = f32x8;
  __device__ static __forceinline__ T ld8(const float* p) { return *reinterpret_cast<const f32x8*>(p); }
  __device__ static __forceinline__ bf16x8 tobf(T x) {
    u32x4 w = {cvtpk(x[0], x[1]), cvtpk(x[2], x[3]), cvtpk(x[4], x[5]), cvtpk(x[6], x[7])}; return *reinterpret_cast<bf16x8*>(&w); } };

__device__ __forceinline__ void partialSM(f32x16& p0, f32x16& p1, float& m_reg, float& mn, float& alpha) {
  constexpr float C = SCALE * 1.4426950408889634f;
  float pmax = p0[0]; for (int r = 1; r < 16; ++r) pmax = fmaxf(pmax, p0[r]); for (int r = 0; r < 16; ++r) pmax = fmaxf(pmax, p1[r]);
  { auto rr = __builtin_amdgcn_permlane32_swap(__float_as_uint(pmax), __float_as_uint(pmax), false, false);
    pmax = fmaxf(__uint_as_float(rr[0]), __uint_as_float(rr[1])); }
  if (__builtin_expect(__all(pmax - m_reg <= THR / SCALE), 1)) { mn = m_reg; alpha = 1.f; }
  else { mn = fmaxf(m_reg, pmax); alpha = __builtin_amdgcn_exp2f((m_reg - mn) * C); m_reg = mn; }
  float mnC = -mn * C;
  for (int r = 0; r < 16; ++r) p0[r] = fmaf(p0[r], C, mnC); for (int r = 0; r < 16; ++r) p1[r] = fmaf(p1[r], C, mnC);
  for (int r = 0; r < 16; ++r) p0[r] = __builtin_amdgcn_exp2f(p0[r]);
}
__device__ __forceinline__ void finishSM(f32x16& p0, f32x16& p1, float alpha, float& l_reg, bf16x8& pa0, bf16x8& pa1, bf16x8& pa2, bf16x8& pa3) {
  for (int r = 0; r < 16; ++r) p1[r] = __builtin_amdgcn_exp2f(p1[r]);
  float ps = 0; for (int r = 0; r < 16; ++r) ps += p0[r]; for (int r = 0; r < 16; ++r) ps += p1[r];
  { auto rr = __builtin_amdgcn_permlane32_swap(__float_as_uint(ps), __float_as_uint(ps), false, false);
    ps = __uint_as_float(rr[0]) + __uint_as_float(rr[1]); }
  l_reg = l_reg * alpha + ps;
#define PK4(P, BASE, OUT) do { unsigned a0 = cvtpk(P[BASE + 0], P[BASE + 1]), a1 = cvtpk(P[BASE + 2], P[BASE + 3]);   \
    unsigned b0 = cvtpk(P[BASE + 4], P[BASE + 5]), b1 = cvtpk(P[BASE + 6], P[BASE + 7]);                              \
    auto r0 = __builtin_amdgcn_permlane32_swap(a0, b0, false, false); auto r1 = __builtin_amdgcn_permlane32_swap(a1, b1, false, false); \
    u32x4 w = {r0[0], r1[0], r0[1], r1[1]}; OUT = *reinterpret_cast<bf16x8*>(&w); } while (0)
  PK4(p0, 0, pa0); PK4(p0, 8, pa1); PK4(p1, 0, pa2); PK4(p1, 8, pa3);
#undef PK4
}
__device__ __forceinline__ void qkt(f32x16& p0, f32x16& p1, const bf16* Ks, const bf16x8* qr, int r32, int hi) {
  p0 = f32x16{}; p1 = f32x16{};
  for (int d0 = 0; d0 < 8; ++d0) { int cb = (d0 * 16 + hi * 8) * 2;
    bf16x8 b0 = *reinterpret_cast<const bf16x8*>((const char*)Ks + KSWZ(r32, cb));
    bf16x8 b1 = *reinterpret_cast<const bf16x8*>((const char*)Ks + KSWZ(32 + r32, cb));
    p0 = __builtin_amdgcn_mfma_f32_32x32x16_bf16(b0, qr[d0], p0, 0, 0, 0);
    p1 = __builtin_amdgcn_mfma_f32_32x32x16_bf16(b1, qr[d0], p1, 0, 0, 0); }
}
__device__ __forceinline__ int v_st(int k, int c) { const int kk = (k & ~0xC) | ((k & 4) << 1) | ((k & 8) >> 1); return ((kk >> 3) * 4 + (c >> 5)) * 512 + ((kk & 7) * 32 + (c & 31)) * 2; }
__device__ __forceinline__ int v_rd_base(int lane) { return ((lane & 3) << 3) | (((lane >> 2) & 3) << 6) | (((lane >> 4) & 1) << 5) | (((lane >> 5) & 1) << 8); }
constexpr int v_rd_off(int d0, int ks, int half) { return d0 * 512 + ks * 4096 + half * 2048; }
template <int OFF> __device__ __forceinline__ s16x4 tr_read(int vb) {
  s16x4 r; asm volatile("ds_read_b64_tr_b16 %0, %1 offset:%2" : "=&v"(r) : "v"(vb), "i"(OFF) : "memory"); return r;
}
template <int D0> __device__ __forceinline__ void pv_one(f32x16& od, int vb, bf16x8 pa0, bf16x8 pa1, bf16x8 pa2, bf16x8 pa3) {
  const s16x4 l0 = tr_read<v_rd_off(D0, 0, 0)>(vb), h0 = tr_read<v_rd_off(D0, 0, 1)>(vb), l1 = tr_read<v_rd_off(D0, 1, 0)>(vb), h1 = tr_read<v_rd_off(D0, 1, 1)>(vb);
  const s16x4 l2 = tr_read<v_rd_off(D0, 2, 0)>(vb), h2 = tr_read<v_rd_off(D0, 2, 1)>(vb), l3 = tr_read<v_rd_off(D0, 3, 0)>(vb), h3 = tr_read<v_rd_off(D0, 3, 1)>(vb);
  asm volatile("s_waitcnt lgkmcnt(0)" ::: "memory"); SBAR();
#define PK(L, H) (bf16x8){L[0], L[1], L[2], L[3], H[0], H[1], H[2], H[3]}
  od = __builtin_amdgcn_mfma_f32_32x32x16_bf16(pa0, PK(l0, h0), od, 0, 0, 0);
  od = __builtin_amdgcn_mfma_f32_32x32x16_bf16(pa1, PK(l1, h1), od, 0, 0, 0);
  od = __builtin_amdgcn_mfma_f32_32x32x16_bf16(pa2, PK(l2, h2), od, 0, 0, 0);
  od = __builtin_amdgcn_mfma_f32_32x32x16_bf16(pa3, PK(l3, h3), od, 0, 0, 0);
#undef PK
}
__device__ __forceinline__ void pv_d0(f32x16* o, int vb, bf16x8 pa0, bf16x8 pa1, bf16x8 pa2, bf16x8 pa3) {
  pv_one<0>(o[0], vb, pa0, pa1, pa2, pa3); pv_one<1>(o[1], vb, pa0, pa1, pa2, pa3); pv_one<2>(o[2], vb, pa0, pa1, pa2, pa3); pv_one<3>(o[3], vb, pa0, pa1, pa2, pa3);
}

template <typename TQ>
__device__ __forceinline__ void attn_dense_body(const TQ* __restrict__ Qb, const bf16* __restrict__ Kh, const bf16* __restrict__ Vh,
                                                bf16* __restrict__ Ob, int seq, char* lds) {
  using St = Stage<bf16>; using SQ = Stage<TQ>;
  const int tid = threadIdx.x, wid = __builtin_amdgcn_readfirstlane(tid >> 6), lane = tid & 63, r32 = lane & 31, hi = lane >> 5;
  bf16* V_lds = (bf16*)lds; bf16* K_lds = (bf16*)(lds + 2 * SHM_V);
  float* ws = (float*)(lds + 2 * SHM_V + 2 * SHM_K) + wid * 64; float* li_l = ws; float* al_l = ws + 32;
  float m_reg = -1e30f, l_reg = 0; f32x16 o[4] = {}; bf16x8 qr[8];
  const TQ* Qw = Qb + (long)(wid * QBLK + r32) * LDQ + hi * 8;
#pragma unroll
  for (int d0 = 0; d0 < 8; ++d0) qr[d0] = SQ::tobf(SQ::ld8(Qw + d0 * 16));
  const int sr = tid >> 4, sc = (tid & 15) * 8, vst0 = v_st(sr, sc), vst1 = v_st(32 + sr, sc);
  const int vb0 = (int)(uintptr_t)V_lds + v_rd_base(lane);
  struct { typename St::T vs0, vs1, ks0, ks1; } sr_[SDEPTH];
#define SLOAD(i, k0) do { sr_[i].vs0 = St::ld8(&Vh[(long)((k0) + sr) * LDK + sc]); sr_[i].vs1 = St::ld8(&Vh[(long)((k0) + 32 + sr) * LDK + sc]); \
    sr_[i].ks0 = St::ld8(&Kh[(long)((k0) + sr) * LDK + sc]); sr_[i].ks1 = St::ld8(&Kh[(long)((k0) + 32 + sr) * LDK + sc]); } while (0)
#define SWRITE(b, i) do { *(bf16x8*)((char*)V_lds + (b) * SHM_V + vst0) = St::tobf(sr_[i].vs0);          \
    *(bf16x8*)((char*)V_lds + (b) * SHM_V + vst1) = St::tobf(sr_[i].vs1); int kc = sc * 2;               \
    *(bf16x8*)((char*)K_lds + (b) * SHM_K + KSWZ(sr, kc)) = St::tobf(sr_[i].ks0);                       \
    *(bf16x8*)((char*)K_lds + (b) * SHM_K + KSWZ(32 + sr, kc)) = St::tobf(sr_[i].ks1); } while (0)
#define SWAIT() do { if constexpr (SDEPTH == 2) asm volatile("s_waitcnt vmcnt(4)" ::: "memory"); else asm volatile("s_waitcnt vmcnt(0)" ::: "memory"); } while (0)
#define RESC(a) do { if (__any((a) < 1.f)) { if (hi == 0) al_l[r32] = (a); asm volatile("s_waitcnt lgkmcnt(0)" ::: "memory"); \
    for (int d = 0; d < 4; ++d) for (int r = 0; r < 16; ++r) o[d][r] *= al_l[crow(r, hi)]; } } while (0)
  f32x16 pA0, pA1, pB0, pB1; float mnA, mnB, alA, alB; bf16x8 pa0, pa1, pa2, pa3; const int NT = seq / KVBLK;
  constexpr int SE = 0, SO = SDEPTH - 1;
  SLOAD(SE, 0); asm volatile("s_waitcnt vmcnt(0)" ::: "memory"); SWRITE(0, SE); __syncthreads();
  qkt(pA0, pA1, K_lds, qr, r32, hi); partialSM(pA0, pA1, m_reg, mnA, alA);
  SLOAD(SO, KVBLK); if constexpr (SDEPTH == 2) { if (2 < NT) SLOAD(SE, 2 * KVBLK); }
  SWAIT(); SWRITE(1, SO); __syncthreads();
  for (int j = 1; j + 1 < NT; j += 2) {
    SBAR(); qkt(pB0, pB1, (bf16*)((char*)K_lds + SHM_K), qr, r32, hi);
    finishSM(pA0, pA1, alA, l_reg, pa0, pa1, pa2, pa3); SBAR();
    SLOAD(SO, (j + SDEPTH) * KVBLK); SBAR();
    pv_d0(o, vb0, pa0, pa1, pa2, pa3); partialSM(pB0, pB1, m_reg, mnB, alB);
    __syncthreads(); SWAIT(); SWRITE(0, SE);
    RESC(alB); __syncthreads();
    SBAR(); qkt(pA0, pA1, K_lds, qr, r32, hi);
    finishSM(pB0, pB1, alB, l_reg, pa0, pa1, pa2, pa3); SBAR();
    if (SDEPTH == 1 || j + 3 < NT) SLOAD(SE, (j + 1 + SDEPTH) * KVBLK); SBAR();
    pv_d0(o, vb0 + (int)SHM_V, pa0, pa1, pa2, pa3); partialSM(pA0, pA1, m_reg, mnA, alA);
    __syncthreads(); SWAIT(); SWRITE(1, SO);
    RESC(alA); __syncthreads();
  }
  SBAR(); qkt(pB0, pB1, (bf16*)((char*)K_lds + SHM_K), qr, r32, hi);
  finishSM(pA0, pA1, alA, l_reg, pa0, pa1, pa2, pa3); SBAR();
  pv_d0(o, vb0, pa0, pa1, pa2, pa3); partialSM(pB0, pB1, m_reg, mnB, alB);
  __syncthreads(); RESC(alB);
  finishSM(pB0, pB1, alB, l_reg, pa0, pa1, pa2, pa3); SBAR();
  pv_d0(o, vb0 + (int)SHM_V, pa0, pa1, pa2, pa3);
  if (hi == 0) li_l[r32] = l_reg; asm volatile("s_waitcnt lgkmcnt(0)" ::: "memory");
  float rli[16];
#pragma unroll
  for (int r = 0; r < 16; ++r) rli[r] = __builtin_amdgcn_rcpf(li_l[crow(r, hi)]);
  bf16* Ow = Ob + (long)(wid * QBLK) * LDO;
#pragma unroll
  for (int r = 0; r < 16; ++r) { int orow = crow(r, hi);
    for (int d0 = 0; d0 < 4; ++d0) Ow[(long)orow * LDO + d0 * 32 + r32] = (bf16)(cvtpk(o[d0][r] * rli[r], 0.f) & 0xffffu); }
#undef SLOAD
#undef SWRITE
#undef SWAIT
#undef RESC
}

#undef KSWZ
#undef SBAR
}

constexpr int LDS_BYTES = 135168;
struct Args { const float* in[19]; float* out; unsigned char* ws; };
#define LAS3 __attribute__((address_space(3)))

#define RLX_AGENT __ATOMIC_RELAXED, __HIP_MEMORY_SCOPE_AGENT
#define XB_TMO      128
#define XB_XCNT(j)  (256  + 64 * (j))
#define XB_XSUB(j)  (1280 + 64 * (j))
#define XB_XGEN(j)  (2304 + 64 * (j))
#define XB_TOP      3328
#define XB_TOPGEN   3392
#define XCD_BAR_WORDS 3456
#define XB_SPIN_CAP (1u << 18)

__device__ __forceinline__ unsigned xb_ld(unsigned* p)              { return __hip_atomic_load(p, __ATOMIC_RELAXED, __HIP_MEMORY_SCOPE_AGENT); }
__device__ __forceinline__ unsigned xb_add(unsigned* p, unsigned v) { return __hip_atomic_fetch_add(p, v, __ATOMIC_RELAXED, __HIP_MEMORY_SCOPE_AGENT); }
__device__ __forceinline__ unsigned xb_xcc_id() { return (unsigned)__builtin_amdgcn_s_getreg((3 << 11) | 20) & 0xFu; }
#define XB_SPIN(cond, bar) do { unsigned _sp = 0; while (cond) { __builtin_amdgcn_s_sleep(1); \
    if ((++_sp & 255u) == 0u) { if (xb_ld(&(bar)[XB_TMO])) break; if (_sp > XB_SPIN_CAP) { atomicAdd(&(bar)[XB_TMO], 1u); break; } } } } while (0)

struct XcdBarrier {
    unsigned* bar; unsigned x;
    volatile LAS3 unsigned* st;
};

__device__ __forceinline__ XcdBarrier xcd_barrier_post(unsigned* bar, volatile LAS3 unsigned* st) {
    XcdBarrier b; b.bar = bar; b.x = xb_xcc_id(); b.st = st;
    if (threadIdx.x == 0) (void)xb_add(&bar[XB_XCNT(b.x)], 1u);
    return b;
}
__device__ __forceinline__ void xcd_barrier_complete(unsigned* bar, unsigned x, unsigned& nloc, unsigned& nx) {
    const unsigned G = gridDim.x * gridDim.y * gridDim.z;
    unsigned sum, cnt, mine, sp = 0u;
    for (;;) {
        sum = 0u; cnt = 0u; mine = 0u;
#pragma unroll
        for (unsigned j = 0; j < 16; ++j) { const unsigned c = xb_ld(&bar[XB_XCNT(j)]); sum += c; cnt += (c > 0u) ? 1u : 0u; mine = (j == x) ? c : mine; }
        if (sum == G) break;
        __builtin_amdgcn_s_sleep(1);
        if ((++sp & 255u) == 0u) { if (xb_ld(&bar[XB_TMO])) break; if (sp > XB_SPIN_CAP) { atomicAdd(&bar[XB_TMO], 1u); break; } }
    }
    nloc = mine > 0u ? mine : 1u; nx = cnt > 0u ? cnt : 1u;
}

__device__ __forceinline__ void xcd_barrier(const XcdBarrier& b) {
    asm volatile("s_waitcnt vmcnt(0)" ::: "memory");
    __syncthreads();
    if (threadIdx.x == 0) {
        unsigned* bar = b.bar;
        __builtin_amdgcn_s_waitcnt(0);
        unsigned nloc = b.st[0], nx = b.st[1];
        if (nloc == 0u) { xcd_barrier_complete(bar, b.x, nloc, nx); b.st[0] = nloc; b.st[1] = nx; }
        const unsigned old = xb_add(&bar[XB_XSUB(b.x)], 1u);
        const unsigned gen = old / nloc;
        if (old + 1u == (gen + 1u) * nloc) {
            __builtin_amdgcn_fence(__ATOMIC_RELEASE, "agent");
            asm volatile("s_waitcnt vmcnt(0)" ::: "memory");
            const unsigned og = xb_add(&bar[XB_TOP], 1u);
            const unsigned tg = og / nx;
            if (og + 1u == (tg + 1u) * nx) xb_add(&bar[XB_TOPGEN], 1u);
            else XB_SPIN(xb_ld(&bar[XB_TOPGEN]) == tg, bar);
            __builtin_amdgcn_fence(__ATOMIC_ACQUIRE, "agent");
            xb_add(&bar[XB_XGEN(b.x)], 1u);
            asm volatile("s_waitcnt vmcnt(0)" ::: "memory");
        } else {
            XB_SPIN(xb_ld(&bar[XB_XGEN(b.x)]) == gen, bar);
            __builtin_amdgcn_fence(__ATOMIC_ACQUIRE, "agent");
            asm volatile("s_waitcnt vmcnt(0)" ::: "memory");
        }
    }
    __syncthreads();
}

constexpr int MISC_OFF = 131072;
constexpr int CW_BAR = 4096;
typedef const __attribute__((address_space(4))) Args* CArgsP;
#ifndef PHM
#define PHM 0xFFFFFFu
#endif
#ifndef PROBE_GLU
#define PROBE_GLU 0
#endif
#ifndef PROBE_MASK
#define PROBE_MASK 0u
#endif
#define REP(b) for (int rep__ = 0; rep__ < 1 + (int)((PROBE_MASK >> (b)) & 1u); ++rep__)
#ifndef PROBE_ATTN
#define PROBE_ATTN 0
#endif
#define PH(b) ((PHM >> (b)) & 1u)
#define PHASE_VARS \
    CArgsP ap = (CArgsP)__builtin_amdgcn_kernarg_segment_ptr(); asm volatile("" : "+s"(ap)); \
    int tid = threadIdx.x; asm volatile("" : "+v"(tid)); \
    const int lane = tid & 63, wave = __builtin_amdgcn_readfirstlane(tid >> 6); \
    const int G = gridDim.x, bx = blockIdx.x, gw = bx * 8 + wave, NGW = G * 8, gt = bx * 512 + tid, NGT = G * 512; \
    unsigned char* ws = ap->ws; float* out = ap->out; bf16_t* H = (bf16_t*)(ws + WS_H); \
    (void)lane; (void)gw; (void)NGW; (void)gt; (void)NGT; (void)out; (void)H; (void)bx; (void)G;
#define GRID_SYNC_CG() cg::this_grid().sync()
#define GRID_SYNC() do { CArgsP ap_ = (CArgsP)__builtin_amdgcn_kernarg_segment_ptr(); asm volatile("" : "+s"(ap_)); \
    XcdBarrier b_; b_.bar = (unsigned*)(ap_->ws + WS_CTL) + CW_BAR; b_.x = xb_xcc_id(); b_.st = (volatile LAS3 unsigned*)(lds3 + MISC_OFF); xcd_barrier(b_); } while (0)

#define SSQP(k) ((float*)(ws + WS_SSQ) + (size_t)(k) * TT)
template <int LAYER> DEVI void ffn_block(LAS3 unsigned char* lds3) {
    { PHASE_VARS
      for (int rep_ = 0; rep_ < (PROBE_GLU ? 2 : 1); ++rep_) if (PH(18)) { pg8::Gemm g{(const bf16_t*)(ws + WS_XBA), (const bf16_t*)(ws + (LAYER ? WS_W_GU1 : WS_W_GU0)), TT, 2 * FFH, 1024}; pg8::StaticOrder S; S.init(TT, 2 * FFH, G, bx);
        Epi<EM_GLU> E{(bf16_t*)(ws + WS_ACT), nullptr, nullptr, nullptr, nullptr, nullptr, nullptr, nullptr, SSQP(LAYER ? 3 : 1), nullptr, nullptr, nullptr};
        pg8::gemm_phase<Epi<EM_GLU>, pg8::StaticOrder, true, true>(lds3, g, S, E); } }
    GRID_SYNC();
    { PHASE_VARS
      if (PH(19)) { pg8::Gemm g{(const bf16_t*)(ws + WS_ACT), (const bf16_t*)(ws + (LAYER ? WS_W_D1 : WS_W_D0)), TT, 1024, FFH}; pg8::StaticOrder S; S.init(TT, 1024, G, bx);
        if constexpr (LAYER == 0) {
            Epi<EM_RES, true> E{nullptr, nullptr, nullptr, out, nullptr, nullptr, nullptr, nullptr, nullptr, SSQP(2), (bf16_t*)(ws + WS_XBB), ap->in[10]};
            pg8::gemm_phase<Epi<EM_RES, true>, pg8::StaticOrder, true, true>(lds3, g, S, E);
        } else {
            Epi<EM_RES> E{nullptr, nullptr, nullptr, out, nullptr, nullptr, nullptr, nullptr, nullptr, nullptr, nullptr, nullptr};
            pg8::gemm_phase<Epi<EM_RES>, pg8::StaticOrder, true, true>(lds3, g, S, E); } } }
}

__global__ void __launch_bounds__(512, 2) mega_fwd(Args a_unused) {
    extern __shared__ __attribute__((aligned(16))) unsigned char lds[];
    LAS3 unsigned char* lds3 = (LAS3 unsigned char*)lds;
    { if (threadIdx.x < 32) ((LAS3 unsigned*)(lds3 + MISC_OFF))[threadIdx.x] = 0u;
      __syncthreads();
      CArgsP ap0 = (CArgsP)__builtin_amdgcn_kernarg_segment_ptr();
      (void)xcd_barrier_post((unsigned*)(ap0->ws + WS_CTL) + CW_BAR, (volatile LAS3 unsigned*)(lds3 + MISC_OFF)); }
    { PHASE_VARS
      REP(0) if (PH(0)) p_fold(ap->in[3], ap->in[4], ap->in[6], (float*)(ws + WS_FOLDF), (float*)(ws + WS_FOLDG), (float*)lds, gw, NGW, lane);
      REP(0) if (PH(1)) { p_dft((bf16_t*)(ws + WS_C4), (bf16_t*)(ws + WS_S4), 4096, 12, gt, NGT); p_dft((bf16_t*)(ws + WS_C2), (bf16_t*)(ws + WS_S2), 2048, 11, gt, NGT); }
      if (gt < 2048) { const int idx = gt >> 5, i = gt & 31; const float inv = powf(10000.f, -(float)(2 * i) * (1.f / 64.f)); const float ang = (float)idx * inv;
          ((float2*)(ws + WS_ROPE))[gt] = make_float2((float)cos((double)ang), (float)sin((double)ang)); }
      for (int i = gt; i < 3 * TT; i += NGT) SSQP(1)[i] = 0.f;
      REP(0) if (PH(2)) p_norm(ap->in[0], ap->in[1], ap->in[2], (bf16_t*)(ws + WS_XBB), SSQP(0), gw, NGW, lane); }
    GRID_SYNC_CG();
    { PHASE_VARS
      REP(3) if (PH(3)) { float* scr = (float*)(lds + wave * 16384);
      const float* win = ap->in[3];
      for (int it = gw; it < 11776; it += NGW) { int r = it;
          if (tr_mat<0>(r, win, 2080, 0, 1024, 256, (bf16_t*)(ws + WS_W_AB1), 0, 0.125f, scr, lane)) continue;
          if (tr_mat<0>(r, win, 2080, 256, 1024, 1280, (bf16_t*)(ws + WS_W_AB1), 256, 1.f, scr, lane)) continue;
          if (tr_mat<0>(r, (const float*)(ws + WS_FOLDG), 512, 0, 1024, 512, (bf16_t*)(ws + WS_W_AB1), 1536, 1.f, scr, lane)) continue;
          if (tr_mat<0>(r, (const float*)(ws + WS_FOLDF), 1024, 0, 1024, 1024, (bf16_t*)(ws + WS_W_FT), 0, 1.f, scr, lane)) continue;
          if (tr_mat<0>(r, ap->in[9], 1024, 0, 1024, 1024, (bf16_t*)(ws + WS_W_ABO), 0, 1.f, scr, lane)) continue;
          if (tr_mat<1>(r, ap->in[16], FFH, 0, 1024, FFH, (bf16_t*)(ws + WS_W_GU0), 0, 1.f, scr, lane)) continue;
          if (tr_mat<2>(r, ap->in[17], FFH, 0, 1024, FFH, (bf16_t*)(ws + WS_W_GU0), 0, 1.f, scr, lane)) continue;
          if (tr_mat<0>(r, ap->in[18], 1024, 0, FFH, 1024, (bf16_t*)(ws + WS_W_D0), 0, 1.f, scr, lane)) continue;
          if (tr_mat<0>(r, ap->in[11], 1536, 0, 1024, 1536, (bf16_t*)(ws + WS_W_QKV), 0, 1.f, scr, lane)) continue;
          if (tr_mat<0>(r, ap->in[14], 1024, 0, 1024, 1024, (bf16_t*)(ws + WS_W_CO), 0, 1.f, scr, lane)) continue;
          if (tr_mat<1>(r, ap->in[16] + (size_t)1024 * FFH, FFH, 0, 1024, FFH, (bf16_t*)(ws + WS_W_GU1), 0, 1.f, scr, lane)) continue;
          if (tr_mat<2>(r, ap->in[17] + (size_t)1024 * FFH, FFH, 0, 1024, FFH, (bf16_t*)(ws + WS_W_GU1), 0, 1.f, scr, lane)) continue;
          if (tr_mat<0>(r, ap->in[18] + (size_t)1024 * FFH, 1024, 0, FFH, 1024, (bf16_t*)(ws + WS_W_D1), 0, 1.f, scr, lane)) continue;
      } } }
    GRID_SYNC();
    { PHASE_VARS
      REP(4) if (PH(4)) { pg8::Gemm g{(const bf16_t*)(ws + WS_XBB), (const bf16_t*)(ws + WS_W_AB1), TT, 2048, 1024}; pg8::StaticOrder S; S.init(TT, 2048, G, bx);
        Epi<EM_AB1> E{(bf16_t*)(ws + WS_QKVR), nullptr, nullptr, (float*)(ws + WS_G), nullptr, nullptr, ap->in[5], ap->in[7], SSQP(0), nullptr, nullptr, nullptr};
        pg8::gemm_phase<Epi<EM_AB1>, pg8::StaticOrder, true, true>(lds3, g, S, E); } }
    { PHASE_VARS
      REP(5) if (PH(5)) { pg8::Gemm g{(const bf16_t*)(ws + WS_W_FT), (const bf16_t*)(ws + WS_XBB), 1024, TT, 1024}; pg8::StaticOrder S; S.init(1024, TT, G, bx);
        Epi<EM_AB1T> E{(bf16_t*)((unsigned char*)out + OUT_YTPC), (bf16_t*)((unsigned char*)out + OUT_YTSC), nullptr, nullptr, nullptr, nullptr, nullptr, nullptr, SSQP(0), nullptr, nullptr, nullptr};
        pg8::gemm_phase<Epi<EM_AB1T>, pg8::StaticOrder, true, true>(lds3, g, S, E); } }
    GRID_SYNC();
    { PHASE_VARS
      REP(6) if (PH(6)) { pg8::Gemm g{(const bf16_t*)(ws + WS_C4), (const bf16_t*)((unsigned char*)out + OUT_YTPC), 2048, 4096, 4096}; pg8::StaticOrder S; S.init(2048, 4096, G, bx);
        Epi<EM_FNETP> E{(bf16_t*)(ws + WS_PCP), nullptr, nullptr, nullptr, nullptr, nullptr, nullptr, nullptr, nullptr, nullptr, nullptr, nullptr};
        pg8::gemm_phase<Epi<EM_FNETP>, pg8::StaticOrder, true, true>(lds3, g, S, E); } }
    { PHASE_VARS
      REP(6) if (PH(6)) { pg8::Gemm g{(const bf16_t*)(ws + WS_S4), (const bf16_t*)((unsigned char*)out + OUT_YTPS), 2048, 4096, 4096}; pg8::StaticOrder S; S.init(2048, 4096, G, (bx + G / 2) % G);
        Epi<EM_FNETP> E{(bf16_t*)(ws + WS_PSP), nullptr, nullptr, nullptr, nullptr, nullptr, nullptr, nullptr, nullptr, nullptr, nullptr, nullptr};
        pg8::gemm_phase<Epi<EM_FNETP>, pg8::StaticOrder, true, true>(lds3, g, S, E); } }
    { PHASE_VARS
      REP(6) if (PH(7)) { pg8::Gemm g{(const bf16_t*)(ws + WS_C2), (const bf16_t*)((unsigned char*)out + OUT_YTSC), 1024, 4096, 2048}; pg8::StaticOrder S; S.init(1024, 4096, G, (bx + G / 2) % G);
        Epi<EM_FNETS> E{(bf16_t*)(ws + WS_PCS), nullptr, nullptr, nullptr, nullptr, nullptr, nullptr, nullptr, nullptr, nullptr, nullptr, nullptr};
        pg8::gemm_phase<Epi<EM_FNETS>, pg8::StaticOrder, true, true>(lds3, g, S, E); } }
    { PHASE_VARS
      REP(6) if (PH(7)) { pg8::Gemm g{(const bf16_t*)(ws + WS_S2), (const bf16_t*)((unsigned char*)out + OUT_YTSS), 1024, 4096, 2048}; pg8::StaticOrder S; S.init(1024, 4096, G, (bx + G / 4) % G);
        Epi<EM_FNETS> E{(bf16_t*)(ws + WS_PSS), nullptr, nullptr, nullptr, nullptr, nullptr, nullptr, nullptr, nullptr, nullptr, nullptr, nullptr};
        pg8::gemm_phase<Epi<EM_FNETS>, pg8::StaticOrder, true, true>(lds3, g, S, E); } }
    { PHASE_VARS
      REP(8) if (PH(8)) { const int half = G / 2;
        const bf16_t* QKVR = (const bf16_t*)(ws + WS_QKVR); const float* Gb = (const float*)(ws + WS_G); bf16_t* DST = (bf16_t*)((unsigned char*)out + OUT_DST); float* DEC = (float*)(ws + WS_DEC);
        const int first = bx < half ? bx : 2048 + bx - half, last = bx < half ? 2048 : 3072;
        GlaLd A; gla_load<false>(A, first, QKVR, Gb, DST, tid);
        for (int item = first; item < last; item += half) { GlaLd B; const int nx = item + half < last ? item + half : item;
            gla_load<false>(B, nx, QKVR, Gb, DST, tid);
            gla_a_item(A, item, DST, DEC, lds, tid, wave, lane); A = B; } } }
    GRID_SYNC();
    { PHASE_VARS
      if (PH(9)) for (int g2 = gt; g2 < 131072; g2 += NGT) p_scan((bf16_t*)((unsigned char*)out + OUT_DST), (const float*)(ws + WS_DEC), g2);
      p_fcombine((const bf16_t*)(ws + WS_PCP), (const bf16_t*)(ws + WS_PSP), H, 0, 4096, 11, gt, NGT);
      p_fcombine((const bf16_t*)(ws + WS_PCS), (const bf16_t*)(ws + WS_PSS), H, TP, 2048, 10, gt, NGT);
      p_fmid((const bf16_t*)((unsigned char*)out + OUT_YTPC), H, 0, 4096, gw, NGW, lane);
      p_fmid((const bf16_t*)((unsigned char*)out + OUT_YTSC), H, TP, 2048, gw, NGW, lane); }
    GRID_SYNC();
    { PHASE_VARS
      REP(10) if (PH(10)) { const bf16_t* QKVR = (const bf16_t*)(ws + WS_QKVR); const float* Gb = (const float*)(ws + WS_G); const bf16_t* DST = (const bf16_t*)((unsigned char*)out + OUT_DST);
        GlaLd A; gla_load<true>(A, bx, QKVR, Gb, DST, tid);
        for (int item = bx; item < 3072; item += G) { GlaLd B; const int nx = item + G < 3072 ? item + G : item;
            gla_load<true>(B, nx, QKVR, Gb, DST, tid);
            gla_c_item(A, item, ap->in[8], H, lds, tid, wave, lane); A = B; } } }
    GRID_SYNC();
    { PHASE_VARS
      if (PH(11)) { pg8::Gemm g{H, (const bf16_t*)(ws + WS_W_ABO), TT, 1024, 1024}; pg8::StaticOrder S; S.init(TT, 1024, G, bx);
        Epi<EM_RESIN, true> E{nullptr, nullptr, nullptr, out, ap->in[0], ap->in[1], nullptr, nullptr, nullptr, SSQP(1), (bf16_t*)(ws + WS_XBA), ap->in[15]};
        pg8::gemm_phase<Epi<EM_RESIN, true>, pg8::StaticOrder, true, true>(lds3, g, S, E); } }
    GRID_SYNC();
    ffn_block<0>(lds3);
    GRID_SYNC();
    { PHASE_VARS
      if (PH(13)) { pg8::Gemm g{(const bf16_t*)(ws + WS_XBB), (const bf16_t*)(ws + WS_W_QKV), TT, 1536, 1024}; pg8::StaticOrder S; S.init(TT, 1536, G, bx);
        Epi<EM_QKV> E{(bf16_t*)(ws + WS_Q), (bf16_t*)(ws + WS_K), (bf16_t*)(ws + WS_V), nullptr, nullptr, nullptr, nullptr, nullptr, SSQP(2), nullptr, nullptr, nullptr};
        pg8::gemm_phase<Epi<EM_QKV>, pg8::StaticOrder, true, true>(lds3, g, S, E); } }
    GRID_SYNC();
    { PHASE_VARS
      if (PH(14)) p_qkrope((bf16_t*)(ws + WS_Q), (bf16_t*)(ws + WS_K), ap->in[12], ap->in[13], (const float2*)(ws + WS_ROPE), gw, NGW, lane); }
    GRID_SYNC();
    { PHASE_VARS
      if (PH(15)) { const int vx = bx & 7, vi = bx >> 3;
        bf16_t* Qb = (bf16_t*)(ws + WS_Q); bf16_t* Kb = (bf16_t*)(ws + WS_K); bf16_t* Vb = (bf16_t*)(ws + WS_V); bf16_t* AO = (bf16_t*)(ws + WS_AO);
        for (int i6 = 0; i6 < (PROBE_ATTN ? 12 : 6); ++i6) { const int i = i6 % 6;
            int b, kvh, hq, qb, row0, seq;
            if (i < 4) { const int combo = vx * 2 + (i >> 1), u = (i & 1) * 32 + vi; b = combo >> 1; kvh = combo & 1; hq = kvh * 4 + (u >> 4); qb = u & 15; row0 = b * 4096; seq = 4096; }
            else { const int combo = vx * 2 + (i - 4), u = vi; b = combo >> 1; kvh = combo & 1; hq = kvh * 4 + (u >> 3); qb = u & 7; row0 = TP + b * 2048; seq = 2048; }
            attn::attn_dense_body<attn::bf16>(Qb + (size_t)(row0 + qb * 256) * 1024 + hq * 128, Kb + (size_t)row0 * 256 + kvh * 128, Vb + (size_t)row0 * 256 + kvh * 128,
                                              AO + (size_t)(row0 + qb * 256) * 1024 + hq * 128, seq, (char*)lds);
            __syncthreads();
        } } }
    GRID_SYNC();
    { PHASE_VARS
      if (PH(16)) { pg8::Gemm g{(const bf16_t*)(ws + WS_AO), (const bf16_t*)(ws + WS_W_CO), TT, 1024, 1024}; pg8::StaticOrder S; S.init(TT, 1024, G, bx);
        Epi<EM_RES, true> E{nullptr, nullptr, nullptr, out, nullptr, nullptr, nullptr, nullptr, nullptr, SSQP(3), (bf16_t*)(ws + WS_XBA), ap->in[15] + 1024};
        pg8::gemm_phase<Epi<EM_RES, true>, pg8::StaticOrder, true, true>(lds3, g, S, E); } }
    GRID_SYNC();
    ffn_block<1>(lds3);
}

extern "C" void kernel_launch(void* const* d_in, const int* in_sizes, int n_in, void* d_out, int out_size, void* d_ws, size_t ws_size, hipStream_t stream) {
    static int grid = 0;
    if (grid == 0) {
        int dev = 0, cus = 0, per_cu = 0;
        if (n_in != 19 || out_size != TT * DM || ws_size < WS_END) { fprintf(stderr, "kernel_launch: unexpected shapes: n_in %d out %d ws %zu (need %zu)\n", n_in, out_size, ws_size, (size_t)WS_END); grid = -1; return; }
        if (hipGetDevice(&dev) != hipSuccess || hipDeviceGetAttribute(&cus, hipDeviceAttributeMultiprocessorCount, dev) != hipSuccess) { fprintf(stderr, "kernel_launch: device query failed\n"); grid = -1; return; }
        if (hipFuncSetAttribute((const void*)mega_fwd, hipFuncAttributeMaxDynamicSharedMemorySize, LDS_BYTES) != hipSuccess) { fprintf(stderr, "kernel_launch: hipFuncSetAttribute failed\n"); grid = -1; return; }
        if (hipOccupancyMaxActiveBlocksPerMultiprocessor(&per_cu, (const void*)mega_fwd, 512, LDS_BYTES) != hipSuccess || per_cu < 1) fprintf(stderr, "kernel_launch: occupancy query reports %d blocks per CU\n", per_cu);
        (void)hipGetLastError();
        if (cus != 256) { fprintf(stderr, "kernel_launch: built for a 256-CU device, found %d\n", cus); grid = -1; return; }
        grid = 256;
    }
    if (grid < 0) return;
    if (hipMemsetAsync((char*)d_ws + WS_CTL, 0, CTL_BYTES, stream) != hipSuccess) { fprintf(stderr, "kernel_launch: memset failed\n"); return; }
    Args a{};
    for (int i = 0; i < 19; ++i) a.in[i] = (const float*)d_in[i];
    a.out = (float*)d_out; a.ws = (unsigned char*)d_ws;
    void* args[] = {&a};
    const hipError_t e = hipLaunchCooperativeKernel((const void*)mega_fwd, dim3(grid), dim3(512), args, LDS_BYTES, stream);
    if (e != hipSuccess) fprintf(stderr, "kernel_launch: cooperative launch failed: %s\n", hipGetErrorString(e));
}
```

```cpp
#include <hip/hip_runtime.h>
#include <hip/hip_cooperative_groups.h>
#include <cstdio>
#include <cstdint>
namespace cg = cooperative_groups;
#define DEVI __device__ __forceinline__
namespace pg8 {
#define PG8_LAS __attribute__((address_space(3)))
typedef unsigned short bf16_t;
typedef short bf16x8 __attribute__((ext_vector_type(8)));
typedef float f32x4 __attribute__((ext_vector_type(4)));
typedef unsigned u32x4 __attribute__((ext_vector_type(4)));
constexpr int BM = 256, BK = 64, HALF = 128, HTB = HALF * BK * 2  , STAGE_BYTES = 8 * HTB, NXCD = 8, WGM = 8;

__host__ __device__ __forceinline__ int lds_byte(int r, int c) { const int st = (r >> 4) * 2 + (c >> 5), rr = r & 15, cc = c & 31, ob = rr * 64 + cc * 2; return st * 1024 + (ob ^ (((ob >> 9) & 1) << 5)); }
__host__ __device__ __forceinline__ void stage_rc(int b, int& R, int& C) { const int st = b / 1024, sb = b % 1024, swz = sb ^ (((sb >> 9) & 1) << 5); R = (st >> 1) * 16 + swz / 64; C = (st & 1) * 32 + (swz % 64) / 2; }
__host__ __device__ __forceinline__ int perm32(int rho) { const int n = rho >> 4, i = rho & 15; return 8 * (i >> 2) + 4 * n + (i & 3); }

struct Unit { int pm, pn; };
struct Gemm { const bf16_t* A; const bf16_t* Bt; int M, N, K; };

struct StaticOrder {
    int nM, nN, nwg, G, c;
    __host__ __device__ void init(int M, int N, int G_, int c_) { nM = M / BM; nN = N / BM; nwg = nM * nN; G = G_; c = c_; }
    __host__ __device__ bool next(int i, Unit& u) const {
        const long L = (long)i * G + c; if (L >= nwg) return false;
        int wgid = (int)L; { const int q = nwg / NXCD, r = nwg % NXCD, xcd = wgid % NXCD, off = wgid / NXCD; wgid = (xcd < r ? xcd * (q + 1) : r * (q + 1) + (xcd - r) * q) + off; }
        const int nig = WGM * nN, gid = wgid / nig, fm = gid * WGM, gsz = (nM - fm) < WGM ? (nM - fm) : WGM;
        u.pm = fm + ((wgid % nig) % gsz); u.pn = (wgid % nig) / gsz; return true;
    }
    __device__ __forceinline__ void a_ready(const Unit&) const {}
    __device__ __forceinline__ void done(const Unit&) const {}
};

__device__ __forceinline__ unsigned cvt_pk_bf16(float lo, float hi) { unsigned r; asm volatile("v_cvt_pk_bf16_f32 %0, %1, %2" : "=v"(r) : "v"(lo), "v"(hi)); return r; }
template <class Epi, class Sched, bool ALIGN_EPI = false, bool SP2 = false>
__device__ __forceinline__ void gemm_phase(PG8_LAS unsigned char* lds, const Gemm g, const Sched& S, const Epi& E) {
    int tid_ = threadIdx.x; asm volatile("" : "+v"(tid_));
    const int tid = tid_, wid = __builtin_amdgcn_readfirstlane(tid >> 6), lane = tid & 63, wr = wid >> 2, wc = wid & 3, fr = lane & 15, fq = lane >> 4;
    const int K = g.K, nt = K / BK;
    unsigned voffA[2], voffB[2];
#pragma unroll
    for (int i = 0; i < 2; ++i) { int R, C; stage_rc(tid * 16 + i * 8192, R, C); const int Rb = Epi::PERM ? ((R & ~31) + perm32(R & 31)) : R;
        voffA[i] = (unsigned)(R * K + C) * 2u; voffB[i] = (unsigned)(Rb * K + C) * 2u; }
    const size_t kstep = (size_t)(BK * 2);
    const size_t hstep = (size_t)HALF * K * 2;
    const size_t tstep = 2 * hstep;
    const unsigned ldsw = (unsigned)wid * 1024u;
    const int aoff = lds_byte(wr * 64 + fr, fq * 8), boff = lds_byte(wc * 32 + fr, fq * 8);
#define PG8_SA(b, h) (((b) * 2 + (h)) * HTB)
#define PG8_SB(b, h) ((4 + (b) * 2 + (h)) * HTB)
#define PG8_STAGE(bufoff, gbase, voff) do { _Pragma("unroll") for (int _i = 0; _i < 2; ++_i) \
        __builtin_amdgcn_global_load_lds((const unsigned*)((const char*)(gbase) + (voff)[_i]), (PG8_LAS unsigned*)(lds + (bufoff) + ldsw + _i * 8192), 16, 0, 0); } while (0)
#define PG8_LDA(dst, b, h) do { _Pragma("unroll") for (int m = 0; m < 4; ++m) _Pragma("unroll") for (int k = 0; k < 2; ++k) dst[m][k] = *(const PG8_LAS bf16x8*)(lds + PG8_SA(b, h) + aoff + m * 2048 + k * 1024); } while (0)
#define PG8_LDB(dst, b, h) do { _Pragma("unroll") for (int n = 0; n < 2; ++n) _Pragma("unroll") for (int k = 0; k < 2; ++k) dst[n][k] = *(const PG8_LAS bf16x8*)(lds + PG8_SB(b, h) + boff + n * 2048 + k * 1024); } while (0)
#define PG8_MMA(ai, bj, At, Bt) do { __builtin_amdgcn_s_setprio(1); _Pragma("unroll") for (int m = 0; m < 4; ++m) _Pragma("unroll") for (int n = 0; n < 2; ++n) _Pragma("unroll") for (int k = 0; k < 2; ++k) \
        acc[ai][bj][m][n] = __builtin_amdgcn_mfma_f32_16x16x32_bf16(Bt[n][k], At[m][k], acc[ai][bj][m][n], 0, 0, 0); __builtin_amdgcn_s_setprio(0); } while (0)
#define PG8_WAIT_V(n) asm volatile("s_waitcnt vmcnt(" #n ")" ::: "memory")
#define PG8_WAIT_L(n) asm volatile("s_waitcnt lgkmcnt(" #n ")" ::: "memory")
#define PG8_BAR __builtin_amdgcn_s_barrier()
#define PG8_SCHED __builtin_amdgcn_sched_barrier(0)
    Unit cur, nxt; int ui = 0;
    if (!S.next(0, cur)) return;
    f32x4 acc[2][2][4][2];
#pragma unroll
    for (int a = 0; a < 2; ++a)
#pragma unroll
        for (int b = 0; b < 2; ++b)
#pragma unroll
            for (int m = 0; m < 4; ++m)
#pragma unroll
                for (int n = 0; n < 2; ++n) acc[a][b][m][n] = (f32x4){0.f, 0.f, 0.f, 0.f};
    bf16x8 At[4][2], B0[2][2], B1[2][2];
    const char* cA = (const char*)g.A + (size_t)cur.pm * tstep; const char* cB = (const char*)g.Bt + (size_t)cur.pn * tstep;
    S.a_ready(cur);
    if constexpr (SP2) {
        PG8_STAGE(PG8_SB(0, 0), cB, voffB); PG8_STAGE(PG8_SB(0, 1), cB + hstep, voffB); PG8_STAGE(PG8_SA(0, 0), cA, voffA); PG8_STAGE(PG8_SA(0, 1), cA + hstep, voffA);
        if (wr == 1) PG8_BAR;
        PG8_WAIT_V(2); PG8_BAR;
        PG8_STAGE(PG8_SB(1, 0), cB + kstep, voffB); PG8_STAGE(PG8_SA(1, 0), cA + kstep, voffA); PG8_STAGE(PG8_SB(1, 1), cB + hstep + kstep, voffB);
        PG8_WAIT_V(6); PG8_BAR;
    } else {
        PG8_STAGE(PG8_SB(0, 0), cB, voffB); PG8_STAGE(PG8_SA(0, 0), cA, voffA); PG8_STAGE(PG8_SB(0, 1), cB + hstep, voffB); PG8_STAGE(PG8_SA(0, 1), cA + hstep, voffA);
        if (wr == 1) PG8_BAR;
        PG8_WAIT_V(4); PG8_BAR;
        PG8_STAGE(PG8_SB(1, 0), cB + kstep, voffB); PG8_STAGE(PG8_SA(1, 0), cA + kstep, voffA); PG8_STAGE(PG8_SB(1, 1), cB + hstep + kstep, voffB);
        PG8_WAIT_V(6); PG8_BAR;
    }
    for (;;) {
        const bool has_next = S.next(ui + 1, nxt);
        const char* nA = has_next ? (const char*)g.A + (size_t)nxt.pm * tstep : cA; const char* nB = has_next ? (const char*)g.Bt + (size_t)nxt.pn * tstep : cB;
        for (int t = 0; t < nt; t += 2) {
            const bool last = (t == nt - 2);
            const char* a1 = cA + (size_t)(t + 1) * kstep;
            const char* a2 = last ? nA : cA + (size_t)(t + 2) * kstep; const char* b2 = last ? nB : cB + (size_t)(t + 2) * kstep;
            const char* a3 = a2 + kstep; const char* b3 = b2 + kstep;
            if (last && has_next) S.a_ready(nxt);
            if constexpr (SP2) {
            PG8_LDB(B0, 0, 0); PG8_LDB(B1, 0, 1); PG8_SCHED; PG8_LDA(At, 0, 0); PG8_STAGE(PG8_SA(1, 1), a1 + hstep, voffA);
            PG8_WAIT_V(8); PG8_WAIT_L(0); PG8_BAR; PG8_MMA(0, 0, At, B0); PG8_MMA(0, 1, At, B1); PG8_BAR; PG8_SCHED;
            PG8_LDA(At, 0, 1); PG8_STAGE(PG8_SB(0, 0), b2, voffB); PG8_STAGE(PG8_SB(0, 1), b2 + hstep, voffB); PG8_STAGE(PG8_SA(0, 0), a2, voffA);
            PG8_WAIT_V(8); PG8_WAIT_L(0); PG8_BAR; PG8_MMA(1, 0, At, B0); PG8_MMA(1, 1, At, B1); PG8_BAR; PG8_SCHED;
            PG8_LDB(B0, 1, 0); PG8_LDB(B1, 1, 1); PG8_SCHED; PG8_LDA(At, 1, 0); PG8_STAGE(PG8_SA(0, 1), a2 + hstep, voffA);
            PG8_WAIT_V(8); PG8_WAIT_L(0); PG8_BAR; PG8_MMA(0, 0, At, B0); PG8_MMA(0, 1, At, B1); PG8_BAR; PG8_SCHED;
            PG8_LDA(At, 1, 1); PG8_STAGE(PG8_SB(1, 0), b3, voffB); PG8_STAGE(PG8_SB(1, 1), b3 + hstep, voffB); PG8_STAGE(PG8_SA(1, 0), a3, voffA);
            PG8_WAIT_V(8); PG8_WAIT_L(0); PG8_BAR; PG8_MMA(1, 0, At, B0); PG8_MMA(1, 1, At, B1); PG8_BAR; PG8_SCHED;
            } else {
            PG8_LDB(B0, 0, 0); PG8_SCHED; PG8_LDA(At, 0, 0); PG8_STAGE(PG8_SA(1, 1), a1 + hstep, voffA);
            PG8_WAIT_L(8); PG8_BAR; PG8_WAIT_L(0); PG8_MMA(0, 0, At, B0); PG8_BAR; PG8_SCHED;
            PG8_LDB(B1, 0, 1); PG8_STAGE(PG8_SB(0, 0), b2, voffB);
            PG8_BAR; PG8_WAIT_L(0); PG8_MMA(0, 1, At, B1); PG8_BAR;
            PG8_LDA(At, 0, 1); PG8_STAGE(PG8_SA(0, 0), a2, voffA);
            PG8_BAR; PG8_WAIT_L(0); PG8_MMA(1, 0, At, B0); PG8_BAR; PG8_SCHED;
            PG8_STAGE(PG8_SB(0, 1), b2 + hstep, voffB);
            PG8_WAIT_V(6); PG8_BAR; PG8_MMA(1, 1, At, B1); PG8_BAR;
            PG8_LDB(B0, 1, 0); PG8_SCHED; PG8_LDA(At, 1, 0); PG8_STAGE(PG8_SA(0, 1), a2 + hstep, voffA);
            PG8_WAIT_L(8); PG8_BAR; PG8_WAIT_L(0); PG8_MMA(0, 0, At, B0); PG8_BAR; PG8_SCHED;
            PG8_LDB(B1, 1, 1); PG8_STAGE(PG8_SB(1, 0), b3, voffB);
            PG8_BAR; PG8_WAIT_L(0); PG8_MMA(0, 1, At, B1); PG8_BAR;
            PG8_LDA(At, 1, 1); PG8_STAGE(PG8_SA(1, 0), a3, voffA);
            PG8_BAR; PG8_WAIT_L(0); PG8_MMA(1, 0, At, B0); PG8_BAR; PG8_SCHED;
            PG8_STAGE(PG8_SB(1, 1), b3 + hstep, voffB);
            PG8_WAIT_V(6); PG8_BAR; PG8_MMA(1, 1, At, B1); PG8_BAR;
            }
        }
        if constexpr (ALIGN_EPI) { if (wr == 0) PG8_BAR; }
        if constexpr (!Epi::AFTER_DRAIN) { E(acc, cur, wr, wc, fr, fq); S.done(cur); }
        if (!has_next) break;
#pragma unroll
        for (int a = 0; a < 2; ++a)
#pragma unroll
            for (int b = 0; b < 2; ++b)
#pragma unroll
                for (int m = 0; m < 4; ++m)
#pragma unroll
                    for (int n = 0; n < 2; ++n) acc[a][b][m][n] = (f32x4){0.f, 0.f, 0.f, 0.f};
        cur = nxt; cA = nA; cB = nB; ++ui;
        if constexpr (ALIGN_EPI) { if (wr == 1) PG8_BAR; }
    }
    PG8_WAIT_V(0);
    if constexpr (!ALIGN_EPI) { if (wr == 0) PG8_BAR; }
    PG8_BAR;
    if constexpr (Epi::AFTER_DRAIN) { E.fused(acc, cur, wr, wc, fr, fq, lds, wid, lane); S.done(cur); }
#undef PG8_SA
#undef PG8_SB
#undef PG8_STAGE
#undef PG8_LDA
#undef PG8_LDB
#undef PG8_MMA
#undef PG8_WAIT_V
#undef PG8_WAIT_L
#undef PG8_BAR
#undef PG8_SCHED
}
}

typedef unsigned short bf16_t;
typedef short bf16x8 __attribute__((ext_vector_type(8)));
typedef float f32x4 __attribute__((ext_vector_type(4)));
typedef float f32x16 __attribute__((ext_vector_type(16)));
typedef unsigned u32x4 __attribute__((ext_vector_type(4)));
typedef unsigned u32x2 __attribute__((ext_vector_type(2)));
typedef float f32x2_t __attribute__((ext_vector_type(2)));
typedef __bf16 bf16x2_t __attribute__((ext_vector_type(2)));

constexpr int TP = 32768, TS = 16384, TT = TP + TS, DM = 1024, FFH = 2816, SP = 4096, SS = 2048;
constexpr float EPS = 1e-6f;
constexpr size_t MiB = 1u << 20;
constexpr size_t WS_CTL = 0, CTL_BYTES = 64 * 1024;
constexpr size_t WS_ROPE = 1 * MiB;
constexpr size_t WS_W_AB1 = 2 * MiB;
constexpr size_t WS_W_FT = 6 * MiB;
constexpr size_t WS_W_ABO = 8 * MiB;
constexpr size_t WS_W_GU0 = 10 * MiB;
constexpr size_t WS_W_D0 = 21 * MiB;
constexpr size_t WS_W_QKV = 27 * MiB;
constexpr size_t WS_W_CO = 30 * MiB;
constexpr size_t WS_W_GU1 = 32 * MiB;
constexpr size_t WS_W_D1 = 43 * MiB;
constexpr size_t WS_DEC = 49 * MiB;
constexpr size_t WS_C4 = 51 * MiB, WS_S4 = 67 * MiB;
constexpr size_t WS_C2 = 83 * MiB, WS_S2 = 87 * MiB;
constexpr size_t WS_PCP = 91 * MiB, WS_PSP = 107 * MiB;
constexpr size_t WS_PCS = 123 * MiB, WS_PSS = 131 * MiB;
constexpr size_t WS_SSQ = 1 * MiB + 256 * 1024;
constexpr size_t WS_XBA = 51 * MiB;
constexpr size_t WS_XBB = 147 * MiB;
constexpr size_t WS_H = WS_XBB;
constexpr size_t WS_BIG = 243 * MiB;
constexpr size_t WS_QKVR = WS_BIG;
constexpr size_t WS_G = WS_BIG + 144 * MiB;
constexpr size_t WS_FOLDF = WS_BIG;
constexpr size_t WS_FOLDG = WS_BIG + 4 * MiB;
constexpr size_t WS_ACT = WS_BIG;
constexpr size_t WS_Q = WS_BIG, WS_K = WS_BIG + 96 * MiB, WS_V = WS_BIG + 120 * MiB, WS_AO = WS_BIG + 144 * MiB;
constexpr size_t WS_END = WS_BIG + 264 * MiB;
constexpr size_t OUT_YTPC = 0, OUT_YTPS = 32 * MiB, OUT_YTSC = 64 * MiB, OUT_YTSS = 80 * MiB, OUT_DST = 96 * MiB;

DEVI float bf2f(bf16_t x) { return __uint_as_float(((unsigned)x) << 16); }
DEVI unsigned pk2(float lo, float hi) { f32x2_t v = {lo, hi}; bf16x2_t b = __builtin_convertvector(v, bf16x2_t); return __builtin_bit_cast(unsigned, b); }
DEVI bf16_t f2bf(float f) { return (bf16_t)(pk2(f, 0.f) & 0xffffu); }
DEVI u32x4 pk8(f32x4 a, f32x4 b) { u32x4 w; w.x = pk2(a[0], a[1]); w.y = pk2(a[2], a[3]); w.z = pk2(b[0], b[1]); w.w = pk2(b[2], b[3]); return w; }
DEVI float wave_sum(float v) {
#pragma unroll
    for (int o = 1; o < 64; o <<= 1) v += __shfl_xor(v, o);
    return v;
}
DEVI float logsig(float z) { return fminf(z, 0.f) - __logf(1.f + __expf(-fabsf(z))); }
DEVI float silu(float z) { return z * __builtin_amdgcn_rcpf(1.f + __expf(-z)); }

struct RotOrder { pg8::StaticOrder S;
    DEVI bool next(int i, pg8::Unit& u) const { if (!S.next(i, u)) return false; u.pn = (u.pn + ((u.pm >> 3) % 3)) & 7; return true; }
    DEVI void a_ready(const pg8::Unit&) const {}
    DEVI void done(const pg8::Unit&) const {} };
enum { EM_AB1, EM_AB1T, EM_FNETP, EM_FNETS, EM_RESIN, EM_RES, EM_GLU, EM_QKV };
template <int MODE, bool NEXT = false> struct Epi {
    static constexpr bool PERM = true, AFTER_DRAIN = false;
    bf16_t* O0; bf16_t* O1; bf16_t* O2; float* F0; const float* X0; const float* X1; const float* B0; const float* B1;
    const float* SQI; float* SQO; bf16_t* XBN; const float* GN;
    DEVI float rstd_of(int row) const { return rsqrtf(SQI[row] * (1.f / 1024.f) + EPS); }
    DEVI void operator()(const f32x4 (&acc)[2][2][4][2], const pg8::Unit& u, int wr, int wc, int fr, int fq) const {
        const int rbase = u.pm * 256 + wr * 64 + fr, cb = wc * 32 + 8 * fq;
        f32x4 ga[2][2];
        if constexpr (NEXT) {
#pragma unroll
            for (int bj = 0; bj < 2; ++bj) { ga[bj][0] = *(const f32x4*)(GN + u.pn * 256 + bj * 128 + cb); ga[bj][1] = *(const f32x4*)(GN + u.pn * 256 + bj * 128 + cb + 4); } }
        if constexpr (MODE == EM_AB1T) {
#pragma unroll
            for (int bj = 0; bj < 2; ++bj) { const f32x4 s0 = *(const f32x4*)(SQI + u.pn * 256 + bj * 128 + cb), s1 = *(const f32x4*)(SQI + u.pn * 256 + bj * 128 + cb + 4);
#pragma unroll
                for (int j = 0; j < 4; ++j) { ga[bj][0][j] = rsqrtf(s0[j] * (1.f / 1024.f) + EPS); ga[bj][1][j] = rsqrtf(s1[j] * (1.f / 1024.f) + EPS); } } }
        float rsv[2][4];
        if constexpr (MODE == EM_AB1 || MODE == EM_GLU || MODE == EM_QKV) {
#pragma unroll
            for (int ai = 0; ai < 2; ++ai)
#pragma unroll
                for (int m = 0; m < 4; ++m) rsv[ai][m] = SQI[rbase + ai * 128 + m * 16];
#pragma unroll
            for (int ai = 0; ai < 2; ++ai)
#pragma unroll
                for (int m = 0; m < 4; ++m) rsv[ai][m] = rsqrtf(rsv[ai][m] * (1.f / 1024.f) + EPS);
        }
#pragma unroll
        for (int ai = 0; ai < 2; ++ai)
#pragma unroll
            for (int m = 0; m < 4; ++m) {
                const int row = rbase + ai * 128 + m * 16;
                float rs = 1.f, ssq = 0.f;
                if constexpr (MODE == EM_AB1 || MODE == EM_GLU || MODE == EM_QKV) rs = rsv[ai][m];
                if constexpr (MODE == EM_GLU) {
                    const f32x4 g0 = acc[ai][0][m][0] * rs, g1 = acc[ai][0][m][1] * rs, u0 = acc[ai][1][m][0] * rs, u1 = acc[ai][1][m][1] * rs;
                    f32x4 a, b;
#pragma unroll
                    for (int j = 0; j < 4; ++j) { a[j] = silu(g0[j]) * u0[j]; b[j] = silu(g1[j]) * u1[j]; }
                    *(u32x4*)(O0 + (size_t)row * FFH + u.pn * 128 + cb) = pk8(a, b);
                } else {
#pragma unroll
                    for (int bj = 0; bj < 2; ++bj) {
                        f32x4 v0 = acc[ai][bj][m][0] * rs, v1 = acc[ai][bj][m][1] * rs;
                        const int c = bj * 128 + cb;
                        if constexpr (MODE == EM_AB1T) { v0 = v0 * ga[bj][0]; v1 = v1 * ga[bj][1]; }
                        if constexpr (MODE == EM_AB1) {
                            if (u.pn < 6) { *(u32x4*)(O0 + (size_t)row * 1536 + u.pn * 256 + c) = pk8(v0, v1); }
                            else { const int dir = u.pn - 6; const float* bias = dir ? B1 : B0;
                                const f32x4 b0 = *(const f32x4*)(bias + c), b1 = *(const f32x4*)(bias + c + 4);
                                f32x4 a, b;
#pragma unroll
                                for (int j = 0; j < 4; ++j) { a[j] = logsig(v0[j] + b0[j]) * 0.0625f; b[j] = logsig(v1[j] + b1[j]) * 0.0625f; }
                                float* gp = F0 + (size_t)row * 512 + dir * 256 + c; *(f32x4*)gp = a; *(f32x4*)(gp + 4) = b; }
                        } else if constexpr (MODE == EM_AB1T) {
                            const int cc = row, t0 = u.pn * 256;
                            bf16_t* dst;
                            if (t0 < TP) { const int b = t0 >> 12, s = (t0 & 4095) + c; dst = O0 + (size_t)(cc >> 9) * (4096 * 4096) + (size_t)(b * 512 + (cc & 511)) * 4096 + s; }
                            else { const int tt = t0 - TP, b = tt >> 11, s = (tt & 2047) + c; dst = O1 + (size_t)(cc >> 9) * (4096 * 2048) + (size_t)(b * 512 + (cc & 511)) * 2048 + s; }
                            *(u32x4*)dst = pk8(v0, v1);
                        } else if constexpr (MODE == EM_FNETP) {
                            *(u32x4*)(O0 + ((size_t)(u.pn >> 1) * 2048 + row) * 512 + (u.pn & 1) * 256 + c) = pk8(v0, v1);
                        } else if constexpr (MODE == EM_FNETS) {
                            *(u32x4*)(O0 + ((size_t)(u.pn >> 1) * 1024 + row) * 512 + (u.pn & 1) * 256 + c) = pk8(v0, v1);
                        } else if constexpr (MODE == EM_RESIN) {
                            const float* xp = (row < TP ? X0 + (size_t)row * 1024 : X1 + (size_t)(row - TP) * 1024) + u.pn * 256 + c;
                            float* op = F0 + (size_t)row * 1024 + u.pn * 256 + c;
                            const f32x4 x0 = *(const f32x4*)xp + v0, x1 = *(const f32x4*)(xp + 4) + v1;
                            *(f32x4*)op = x0; *(f32x4*)(op + 4) = x1;
                            if constexpr (NEXT) { ssq += (x0[0] * x0[0] + x0[1] * x0[1]) + (x0[2] * x0[2] + x0[3] * x0[3]) + (x1[0] * x1[0] + x1[1] * x1[1]) + (x1[2] * x1[2] + x1[3] * x1[3]);
                                *(u32x4*)(XBN + (size_t)row * 1024 + u.pn * 256 + c) = pk8(x0 * ga[bj][0], x1 * ga[bj][1]); }
                        } else if constexpr (MODE == EM_RES) {
                            float* op = F0 + (size_t)row * 1024 + u.pn * 256 + c;
                            const f32x4 x0 = *(const f32x4*)op + v0, x1 = *(const f32x4*)(op + 4) + v1;
                            *(f32x4*)op = x0; *(f32x4*)(op + 4) = x1;
                            if constexpr (NEXT) { ssq += (x0[0] * x0[0] + x0[1] * x0[1]) + (x0[2] * x0[2] + x0[3] * x0[3]) + (x1[0] * x1[0] + x1[1] * x1[1]) + (x1[2] * x1[2] + x1[3] * x1[3]);
                                *(u32x4*)(XBN + (size_t)row * 1024 + u.pn * 256 + c) = pk8(x0 * ga[bj][0], x1 * ga[bj][1]); }
                        } else if constexpr (MODE == EM_QKV) {
                            bf16_t* dst;
                            if (u.pn < 4) dst = O0 + (size_t)row * 1024 + u.pn * 256 + c;
                            else if (u.pn == 4) dst = O1 + (size_t)row * 256 + c;
                            else dst = O2 + (size_t)row * 256 + c;
                            *(u32x4*)dst = pk8(v0, v1);
                        }
                    }
                    if constexpr (NEXT) { ssq += __shfl_xor(ssq, 16); ssq += __shfl_xor(ssq, 32); if (fq == 0) atomicAdd(SQO + row, ssq); }
                }
            }
    }
};

DEVI void p_fold(const float* win, const float* upf, const float* upb, bf16_t* WFT, bf16_t* WG, float* tab, int gw, int NGW, int lane) {
    if (threadIdx.x < 128) tab[threadIdx.x] = cospif((float)threadIdx.x * (1.f / 64.f));
    __syncthreads();
    for (int it = gw; it < 1024 * 16; it += NGW) {
        const int k = it >> 4, cb = it & 15, cc = cb * 64 + lane, part = cc >> 9, g = (cc >> 7) & 3, l = cc & 127;
        const float* wr = win + (size_t)k * 2080 + 1568 + g * 128;
        const int sh = part ? 96 : 0;
        float acc = 0.f;
#pragma unroll 8
        for (int w = 0; w < 128; ++w) acc += wr[w] * tab[(w * l + sh) & 127];
        WFT[(size_t)cc * 1024 + k] = f2bf(acc);
    }
    for (int it = gw; it < 1024 * 8; it += NGW) {
        const int k = it >> 3, nb = it & 7, n = nb * 64 + lane, dir = n >> 8, nn = n & 255;
        const float* wr = win + (size_t)k * 2080 + 1536 + dir * 16;
        const float* up = dir ? upb : upf;
        float acc = 0.f;
#pragma unroll
        for (int r = 0; r < 16; ++r) acc += wr[r] * up[r * 256 + nn];
        WG[(size_t)n * 1024 + k] = f2bf(acc);
    }
    __syncthreads();
}
DEVI void p_dft(bf16_t* C, bf16_t* Sn, int S, int logS, int gt, int NGT) {
    const int lri = logS - 3;
    const long total = (long)(S / 2) << lri;
    const float nrm = rsqrtf((float)S * 128.f), xs = 2.f / (float)S;
    for (long it = gt; it < 2 * total; it += NGT) {
        const int part = it >= total; const long i2 = part ? it - total : it;
        const int k = (int)(i2 >> lri), s0 = (int)(i2 & ((1 << lri) - 1)) * 8;
        float v[8];
#pragma unroll
        for (int j = 0; j < 8; ++j) { const int idx = (k * (s0 + j)) & (S - 1); const float x = (float)idx * xs; v[j] = (part ? sinpif(x) : cospif(x)) * nrm; }
        u32x4 w; w.x = pk2(v[0], v[1]); w.y = pk2(v[2], v[3]); w.z = pk2(v[4], v[5]); w.w = pk2(v[6], v[7]);
        *(u32x4*)((part ? Sn : C) + (size_t)k * S + s0) = w;
    }
}
DEVI void p_fcombine(const bf16_t* PC, const bf16_t* PS, bf16_t* MIX, int tokbase, int S, int logSH, int gt, int NGT) {
    const int total = 8 << (logSH + 6);
    for (int it0 = gt; it0 < total; it0 += 4 * NGT) {
        u32x4 pc[4], ps[4];
#pragma unroll
        for (int u = 0; u < 4; ++u) { const int it = it0 + u * NGT, ch = it & 63, k = (it >> 6) & ((1 << logSH) - 1), b = it >> (6 + logSH);
            pc[u] = *(const u32x4*)(PC + ((size_t)(b << logSH) + k) * 512 + ch * 8); ps[u] = *(const u32x4*)(PS + ((size_t)(b << logSH) + k) * 512 + ch * 8); }
#pragma unroll
        for (int u = 0; u < 4; ++u) { const int it = it0 + u * NGT, ch = it & 63, k = (it >> 6) & ((1 << logSH) - 1), b = it >> (6 + logSH);
            u32x4 lo, hi;
#pragma unroll
            for (int j = 0; j < 4; ++j) { const float c0 = __uint_as_float(pc[u][j] << 16), c1 = __uint_as_float(pc[u][j] & 0xffff0000u), s0 = __uint_as_float(ps[u][j] << 16), s1 = __uint_as_float(ps[u][j] & 0xffff0000u);
                lo[j] = pk2(c0 - s0, c1 - s1); hi[j] = pk2(c0 + s0, c1 + s1); }
            *(u32x4*)(MIX + (size_t)(tokbase + b * S + k) * 1024 + 512 + ch * 8) = lo;
            if (k) *(u32x4*)(MIX + (size_t)(tokbase + b * S + S - k) * 1024 + 512 + ch * 8) = hi; }
    }
}
DEVI void p_fmid(const bf16_t* YC, bf16_t* MIX, int tokbase, int S, int gw, int NGW, int lane) {
    const float nrm = rsqrtf((float)S * 128.f);
    for (int r = gw; r < 4096; r += NGW) {
        const bf16_t* row = YC + (size_t)r * S; float acc = 0.f;
        for (int s0 = lane * 8; s0 < S; s0 += 512) { const u32x4 w = *(const u32x4*)(row + s0);
#pragma unroll
            for (int j = 0; j < 4; ++j) acc += __uint_as_float(w[j] << 16) - __uint_as_float(w[j] & 0xffff0000u); }
        acc = wave_sum(acc);
        if (lane == 0) MIX[(size_t)(tokbase + (r >> 9) * S + S / 2) * 1024 + 512 + (r & 511)] = f2bf(acc * nrm);
    }
}
DEVI void p_norm(const float* src0, const float* src1, const float* gain, bf16_t* H, float* SQ, int gw, int NGW, int lane) {
    f32x4 gv[4];
#pragma unroll
    for (int j = 0; j < 4; ++j) gv[j] = *((const f32x4*)gain + lane + 64 * j);
    for (int m = gw; m < TT; m += NGW) {
        const f32x4* xr = (const f32x4*)(m < TP ? src0 + (size_t)m * DM : src1 + (size_t)(m - TP) * DM) + lane;
        f32x4 v[4]; float s = 0.f;
#pragma unroll
        for (int j = 0; j < 4; ++j) { v[j] = xr[64 * j]; s += (v[j].x * v[j].x + v[j].y * v[j].y) + (v[j].z * v[j].z + v[j].w * v[j].w); }
        const float rstd = 1.f; { const float tot = wave_sum(s); if (lane == 0) SQ[m] = tot; }
        u32x2* o8 = (u32x2*)(H + (size_t)m * DM) + lane;
#pragma unroll
        for (int j = 0; j < 4; ++j) { u32x2 w; w.x = pk2(v[j].x * rstd * gv[j].x, v[j].y * rstd * gv[j].y); w.y = pk2(v[j].z * rstd * gv[j].z, v[j].w * rstd * gv[j].w); o8[64 * j] = w; }
    }
}
DEVI void tr_item(const float* W, int ld, int col0, bf16_t* WT, int Kd, int drow0, float scale, float* scr, int k0, int n0, int lane) {
#pragma unroll 8
    for (int i = 0; i < 32; ++i) { const int kk = 2 * i + (lane >> 5); scr[kk * 33 + (lane & 31)] = W[(size_t)(k0 + kk) * ld + col0 + n0 + (lane & 31)]; }
    asm volatile("s_waitcnt lgkmcnt(0)" ::: "memory");
    const int c = lane & 7;
#pragma unroll
    for (int j = 0; j < 4; ++j) { const int n = (lane >> 3) + 8 * j; const float* s = scr + (8 * c) * 33 + n;
        u32x4 o; o.x = pk2(s[0] * scale, s[33] * scale); o.y = pk2(s[66] * scale, s[99] * scale); o.z = pk2(s[132] * scale, s[165] * scale); o.w = pk2(s[198] * scale, s[231] * scale);
        *(u32x4*)(WT + (size_t)(drow0 + n) * Kd + k0 + 8 * c) = o; }
    asm volatile("s_waitcnt lgkmcnt(0)" ::: "memory");
}
template <int MAP> DEVI bool tr_mat(int& r, const float* W, int ld, int col0, int K, int ncols, bf16_t* WT, int drow, float scale, float* scr, int lane) {
    const int nblk = ncols >> 5, cnt = (K >> 6) * nblk;
    if (r >= cnt) { r -= cnt; return false; }
    const int kb = r / nblk, nb = r - kb * nblk, n0 = nb * 32;
    int d0 = drow + n0;
    if (MAP == 1) d0 = (n0 >> 7) * 256 + (n0 & 127);
    if (MAP == 2) d0 = (n0 >> 7) * 256 + 128 + (n0 & 127);
    tr_item(W, ld, col0, WT, K, d0, scale, scr, kb * 64, n0, lane);
    return true;
}

constexpr int GP = 144;
constexpr int L_QF = 0, L_QB = 9216, L_KF = 18432, L_KB = 27648, L_VT = 36864, L_ATF = 55296, L_ATB = 64512, L_SPF = 73728, L_SPB = 92160, L_SEG = 110592;
constexpr int L_KDF = 0, L_KDB = 9216;
DEVI int crow(int r, int hi) { return (r & 3) + 8 * (r >> 2) + 4 * hi; }
DEVI bf16x8 ldf(const unsigned char* base, int row, int ks, int hi) { return *(const bf16x8*)(base + row * GP + ks * 32 + hi * 16); }

#define LBAR() do { asm volatile("s_waitcnt lgkmcnt(0)" ::: "memory"); __builtin_amdgcn_s_barrier(); asm volatile("" ::: "memory"); } while (0)
struct GlaLd { float gf[8], gb[8]; bf16_t qh[8], kh[8], vh[16]; };
template <bool FULL> DEVI void gla_load(GlaLd& L, int item, const bf16_t* QKVR, const float* G, const bf16_t* DST, int tid) {
    const int n = item >> 2, h = item & 3, tok0 = n * 64, d = tid & 63, sg = tid >> 6, e = tid & 127, s4 = tid >> 7;
#pragma unroll
    for (int i = 0; i < 8; ++i) { const float* p = G + (size_t)(tok0 + 8 * sg + i) * 512 + h * 64 + d; L.gf[i] = p[0]; L.gb[i] = p[256]; }
#pragma unroll
    for (int i = 0; i < 8; ++i) { const bf16_t* tr = QKVR + (size_t)(tok0 + 8 * sg + i) * 1536 + h * 64 + d; if (FULL) L.qh[i] = tr[0]; L.kh[i] = tr[256]; }
#pragma unroll
    for (int i = 0; i < 16; ++i) L.vh[i] = QKVR[(size_t)(tok0 + 16 * s4 + i) * 1536 + 512 + h * 128 + e];
}
DEVI void gla_prefix(const GlaLd& L, float* SEG, int tid, float (&bF)[8], float (&bB)[8], float& totF, float& totB) {
    const int d = tid & 63, sg = tid >> 6;
    bF[0] = L.gf[0];
#pragma unroll
    for (int i = 1; i < 8; ++i) bF[i] = bF[i - 1] + L.gf[i];
    bB[7] = L.gb[7];
#pragma unroll
    for (int i = 6; i >= 0; --i) bB[i] = bB[i + 1] + L.gb[i];
    SEG[sg * 64 + d] = bF[7]; SEG[512 + sg * 64 + d] = bB[0];
    LBAR();
    float offF = 0.f, offB = 0.f; totF = 0.f; totB = 0.f;
#pragma unroll
    for (int s = 0; s < 8; ++s) { const float a = SEG[s * 64 + d], b = SEG[512 + s * 64 + d]; totF += a; totB += b; if (s < sg) offF += a; if (s > sg) offB += b; }
#pragma unroll
    for (int i = 0; i < 8; ++i) { bF[i] += offF; bB[i] += offB; }
}
DEVI void gla_stage_vt(const GlaLd& L, unsigned char* VT, int tid) {
    const int e = tid & 127, s4 = tid >> 7;
    unsigned w[8];
#pragma unroll
    for (int i = 0; i < 8; ++i) w[i] = (unsigned)L.vh[2 * i] | ((unsigned)L.vh[2 * i + 1] << 16);
    u32x4 a = {w[0], w[1], w[2], w[3]}, b = {w[4], w[5], w[6], w[7]};
    *(u32x4*)(VT + e * GP + s4 * 32) = a; *(u32x4*)(VT + e * GP + s4 * 32 + 16) = b;
}
DEVI void gla_a_item(const GlaLd& L, int item, bf16_t* DST, float* DEC, unsigned char* lds, int tid, int wave, int lane) {
    const int d = tid & 63, sg = tid >> 6;
    float bF[8], bB[8], totF, totB;
    gla_prefix(L, (float*)(lds + L_SEG), tid, bF, bB, totF, totB);
    float kf[8], kb[8];
#pragma unroll
    for (int i = 0; i < 8; ++i) { const float kk = bf2f(L.kh[i]); kf[i] = kk * __expf(totF - bF[i]); kb[i] = kk * __expf(totB - bB[i]); }
    { u32x4 a = {pk2(kf[0], kf[1]), pk2(kf[2], kf[3]), pk2(kf[4], kf[5]), pk2(kf[6], kf[7])}, b = {pk2(kb[0], kb[1]), pk2(kb[2], kb[3]), pk2(kb[4], kb[5]), pk2(kb[6], kb[7])};
      *(u32x4*)(lds + L_KDF + d * GP + sg * 16) = a; *(u32x4*)(lds + L_KDB + d * GP + sg * 16) = b; }
    if (sg == 0) { DEC[(size_t)(item * 2) * 64 + d] = __expf(totF); DEC[(size_t)(item * 2 + 1) * 64 + d] = __expf(totB); }
    gla_stage_vt(L, lds + L_VT, tid);
    LBAR();
    { const int dir = wave >> 2, et = wave & 3, r32 = lane & 31, hi = lane >> 5;
      const unsigned char* KD = lds + (dir ? L_KDB : L_KDF);
      f32x16 c0 = {}, c1 = {};
#pragma unroll
      for (int ks = 0; ks < 4; ++ks) { const bf16x8 b = ldf(lds + L_VT, 32 * et + r32, ks, hi), a0 = ldf(KD, r32, ks, hi), a1 = ldf(KD, 32 + r32, ks, hi);
          c0 = __builtin_amdgcn_mfma_f32_32x32x16_bf16(a0, b, c0, 0, 0, 0); c1 = __builtin_amdgcn_mfma_f32_32x32x16_bf16(a1, b, c1, 0, 0, 0); }
      bf16_t* dst = DST + (size_t)(item * 2 + dir) * 8192 + (32 * et + r32) * 64 + 4 * hi;
#pragma unroll
      for (int q = 0; q < 4; ++q) { u32x2 w0 = {pk2(c0[4 * q], c0[4 * q + 1]), pk2(c0[4 * q + 2], c0[4 * q + 3])}, w1 = {pk2(c1[4 * q], c1[4 * q + 1]), pk2(c1[4 * q + 2], c1[4 * q + 3])};
          *(u32x2*)(dst + 8 * q) = w0; *(u32x2*)(dst + 32 + 8 * q) = w1; } }
    LBAR();
}
DEVI void p_scan(bf16_t* DST, const float* DEC, int gt) {
    const int combo = gt >> 10, el = gt & 1023, e = el >> 3, d0 = (el & 7) * 8;
    const int seq = combo >> 3, h = (combo >> 1) & 3, dir = combo & 1;
    const int nch = seq < 8 ? 64 : 32, n0 = seq < 8 ? seq * 64 : 512 + (seq - 8) * 32;
    float S[8];
#pragma unroll
    for (int j = 0; j < 8; ++j) S[j] = 0.f;
    for (int st0 = 0; st0 < nch; st0 += 8) {
        u32x4 ds[8]; f32x4 dc0[8], dc1[8];
#pragma unroll
        for (int u = 0; u < 8; ++u) { const int n = dir ? nch - 1 - (st0 + u) : st0 + u; const size_t item = (size_t)((n0 + n) * 4 + h) * 2 + dir;
            ds[u] = *(const u32x4*)(DST + item * 8192 + e * 64 + d0); dc0[u] = *(const f32x4*)(DEC + item * 64 + d0); dc1[u] = *(const f32x4*)(DEC + item * 64 + d0 + 4); }
#pragma unroll
        for (int u = 0; u < 8; ++u) { const int n = dir ? nch - 1 - (st0 + u) : st0 + u; const size_t item = (size_t)((n0 + n) * 4 + h) * 2 + dir;
            u32x4 w = {pk2(S[0], S[1]), pk2(S[2], S[3]), pk2(S[4], S[5]), pk2(S[6], S[7])};
            *(u32x4*)(DST + item * 8192 + e * 64 + d0) = w;
            S[0] = dc0[u][0] * S[0] + __uint_as_float(ds[u][0] << 16); S[1] = dc0[u][1] * S[1] + __uint_as_float(ds[u][0] & 0xffff0000u);
            S[2] = dc0[u][2] * S[2] + __uint_as_float(ds[u][1] << 16); S[3] = dc0[u][3] * S[3] + __uint_as_float(ds[u][1] & 0xffff0000u);
            S[4] = dc1[u][0] * S[4] + __uint_as_float(ds[u][2] << 16); S[5] = dc1[u][1] * S[5] + __uint_as_float(ds[u][2] & 0xffff0000u);
            S[6] = dc1[u][2] * S[6] + __uint_as_float(ds[u][3] << 16); S[7] = dc1[u][3] * S[7] + __uint_as_float(ds[u][3] & 0xffff0000u); }
    }
}
DEVI void gla_c_item(const GlaLd& L, int item, const bf16_t* QKVR, const bf16_t* DST, const float* outg, bf16_t* MIX, unsigned char* lds, int tid, int wave, int lane) {
    const int n = item >> 2, h = item & 3, tok0 = n * 64, d = tid & 63, sg = tid >> 6, r32 = lane & 31, hi = lane >> 5;
    u32x4 sp[4], rg0, rg1;
#pragma unroll
    for (int p = 0; p < 2; ++p) { const int row = (tid >> 3) + 64 * p, c = tid & 7;
        sp[2 * p] = *(const u32x4*)(DST + (size_t)(item * 2) * 8192 + row * 64 + c * 8); sp[2 * p + 1] = *(const u32x4*)(DST + (size_t)(item * 2 + 1) * 8192 + row * 64 + c * 8); }
    { const bf16_t* rp = QKVR + (size_t)(tok0 + (tid >> 3)) * 1536 + 1024 + h * 128 + 16 * (tid & 7); rg0 = *(const u32x4*)rp; rg1 = *(const u32x4*)(rp + 8); }
    float bF[8], bB[8], totF, totB;
    gla_prefix(L, (float*)(lds + L_SEG), tid, bF, bB, totF, totB);
    bf16_t* QF = (bf16_t*)(lds + L_QF); bf16_t* QB = (bf16_t*)(lds + L_QB); bf16_t* KF = (bf16_t*)(lds + L_KF); bf16_t* KB = (bf16_t*)(lds + L_KB);
#pragma unroll
    for (int i = 0; i < 8; ++i) { const float qv = bf2f(L.qh[i]), kv = bf2f(L.kh[i]);
        const int o = (8 * sg + i) * (GP / 2) + d;
        QF[o] = f2bf(qv * __expf(bF[i])); KF[o] = f2bf(kv * __expf(-bF[i])); QB[o] = f2bf(qv * __expf(bB[i])); KB[o] = f2bf(kv * __expf(-bB[i])); }
    gla_stage_vt(L, lds + L_VT, tid);
#pragma unroll
    for (int p = 0; p < 2; ++p) { const int row = (tid >> 3) + 64 * p, c = tid & 7;
        *(u32x4*)(lds + L_SPF + row * GP + c * 16) = sp[2 * p]; *(u32x4*)(lds + L_SPB + row * GP + c * 16) = sp[2 * p + 1]; }
    LBAR();
    { const int dir = wave >> 2, it = (wave >> 1) & 1, jt = wave & 1;
      const unsigned char* Qd = lds + (dir ? L_QB : L_QF); const unsigned char* Kd = lds + (dir ? L_KB : L_KF);
      f32x16 c = {};
#pragma unroll
      for (int ks = 0; ks < 4; ++ks) c = __builtin_amdgcn_mfma_f32_32x32x16_bf16(ldf(Qd, 32 * it + r32, ks, hi), ldf(Kd, 32 * jt + r32, ks, hi), c, 0, 0, 0);
      bf16_t* AT = (bf16_t*)(lds + (dir ? L_ATB : L_ATF));
      const int j = 32 * jt + r32;
#pragma unroll
      for (int r = 0; r < 16; ++r) { const int i = 32 * it + crow(r, hi); const bool keep = dir ? (j >= i) : (j <= i); AT[i * (GP / 2) + j] = f2bf(keep ? c[r] : 0.f); } }
    LBAR();
    { const int it = wave >> 2, et = wave & 3;
      f32x16 o = {};
#pragma unroll
      for (int dir = 0; dir < 2; ++dir) {
          const unsigned char* AT = lds + (dir ? L_ATB : L_ATF); const unsigned char* Qd = lds + (dir ? L_QB : L_QF); const unsigned char* SPd = lds + (dir ? L_SPB : L_SPF);
#pragma unroll
          for (int ks = 0; ks < 4; ++ks) o = __builtin_amdgcn_mfma_f32_32x32x16_bf16(ldf(AT, 32 * it + r32, ks, hi), ldf(lds + L_VT, 32 * et + r32, ks, hi), o, 0, 0, 0);
#pragma unroll
          for (int ks = 0; ks < 4; ++ks) o = __builtin_amdgcn_mfma_f32_32x32x16_bf16(ldf(Qd, 32 * it + r32, ks, hi), ldf(SPd, 32 * et + r32, ks, hi), o, 0, 0, 0); }
      LBAR();
      float* OB = (float*)lds;
#pragma unroll
      for (int r = 0; r < 16; ++r) OB[(32 * it + crow(r, hi)) * 132 + 32 * et + r32] = o[r]; }
    LBAR();
    { const int i = tid >> 3, s8 = tid & 7; const float* OB = (const float*)lds + i * 132 + 16 * s8;
      f32x4 v[4]; float ss = 0.f;
#pragma unroll
      for (int q = 0; q < 4; ++q) { v[q] = *(const f32x4*)(OB + 4 * q); ss += (v[q].x * v[q].x + v[q].y * v[q].y) + (v[q].z * v[q].z + v[q].w * v[q].w); }
      ss += __shfl_xor(ss, 1); ss += __shfl_xor(ss, 2); ss += __shfl_xor(ss, 4);
      const float rstd = rsqrtf(ss * (1.f / 128.f) + EPS);
      const int tok = tok0 + i;
      const u32x4 r0 = rg0, r1 = rg1;
      float y[16];
#pragma unroll
      for (int q = 0; q < 4; ++q) { const f32x4 g = *(const f32x4*)(outg + 16 * s8 + 4 * q);
          const unsigned w0 = q < 2 ? r0[2 * q] : r1[2 * (q - 2)], w1 = q < 2 ? r0[2 * q + 1] : r1[2 * (q - 2) + 1];
          y[4 * q + 0] = v[q].x * rstd * g.x * silu(__uint_as_float(w0 << 16)); y[4 * q + 1] = v[q].y * rstd * g.y * silu(__uint_as_float(w0 & 0xffff0000u));
          y[4 * q + 2] = v[q].z * rstd * g.z * silu(__uint_as_float(w1 << 16)); y[4 * q + 3] = v[q].w * rstd * g.w * silu(__uint_as_float(w1 & 0xffff0000u)); }
      u32x4 a = {pk2(y[0], y[1]), pk2(y[2], y[3]), pk2(y[4], y[5]), pk2(y[6], y[7])}, b = {pk2(y[8], y[9]), pk2(y[10], y[11]), pk2(y[12], y[13]), pk2(y[14], y[15])};
      bf16_t* mp = MIX + (size_t)tok * 1024 + h * 128 + 16 * s8;
      *(u32x4*)mp = a; *(u32x4*)(mp + 8) = b; }
    LBAR();
}

DEVI void p_qkrope(bf16_t* Q, bf16_t* K, const float* qg, const float* kg, const float2* rope, int gw, int NGW, int lane) {
    const int i = lane & 31, hh = lane >> 5;
    float gq[4], gk[4];
#pragma unroll
    for (int j = 0; j < 4; ++j) { gq[j] = qg[32 * j + i]; gk[j] = kg[32 * j + i]; }
    for (int t0 = gw * 4; t0 < TT; t0 += NGW * 4) {
        bf16_t xr[4][5][4]; float2 rr[4], rc[4];
#pragma unroll
        for (int u = 0; u < 4; ++u) { const int t = t0 + u, s = t < TP ? (t & 4095) : ((t - TP) & 2047);
            rr[u] = rope[(s >> 6) * 32 + i]; rc[u] = rope[(s & 63) * 32 + i];
#pragma unroll
            for (int p = 0; p < 5; ++p) { const int slot = 2 * p + hh;
                const bf16_t* base = slot < 8 ? Q + (size_t)t * 1024 + slot * 128 : K + (size_t)t * 256 + (slot - 8) * 128;
#pragma unroll
                for (int j = 0; j < 4; ++j) xr[u][p][j] = base[32 * j + i]; } }
#pragma unroll
        for (int u = 0; u < 4; ++u) { const int t = t0 + u;
#pragma unroll
            for (int p = 0; p < 5; ++p) {
                const int slot = 2 * p + hh;
                bf16_t* base = slot < 8 ? Q + (size_t)t * 1024 + slot * 128 : K + (size_t)t * 256 + (slot - 8) * 128;
                float x[4]; float ss = 0.f;
#pragma unroll
                for (int j = 0; j < 4; ++j) { x[j] = bf2f(xr[u][p][j]); ss += x[j] * x[j]; }
                ss += __shfl_xor(ss, 1); ss += __shfl_xor(ss, 2); ss += __shfl_xor(ss, 4); ss += __shfl_xor(ss, 8); ss += __shfl_xor(ss, 16);
                const float rstd = rsqrtf(ss * (1.f / 128.f) + EPS);
#pragma unroll
                for (int j = 0; j < 4; ++j) x[j] *= rstd * (slot < 8 ? gq[j] : gk[j]);
                base[i] = f2bf(x[0] * rr[u].x - x[1] * rr[u].y); base[32 + i] = f2bf(x[1] * rr[u].x + x[0] * rr[u].y);
                base[64 + i] = f2bf(x[2] * rc[u].x - x[3] * rc[u].y); base[96 + i] = f2bf(x[3] * rc[u].x + x[2] * rc[u].y);
            } }
    }
}
namespace attn {
using bf16 = unsigned short;
constexpr int   D = 128, NW = 8, QBLK = 32, KVBLK = 64;
constexpr float SCALE = 0.088388347648318440f;
constexpr float THR = 8.f;
constexpr int SDEPTH = 2;
constexpr int LDQ = 1024, LDK = 256, LDO = 1024;
constexpr size_t SHM_V = KVBLK * D * 2, SHM_K = KVBLK * D * 2, SHM_ATTN = 2 * SHM_V + 2 * SHM_K + NW * 64 * 4;
using bf16x8 = __attribute__((ext_vector_type(8))) short;
using s16x4  = __attribute__((ext_vector_type(4))) short;
using f32x16 = __attribute__((ext_vector_type(16))) float;
using f32x8  = __attribute__((ext_vector_type(8))) float;
using u32x4  = __attribute__((ext_vector_type(4))) unsigned;
#define KSWZ(row, colB) ((row) * 256 + ((colB) ^ (((row) & 7) << 4)))
#define SBAR() __builtin_amdgcn_sched_barrier(0)
__device__ __forceinline__ int crow(int r, int hi) { return (r & 3) + 8 * (r >> 2) + 4 * hi; }
__device__ __forceinline__ unsigned cvtpk(float lo, float hi) {
  unsigned r; asm volatile("v_cvt_pk_bf16_f32 %0, %1, %2" : "=v"(r) : "v"(lo), "v"(hi)); return r;
}
template <typename TIn> struct Stage;
template <> struct Stage<bf16>  { using T = bf16x8;
  __device__ static __forceinline__ T ld8(const bf16* p) { return *reinterpret_cast<const bf16x8*>(p); }
  __device__ static __forceinline__ bf16x8 tobf(T x) { return x; } };
template <> struct Stage<float> { using T = f32x8;
  __device__ static __forceinline__ T ld8(const float* p) { return *reinterpret_cast<const f32x8*>(p); }
  __device__ static __forceinline__ bf16x8 tobf(T x) {
    u32x4 w = {cvtpk(x[0], x[1]), cvtpk(x[2], x[3]), cvtpk(x[4], x[5]), cvtpk(x[6], x[7])}; return *reinterpret_cast<bf16x8*>(&w); } };

__device__ __forceinline__ void partialSM(f32x16& p0, f32x16& p1, float& m_reg, float& mn, float& alpha) {
  constexpr float C = SCALE * 1.4426950408889634f;
  float pmax = p0[0]; for (int r = 1; r < 16; ++r) pmax = fmaxf(pmax, p0[r]); for (int r = 0; r < 16; ++r) pmax = fmaxf(pmax, p1[r]);
  { auto rr = __builtin_amdgcn_permlane32_swap(__float_as_uint(pmax), __float_as_uint(pmax), false, false);
    pmax = fmaxf(__uint_as_float(rr[0]), __uint_as_float(rr[1])); }
  if (__builtin_expect(__all(pmax - m_reg <= THR / SCALE), 1)) { mn = m_reg; alpha = 1.f; }
  else { mn = fmaxf(m_reg, pmax); alpha = __builtin_amdgcn_exp2f((m_reg - mn) * C); m_reg = mn; }
  float mnC = -mn * C;
  for (int r = 0; r < 16; ++r) p0[r] = fmaf(p0[r], C, mnC); for (int r = 0; r < 16; ++r) p1[r] = fmaf(p1[r], C, mnC);
  for (int r = 0; r < 16; ++r) p0[r] = __builtin_amdgcn_exp2f(p0[r]);
}
__device__ __forceinline__ void finishSM(f32x16& p0, f32x16& p1, float alpha, float& l_reg, bf16x8& pa0, bf16x8& pa1, bf16x8& pa2, bf16x8& pa3) {
  for (int r = 0; r < 16; ++r) p1[r] = __builtin_amdgcn_exp2f(p1[r]);
  float ps = 0; for (int r = 0; r < 16; ++r) ps += p0[r]; for (int r = 0; r < 16; ++r) ps += p1[r];
  { auto rr = __builtin_amdgcn_permlane32_swap(__float_as_uint(ps), __float_as_uint(ps), false, false);
    ps = __uint_as_float(rr[0]) + __uint_as_float(rr[1]); }
  l_reg = l_reg * alpha + ps;
#define PK4(P, BASE, OUT) do { unsigned a0 = cvtpk(P[BASE + 0], P[BASE + 1]), a1 = cvtpk(P[BASE + 2], P[BASE + 3]);   \
    unsigned b0 = cvtpk(P[BASE + 4], P[BASE + 5]), b1 = cvtpk(P[BASE + 6], P[BASE + 7]);                              \
    auto r0 = __builtin_amdgcn_permlane32_swap(a0, b0, false, false); auto r1 = __builtin_amdgcn_permlane32_swap(a1, b1, false, false); \
    u32x4 w = {r0[0], r1[0], r0[1], r1[1]}; OUT = *reinterpret_cast<bf16x8*>(&w); } while (0)
  PK4(p0, 0, pa0); PK4(p0, 8, pa1); PK4(p1, 0, pa2); PK4(p1, 8, pa3);
#undef PK4
}
__device__ __forceinline__ void qkt(f32x16& p0, f32x16& p1, const bf16* Ks, const bf16x8* qr, int r32, int hi) {
  p0 = f32x16{}; p1 = f32x16{};
  for (int d0 = 0; d0 < 8; ++d0) { int cb = (d0 * 16 + hi * 8) * 2;
    bf16x8 b0 = *reinterpret_cast<const bf16x8*>((const char*)Ks + KSWZ(r32, cb));
    bf16x8 b1 = *reinterpret_cast<const bf16x8*>((const char*)Ks + KSWZ(32 + r32, cb));
    p0 = __builtin_amdgcn_mfma_f32_32x32x16_bf16(b0, qr[d0], p0, 0, 0, 0);
    p1 = __builtin_amdgcn_mfma_f32_32x32x16_bf16(b1, qr[d0], p1, 0, 0, 0); }
}
__device__ __forceinline__ int v_st(int k, int c) { const int kk = (k & ~0xC) | ((k & 4) << 1) | ((k & 8) >> 1); return ((kk >> 3) * 4 + (c >> 5)) * 512 + ((kk & 7) * 32 + (c & 31)) * 2; }
__device__ __forceinline__ int v_rd_base(int lane) { return ((lane & 3) << 3) | (((lane >> 2) & 3) << 6) | (((lane >> 4) & 1) << 5) | (((lane >> 5) & 1) << 8); }
constexpr int v_rd_off(int d0, int ks, int half) { return d0 * 512 + ks * 4096 + half * 2048; }
template <int OFF> __device__ __forceinline__ s16x4 tr_read(int vb) {
  s16x4 r; asm volatile("ds_read_b64_tr_b16 %0, %1 offset:%2" : "=&v"(r) : "v"(vb), "i"(OFF) : "memory"); return r;
}
template <int D0> __device__ __forceinline__ void pv_one(f32x16& od, int vb, bf16x8 pa0, bf16x8 pa1, bf16x8 pa2, bf16x8 pa3) {
  const s16x4 l0 = tr_read<v_rd_off(D0, 0, 0)>(vb), h0 = tr_read<v_rd_off(D0, 0, 1)>(vb), l1 = tr_read<v_rd_off(D0, 1, 0)>(vb), h1 = tr_read<v_rd_off(D0, 1, 1)>(vb);
  const s16x4 l2 = tr_read<v_rd_off(D0, 2, 0)>(vb), h2 = tr_read<v_rd_off(D0, 2, 1)>(vb), l3 = tr_read<v_rd_off(D0, 3, 0)>(vb), h3 = tr_read<v_rd_off(D0, 3, 1)>(vb);
  asm volatile("s_waitcnt lgkmcnt(0)" ::: "memory"); SBAR();
#define PK(L, H) (bf16x8){L[0], L[1], L[2], L[3], H[0], H[1], H[2], H[3]}
  od = __builtin_amdgcn_mfma_f32_32x32x16_bf16(pa0, PK(l0, h0), od, 0, 0, 0);
  od = __builtin_amdgcn_mfma_f32_32x32x16_bf16(pa1, PK(l1, h1), od, 0, 0, 0);
  od = __builtin_amdgcn_mfma_f32_32x32x16_bf16(pa2, PK(l2, h2), od, 0, 0, 0);
  od = __builtin_amdgcn_mfma_f32_32x32x16_bf16(pa3, PK(l3, h3), od, 0, 0, 0);
#undef PK
}
__device__ __forceinline__ void pv_d0(f32x16* o, int vb, bf16x8 pa0, bf16x8 pa1, bf16x8 pa2, bf16x8 pa3) {
  pv_one<0>(o[0], vb, pa0, pa1, pa2, pa3); pv_one<1>(o[1], vb, pa0, pa1, pa2, pa3); pv_one<2>(o[2], vb, pa0, pa1, pa2, pa3); pv_one<3>(o[3], vb, pa0, pa1, pa2, pa3);
}

template <typename TQ>
__device__ __forceinline__ void attn_dense_body(const TQ* __restrict__ Qb, const bf16* __restrict__ Kh, const bf16* __restrict__ Vh,
                                                bf16* __restrict__ Ob, int seq, char* lds) {
  using St = Stage<bf16>; using SQ = Stage<TQ>;
  const int tid = threadIdx.x, wid = __builtin_amdgcn_readfirstlane(tid >> 6), lane = tid & 63, r32 = lane & 31, hi = lane >> 5;
  bf16* V_lds = (bf16*)lds; bf16* K_lds = (bf16*)(lds + 2 * SHM_V);
  float* ws = (float*)(lds + 2 * SHM_V + 2 * SHM_K) + wid * 64; float* li_l = ws; float* al_l = ws + 32;
  float m_reg = -1e30f, l_reg = 0; f32x16 o[4] = {}; bf16x8 qr[8];
  const TQ* Qw = Qb + (long)(wid * QBLK + r32) * LDQ + hi * 8;
#pragma unroll
  for (int d0 = 0; d0 < 8; ++d0) qr[d0] = SQ::tobf(SQ::ld8(Qw + d0 * 16));
  const int sr = tid >> 4, sc = (tid & 15) * 8, vst0 = v_st(sr, sc), vst1 = v_st(32 + sr, sc);
  const int vb0 = (int)(uintptr_t)V_lds + v_rd_base(lane);
  struct { typename St::T vs0, vs1, ks0, ks1; } sr_[SDEPTH];
#define SLOAD(i, k0) do { sr_[i].vs0 = St::ld8(&Vh[(long)((k0) + sr) * LDK + sc]); sr_[i].vs1 = St::ld8(&Vh[(long)((k0) + 32 + sr) * LDK + sc]); \
    sr_[i].ks0 = St::ld8(&Kh[(long)((k0) + sr) * LDK + sc]); sr_[i].ks1 = St::ld8(&Kh[(long)((k0) + 32 + sr) * LDK + sc]); } while (0)
#define SWRITE(b, i) do { *(bf16x8*)((char*)V_lds + (b) * SHM_V + vst0) = St::tobf(sr_[i].vs0);          \
    *(bf16x8*)((char*)V_lds + (b) * SHM_V + vst1) = St::tobf(sr_[i].vs1); int kc = sc * 2;               \
    *(bf16x8*)((char*)K_lds + (b) * SHM_K + KSWZ(sr, kc)) = St::tobf(sr_[i].ks0);                       \
    *(bf16x8*)((char*)K_lds + (b) * SHM_K + KSWZ(32 + sr, kc)) = St::tobf(sr_[i].ks1); } while (0)
#define SWAIT() do { if constexpr (SDEPTH == 2) asm volatile("s_waitcnt vmcnt(4)" ::: "memory"); else asm volatile("s_waitcnt vmcnt(0)" ::: "memory"); } while (0)
#define RESC(a) do { if (__any((a) < 1.f)) { if (hi == 0) al_l[r32] = (a); asm volatile("s_waitcnt lgkmcnt(0)" ::: "memory"); \
    for (int d = 0; d < 4; ++d) for (int r = 0; r < 16; ++r) o[d][r] *= al_l[crow(r, hi)]; } } while (0)
  f32x16 pA0, pA1, pB0, pB1; float mnA, mnB, alA, alB; bf16x8 pa0, pa1, pa2, pa3; const int NT = seq / KVBLK;
  constexpr int SE = 0, SO = SDEPTH - 1;
  SLOAD(SE, 0); asm volatile("s_waitcnt vmcnt(0)" ::: "memory"); SWRITE(0, SE); __syncthreads();
  qkt(pA0, pA1, K_lds, qr, r32, hi); partialSM(pA0, pA1, m_reg, mnA, alA);
  SLOAD(SO, KVBLK); if constexpr (SDEPTH == 2) { if (2 < NT) SLOAD(SE, 2 * KVBLK); }
  SWAIT(); SWRITE(1, SO); __syncthreads();
  for (int j = 1; j + 1 < NT; j += 2) {
    SBAR(); qkt(pB0, pB1, (bf16*)((char*)K_lds + SHM_K), qr, r32, hi);
    finishSM(pA0, pA1, alA, l_reg, pa0, pa1, pa2, pa3); SBAR();
    SLOAD(SO, (j + SDEPTH) * KVBLK); SBAR();
    pv_d0(o, vb0, pa0, pa1, pa2, pa3); partialSM(pB0, pB1, m_reg, mnB, alB);
    __syncthreads(); SWAIT(); SWRITE(0, SE);
    RESC(alB); __syncthreads();
    SBAR(); qkt(pA0, pA1, K_lds, qr, r32, hi);
    finishSM(pB0, pB1, alB, l_reg, pa0, pa1, pa2, pa3); SBAR();
    if (SDEPTH == 1 || j + 3 < NT) SLOAD(SE, (j + 1 + SDEPTH) * KVBLK); SBAR();
    pv_d0(o, vb0 + (int)SHM_V, pa0, pa1, pa2, pa3); partialSM(pA0, pA1, m_reg, mnA, alA);
    __syncthreads(); SWAIT(); SWRITE(1, SO);
    RESC(alA); __syncthreads();
  }
  SBAR(); qkt(pB0, pB1, (bf16*)((char*)K_lds + SHM_K), qr, r32, hi);
  finishSM(pA0, pA1, alA, l_reg, pa0, pa1, pa2, pa3); SBAR();
  pv_d0(o, vb0, pa0, pa1, pa2, pa3); partialSM(pB0, pB1, m_reg, mnB, alB);
  __syncthreads(); RESC(alB);
  finishSM(pB0, pB1, alB, l_reg, pa0, pa1, pa2, pa3); SBAR();
  pv_d0(o, vb0 + (int)SHM_V, pa0, pa1, pa2, pa3);
  if (hi == 0) li_l[r32] = l_reg; asm volatile("s_waitcnt lgkmcnt(0)" ::: "memory");
  float rli[16];
#pragma unroll
  for (int r = 0; r < 16; ++r) rli[r] = __builtin_amdgcn_rcpf(li_l[crow(r, hi)]);
  bf16* Ow = Ob + (long)(wid * QBLK) * LDO;
#pragma unroll
  for (int r = 0; r < 16; ++r) { int orow = crow(r, hi);
    for (int d0 = 0; d0 < 4; ++d0) Ow[(long)orow * LDO + d0 * 32 + r32] = (bf16)(cvtpk(o[d0][r] * rli[r], 0.f) & 0xffffu); }
#undef SLOAD
#undef SWRITE
#undef SWAIT
#undef RESC
}

#undef KSWZ
#undef SBAR
}

constexpr int LDS_BYTES = 135168;
struct Args { const float* in[19]; float* out; unsigned char* ws; };
#define LAS3 __attribute__((address_space(3)))

#define RLX_AGENT __ATOMIC_RELAXED, __HIP_MEMORY_SCOPE_AGENT
#define XB_TMO      128
#define XB_XCNT(j)  (256  + 64 * (j))
#define XB_XSUB(j)  (1280 + 64 * (j))
#define XB_XGEN(j)  (2304 + 64 * (j))
#define XB_TOP      3328
#define XB_TOPGEN   3392
#define XCD_BAR_WORDS 3456
#define XB_SPIN_CAP (1u << 18)

__device__ __forceinline__ unsigned xb_ld(unsigned* p)              { return __hip_atomic_load(p, __ATOMIC_RELAXED, __HIP_MEMORY_SCOPE_AGENT); }
__device__ __forceinline__ unsigned xb_add(unsigned* p, unsigned v) { return __hip_atomic_fetch_add(p, v, __ATOMIC_RELAXED, __HIP_MEMORY_SCOPE_AGENT); }
__device__ __forceinline__ unsigned xb_xcc_id() { return (unsigned)__builtin_amdgcn_s_getreg((3 << 11) | 20) & 0xFu; }
#define XB_SPIN(cond, bar) do { unsigned _sp = 0; while (cond) { __builtin_amdgcn_s_sleep(1); \
    if ((++_sp & 255u) == 0u) { if (xb_ld(&(bar)[XB_TMO])) break; if (_sp > XB_SPIN_CAP) { atomicAdd(&(bar)[XB_TMO], 1u); break; } } } } while (0)

struct XcdBarrier {
    unsigned* bar; unsigned x;
    volatile LAS3 unsigned* st;
};

__device__ __forceinline__ XcdBarrier xcd_barrier_post(unsigned* bar, volatile LAS3 unsigned* st) {
    XcdBarrier b; b.bar = bar; b.x = xb_xcc_id(); b.st = st;
    if (threadIdx.x == 0) (void)xb_add(&bar[XB_XCNT(b.x)], 1u);
    return b;
}
__device__ __forceinline__ void xcd_barrier_complete(unsigned* bar, unsigned x, unsigned& nloc, unsigned& nx) {
    const unsigned G = gridDim.x * gridDim.y * gridDim.z;
    unsigned sum, cnt, mine, sp = 0u;
    for (;;) {
        sum = 0u; cnt = 0u; mine = 0u;
#pragma unroll
        for (unsigned j = 0; j < 16; ++j) { const unsigned c = xb_ld(&bar[XB_XCNT(j)]); sum += c; cnt += (c > 0u) ? 1u : 0u; mine = (j == x) ? c : mine; }
        if (sum == G) break;
        __builtin_amdgcn_s_sleep(1);
        if ((++sp & 255u) == 0u) { if (xb_ld(&bar[XB_TMO])) break; if (sp > XB_SPIN_CAP) { atomicAdd(&bar[XB_TMO], 1u); break; } }
    }
    nloc = mine > 0u ? mine : 1u; nx = cnt > 0u ? cnt : 1u;
}

__device__ __forceinline__ void xcd_barrier(const XcdBarrier& b) {
    asm volatile("s_waitcnt vmcnt(0)" ::: "memory");
    __syncthreads();
    if (threadIdx.x == 0) {
        unsigned* bar = b.bar;
        __builtin_amdgcn_s_waitcnt(0);
        unsigned nloc = b.st[0], nx = b.st[1];
        if (nloc == 0u) { xcd_barrier_complete(bar, b.x, nloc, nx); b.st[0] = nloc; b.st[1] = nx; }
        const unsigned old = xb_add(&bar[XB_XSUB(b.x)], 1u);
        const unsigned gen = old / nloc;
        if (old + 1u == (gen + 1u) * nloc) {
            __builtin_amdgcn_fence(__ATOMIC_RELEASE, "agent");
            asm volatile("s_waitcnt vmcnt(0)" ::: "memory");
            const unsigned og = xb_add(&bar[XB_TOP], 1u);
            const unsigned tg = og / nx;
            if (og + 1u == (tg + 1u) * nx) xb_add(&bar[XB_TOPGEN], 1u);
            else XB_SPIN(xb_ld(&bar[XB_TOPGEN]) == tg, bar);
            __builtin_amdgcn_fence(__ATOMIC_ACQUIRE, "agent");
            xb_add(&bar[XB_XGEN(b.x)], 1u);
            asm volatile("s_waitcnt vmcnt(0)" ::: "memory");
        } else {
            XB_SPIN(xb_ld(&bar[XB_XGEN(b.x)]) == gen, bar);
            __builtin_amdgcn_fence(__ATOMIC_ACQUIRE, "agent");
            asm volatile("s_waitcnt vmcnt(0)" ::: "memory");
        }
    }
    __syncthreads();
}

constexpr int MISC_OFF = 131072;
constexpr int CW_BAR = 4096;
typedef const __attribute__((address_space(4))) Args* CArgsP;
#ifndef PHM
#define PHM 0xFFFFFFu
#endif
#ifndef PROBE_GLU
#define PROBE_GLU 0
#endif
#ifndef PROBE_MASK
#define PROBE_MASK 0u
#endif
#define REP(b) for (int rep__ = 0; rep__ < 1 + (int)((PROBE_MASK >> (b)) & 1u); ++rep__)
#ifndef PROBE_ATTN
#define PROBE_ATTN 0
#endif
#define PH(b) ((PHM >> (b)) & 1u)
#define PHASE_VARS \
    CArgsP ap = (CArgsP)__builtin_amdgcn_kernarg_segment_ptr(); asm volatile("" : "+s"(ap)); \
    int tid = threadIdx.x; asm volatile("" : "+v"(tid)); \
    const int lane = tid & 63, wave = __builtin_amdgcn_readfirstlane(tid >> 6); \
    const int G = gridDim.x, bx = blockIdx.x, gw = bx * 8 + wave, NGW = G * 8, gt = bx * 512 + tid, NGT = G * 512; \
    unsigned char* ws = ap->ws; float* out = ap->out; bf16_t* H = (bf16_t*)(ws + WS_H); \
    (void)lane; (void)gw; (void)NGW; (void)gt; (void)NGT; (void)out; (void)H; (void)bx; (void)G;
#define GRID_SYNC_CG() cg::this_grid().sync()
#define GRID_SYNC() do { CArgsP ap_ = (CArgsP)__builtin_amdgcn_kernarg_segment_ptr(); asm volatile("" : "+s"(ap_)); \
    XcdBarrier b_; b_.bar = (unsigned*)(ap_->ws + WS_CTL) + CW_BAR; b_.x = xb_xcc_id(); b_.st = (volatile LAS3 unsigned*)(lds3 + MISC_OFF); xcd_barrier(b_); } while (0)

#define SSQP(k) ((float*)(ws + WS_SSQ) + (size_t)(k) * TT)
template <int LAYER> DEVI void ffn_block(LAS3 unsigned char* lds3) {
    { PHASE_VARS
      for (int rep_ = 0; rep_ < (PROBE_GLU ? 2 : 1); ++rep_) if (PH(18)) { pg8::Gemm g{(const bf16_t*)(ws + WS_XBA), (const bf16_t*)(ws + (LAYER ? WS_W_GU1 : WS_W_GU0)), TT, 2 * FFH, 1024}; pg8::StaticOrder S; S.init(TT, 2 * FFH, G, bx);
        Epi<EM_GLU> E{(bf16_t*)(ws + WS_ACT), nullptr, nullptr, nullptr, nullptr, nullptr, nullptr, nullptr, SSQP(LAYER ? 3 : 1), nullptr, nullptr, nullptr};
        pg8::gemm_phase<Epi<EM_GLU>, pg8::StaticOrder, true, true>(lds3, g, S, E); } }
    GRID_SYNC();
    { PHASE_VARS
      if (PH(19)) { pg8::Gemm g{(const bf16_t*)(ws + WS_ACT), (const bf16_t*)(ws + (LAYER ? WS_W_D1 : WS_W_D0)), TT, 1024, FFH}; pg8::StaticOrder S; S.init(TT, 1024, G, bx);
        if constexpr (LAYER == 0) {
            Epi<EM_RES, true> E{nullptr, nullptr, nullptr, out, nullptr, nullptr, nullptr, nullptr, nullptr, SSQP(2), (bf16_t*)(ws + WS_XBB), ap->in[10]};
            pg8::gemm_phase<Epi<EM_RES, true>, pg8::StaticOrder, true, true>(lds3, g, S, E);
        } else {
            Epi<EM_RES> E{nullptr, nullptr, nullptr, out, nullptr, nullptr, nullptr, nullptr, nullptr, nullptr, nullptr, nullptr};
            pg8::gemm_phase<Epi<EM_RES>, pg8::StaticOrder, true, true>(lds3, g, S, E); } } }
}

__global__ void __launch_bounds__(512, 2) mega_fwd(Args a_unused) {
    extern __shared__ __attribute__((aligned(16))) unsigned char lds[];
    LAS3 unsigned char* lds3 = (LAS3 unsigned char*)lds;
    { if (threadIdx.x < 32) ((LAS3 unsigned*)(lds3 + MISC_OFF))[threadIdx.x] = 0u;
      __syncthreads();
      CArgsP ap0 = (CArgsP)__builtin_amdgcn_kernarg_segment_ptr();
      (void)xcd_barrier_post((unsigned*)(ap0->ws + WS_CTL) + CW_BAR, (volatile LAS3 unsigned*)(lds3 + MISC_OFF)); }
    { PHASE_VARS
      REP(0) if (PH(0)) p_fold(ap->in[3], ap->in[4], ap->in[6], (bf16_t*)(ws + WS_W_FT), (bf16_t*)(ws + WS_W_AB1) + (size_t)1536 * 1024, (float*)lds, gw, NGW, lane);
      REP(0) if (PH(1)) { p_dft((bf16_t*)(ws + WS_C4), (bf16_t*)(ws + WS_S4), 4096, 12, gt, NGT); p_dft((bf16_t*)(ws + WS_C2), (bf16_t*)(ws + WS_S2), 2048, 11, gt, NGT); }
      if (gt < 2048) { const int idx = gt >> 5, i = gt & 31; const float inv = powf(10000.f, -(float)(2 * i) * (1.f / 64.f)); const float ang = (float)idx * inv;
          ((float2*)(ws + WS_ROPE))[gt] = make_float2((float)cos((double)ang), (float)sin((double)ang)); }
      for (int i = gt; i < 3 * TT; i += NGT) SSQP(1)[i] = 0.f;
      REP(0) if (PH(2)) p_norm(ap->in[0], ap->in[1], ap->in[2], (bf16_t*)(ws + WS_XBB), SSQP(0), gw, NGW, lane); }
    __syncthreads();
    { PHASE_VARS
      REP(3) if (PH(3)) { float* scr = (float*)(lds + wave * 16384);
      const float* win = ap->in[3];
      for (int it = gw; it < 11008; it += NGW) { int r = it;
          if (tr_mat<0>(r, win, 2080, 0, 1024, 256, (bf16_t*)(ws + WS_W_AB1), 0, 0.125f, scr, lane)) continue;
          if (tr_mat<0>(r, win, 2080, 256, 1024, 1280, (bf16_t*)(ws + WS_W_AB1), 256, 1.f, scr, lane)) continue;
          if (tr_mat<0>(r, ap->in[9], 1024, 0, 1024, 1024, (bf16_t*)(ws + WS_W_ABO), 0, 1.f, scr, lane)) continue;
          if (tr_mat<1>(r, ap->in[16], FFH, 0, 1024, FFH, (bf16_t*)(ws + WS_W_GU0), 0, 1.f, scr, lane)) continue;
          if (tr_mat<2>(r, ap->in[17], FFH, 0, 1024, FFH, (bf16_t*)(ws + WS_W_GU0), 0, 1.f, scr, lane)) continue;
          if (tr_mat<0>(r, ap->in[18], 1024, 0, FFH, 1024, (bf16_t*)(ws + WS_W_D0), 0, 1.f, scr, lane)) continue;
          if (tr_mat<0>(r, ap->in[11], 1536, 0, 1024, 1536, (bf16_t*)(ws + WS_W_QKV), 0, 1.f, scr, lane)) continue;
          if (tr_mat<0>(r, ap->in[14], 1024, 0, 1024, 1024, (bf16_t*)(ws + WS_W_CO), 0, 1.f, scr, lane)) continue;
          if (tr_mat<1>(r, ap->in[16] + (size_t)1024 * FFH, FFH, 0, 1024, FFH, (bf16_t*)(ws + WS_W_GU1), 0, 1.f, scr, lane)) continue;
          if (tr_mat<2>(r, ap->in[17] + (size_t)1024 * FFH, FFH, 0, 1024, FFH, (bf16_t*)(ws + WS_W_GU1), 0, 1.f, scr, lane)) continue;
          if (tr_mat<0>(r, ap->in[18] + (size_t)1024 * FFH, 1024, 0, FFH, 1024, (bf16_t*)(ws + WS_W_D1), 0, 1.f, scr, lane)) continue;
      } } }
    GRID_SYNC_CG();
    { PHASE_VARS
      REP(4) if (PH(4)) { pg8::Gemm g{(const bf16_t*)(ws + WS_XBB), (const bf16_t*)(ws + WS_W_AB1), TT, 2048, 1024}; RotOrder S; S.S.init(TT, 2048, G, bx);
        Epi<EM_AB1> E{(bf16_t*)(ws + WS_QKVR), nullptr, nullptr, (float*)(ws + WS_G), nullptr, nullptr, ap->in[5], ap->in[7], SSQP(0), nullptr, nullptr, nullptr};
        pg8::gemm_phase<Epi<EM_AB1>, RotOrder, true, true>(lds3, g, S, E); } }
    { PHASE_VARS
      REP(5) if (PH(5)) { pg8::Gemm g{(const bf16_t*)(ws + WS_W_FT), (const bf16_t*)(ws + WS_XBB), 1024, TT, 1024}; pg8::StaticOrder S; S.init(1024, TT, G, bx);
        Epi<EM_AB1T> E{(bf16_t*)((unsigned char*)out + OUT_YTPC), (bf16_t*)((unsigned char*)out + OUT_YTSC), nullptr, nullptr, nullptr, nullptr, nullptr, nullptr, SSQP(0), nullptr, nullptr, nullptr};
        pg8::gemm_phase<Epi<EM_AB1T>, pg8::StaticOrder, true, true>(lds3, g, S, E); } }
    GRID_SYNC();
    { PHASE_VARS
      REP(6) if (PH(6)) { pg8::Gemm g{(const bf16_t*)(ws + WS_C4), (const bf16_t*)((unsigned char*)out + OUT_YTPC), 2048, 4096, 4096}; pg8::StaticOrder S; S.init(2048, 4096, G, bx);
        Epi<EM_FNETP> E{(bf16_t*)(ws + WS_PCP), nullptr, nullptr, nullptr, nullptr, nullptr, nullptr, nullptr, nullptr, nullptr, nullptr, nullptr};
        pg8::gemm_phase<Epi<EM_FNETP>, pg8::StaticOrder, true, true>(lds3, g, S, E); } }
    { PHASE_VARS
      REP(6) if (PH(6)) { pg8::Gemm g{(const bf16_t*)(ws + WS_S4), (const bf16_t*)((unsigned char*)out + OUT_YTPS), 2048, 4096, 4096}; pg8::StaticOrder S; S.init(2048, 4096, G, (bx + G / 2) % G);
        Epi<EM_FNETP> E{(bf16_t*)(ws + WS_PSP), nullptr, nullptr, nullptr, nullptr, nullptr, nullptr, nullptr, nullptr, nullptr, nullptr, nullptr};
        pg8::gemm_phase<Epi<EM_FNETP>, pg8::StaticOrder, true, true>(lds3, g, S, E); } }
    { PHASE_VARS
      REP(6) if (PH(7)) { pg8::Gemm g{(const bf16_t*)(ws + WS_C2), (const bf16_t*)((unsigned char*)out + OUT_YTSC), 1024, 4096, 2048}; pg8::StaticOrder S; S.init(1024, 4096, G, (bx + G / 2) % G);
        Epi<EM_FNETS> E{(bf16_t*)(ws + WS_PCS), nullptr, nullptr, nullptr, nullptr, nullptr, nullptr, nullptr, nullptr, nullptr, nullptr, nullptr};
        pg8::gemm_phase<Epi<EM_FNETS>, pg8::StaticOrder, true, true>(lds3, g, S, E); } }
    { PHASE_VARS
      REP(6) if (PH(7)) { pg8::Gemm g{(const bf16_t*)(ws + WS_S2), (const bf16_t*)((unsigned char*)out + OUT_YTSS), 1024, 4096, 2048}; pg8::StaticOrder S; S.init(1024, 4096, G, (bx + G / 4) % G);
        Epi<EM_FNETS> E{(bf16_t*)(ws + WS_PSS), nullptr, nullptr, nullptr, nullptr, nullptr, nullptr, nullptr, nullptr, nullptr, nullptr, nullptr};
        pg8::gemm_phase<Epi<EM_FNETS>, pg8::StaticOrder, true, true>(lds3, g, S, E); } }
    { PHASE_VARS
      REP(8) if (PH(8)) { const int half = G / 2;
        const bf16_t* QKVR = (const bf16_t*)(ws + WS_QKVR); const float* Gb = (const float*)(ws + WS_G); bf16_t* DST = (bf16_t*)((unsigned char*)out + OUT_DST); float* DEC = (float*)(ws + WS_DEC);
        const int first = bx < half ? bx : 2048 + bx - half, last = bx < half ? 2048 : 3072;
        GlaLd A; gla_load<false>(A, first, QKVR, Gb, DST, tid);
        for (int item = first; item < last; item += half) { GlaLd B; const int nx = item + half < last ? item + half : item;
            gla_load<false>(B, nx, QKVR, Gb, DST, tid);
            gla_a_item(A, item, DST, DEC, lds, tid, wave, lane); A = B; } } }
    GRID_SYNC();
    { PHASE_VARS
      if (PH(9)) for (int g2 = gt; g2 < 131072; g2 += NGT) p_scan((bf16_t*)((unsigned char*)out + OUT_DST), (const float*)(ws + WS_DEC), g2);
      p_fcombine((const bf16_t*)(ws + WS_PCP), (const bf16_t*)(ws + WS_PSP), H, 0, 4096, 11, gt, NGT);
      p_fcombine((const bf16_t*)(ws + WS_PCS), (const bf16_t*)(ws + WS_PSS), H, TP, 2048, 10, gt, NGT);
      p_fmid((const bf16_t*)((unsigned char*)out + OUT_YTPC), H, 0, 4096, gw, NGW, lane);
      p_fmid((const bf16_t*)((unsigned char*)out + OUT_YTSC), H, TP, 2048, gw, NGW, lane); }
    GRID_SYNC();
    { PHASE_VARS
      REP(10) if (PH(10)) { const bf16_t* QKVR = (const bf16_t*)(ws + WS_QKVR); const float* Gb = (const float*)(ws + WS_G); const bf16_t* DST = (const bf16_t*)((unsigned char*)out + OUT_DST);
        GlaLd A; gla_load<true>(A, bx, QKVR, Gb, DST, tid);
        for (int item = bx; item < 3072; item += G) { GlaLd B; const int nx = item + G < 3072 ? item + G : item;
            gla_load<true>(B, nx, QKVR, Gb, DST, tid);
            gla_c_item(A, item, QKVR, DST, ap->in[8], H, lds, tid, wave, lane); A = B; } } }
    GRID_SYNC();
    { PHASE_VARS
      if (PH(11)) { pg8::Gemm g{H, (const bf16_t*)(ws + WS_W_ABO), TT, 1024, 1024}; pg8::StaticOrder S; S.init(TT, 1024, G, bx);
        Epi<EM_RESIN, true> E{nullptr, nullptr, nullptr, out, ap->in[0], ap->in[1], nullptr, nullptr, nullptr, SSQP(1), (bf16_t*)(ws + WS_XBA), ap->in[15]};
        pg8::gemm_phase<Epi<EM_RESIN, true>, pg8::StaticOrder, true, true>(lds3, g, S, E); } }
    GRID_SYNC();
    ffn_block<0>(lds3);
    GRID_SYNC();
    { PHASE_VARS
      if (PH(13)) { pg8::Gemm g{(const bf16_t*)(ws + WS_XBB), (const bf16_t*)(ws + WS_W_QKV), TT, 1536, 1024}; pg8::StaticOrder S; S.init(TT, 1536, G, bx);
        Epi<EM_QKV> E{(bf16_t*)(ws + WS_Q), (bf16_t*)(ws + WS_K), (bf16_t*)(ws + WS_V), nullptr, nullptr, nullptr, nullptr, nullptr, SSQP(2), nullptr, nullptr, nullptr};
        pg8::gemm_phase<Epi<EM_QKV>, pg8::StaticOrder, true, true>(lds3, g, S, E); } }
    GRID_SYNC();
    { PHASE_VARS
      if (PH(14)) p_qkrope((bf16_t*)(ws + WS_Q), (bf16_t*)(ws + WS_K), ap->in[12], ap->in[13], (const float2*)(ws + WS_ROPE), gw, NGW, lane); }
    GRID_SYNC();
    { PHASE_VARS
      if (PH(15)) { const int vx = bx & 7, vi = bx >> 3;
        bf16_t* Qb = (bf16_t*)(ws + WS_Q); bf16_t* Kb = (bf16_t*)(ws + WS_K); bf16_t* Vb = (bf16_t*)(ws + WS_V); bf16_t* AO = (bf16_t*)(ws + WS_AO);
        for (int i6 = 0; i6 < (PROBE_ATTN ? 12 : 6); ++i6) { const int i = i6 % 6;
            int b, kvh, hq, qb, row0, seq;
            if (i < 4) { const int combo = vx * 2 + (i >> 1), u = (i & 1) * 32 + vi; b = combo >> 1; kvh = combo & 1; hq = kvh * 4 + (u >> 4); qb = u & 15; row0 = b * 4096; seq = 4096; }
            else { const int combo = vx * 2 + (i - 4), u = vi; b = combo >> 1; kvh = combo & 1; hq = kvh * 4 + (u >> 3); qb = u & 7; row0 = TP + b * 2048; seq = 2048; }
            attn::attn_dense_body<attn::bf16>(Qb + (size_t)(row0 + qb * 256) * 1024 + hq * 128, Kb + (size_t)row0 * 256 + kvh * 128, Vb + (size_t)row0 * 256 + kvh * 128,
                                              AO + (size_t)(row0 + qb * 256) * 1024 + hq * 128, seq, (char*)lds);
            __syncthreads();
        } } }
    GRID_SYNC();
    { PHASE_VARS
      if (PH(16)) { pg8::Gemm g{(const bf16_t*)(ws + WS_AO), (const bf16_t*)(ws + WS_W_CO), TT, 1024, 1024}; pg8::StaticOrder S; S.init(TT, 1024, G, bx);
        Epi<EM_RES, true> E{nullptr, nullptr, nullptr, out, nullptr, nullptr, nullptr, nullptr, nullptr, SSQP(3), (bf16_t*)(ws + WS_XBA), ap->in[15] + 1024};
        pg8::gemm_phase<Epi<EM_RES, true>, pg8::StaticOrder, true, true>(lds3, g, S, E); } }
    GRID_SYNC();
    ffn_block<1>(lds3);
}

extern "C" void kernel_launch(void* const* d_in, const int* in_sizes, int n_in, void* d_out, int out_size, void* d_ws, size_t ws_size, hipStream_t stream) {
    static int grid = 0;
    if (grid == 0) {
        int dev = 0, cus = 0, per_cu = 0;
        if (n_in != 19 || out_size != TT * DM || ws_size < WS_END) { fprintf(stderr, "kernel_launch: unexpected shapes: n_in %d out %d ws %zu (need %zu)\n", n_in, out_size, ws_size, (size_t)WS_END); grid = -1; return; }
        if (hipGetDevice(&dev) != hipSuccess || hipDeviceGetAttribute(&cus, hipDeviceAttributeMultiprocessorCount, dev) != hipSuccess) { fprintf(stderr, "kernel_launch: device query failed\n"); grid = -1; return; }
        if (hipFuncSetAttribute((const void*)mega_fwd, hipFuncAttributeMaxDynamicSharedMemorySize, LDS_BYTES) != hipSuccess) { fprintf(stderr, "kernel_launch: hipFuncSetAttribute failed\n"); grid = -1; return; }
        if (hipOccupancyMaxActiveBlocksPerMultiprocessor(&per_cu, (const void*)mega_fwd, 512, LDS_BYTES) != hipSuccess || per_cu < 1) fprintf(stderr, "kernel_launch: occupancy query reports %d blocks per CU\n", per_cu);
        (void)hipGetLastError();
        if (cus != 256) { fprintf(stderr, "kernel_launch: built for a 256-CU device, found %d\n", cus); grid = -1; return; }
        grid = 256;
    }
    if (grid < 0) return;
    if (hipMemsetAsync((char*)d_ws + WS_CTL, 0, CTL_BYTES, stream) != hipSuccess) { fprintf(stderr, "kernel_launch: memset failed\n"); return; }
    Args a{};
    for (int i = 0; i < 19; ++i) a.in[i] = (const float*)d_in[i];
    a.out = (float*)d_out; a.ws = (unsigned char*)d_ws;
    void* args[] = {&a};
    const hipError_t e = hipLaunchCooperativeKernel((const void*)mega_fwd, dim3(grid), dim3(512), args, LDS_BYTES, stream);
    if (e != hipSuccess) fprintf(stderr, "kernel_launch: cooperative launch failed: %s\n", hipGetErrorString(e));
}
```

```cpp
#include <hip/hip_runtime.h>
#include <hip/hip_cooperative_groups.h>
#include <cstdio>
#include <cstdint>
namespace cg = cooperative_groups;
#define DEVI __device__ __forceinline__
namespace pg8 {
#define PG8_LAS __attribute__((address_space(3)))
typedef unsigned short bf16_t;
typedef short bf16x8 __attribute__((ext_vector_type(8)));
typedef float f32x4 __attribute__((ext_vector_type(4)));
typedef unsigned u32x4 __attribute__((ext_vector_type(4)));
constexpr int BM = 256, BK = 64, HALF = 128, HTB = HALF * BK * 2  , STAGE_BYTES = 8 * HTB, NXCD = 8, WGM = 8;

__host__ __device__ __forceinline__ int lds_byte(int r, int c) { const int st = (r >> 4) * 2 + (c >> 5), rr = r & 15, cc = c & 31, ob = rr * 64 + cc * 2; return st * 1024 + (ob ^ (((ob >> 9) & 1) << 5)); }
__host__ __device__ __forceinline__ void stage_rc(int b, int& R, int& C) { const int st = b / 1024, sb = b % 1024, swz = sb ^ (((sb >> 9) & 1) << 5); R = (st >> 1) * 16 + swz / 64; C = (st & 1) * 32 + (swz % 64) / 2; }
__host__ __device__ __forceinline__ int perm32(int rho) { const int n = rho >> 4, i = rho & 15; return 8 * (i >> 2) + 4 * n + (i & 3); }

struct Unit { int pm, pn; };
struct Gemm { const bf16_t* A; const bf16_t* Bt; int M, N, K; };

struct StaticOrder {
    int nM, nN, nwg, G, c;
    __host__ __device__ void init(int M, int N, int G_, int c_) { nM = M / BM; nN = N / BM; nwg = nM * nN; G = G_; c = c_; }
    __host__ __device__ bool next(int i, Unit& u) const {
        const long L = (long)i * G + c; if (L >= nwg) return false;
        int wgid = (int)L; { const int q = nwg / NXCD, r = nwg % NXCD, xcd = wgid % NXCD, off = wgid / NXCD; wgid = (xcd < r ? xcd * (q + 1) : r * (q + 1) + (xcd - r) * q) + off; }
        const int nig = WGM * nN, gid = wgid / nig, fm = gid * WGM, gsz = (nM - fm) < WGM ? (nM - fm) : WGM;
        u.pm = fm + ((wgid % nig) % gsz); u.pn = (wgid % nig) / gsz; return true;
    }
    __device__ __forceinline__ void a_ready(const Unit&) const {}
    __device__ __forceinline__ void done(const Unit&) const {}
};

__device__ __forceinline__ unsigned cvt_pk_bf16(float lo, float hi) { unsigned r; asm volatile("v_cvt_pk_bf16_f32 %0, %1, %2" : "=v"(r) : "v"(lo), "v"(hi)); return r; }
template <class Epi, class Sched, bool ALIGN_EPI = false, bool SP2 = false>
__device__ __forceinline__ void gemm_phase(PG8_LAS unsigned char* lds, const Gemm g, const Sched& S, const Epi& E) {
    int tid_ = threadIdx.x; asm volatile("" : "+v"(tid_));
    const int tid = tid_, wid = __builtin_amdgcn_readfirstlane(tid >> 6), lane = tid & 63, wr = wid >> 2, wc = wid & 3, fr = lane & 15, fq = lane >> 4;
    const int K = g.K, nt = K / BK;
    unsigned voffA[2], voffB[2];
#pragma unroll
    for (int i = 0; i < 2; ++i) { int R, C; stage_rc(tid * 16 + i * 8192, R, C); const int Rb = Epi::PERM ? ((R & ~31) + perm32(R & 31)) : R;
        voffA[i] = (unsigned)(R * K + C) * 2u; voffB[i] = (unsigned)(Rb * K + C) * 2u; }
    const size_t kstep = (size_t)(BK * 2);
    const size_t hstep = (size_t)HALF * K * 2;
    const size_t tstep = 2 * hstep;
    const unsigned ldsw = (unsigned)wid * 1024u;
    const int aoff = lds_byte(wr * 64 + fr, fq * 8), boff = lds_byte(wc * 32 + fr, fq * 8);
#define PG8_SA(b, h) (((b) * 2 + (h)) * HTB)
#define PG8_SB(b, h) ((4 + (b) * 2 + (h)) * HTB)
#define PG8_STAGE(bufoff, gbase, voff) do { _Pragma("unroll") for (int _i = 0; _i < 2; ++_i) \
        __builtin_amdgcn_global_load_lds((const unsigned*)((const char*)(gbase) + (voff)[_i]), (PG8_LAS unsigned*)(lds + (bufoff) + ldsw + _i * 8192), 16, 0, 0); } while (0)
#define PG8_LDA(dst, b, h) do { _Pragma("unroll") for (int m = 0; m < 4; ++m) _Pragma("unroll") for (int k = 0; k < 2; ++k) dst[m][k] = *(const PG8_LAS bf16x8*)(lds + PG8_SA(b, h) + aoff + m * 2048 + k * 1024); } while (0)
#define PG8_LDB(dst, b, h) do { _Pragma("unroll") for (int n = 0; n < 2; ++n) _Pragma("unroll") for (int k = 0; k < 2; ++k) dst[n][k] = *(const PG8_LAS bf16x8*)(lds + PG8_SB(b, h) + boff + n * 2048 + k * 1024); } while (0)
#define PG8_MMA(ai, bj, At, Bt) do { __builtin_amdgcn_s_setprio(1); _Pragma("unroll") for (int m = 0; m < 4; ++m) _Pragma("unroll") for (int n = 0; n < 2; ++n) _Pragma("unroll") for (int k = 0; k < 2; ++k) \
        acc[ai][bj][m][n] = __builtin_amdgcn_mfma_f32_16x16x32_bf16(Bt[n][k], At[m][k], acc[ai][bj][m][n], 0, 0, 0); __builtin_amdgcn_s_setprio(0); } while (0)
#define PG8_WAIT_V(n) asm volatile("s_waitcnt vmcnt(" #n ")" ::: "memory")
#define PG8_WAIT_L(n) asm volatile("s_waitcnt lgkmcnt(" #n ")" ::: "memory")
#define PG8_BAR __builtin_amdgcn_s_barrier()
#define PG8_SCHED __builtin_amdgcn_sched_barrier(0)
    Unit cur, nxt; int ui = 0;
    if (!S.next(0, cur)) return;
    f32x4 acc[2][2][4][2];
#pragma unroll
    for (int a = 0; a < 2; ++a)
#pragma unroll
        for (int b = 0; b < 2; ++b)
#pragma unroll
            for (int m = 0; m < 4; ++m)
#pragma unroll
                for (int n = 0; n < 2; ++n) acc[a][b][m][n] = (f32x4){0.f, 0.f, 0.f, 0.f};
    bf16x8 At[4][2], B0[2][2], B1[2][2];
    const char* cA = (const char*)g.A + (size_t)cur.pm * tstep; const char* cB = (const char*)g.Bt + (size_t)cur.pn * tstep;
    S.a_ready(cur);
    if constexpr (SP2) {
        PG8_STAGE(PG8_SB(0, 0), cB, voffB); PG8_STAGE(PG8_SB(0, 1), cB + hstep, voffB); PG8_STAGE(PG8_SA(0, 0), cA, voffA); PG8_STAGE(PG8_SA(0, 1), cA + hstep, voffA);
        if (wr == 1) PG8_BAR;
        PG8_WAIT_V(2); PG8_BAR;
        PG8_STAGE(PG8_SB(1, 0), cB + kstep, voffB); PG8_STAGE(PG8_SA(1, 0), cA + kstep, voffA); PG8_STAGE(PG8_SB(1, 1), cB + hstep + kstep, voffB);
        PG8_WAIT_V(6); PG8_BAR;
    } else {
        PG8_STAGE(PG8_SB(0, 0), cB, voffB); PG8_STAGE(PG8_SA(0, 0), cA, voffA); PG8_STAGE(PG8_SB(0, 1), cB + hstep, voffB); PG8_STAGE(PG8_SA(0, 1), cA + hstep, voffA);
        if (wr == 1) PG8_BAR;
        PG8_WAIT_V(4); PG8_BAR;
        PG8_STAGE(PG8_SB(1, 0), cB + kstep, voffB); PG8_STAGE(PG8_SA(1, 0), cA + kstep, voffA); PG8_STAGE(PG8_SB(1, 1), cB + hstep + kstep, voffB);
        PG8_WAIT_V(6); PG8_BAR;
    }
    for (;;) {
        const bool has_next = S.next(ui + 1, nxt);
        const char* nA = has_next ? (const char*)g.A + (size_t)nxt.pm * tstep : cA; const char* nB = has_next ? (const char*)g.Bt + (size_t)nxt.pn * tstep : cB;
        for (int t = 0; t < nt; t += 2) {
            const bool last = (t == nt - 2);
            const char* a1 = cA + (size_t)(t + 1) * kstep;
            const char* a2 = last ? nA : cA + (size_t)(t + 2) * kstep; const char* b2 = last ? nB : cB + (size_t)(t + 2) * kstep;
            const char* a3 = a2 + kstep; const char* b3 = b2 + kstep;
            if (last && has_next) S.a_ready(nxt);
            if constexpr (SP2) {
            PG8_LDB(B0, 0, 0); PG8_LDB(B1, 0, 1); PG8_SCHED; PG8_LDA(At, 0, 0); PG8_STAGE(PG8_SA(1, 1), a1 + hstep, voffA);
            PG8_WAIT_V(8); PG8_WAIT_L(0); PG8_BAR; PG8_MMA(0, 0, At, B0); PG8_MMA(0, 1, At, B1); PG8_BAR; PG8_SCHED;
            PG8_LDA(At, 0, 1); PG8_STAGE(PG8_SB(0, 0), b2, voffB); PG8_STAGE(PG8_SB(0, 1), b2 + hstep, voffB); PG8_STAGE(PG8_SA(0, 0), a2, voffA);
            PG8_WAIT_V(8); PG8_WAIT_L(0); PG8_BAR; PG8_MMA(1, 0, At, B0); PG8_MMA(1, 1, At, B1); PG8_BAR; PG8_SCHED;
            PG8_LDB(B0, 1, 0); PG8_LDB(B1, 1, 1); PG8_SCHED; PG8_LDA(At, 1, 0); PG8_STAGE(PG8_SA(0, 1), a2 + hstep, voffA);
            PG8_WAIT_V(8); PG8_WAIT_L(0); PG8_BAR; PG8_MMA(0, 0, At, B0); PG8_MMA(0, 1, At, B1); PG8_BAR; PG8_SCHED;
            PG8_LDA(At, 1, 1); PG8_STAGE(PG8_SB(1, 0), b3, voffB); PG8_STAGE(PG8_SB(1, 1), b3 + hstep, voffB); PG8_STAGE(PG8_SA(1, 0), a3, voffA);
            PG8_WAIT_V(8); PG8_WAIT_L(0); PG8_BAR; PG8_MMA(1, 0, At, B0); PG8_MMA(1, 1, At, B1); PG8_BAR; PG8_SCHED;
            } else {
            PG8_LDB(B0, 0, 0); PG8_SCHED; PG8_LDA(At, 0, 0); PG8_STAGE(PG8_SA(1, 1), a1 + hstep, voffA);
            PG8_WAIT_L(8); PG8_BAR; PG8_WAIT_L(0); PG8_MMA(0, 0, At, B0); PG8_BAR; PG8_SCHED;
            PG8_LDB(B1, 0, 1); PG8_STAGE(PG8_SB(0, 0), b2, voffB);
            PG8_BAR; PG8_WAIT_L(0); PG8_MMA(0, 1, At, B1); PG8_BAR;
            PG8_LDA(At, 0, 1); PG8_STAGE(PG8_SA(0, 0), a2, voffA);
            PG8_BAR; PG8_WAIT_L(0); PG8_MMA(1, 0, At, B0); PG8_BAR; PG8_SCHED;
            PG8_STAGE(PG8_SB(0, 1), b2 + hstep, voffB);
            PG8_WAIT_V(6); PG8_BAR; PG8_MMA(1, 1, At, B1); PG8_BAR;
            PG8_LDB(B0, 1, 0); PG8_SCHED; PG8_LDA(At, 1, 0); PG8_STAGE(PG8_SA(0, 1), a2 + hstep, voffA);
            PG8_WAIT_L(8); PG8_BAR; PG8_WAIT_L(0); PG8_MMA(0, 0, At, B0); PG8_BAR; PG8_SCHED;
            PG8_LDB(B1, 1, 1); PG8_STAGE(PG8_SB(1, 0), b3, voffB);
            PG8_BAR; PG8_WAIT_L(0); PG8_MMA(0, 1, At, B1); PG8_BAR;
            PG8_LDA(At, 1, 1); PG8_STAGE(PG8_SA(1, 0), a3, voffA);
            PG8_BAR; PG8_WAIT_L(0); PG8_MMA(1, 0, At, B0); PG8_BAR; PG8_SCHED;
            PG8_STAGE(PG8_SB(1, 1), b3 + hstep, voffB);
            PG8_WAIT_V(6); PG8_BAR; PG8_MMA(1, 1, At, B1); PG8_BAR;
            }
        }
        if constexpr (ALIGN_EPI) { if (wr == 0) PG8_BAR; }
        if constexpr (!Epi::AFTER_DRAIN) { E(acc, cur, wr, wc, fr, fq); S.done(cur); }
        if (!has_next) break;
#pragma unroll
        for (int a = 0; a < 2; ++a)
#pragma unroll
            for (int b = 0; b < 2; ++b)
#pragma unroll
                for (int m = 0; m < 4; ++m)
#pragma unroll
                    for (int n = 0; n < 2; ++n) acc[a][b][m][n] = (f32x4){0.f, 0.f, 0.f, 0.f};
        cur = nxt; cA = nA; cB = nB; ++ui;
        if constexpr (ALIGN_EPI) { if (wr == 1) PG8_BAR; }
    }
    PG8_WAIT_V(0);
    if constexpr (!ALIGN_EPI) { if (wr == 0) PG8_BAR; }
    PG8_BAR;
    if constexpr (Epi::AFTER_DRAIN) { E.fused(acc, cur, wr, wc, fr, fq, lds, wid, lane); S.done(cur); }
#undef PG8_SA
#undef PG8_SB
#undef PG8_STAGE
#undef PG8_LDA
#undef PG8_LDB
#undef PG8_MMA
#undef PG8_WAIT_V
#undef PG8_WAIT_L
#undef PG8_BAR
#undef PG8_SCHED
}
}

typedef unsigned short bf16_t;
typedef short bf16x8 __attribute__((ext_vector_type(8)));
typedef float f32x4 __attribute__((ext_vector_type(4)));
typedef float f32x16 __attribute__((ext_vector_type(16)));
typedef unsigned u32x4 __attribute__((ext_vector_type(4)));
typedef unsigned u32x2 __attribute__((ext_vector_type(2)));
typedef float f32x2_t __attribute__((ext_vector_type(2)));
typedef __bf16 bf16x2_t __attribute__((ext_vector_type(2)));

constexpr int TP = 32768, TS = 16384, TT = TP + TS, DM = 1024, FFH = 2816, SP = 4096, SS = 2048;
constexpr float EPS = 1e-6f;
constexpr size_t MiB = 1u << 20;
constexpr size_t WS_CTL = 0, CTL_BYTES = 64 * 1024;
constexpr size_t WS_ROPE = 1 * MiB;
constexpr size_t WS_W_AB1 = 2 * MiB;
constexpr size_t WS_W_FT = 6 * MiB;
constexpr size_t WS_W_ABO = 8 * MiB;
constexpr size_t WS_W_GU0 = 10 * MiB;
constexpr size_t WS_W_D0 = 21 * MiB;
constexpr size_t WS_W_QKV = 27 * MiB;
constexpr size_t WS_W_CO = 30 * MiB;
constexpr size_t WS_W_GU1 = 32 * MiB;
constexpr size_t WS_W_D1 = 43 * MiB;
constexpr size_t WS_DEC = 49 * MiB;
constexpr size_t WS_C4 = 51 * MiB, WS_S4 = 59 * MiB;
constexpr size_t WS_C2 = 67 * MiB, WS_S2 = 69 * MiB;
constexpr size_t WS_HM = 1 * MiB + 64 * 1024;
constexpr size_t WS_YMID = 1 * MiB + 128 * 1024;
constexpr size_t WS_PCP = 91 * MiB, WS_PSP = 107 * MiB;
constexpr size_t WS_PCS = 123 * MiB, WS_PSS = 131 * MiB;
constexpr size_t WS_SSQ = 1 * MiB + 256 * 1024;
constexpr size_t WS_XBA = 51 * MiB;
constexpr size_t WS_XBB = 147 * MiB;
constexpr size_t WS_H = WS_XBB;
constexpr size_t WS_BIG = 243 * MiB;
constexpr size_t WS_QKVR = WS_BIG;
constexpr size_t WS_G = WS_BIG + 144 * MiB;
constexpr size_t WS_FOLDF = WS_BIG;
constexpr size_t WS_FOLDG = WS_BIG + 4 * MiB;
constexpr size_t WS_ACT = WS_BIG;
constexpr size_t WS_Q = WS_BIG, WS_K = WS_BIG + 96 * MiB, WS_V = WS_BIG + 120 * MiB, WS_AO = WS_BIG + 144 * MiB;
constexpr size_t WS_END = WS_BIG + 264 * MiB;
constexpr size_t OUT_YTPC = 0, OUT_YTPS = 16 * MiB, OUT_YTSC = 32 * MiB, OUT_YTSS = 40 * MiB, OUT_HS = 96 * MiB, OUT_HD = 144 * MiB, OUT_DST = 96 * MiB;
constexpr int TF = 24576, TFP = 16384;

DEVI float bf2f(bf16_t x) { return __uint_as_float(((unsigned)x) << 16); }
DEVI unsigned pk2(float lo, float hi) { f32x2_t v = {lo, hi}; bf16x2_t b = __builtin_convertvector(v, bf16x2_t); return __builtin_bit_cast(unsigned, b); }
DEVI bf16_t f2bf(float f) { return (bf16_t)(pk2(f, 0.f) & 0xffffu); }
DEVI u32x4 pk8(f32x4 a, f32x4 b) { u32x4 w; w.x = pk2(a[0], a[1]); w.y = pk2(a[2], a[3]); w.z = pk2(b[0], b[1]); w.w = pk2(b[2], b[3]); return w; }
DEVI float wave_sum(float v) {
#pragma unroll
    for (int o = 1; o < 64; o <<= 1) v += __shfl_xor(v, o);
    return v;
}
DEVI float logsig(float z) { return fminf(z, 0.f) - __logf(1.f + __expf(-fabsf(z))); }
DEVI float silu(float z) { return z * __builtin_amdgcn_rcpf(1.f + __expf(-z)); }

struct RotOrder { pg8::StaticOrder S;
    DEVI bool next(int i, pg8::Unit& u) const { if (!S.next(i, u)) return false; u.pn = (u.pn + ((u.pm >> 3) % 3)) & 7; return true; }
    DEVI void a_ready(const pg8::Unit&) const {}
    DEVI void done(const pg8::Unit&) const {} };
struct FoldOrder { int G, c;
    DEVI bool next(int i, pg8::Unit& u) const { const int L = i * G + c; if (L >= 384) return false; u.pm = L & 3; u.pn = (L >> 2) + (u.pm >> 1) * 96; return true; }
    DEVI void a_ready(const pg8::Unit&) const {}
    DEVI void done(const pg8::Unit&) const {} };
enum { EM_AB1, EM_AB1T, EM_FNETP, EM_FNETS, EM_RESIN, EM_RES, EM_GLU, EM_QKV };
template <int MODE, bool NEXT = false> struct Epi {
    static constexpr bool PERM = true, AFTER_DRAIN = false;
    bf16_t* O0; bf16_t* O1; bf16_t* O2; float* F0; const float* X0; const float* X1; const float* B0; const float* B1;
    const float* SQI; float* SQO; bf16_t* XBN; const float* GN;
    DEVI float rstd_of(int row) const { return rsqrtf(SQI[row] * (1.f / 1024.f) + EPS); }
    DEVI void operator()(const f32x4 (&acc)[2][2][4][2], const pg8::Unit& u, int wr, int wc, int fr, int fq) const {
        const int rbase = u.pm * 256 + wr * 64 + fr, cb = wc * 32 + 8 * fq;
        f32x4 ga[2][2];
        if constexpr (NEXT) {
#pragma unroll
            for (int bj = 0; bj < 2; ++bj) { ga[bj][0] = *(const f32x4*)(GN + u.pn * 256 + bj * 128 + cb); ga[bj][1] = *(const f32x4*)(GN + u.pn * 256 + bj * 128 + cb + 4); } }
        float rsv[2][4];
        if constexpr (MODE == EM_AB1 || MODE == EM_GLU || MODE == EM_QKV) {
#pragma unroll
            for (int ai = 0; ai < 2; ++ai)
#pragma unroll
                for (int m = 0; m < 4; ++m) rsv[ai][m] = SQI[rbase + ai * 128 + m * 16];
#pragma unroll
            for (int ai = 0; ai < 2; ++ai)
#pragma unroll
                for (int m = 0; m < 4; ++m) rsv[ai][m] = rsqrtf(rsv[ai][m] * (1.f / 1024.f) + EPS);
        }
#pragma unroll
        for (int ai = 0; ai < 2; ++ai)
#pragma unroll
            for (int m = 0; m < 4; ++m) {
                const int row = rbase + ai * 128 + m * 16;
                float rs = 1.f, ssq = 0.f;
                if constexpr (MODE == EM_AB1 || MODE == EM_GLU || MODE == EM_QKV) rs = rsv[ai][m];
                if constexpr (MODE == EM_GLU) {
                    const f32x4 g0 = acc[ai][0][m][0] * rs, g1 = acc[ai][0][m][1] * rs, u0 = acc[ai][1][m][0] * rs, u1 = acc[ai][1][m][1] * rs;
                    f32x4 a, b;
#pragma unroll
                    for (int j = 0; j < 4; ++j) { a[j] = silu(g0[j]) * u0[j]; b[j] = silu(g1[j]) * u1[j]; }
                    *(u32x4*)(O0 + (size_t)row * FFH + u.pn * 128 + cb) = pk8(a, b);
                } else {
#pragma unroll
                    for (int bj = 0; bj < 2; ++bj) {
                        f32x4 v0 = acc[ai][bj][m][0] * rs, v1 = acc[ai][bj][m][1] * rs;
                        const int c = bj * 128 + cb;
                        if constexpr (MODE == EM_AB1) {
                            if (u.pn < 6) { *(u32x4*)(O0 + (size_t)row * 1536 + u.pn * 256 + c) = pk8(v0, v1); }
                            else { const int dir = u.pn - 6; const float* bias = dir ? B1 : B0;
                                const f32x4 b0 = *(const f32x4*)(bias + c), b1 = *(const f32x4*)(bias + c + 4);
                                f32x4 a, b;
#pragma unroll
                                for (int j = 0; j < 4; ++j) { a[j] = logsig(v0[j] + b0[j]) * 0.0625f; b[j] = logsig(v1[j] + b1[j]) * 0.0625f; }
                                float* gp = F0 + (size_t)row * 512 + dir * 256 + c; *(f32x4*)gp = a; *(f32x4*)(gp + 4) = b; }
                        } else if constexpr (MODE == EM_AB1T) {
                            const int cc = row, part = cc >> 9, t0 = (u.pn - 96 * part) * 256;
                            bf16_t* dst;
                            if (t0 < TFP) { const int b = t0 >> 11, s = (t0 & 2047) + c; dst = O0 + (size_t)part * (4096 * 2048) + (size_t)(b * 512 + (cc & 511)) * 2048 + s; }
                            else { const int tt = t0 - TFP, b = tt >> 10, s = (tt & 1023) + c; dst = O1 + (size_t)part * (4096 * 1024) + (size_t)(b * 512 + (cc & 511)) * 1024 + s; }
                            *(u32x4*)dst = pk8(v0, v1);
                        } else if constexpr (MODE == EM_FNETP) {
                            *(u32x4*)(O0 + ((size_t)(u.pn >> 1) * 2048 + row) * 512 + (u.pn & 1) * 256 + c) = pk8(v0, v1);
                        } else if constexpr (MODE == EM_FNETS) {
                            *(u32x4*)(O0 + ((size_t)(u.pn >> 1) * 1024 + row) * 512 + (u.pn & 1) * 256 + c) = pk8(v0, v1);
                        } else if constexpr (MODE == EM_RESIN) {
                            const float* xp = (row < TP ? X0 + (size_t)row * 1024 : X1 + (size_t)(row - TP) * 1024) + u.pn * 256 + c;
                            float* op = F0 + (size_t)row * 1024 + u.pn * 256 + c;
                            const f32x4 x0 = *(const f32x4*)xp + v0, x1 = *(const f32x4*)(xp + 4) + v1;
                            *(f32x4*)op = x0; *(f32x4*)(op + 4) = x1;
                            if constexpr (NEXT) { ssq += (x0[0] * x0[0] + x0[1] * x0[1]) + (x0[2] * x0[2] + x0[3] * x0[3]) + (x1[0] * x1[0] + x1[1] * x1[1]) + (x1[2] * x1[2] + x1[3] * x1[3]);
                                *(u32x4*)(XBN + (size_t)row * 1024 + u.pn * 256 + c) = pk8(x0 * ga[bj][0], x1 * ga[bj][1]); }
                        } else if constexpr (MODE == EM_RES) {
                            float* op = F0 + (size_t)row * 1024 + u.pn * 256 + c;
                            const f32x4 x0 = *(const f32x4*)op + v0, x1 = *(const f32x4*)(op + 4) + v1;
                            *(f32x4*)op = x0; *(f32x4*)(op + 4) = x1;
                            if constexpr (NEXT) { ssq += (x0[0] * x0[0] + x0[1] * x0[1]) + (x0[2] * x0[2] + x0[3] * x0[3]) + (x1[0] * x1[0] + x1[1] * x1[1]) + (x1[2] * x1[2] + x1[3] * x1[3]);
                                *(u32x4*)(XBN + (size_t)row * 1024 + u.pn * 256 + c) = pk8(x0 * ga[bj][0], x1 * ga[bj][1]); }
                        } else if constexpr (MODE == EM_QKV) {
                            bf16_t* dst;
                            if (u.pn < 4) dst = O0 + (size_t)row * 1024 + u.pn * 256 + c;
                            else if (u.pn == 4) dst = O1 + (size_t)row * 256 + c;
                            else dst = O2 + (size_t)row * 256 + c;
                            *(u32x4*)dst = pk8(v0, v1);
                        }
                    }
                    if constexpr (NEXT) { ssq += __shfl_xor(ssq, 16); ssq += __shfl_xor(ssq, 32); if (fq == 0) atomicAdd(SQO + row, ssq); }
                }
            }
    }
};

DEVI void p_fold(const float* win, const float* upf, const float* upb, bf16_t* WFT, bf16_t* WG, float* tab, int gw, int NGW, int lane) {
    if (threadIdx.x < 128) tab[threadIdx.x] = cospif((float)threadIdx.x * (1.f / 64.f));
    __syncthreads();
    for (int it = gw; it < 1024 * 16; it += NGW) {
        const int k = it >> 4, cb = it & 15, cc = cb * 64 + lane, part = cc >> 9, g = (cc >> 7) & 3, l = cc & 127;
        const float* wr = win + (size_t)k * 2080 + 1568 + g * 128;
        const int sh = part ? 96 : 0;
        float acc = 0.f;
#pragma unroll 8
        for (int w = 0; w < 128; ++w) acc += wr[w] * tab[(w * l + sh) & 127];
        WFT[(size_t)cc * 1024 + k] = f2bf(acc);
    }
    for (int it = gw; it < 1024 * 8; it += NGW) {
        const int k = it >> 3, nb = it & 7, n = nb * 64 + lane, dir = n >> 8, nn = n & 255;
        const float* wr = win + (size_t)k * 2080 + 1536 + dir * 16;
        const float* up = dir ? upb : upf;
        float acc = 0.f;
#pragma unroll
        for (int r = 0; r < 16; ++r) acc += wr[r] * up[r * 256 + nn];
        WG[(size_t)n * 1024 + k] = f2bf(acc);
    }
    __syncthreads();
}
DEVI void p_dft(bf16_t* C, bf16_t* Sn, int S, int logS, int gt, int NGT) {
    const int lri = logS - 4;
    const long total = (long)(S / 2) << lri;
    const float nrm = rsqrtf((float)S * 128.f), xs = 2.f / (float)S;
    for (long it = gt; it < 2 * total; it += NGT) {
        const int part = it >= total; const long i2 = part ? it - total : it;
        const int k = (int)(i2 >> lri), s0 = (int)(i2 & ((1 << lri) - 1)) * 8;
        float v[8];
#pragma unroll
        for (int j = 0; j < 8; ++j) { const int idx = (k * (s0 + j)) & (S - 1); const float x = (float)idx * xs; v[j] = (part ? sinpif(x) : cospif(x)) * nrm; }
        u32x4 w; w.x = pk2(v[0], v[1]); w.y = pk2(v[2], v[3]); w.z = pk2(v[4], v[5]); w.w = pk2(v[6], v[7]);
        *(u32x4*)((part ? Sn : C) + (size_t)k * (S / 2) + s0) = w;
    }
}
DEVI void p_fcombine(const bf16_t* PC, const bf16_t* PS, const float* YM, bf16_t* MIX, int tokbase, int S, int logSH, int gt, int NGT) {
    const float nrm = rsqrtf((float)S * 128.f);
    const int total = 8 << (logSH + 6);
    for (int it0 = gt; it0 < total; it0 += 4 * NGT) {
        u32x4 pc[4], ps[4];
#pragma unroll
        for (int u = 0; u < 4; ++u) { const int it = it0 + u * NGT, ch = it & 63, k = (it >> 6) & ((1 << logSH) - 1), b = it >> (6 + logSH);
            pc[u] = *(const u32x4*)(PC + ((size_t)(b << logSH) + k) * 512 + ch * 8); ps[u] = *(const u32x4*)(PS + ((size_t)(b << logSH) + k) * 512 + ch * 8); }
#pragma unroll
        for (int u = 0; u < 4; ++u) { const int it = it0 + u * NGT, ch = it & 63, k = (it >> 6) & ((1 << logSH) - 1), b = it >> (6 + logSH);
            u32x4 lo, hi; const float sg = (k & 1) ? -nrm : nrm;
            const f32x4 m0 = *(const f32x4*)(YM + b * 512 + ch * 8), m1 = *(const f32x4*)(YM + b * 512 + ch * 8 + 4);
#pragma unroll
            for (int j = 0; j < 4; ++j) { const float c0 = __uint_as_float(pc[u][j] << 16), c1 = __uint_as_float(pc[u][j] & 0xffff0000u), s0 = __uint_as_float(ps[u][j] << 16), s1 = __uint_as_float(ps[u][j] & 0xffff0000u);
                const float e0 = sg * (j < 2 ? m0[2 * j] : m1[2 * j - 4]), e1 = sg * (j < 2 ? m0[2 * j + 1] : m1[2 * j - 3]);
                lo[j] = pk2(c0 - s0 + e0, c1 - s1 + e1); hi[j] = pk2(c0 + s0 + e0, c1 + s1 + e1); }
            *(u32x4*)(MIX + (size_t)(tokbase + b * S + k) * 1024 + 512 + ch * 8) = lo;
            if (k) *(u32x4*)(MIX + (size_t)(tokbase + b * S + S - k) * 1024 + 512 + ch * 8) = hi; }
    }
}
DEVI void p_fmid(const bf16_t* YC, const float* YM, bf16_t* MIX, int tokbase, int S, int gw, int NGW, int lane) {
    const float nrm = rsqrtf((float)S * 128.f); const int SH = S / 2;
    for (int r = gw; r < 4096; r += NGW) {
        const bf16_t* row = YC + (size_t)r * SH; float acc = 0.f;
        for (int s0 = lane * 8; s0 < SH; s0 += 512) { const u32x4 w = *(const u32x4*)(row + s0);
#pragma unroll
            for (int j = 0; j < 4; ++j) acc += __uint_as_float(w[j] << 16) - __uint_as_float(w[j] & 0xffff0000u); }
        acc = wave_sum(acc);
        if (lane == 0) MIX[(size_t)(tokbase + (r >> 9) * S + SH) * 1024 + 512 + (r & 511)] = f2bf((acc + YM[r]) * nrm);
    }
}
DEVI void p_ymid(const bf16_t* HM, const bf16_t* WFT, float* YM, int gw, int NGW, int lane) {
    for (int it = gw; it < 16 * 512; it += NGW) { const int q = it >> 9, c = it & 511;
        const u32x4 a0 = *(const u32x4*)(HM + q * 1024 + lane * 16), a1 = *(const u32x4*)(HM + q * 1024 + lane * 16 + 8);
        const u32x4 w0 = *(const u32x4*)(WFT + (size_t)c * 1024 + lane * 16), w1 = *(const u32x4*)(WFT + (size_t)c * 1024 + lane * 16 + 8);
        float acc = 0.f;
#pragma unroll
        for (int j = 0; j < 4; ++j) { acc += __uint_as_float(a0[j] << 16) * __uint_as_float(w0[j] << 16) + __uint_as_float(a0[j] & 0xffff0000u) * __uint_as_float(w0[j] & 0xffff0000u);
            acc += __uint_as_float(a1[j] << 16) * __uint_as_float(w1[j] << 16) + __uint_as_float(a1[j] & 0xffff0000u) * __uint_as_float(w1[j] & 0xffff0000u); }
        acc = wave_sum(acc);
        if (lane == 0) YM[it] = acc;
    }
}
DEVI void p_prep_fold(const float* x_p, const float* x_s, const float* gain, bf16_t* XB, float* SQ, bf16_t* HS, bf16_t* HD, bf16_t* HM, int gw, int NGW, int lane) {
    f32x4 gv[4];
#pragma unroll
    for (int j = 0; j < 4; ++j) gv[j] = *((const f32x4*)gain + lane + 64 * j);
    for (int it = gw; it < 8 * 2049 + 8 * 1025; it += NGW) {
        int q, j, S, tb, tfb;
        if (it < 8 * 2049) { q = it / 2049; j = it - q * 2049; S = 4096; tb = q * 4096; tfb = q * 2048; }
        else { const int i2 = it - 8 * 2049; q = i2 / 1025; j = i2 - q * 1025; S = 2048; tb = TP + q * 2048; tfb = TFP + q * 1024; q += 8; }
        const bool pair = j > 0 && j < S / 2;
        const int ra = tb + j, rb = pair ? tb + S - j : ra;
        const f32x4* xa = (const f32x4*)(ra < TP ? x_p + (size_t)ra * DM : x_s + (size_t)(ra - TP) * DM) + lane;
        const f32x4* xb = (const f32x4*)(rb < TP ? x_p + (size_t)rb * DM : x_s + (size_t)(rb - TP) * DM) + lane;
        f32x4 va[4], vb[4]; float sa = 0.f, sb = 0.f;
#pragma unroll
        for (int t = 0; t < 4; ++t) { va[t] = xa[64 * t]; vb[t] = xb[64 * t]; }
#pragma unroll
        for (int t = 0; t < 4; ++t) { sa += (va[t].x * va[t].x + va[t].y * va[t].y) + (va[t].z * va[t].z + va[t].w * va[t].w); sb += (vb[t].x * vb[t].x + vb[t].y * vb[t].y) + (vb[t].z * vb[t].z + vb[t].w * vb[t].w); }
        sa = wave_sum(sa); sb = wave_sum(sb);
        const float rsa = rsqrtf(sa * (1.f / DM) + EPS), rsb = pair ? rsqrtf(sb * (1.f / DM) + EPS) : 0.f;
        if (lane == 0) { SQ[ra] = sa; if (pair) SQ[rb] = sb; }
        u32x2* oa = (u32x2*)(XB + (size_t)ra * DM) + lane; u32x2* ob = (u32x2*)(XB + (size_t)rb * DM) + lane;
        u32x2* os = (u32x2*)((j == S / 2 ? HM + (size_t)q * DM : HS + (size_t)(tfb + j) * DM)) + lane; u32x2* od = (u32x2*)(HD + (size_t)(tfb + (j == S / 2 ? 0 : j)) * DM) + lane;
#pragma unroll
        for (int t = 0; t < 4; ++t) { const f32x4 ga = va[t] * gv[t], gb = vb[t] * gv[t];
            u32x2 w; w.x = pk2(ga.x, ga.y); w.y = pk2(ga.z, ga.w); oa[64 * t] = w;
            if (pair) { w.x = pk2(gb.x, gb.y); w.y = pk2(gb.z, gb.w); ob[64 * t] = w; }
            const f32x4 ha = ga * rsa, hb = gb * rsb;
            w.x = pk2(ha.x + hb.x, ha.y + hb.y); w.y = pk2(ha.z + hb.z, ha.w + hb.w); os[64 * t] = w;
            if (j != S / 2) { w.x = pk2(ha.x - hb.x, ha.y - hb.y); w.y = pk2(ha.z - hb.z, ha.w - hb.w); od[64 * t] = w; } }
    }
}
DEVI void p_norm(const float* src0, const float* src1, const float* gain, bf16_t* H, float* SQ, int gw, int NGW, int lane) {
    f32x4 gv[4];
#pragma unroll
    for (int j = 0; j < 4; ++j) gv[j] = *((const f32x4*)gain + lane + 64 * j);
    for (int m = gw; m < TT; m += NGW) {
        const f32x4* xr = (const f32x4*)(m < TP ? src0 + (size_t)m * DM : src1 + (size_t)(m - TP) * DM) + lane;
        f32x4 v[4]; float s = 0.f;
#pragma unroll
        for (int j = 0; j < 4; ++j) { v[j] = xr[64 * j]; s += (v[j].x * v[j].x + v[j].y * v[j].y) + (v[j].z * v[j].z + v[j].w * v[j].w); }
        const float rstd = 1.f; { const float tot = wave_sum(s); if (lane == 0) SQ[m] = tot; }
        u32x2* o8 = (u32x2*)(H + (size_t)m * DM) + lane;
#pragma unroll
        for (int j = 0; j < 4; ++j) { u32x2 w; w.x = pk2(v[j].x * rstd * gv[j].x, v[j].y * rstd * gv[j].y); w.y = pk2(v[j].z * rstd * gv[j].z, v[j].w * rstd * gv[j].w); o8[64 * j] = w; }
    }
}
DEVI void tr_item(const float* W, int ld, int col0, bf16_t* WT, int Kd, int drow0, float scale, float* scr, int k0, int n0, int lane) {
#pragma unroll 8
    for (int i = 0; i < 32; ++i) { const int kk = 2 * i + (lane >> 5); scr[kk * 33 + (lane & 31)] = W[(size_t)(k0 + kk) * ld + col0 + n0 + (lane & 31)]; }
    asm volatile("s_waitcnt lgkmcnt(0)" ::: "memory");
    const int c = lane & 7;
#pragma unroll
    for (int j = 0; j < 4; ++j) { const int n = (lane >> 3) + 8 * j; const float* s = scr + (8 * c) * 33 + n;
        u32x4 o; o.x = pk2(s[0] * scale, s[33] * scale); o.y = pk2(s[66] * scale, s[99] * scale); o.z = pk2(s[132] * scale, s[165] * scale); o.w = pk2(s[198] * scale, s[231] * scale);
        *(u32x4*)(WT + (size_t)(drow0 + n) * Kd + k0 + 8 * c) = o; }
    asm volatile("s_waitcnt lgkmcnt(0)" ::: "memory");
}
template <int MAP> DEVI bool tr_mat(int& r, const float* W, int ld, int col0, int K, int ncols, bf16_t* WT, int drow, float scale, float* scr, int lane) {
    const int nblk = ncols >> 5, cnt = (K >> 6) * nblk;
    if (r >= cnt) { r -= cnt; return false; }
    const int kb = r / nblk, nb = r - kb * nblk, n0 = nb * 32;
    int d0 = drow + n0;
    if (MAP == 1) d0 = (n0 >> 7) * 256 + (n0 & 127);
    if (MAP == 2) d0 = (n0 >> 7) * 256 + 128 + (n0 & 127);
    tr_item(W, ld, col0, WT, K, d0, scale, scr, kb * 64, n0, lane);
    return true;
}

constexpr int GP = 144;
constexpr int L_QF = 0, L_QB = 9216, L_KF = 18432, L_KB = 27648, L_VT = 36864, L_ATF = 55296, L_ATB = 64512, L_SPF = 73728, L_SPB = 92160, L_SEG = 110592;
constexpr int L_KDF = 0, L_KDB = 9216;
DEVI int crow(int r, int hi) { return (r & 3) + 8 * (r >> 2) + 4 * hi; }
DEVI bf16x8 ldf(const unsigned char* base, int row, int ks, int hi) { return *(const bf16x8*)(base + row * GP + ks * 32 + hi * 16); }

#define LBAR() do { asm volatile("s_waitcnt lgkmcnt(0)" ::: "memory"); __builtin_amdgcn_s_barrier(); asm volatile("" ::: "memory"); } while (0)
struct GlaLd { float gf[8], gb[8]; bf16_t qh[8], kh[8], vh[16]; };
template <bool FULL> DEVI void gla_load(GlaLd& L, int item, const bf16_t* QKVR, const float* G, const bf16_t* DST, int tid) {
    const int n = item >> 2, h = item & 3, tok0 = n * 64, d = tid & 63, sg = tid >> 6, e = tid & 127, s4 = tid >> 7;
#pragma unroll
    for (int i = 0; i < 8; ++i) { const float* p = G + (size_t)(tok0 + 8 * sg + i) * 512 + h * 64 + d; L.gf[i] = p[0]; L.gb[i] = p[256]; }
#pragma unroll
    for (int i = 0; i < 8; ++i) { const bf16_t* tr = QKVR + (size_t)(tok0 + 8 * sg + i) * 1536 + h * 64 + d; if (FULL) L.qh[i] = tr[0]; L.kh[i] = tr[256]; }
#pragma unroll
    for (int i = 0; i < 16; ++i) L.vh[i] = QKVR[(size_t)(tok0 + 16 * s4 + i) * 1536 + 512 + h * 128 + e];
}
DEVI void gla_prefix(const GlaLd& L, float* SEG, int tid, float (&bF)[8], float (&bB)[8], float& totF, float& totB) {
    const int d = tid & 63, sg = tid >> 6;
    bF[0] = L.gf[0];
#pragma unroll
    for (int i = 1; i < 8; ++i) bF[i] = bF[i - 1] + L.gf[i];
    bB[7] = L.gb[7];
#pragma unroll
    for (int i = 6; i >= 0; --i) bB[i] = bB[i + 1] + L.gb[i];
    SEG[sg * 64 + d] = bF[7]; SEG[512 + sg * 64 + d] = bB[0];
    LBAR();
    float offF = 0.f, offB = 0.f; totF = 0.f; totB = 0.f;
#pragma unroll
    for (int s = 0; s < 8; ++s) { const float a = SEG[s * 64 + d], b = SEG[512 + s * 64 + d]; totF += a; totB += b; if (s < sg) offF += a; if (s > sg) offB += b; }
#pragma unroll
    for (int i = 0; i < 8; ++i) { bF[i] += offF; bB[i] += offB; }
}
DEVI void gla_stage_vt(const GlaLd& L, unsigned char* VT, int tid) {
    const int e = tid & 127, s4 = tid >> 7;
    unsigned w[8];
#pragma unroll
    for (int i = 0; i < 8; ++i) w[i] = (unsigned)L.vh[2 * i] | ((unsigned)L.vh[2 * i + 1] << 16);
    u32x4 a = {w[0], w[1], w[2], w[3]}, b = {w[4], w[5], w[6], w[7]};
    *(u32x4*)(VT + e * GP + s4 * 32) = a; *(u32x4*)(VT + e * GP + s4 * 32 + 16) = b;
}
DEVI void gla_a_item(const GlaLd& L, int item, bf16_t* DST, float* DEC, unsigned char* lds, int tid, int wave, int lane) {
    const int d = tid & 63, sg = tid >> 6;
    float bF[8], bB[8], totF, totB;
    gla_prefix(L, (float*)(lds + L_SEG), tid, bF, bB, totF, totB);
    float kf[8], kb[8];
#pragma unroll
    for (int i = 0; i < 8; ++i) { const float kk = bf2f(L.kh[i]); kf[i] = kk * __expf(totF - bF[i]); kb[i] = kk * __expf(totB - bB[i]); }
    { u32x4 a = {pk2(kf[0], kf[1]), pk2(kf[2], kf[3]), pk2(kf[4], kf[5]), pk2(kf[6], kf[7])}, b = {pk2(kb[0], kb[1]), pk2(kb[2], kb[3]), pk2(kb[4], kb[5]), pk2(kb[6], kb[7])};
      *(u32x4*)(lds + L_KDF + d * GP + sg * 16) = a; *(u32x4*)(lds + L_KDB + d * GP + sg * 16) = b; }
    if (sg == 0) { DEC[(size_t)(item * 2) * 64 + d] = __expf(totF); DEC[(size_t)(item * 2 + 1) * 64 + d] = __expf(totB); }
    gla_stage_vt(L, lds + L_VT, tid);
    LBAR();
    { const int dir = wave >> 2, et = wave & 3, r32 = lane & 31, hi = lane >> 5;
      const unsigned char* KD = lds + (dir ? L_KDB : L_KDF);
      f32x16 c0 = {}, c1 = {};
#pragma unroll
      for (int ks = 0; ks < 4; ++ks) { const bf16x8 b = ldf(lds + L_VT, 32 * et + r32, ks, hi), a0 = ldf(KD, r32, ks, hi), a1 = ldf(KD, 32 + r32, ks, hi);
          c0 = __builtin_amdgcn_mfma_f32_32x32x16_bf16(a0, b, c0, 0, 0, 0); c1 = __builtin_amdgcn_mfma_f32_32x32x16_bf16(a1, b, c1, 0, 0, 0); }
      bf16_t* dst = DST + (size_t)(item * 2 + dir) * 8192 + (32 * et + r32) * 64 + 4 * hi;
#pragma unroll
      for (int q = 0; q < 4; ++q) { u32x2 w0 = {pk2(c0[4 * q], c0[4 * q + 1]), pk2(c0[4 * q + 2], c0[4 * q + 3])}, w1 = {pk2(c1[4 * q], c1[4 * q + 1]), pk2(c1[4 * q + 2], c1[4 * q + 3])};
          *(u32x2*)(dst + 8 * q) = w0; *(u32x2*)(dst + 32 + 8 * q) = w1; } }
    LBAR();
}
DEVI void p_scan(bf16_t* DST, const float* DEC, int gt) {
    const int combo = gt >> 10, el = gt & 1023, e = el >> 3, d0 = (el & 7) * 8;
    const int seq = combo >> 3, h = (combo >> 1) & 3, dir = combo & 1;
    const int nch = seq < 8 ? 64 : 32, n0 = seq < 8 ? seq * 64 : 512 + (seq - 8) * 32;
    float S[8];
#pragma unroll
    for (int j = 0; j < 8; ++j) S[j] = 0.f;
    for (int st0 = 0; st0 < nch; st0 += 8) {
        u32x4 ds[8]; f32x4 dc0[8], dc1[8];
#pragma unroll
        for (int u = 0; u < 8; ++u) { const int n = dir ? nch - 1 - (st0 + u) : st0 + u; const size_t item = (size_t)((n0 + n) * 4 + h) * 2 + dir;
            ds[u] = *(const u32x4*)(DST + item * 8192 + e * 64 + d0); dc0[u] = *(const f32x4*)(DEC + item * 64 + d0); dc1[u] = *(const f32x4*)(DEC + item * 64 + d0 + 4); }
#pragma unroll
        for (int u = 0; u < 8; ++u) { const int n = dir ? nch - 1 - (st0 + u) : st0 + u; const size_t item = (size_t)((n0 + n) * 4 + h) * 2 + dir;
            u32x4 w = {pk2(S[0], S[1]), pk2(S[2], S[3]), pk2(S[4], S[5]), pk2(S[6], S[7])};
            *(u32x4*)(DST + item * 8192 + e * 64 + d0) = w;
            S[0] = dc0[u][0] * S[0] + __uint_as_float(ds[u][0] << 16); S[1] = dc0[u][1] * S[1] + __uint_as_float(ds[u][0] & 0xffff0000u);
            S[2] = dc0[u][2] * S[2] + __uint_as_float(ds[u][1] << 16); S[3] = dc0[u][3] * S[3] + __uint_as_float(ds[u][1] & 0xffff0000u);
            S[4] = dc1[u][0] * S[4] + __uint_as_float(ds[u][2] << 16); S[5] = dc1[u][1] * S[5] + __uint_as_float(ds[u][2] & 0xffff0000u);
            S[6] = dc1[u][2] * S[6] + __uint_as_float(ds[u][3] << 16); S[7] = dc1[u][3] * S[7] + __uint_as_float(ds[u][3] & 0xffff0000u); }
    }
}
DEVI void gla_c_item(const GlaLd& L, int item, const bf16_t* QKVR, const bf16_t* DST, const float* outg, bf16_t* MIX, unsigned char* lds, int tid, int wave, int lane) {
    const int n = item >> 2, h = item & 3, tok0 = n * 64, d = tid & 63, sg = tid >> 6, r32 = lane & 31, hi = lane >> 5;
    u32x4 sp[4], rg0, rg1;
#pragma unroll
    for (int p = 0; p < 2; ++p) { const int row = (tid >> 3) + 64 * p, c = tid & 7;
        sp[2 * p] = *(const u32x4*)(DST + (size_t)(item * 2) * 8192 + row * 64 + c * 8); sp[2 * p + 1] = *(const u32x4*)(DST + (size_t)(item * 2 + 1) * 8192 + row * 64 + c * 8); }
    { const bf16_t* rp = QKVR + (size_t)(tok0 + (tid >> 3)) * 1536 + 1024 + h * 128 + 16 * (tid & 7); rg0 = *(const u32x4*)rp; rg1 = *(const u32x4*)(rp + 8); }
    float bF[8], bB[8], totF, totB;
    gla_prefix(L, (float*)(lds + L_SEG), tid, bF, bB, totF, totB);
    bf16_t* QF = (bf16_t*)(lds + L_QF); bf16_t* QB = (bf16_t*)(lds + L_QB); bf16_t* KF = (bf16_t*)(lds + L_KF); bf16_t* KB = (bf16_t*)(lds + L_KB);
#pragma unroll
    for (int i = 0; i < 8; ++i) { const float qv = bf2f(L.qh[i]), kv = bf2f(L.kh[i]);
        const int o = (8 * sg + i) * (GP / 2) + d;
        QF[o] = f2bf(qv * __expf(bF[i])); KF[o] = f2bf(kv * __expf(-bF[i])); QB[o] = f2bf(qv * __expf(bB[i])); KB[o] = f2bf(kv * __expf(-bB[i])); }
    gla_stage_vt(L, lds + L_VT, tid);
#pragma unroll
    for (int p = 0; p < 2; ++p) { const int row = (tid >> 3) + 64 * p, c = tid & 7;
        *(u32x4*)(lds + L_SPF + row * GP + c * 16) = sp[2 * p]; *(u32x4*)(lds + L_SPB + row * GP + c * 16) = sp[2 * p + 1]; }
    LBAR();
    { const int dir = wave >> 2, it = (wave >> 1) & 1, jt = wave & 1;
      const unsigned char* Qd = lds + (dir ? L_QB : L_QF); const unsigned char* Kd = lds + (dir ? L_KB : L_KF);
      f32x16 c = {};
#pragma unroll
      for (int ks = 0; ks < 4; ++ks) c = __builtin_amdgcn_mfma_f32_32x32x16_bf16(ldf(Qd, 32 * it + r32, ks, hi), ldf(Kd, 32 * jt + r32, ks, hi), c, 0, 0, 0);
      bf16_t* AT = (bf16_t*)(lds + (dir ? L_ATB : L_ATF));
      const int j = 32 * jt + r32;
#pragma unroll
      for (int r = 0; r < 16; ++r) { const int i = 32 * it + crow(r, hi); const bool keep = dir ? (j >= i) : (j <= i); AT[i * (GP / 2) + j] = f2bf(keep ? c[r] : 0.f); } }
    LBAR();
    { const int it = wave >> 2, et = wave & 3;
      f32x16 o = {};
#pragma unroll
      for (int dir = 0; dir < 2; ++dir) {
          const unsigned char* AT = lds + (dir ? L_ATB : L_ATF); const unsigned char* Qd = lds + (dir ? L_QB : L_QF); const unsigned char* SPd = lds + (dir ? L_SPB : L_SPF);
#pragma unroll
          for (int ks = 0; ks < 4; ++ks) o = __builtin_amdgcn_mfma_f32_32x32x16_bf16(ldf(AT, 32 * it + r32, ks, hi), ldf(lds + L_VT, 32 * et + r32, ks, hi), o, 0, 0, 0);
#pragma unroll
          for (int ks = 0; ks < 4; ++ks) o = __builtin_amdgcn_mfma_f32_32x32x16_bf16(ldf(Qd, 32 * it + r32, ks, hi), ldf(SPd, 32 * et + r32, ks, hi), o, 0, 0, 0); }
      LBAR();
      float* OB = (float*)lds;
#pragma unroll
      for (int r = 0; r < 16; ++r) OB[(32 * it + crow(r, hi)) * 132 + 32 * et + r32] = o[r]; }
    LBAR();
    { const int i = tid >> 3, s8 = tid & 7; const float* OB = (const float*)lds + i * 132 + 16 * s8;
      f32x4 v[4]; float ss = 0.f;
#pragma unroll
      for (int q = 0; q < 4; ++q) { v[q] = *(const f32x4*)(OB + 4 * q); ss += (v[q].x * v[q].x + v[q].y * v[q].y) + (v[q].z * v[q].z + v[q].w * v[q].w); }
      ss += __shfl_xor(ss, 1); ss += __shfl_xor(ss, 2); ss += __shfl_xor(ss, 4);
      const float rstd = rsqrtf(ss * (1.f / 128.f) + EPS);
      const int tok = tok0 + i;
      const u32x4 r0 = rg0, r1 = rg1;
      float y[16];
#pragma unroll
      for (int q = 0; q < 4; ++q) { const f32x4 g = *(const f32x4*)(outg + 16 * s8 + 4 * q);
          const unsigned w0 = q < 2 ? r0[2 * q] : r1[2 * (q - 2)], w1 = q < 2 ? r0[2 * q + 1] : r1[2 * (q - 2) + 1];
          y[4 * q + 0] = v[q].x * rstd * g.x * silu(__uint_as_float(w0 << 16)); y[4 * q + 1] = v[q].y * rstd * g.y * silu(__uint_as_float(w0 & 0xffff0000u));
          y[4 * q + 2] = v[q].z * rstd * g.z * silu(__uint_as_float(w1 << 16)); y[4 * q + 3] = v[q].w * rstd * g.w * silu(__uint_as_float(w1 & 0xffff0000u)); }
      u32x4 a = {pk2(y[0], y[1]), pk2(y[2], y[3]), pk2(y[4], y[5]), pk2(y[6], y[7])}, b = {pk2(y[8], y[9]), pk2(y[10], y[11]), pk2(y[12], y[13]), pk2(y[14], y[15])};
      bf16_t* mp = MIX + (size_t)tok * 1024 + h * 128 + 16 * s8;
      *(u32x4*)mp = a; *(u32x4*)(mp + 8) = b; }
    LBAR();
}

DEVI void p_qkrope(bf16_t* Q, bf16_t* K, const float* qg, const float* kg, const float2* rope, int gw, int NGW, int lane) {
    const int i = lane & 31, hh = lane >> 5;
    float gq[4], gk[4];
#pragma unroll
    for (int j = 0; j < 4; ++j) { gq[j] = qg[32 * j + i]; gk[j] = kg[32 * j + i]; }
    for (int t0 = gw * 4; t0 < TT; t0 += NGW * 4) {
        bf16_t xr[4][5][4]; float2 rr[4], rc[4];
#pragma unroll
        for (int u = 0; u < 4; ++u) { const int t = t0 + u, s = t < TP ? (t & 4095) : ((t - TP) & 2047);
            rr[u] = rope[(s >> 6) * 32 + i]; rc[u] = rope[(s & 63) * 32 + i];
#pragma unroll
            for (int p = 0; p < 5; ++p) { const int slot = 2 * p + hh;
                const bf16_t* base = slot < 8 ? Q + (size_t)t * 1024 + slot * 128 : K + (size_t)t * 256 + (slot - 8) * 128;
#pragma unroll
                for (int j = 0; j < 4; ++j) xr[u][p][j] = base[32 * j + i]; } }
#pragma unroll
        for (int u = 0; u < 4; ++u) { const int t = t0 + u;
#pragma unroll
            for (int p = 0; p < 5; ++p) {
                const int slot = 2 * p + hh;
                bf16_t* base = slot < 8 ? Q + (size_t)t * 1024 + slot * 128 : K + (size_t)t * 256 + (slot - 8) * 128;
                float x[4]; float ss = 0.f;
#pragma unroll
                for (int j = 0; j < 4; ++j) { x[j] = bf2f(xr[u][p][j]); ss += x[j] * x[j]; }
                ss += __shfl_xor(ss, 1); ss += __shfl_xor(ss, 2); ss += __shfl_xor(ss, 4); ss += __shfl_xor(ss, 8); ss += __shfl_xor(ss, 16);
                const float rstd = rsqrtf(ss * (1.f / 128.f) + EPS);
#pragma unroll
                for (int j = 0; j < 4; ++j) x[j] *= rstd * (slot < 8 ? gq[j] : gk[j]);
                base[i] = f2bf(x[0] * rr[u].x - x[1] * rr[u].y); base[32 + i] = f2bf(x[1] * rr[u].x + x[0] * rr[u].y);
                base[64 + i] = f2bf(x[2] * rc[u].x - x[3] * rc[u].y); base[96 + i] = f2bf(x[3] * rc[u].x + x[2] * rc[u].y);
            } }
    }
}
namespace attn {
using bf16 = unsigned short;
constexpr int   D = 128, NW = 8, QBLK = 32, KVBLK = 64;
constexpr float SCALE = 0.088388347648318440f;
constexpr float THR = 8.f;
constexpr int SDEPTH = 2;
constexpr int LDQ = 1024, LDK = 256, LDO = 1024;
constexpr size_t SHM_V = KVBLK * D * 2, SHM_K = KVBLK * D * 2, SHM_ATTN = 2 * SHM_V + 2 * SHM_K + NW * 64 * 4;
using bf16x8 = __attribute__((ext_vector_type(8))) short;
using s16x4  = __attribute__((ext_vector_type(4))) short;
using f32x16 = __attribute__((ext_vector_type(16))) float;
using f32x8  = __attribute__((ext_vector_type(8))) float;
using u32x4  = __attribute__((ext_vector_type(4))) unsigned;
#define KSWZ(row, colB) ((row) * 256 + ((colB) ^ (((row) & 7) << 4)))
#define SBAR() __builtin_amdgcn_sched_barrier(0)
__device__ __forceinline__ int crow(int r, int hi) { return (r & 3) + 8 * (r >> 2) + 4 * hi; }
__device__ __forceinline__ unsigned cvtpk(float lo, float hi) {
  unsigned r; asm volatile("v_cvt_pk_bf16_f32 %0, %1, %2" : "=v"(r) : "v"(lo), "v"(hi)); return r;
}
template <typename TIn> struct Stage;
template <> struct Stage<bf16>  { using T = bf16x8;
  __device__ static __forceinline__ T ld8(const bf16* p) { return *reinterpret_cast<const bf16x8*>(p); }
  __device__ static __forceinline__ bf16x8 tobf(T x) { return x; } };
template <> struct Stage<float> { using T = f32x8;
  __device__ static __forceinline__ T ld8(const float* p) { return *reinterpret_cast<const f32x8*>(p); }
  __device__ static __forceinline__ bf16x8 tobf(T x) {
    u32x4 w = {cvtpk(x[0], x[1]), cvtpk(x[2], x[3]), cvtpk(x[4], x[5]), cvtpk(x[6], x[7])}; return *reinterpret_cast<bf16x8*>(&w); } };

__device__ __forceinline__ void partialSM(f32x16& p0, f32x16& p1, float& m_reg, float& mn, float& alpha) {
  constexpr float C = SCALE * 1.4426950408889634f;
  float pmax = p0[0]; for (int r = 1; r < 16; ++r) pmax = fmaxf(pmax, p0[r]); for (int r = 0; r < 16; ++r) pmax = fmaxf(pmax, p1[r]);
  { auto rr = __builtin_amdgcn_permlane32_swap(__float_as_uint(pmax), __float_as_uint(pmax), false, false);
    pmax = fmaxf(__uint_as_float(rr[0]), __uint_as_float(rr[1])); }
  if (__builtin_expect(__all(pmax - m_reg <= THR / SCALE), 1)) { mn = m_reg; alpha = 1.f; }
  else { mn = fmaxf(m_reg, pmax); alpha = __builtin_amdgcn_exp2f((m_reg - mn) * C); m_reg = mn; }
  float mnC = -mn * C;
  for (int r = 0; r < 16; ++r) p0[r] = fmaf(p0[r], C, mnC); for (int r = 0; r < 16; ++r) p1[r] = fmaf(p1[r], C, mnC);
  for (int r = 0; r < 16; ++r) p0[r] = __builtin_amdgcn_exp2f(p0[r]);
}
__device__ __forceinline__ void finishSM(f32x16& p0, f32x16& p1, float alpha, float& l_reg, bf16x8& pa0, bf16x8& pa1, bf16x8& pa2, bf16x8& pa3) {
  for (int r = 0; r < 16; ++r) p1[r] = __builtin_amdgcn_exp2f(p1[r]);
  float ps = 0; for (int r = 0; r < 16; ++r) ps += p0[r]; for (int r = 0; r < 16; ++r) ps += p1[r];
  { auto rr = __builtin_amdgcn_permlane32_swap(__float_as_uint(ps), __float_as_uint(ps), false, false);
    ps = __uint_as_float(rr[0]) + __uint_as_float(rr[1]); }
  l_reg = l_reg * alpha + ps;
#define PK4(P, BASE, OUT) do { unsigned a0 = cvtpk(P[BASE + 0], P[BASE + 1]), a1 = cvtpk(P[BASE + 2], P[BASE + 3]);   \
    unsigned b0 = cvtpk(P[BASE + 4], P[BASE + 5]), b1 = cvtpk(P[BASE + 6], P[BASE + 7]);                              \
    auto r0 = __builtin_amdgcn_permlane32_swap(a0, b0, false, false); auto r1 = __builtin_amdgcn_permlane32_swap(a1, b1, false, false); \
    u32x4 w = {r0[0], r1[0], r0[1], r1[1]}; OUT = *reinterpret_cast<bf16x8*>(&w); } while (0)
  PK4(p0, 0, pa0); PK4(p0, 8, pa1); PK4(p1, 0, pa2); PK4(p1, 8, pa3);
#undef PK4
}
__device__ __forceinline__ void qkt(f32x16& p0, f32x16& p1, const bf16* Ks, const bf16x8* qr, int r32, int hi) {
  p0 = f32x16{}; p1 = f32x16{};
  for (int d0 = 0; d0 < 8; ++d0) { int cb = (d0 * 16 + hi * 8) * 2;
    bf16x8 b0 = *reinterpret_cast<const bf16x8*>((const char*)Ks + KSWZ(r32, cb));
    bf16x8 b1 = *reinterpret_cast<const bf16x8*>((const char*)Ks + KSWZ(32 + r32, cb));
    p0 = __builtin_amdgcn_mfma_f32_32x32x16_bf16(b0, qr[d0], p0, 0, 0, 0);
    p1 = __builtin_amdgcn_mfma_f32_32x32x16_bf16(b1, qr[d0], p1, 0, 0, 0); }
}
__device__ __forceinline__ int v_st(int k, int c) { const int kk = (k & ~0xC) | ((k & 4) << 1) | ((k & 8) >> 1); return ((kk >> 3) * 4 + (c >> 5)) * 512 + ((kk & 7) * 32 + (c & 31)) * 2; }
__device__ __forceinline__ int v_rd_base(int lane) { return ((lane & 3) << 3) | (((lane >> 2) & 3) << 6) | (((lane >> 4) & 1) << 5) | (((lane >> 5) & 1) << 8); }
constexpr int v_rd_off(int d0, int ks, int half) { return d0 * 512 + ks * 4096 + half * 2048; }
template <int OFF> __device__ __forceinline__ s16x4 tr_read(int vb) {
  s16x4 r; asm volatile("ds_read_b64_tr_b16 %0, %1 offset:%2" : "=&v"(r) : "v"(vb), "i"(OFF) : "memory"); return r;
}
template <int D0> __device__ __forceinline__ void pv_one(f32x16& od, int vb, bf16x8 pa0, bf16x8 pa1, bf16x8 pa2, bf16x8 pa3) {
  const s16x4 l0 = tr_read<v_rd_off(D0, 0, 0)>(vb), h0 = tr_read<v_rd_off(D0, 0, 1)>(vb), l1 = tr_read<v_rd_off(D0, 1, 0)>(vb), h1 = tr_read<v_rd_off(D0, 1, 1)>(vb);
  const s16x4 l2 = tr_read<v_rd_off(D0, 2, 0)>(vb), h2 = tr_read<v_rd_off(D0, 2, 1)>(vb), l3 = tr_read<v_rd_off(D0, 3, 0)>(vb), h3 = tr_read<v_rd_off(D0, 3, 1)>(vb);
  asm volatile("s_waitcnt lgkmcnt(0)" ::: "memory"); SBAR();
#define PK(L, H) (bf16x8){L[0], L[1], L[2], L[3], H[0], H[1], H[2], H[3]}
  od = __builtin_amdgcn_mfma_f32_32x32x16_bf16(pa0, PK(l0, h0), od, 0, 0, 0);
  od = __builtin_amdgcn_mfma_f32_32x32x16_bf16(pa1, PK(l1, h1), od, 0, 0, 0);
  od = __builtin_amdgcn_mfma_f32_32x32x16_bf16(pa2, PK(l2, h2), od, 0, 0, 0);
  od = __builtin_amdgcn_mfma_f32_32x32x16_bf16(pa3, PK(l3, h3), od, 0, 0, 0);
#undef PK
}
__device__ __forceinline__ void pv_d0(f32x16* o, int vb, bf16x8 pa0, bf16x8 pa1, bf16x8 pa2, bf16x8 pa3) {
  pv_one<0>(o[0], vb, pa0, pa1, pa2, pa3); pv_one<1>(o[1], vb, pa0, pa1, pa2, pa3); pv_one<2>(o[2], vb, pa0, pa1, pa2, pa3); pv_one<3>(o[3], vb, pa0, pa1, pa2, pa3);
}

template <typename TQ>
__device__ __forceinline__ void attn_dense_body(const TQ* __restrict__ Qb, const bf16* __restrict__ Kh, const bf16* __restrict__ Vh,
                                                bf16* __restrict__ Ob, int seq, char* lds) {
  using St = Stage<bf16>; using SQ = Stage<TQ>;
  const int tid = threadIdx.x, wid = __builtin_amdgcn_readfirstlane(tid >> 6), lane = tid & 63, r32 = lane & 31, hi = lane >> 5;
  bf16* V_lds = (bf16*)lds; bf16* K_lds = (bf16*)(lds + 2 * SHM_V);
  float* ws = (float*)(lds + 2 * SHM_V + 2 * SHM_K) + wid * 64; float* li_l = ws; float* al_l = ws + 32;
  float m_reg = -1e30f, l_reg = 0; f32x16 o[4] = {}; bf16x8 qr[8];
  const TQ* Qw = Qb + (long)(wid * QBLK + r32) * LDQ + hi * 8;
#pragma unroll
  for (int d0 = 0; d0 < 8; ++d0) qr[d0] = SQ::tobf(SQ::ld8(Qw + d0 * 16));
  const int sr = tid >> 4, sc = (tid & 15) * 8, vst0 = v_st(sr, sc), vst1 = v_st(32 + sr, sc);
  const int vb0 = (int)(uintptr_t)V_lds + v_rd_base(lane);
  struct { typename St::T vs0, vs1, ks0, ks1; } sr_[SDEPTH];
#define SLOAD(i, k0) do { sr_[i].vs0 = St::ld8(&Vh[(long)((k0) + sr) * LDK + sc]); sr_[i].vs1 = St::ld8(&Vh[(long)((k0) + 32 + sr) * LDK + sc]); \
    sr_[i].ks0 = St::ld8(&Kh[(long)((k0) + sr) * LDK + sc]); sr_[i].ks1 = St::ld8(&Kh[(long)((k0) + 32 + sr) * LDK + sc]); } while (0)
#define SWRITE(b, i) do { *(bf16x8*)((char*)V_lds + (b) * SHM_V + vst0) = St::tobf(sr_[i].vs0);          \
    *(bf16x8*)((char*)V_lds + (b) * SHM_V + vst1) = St::tobf(sr_[i].vs1); int kc = sc * 2;               \
    *(bf16x8*)((char*)K_lds + (b) * SHM_K + KSWZ(sr, kc)) = St::tobf(sr_[i].ks0);                       \
    *(bf16x8*)((char*)K_lds + (b) * SHM_K + KSWZ(32 + sr, kc)) = St::tobf(sr_[i].ks1); } while (0)
#define SWAIT() do { if constexpr (SDEPTH == 2) asm volatile("s_waitcnt vmcnt(4)" ::: "memory"); else asm volatile("s_waitcnt vmcnt(0)" ::: "memory"); } while (0)
#define RESC(a) do { if (__any((a) < 1.f)) { if (hi == 0) al_l[r32] = (a); asm volatile("s_waitcnt lgkmcnt(0)" ::: "memory"); \
    for (int d = 0; d < 4; ++d) for (int r = 0; r < 16; ++r) o[d][r] *= al_l[crow(r, hi)]; } } while (0)
  f32x16 pA0, pA1, pB0, pB1; float mnA, mnB, alA, alB; bf16x8 pa0, pa1, pa2, pa3; const int NT = seq / KVBLK;
  constexpr int SE = 0, SO = SDEPTH - 1;
  SLOAD(SE, 0); asm volatile("s_waitcnt vmcnt(0)" ::: "memory"); SWRITE(0, SE); __syncthreads();
  qkt(pA0, pA1, K_lds, qr, r32, hi); partialSM(pA0, pA1, m_reg, mnA, alA);
  SLOAD(SO, KVBLK); if constexpr (SDEPTH == 2) { if (2 < NT) SLOAD(SE, 2 * KVBLK); }
  SWAIT(); SWRITE(1, SO); __syncthreads();
  for (int j = 1; j + 1 < NT; j += 2) {
    SBAR(); qkt(pB0, pB1, (bf16*)((char*)K_lds + SHM_K), qr, r32, hi);
    finishSM(pA0, pA1, alA, l_reg, pa0, pa1, pa2, pa3); SBAR();
    SLOAD(SO, (j + SDEPTH) * KVBLK); SBAR();
    pv_d0(o, vb0, pa0, pa1, pa2, pa3); partialSM(pB0, pB1, m_reg, mnB, alB);
    __syncthreads(); SWAIT(); SWRITE(0, SE);
    RESC(alB); __syncthreads();
    SBAR(); qkt(pA0, pA1, K_lds, qr, r32, hi);
    finishSM(pB0, pB1, alB, l_reg, pa0, pa1, pa2, pa3); SBAR();
    if (SDEPTH == 1 || j + 3 < NT) SLOAD(SE, (j + 1 + SDEPTH) * KVBLK); SBAR();
    pv_d0(o, vb0 + (int)SHM_V, pa0, pa1, pa2, pa3); partialSM(pA0, pA1, m_reg, mnA, alA);
    __syncthreads(); SWAIT(); SWRITE(1, SO);
    RESC(alA); __syncthreads();
  }
  SBAR(); qkt(pB0, pB1, (bf16*)((char*)K_lds + SHM_K), qr, r32, hi);
  finishSM(pA0, pA1, alA, l_reg, pa0, pa1, pa2, pa3); SBAR();
  pv_d0(o, vb0, pa0, pa1, pa2, pa3); partialSM(pB0, pB1, m_reg, mnB, alB);
  __syncthreads(); RESC(alB);
  finishSM(pB0, pB1, alB, l_reg, pa0, pa1, pa2, pa3); SBAR();
  pv_d0(o, vb0 + (int)SHM_V, pa0, pa1, pa2, pa3);
  if (hi == 0) li_l[r32] = l_reg; asm volatile("s_waitcnt lgkmcnt(0)" ::: "memory");
  float rli[16];
#pragma unroll
  for (int r = 0; r < 16; ++r) rli[r] = __builtin_amdgcn_rcpf(li_l[crow(r, hi)]);
  bf16* Ow = Ob + (long)(wid * QBLK) * LDO;
#pragma unroll
  for (int r = 0; r < 16; ++r) { int orow = crow(r, hi);
    for (int d0 = 0; d0 < 4; ++d0) Ow[(long)orow * LDO + d0 * 32 + r32] = (bf16)(cvtpk(o[d0][r] * rli[r], 0.f) & 0xffffu); }
#undef SLOAD
#undef SWRITE
#undef SWAIT
#undef RESC
}

#undef KSWZ
#undef SBAR
}

constexpr int LDS_BYTES = 135168;
struct Args { const float* in[19]; float* out; unsigned char* ws; };
#define LAS3 __attribute__((address_space(3)))

#define RLX_AGENT __ATOMIC_RELAXED, __HIP_MEMORY_SCOPE_AGENT
#define XB_TMO      128
#define XB_XCNT(j)  (256  + 64 * (j))
#define XB_XSUB(j)  (1280 + 64 * (j))
#define XB_XGEN(j)  (2304 + 64 * (j))
#define XB_TOP      3328
#define XB_TOPGEN   3392
#define XCD_BAR_WORDS 3456
#define XB_SPIN_CAP (1u << 18)

__device__ __forceinline__ unsigned xb_ld(unsigned* p)              { return __hip_atomic_load(p, __ATOMIC_RELAXED, __HIP_MEMORY_SCOPE_AGENT); }
__device__ __forceinline__ unsigned xb_add(unsigned* p, unsigned v) { return __hip_atomic_fetch_add(p, v, __ATOMIC_RELAXED, __HIP_MEMORY_SCOPE_AGENT); }
__device__ __forceinline__ unsigned xb_xcc_id() { return (unsigned)__builtin_amdgcn_s_getreg((3 << 11) | 20) & 0xFu; }
#define XB_SPIN(cond, bar) do { unsigned _sp = 0; while (cond) { __builtin_amdgcn_s_sleep(1); \
    if ((++_sp & 255u) == 0u) { if (xb_ld(&(bar)[XB_TMO])) break; if (_sp > XB_SPIN_CAP) { atomicAdd(&(bar)[XB_TMO], 1u); break; } } } } while (0)

struct XcdBarrier {
    unsigned* bar; unsigned x;
    volatile LAS3 unsigned* st;
};

__device__ __forceinline__ XcdBarrier xcd_barrier_post(unsigned* bar, volatile LAS3 unsigned* st) {
    XcdBarrier b; b.bar = bar; b.x = xb_xcc_id(); b.st = st;
    if (threadIdx.x == 0) (void)xb_add(&bar[XB_XCNT(b.x)], 1u);
    return b;
}
__device__ __forceinline__ void xcd_barrier_complete(unsigned* bar, unsigned x, unsigned& nloc, unsigned& nx) {
    const unsigned G = gridDim.x * gridDim.y * gridDim.z;
    unsigned sum, cnt, mine, sp = 0u;
    for (;;) {
        sum = 0u; cnt = 0u; mine = 0u;
#pragma unroll
        for (unsigned j = 0; j < 16; ++j) { const unsigned c = xb_ld(&bar[XB_XCNT(j)]); sum += c; cnt += (c > 0u) ? 1u : 0u; mine = (j == x) ? c : mine; }
        if (sum == G) break;
        __builtin_amdgcn_s_sleep(1);
        if ((++sp & 255u) == 0u) { if (xb_ld(&bar[XB_TMO])) break; if (sp > XB_SPIN_CAP) { atomicAdd(&bar[XB_TMO], 1u); break; } }
    }
    nloc = mine > 0u ? mine : 1u; nx = cnt > 0u ? cnt : 1u;
}

__device__ __forceinline__ void xcd_barrier(const XcdBarrier& b) {
    asm volatile("s_waitcnt vmcnt(0)" ::: "memory");
    __syncthreads();
    if (threadIdx.x == 0) {
        unsigned* bar = b.bar;
        __builtin_amdgcn_s_waitcnt(0);
        unsigned nloc = b.st[0], nx = b.st[1];
        if (nloc == 0u) { xcd_barrier_complete(bar, b.x, nloc, nx); b.st[0] = nloc; b.st[1] = nx; }
        const unsigned old = xb_add(&bar[XB_XSUB(b.x)], 1u);
        const unsigned gen = old / nloc;
        if (old + 1u == (gen + 1u) * nloc) {
            __builtin_amdgcn_fence(__ATOMIC_RELEASE, "agent");
            asm volatile("s_waitcnt vmcnt(0)" ::: "memory");
            const unsigned og = xb_add(&bar[XB_TOP], 1u);
            const unsigned tg = og / nx;
            if (og + 1u == (tg + 1u) * nx) xb_add(&bar[XB_TOPGEN], 1u);
            else XB_SPIN(xb_ld(&bar[XB_TOPGEN]) == tg, bar);
            __builtin_amdgcn_fence(__ATOMIC_ACQUIRE, "agent");
            xb_add(&bar[XB_XGEN(b.x)], 1u);
            asm volatile("s_waitcnt vmcnt(0)" ::: "memory");
        } else {
            XB_SPIN(xb_ld(&bar[XB_XGEN(b.x)]) == gen, bar);
            __builtin_amdgcn_fence(__ATOMIC_ACQUIRE, "agent");
            asm volatile("s_waitcnt vmcnt(0)" ::: "memory");
        }
    }
    __syncthreads();
}

constexpr int MISC_OFF = 131072;
constexpr int CW_BAR = 4096;
typedef const __attribute__((address_space(4))) Args* CArgsP;
#ifndef PHM
#define PHM 0xFFFFFFu
#endif
#ifndef PROBE_GLU
#define PROBE_GLU 0
#endif
#ifndef PROBE_MASK
#define PROBE_MASK 0u
#endif
#define REP(b) for (int rep__ = 0; rep__ < 1 + (int)((PROBE_MASK >> (b)) & 1u); ++rep__)
#ifndef PROBE_ATTN
#define PROBE_ATTN 0
#endif
#define PH(b) ((PHM >> (b)) & 1u)
#define PHASE_VARS \
    CArgsP ap = (CArgsP)__builtin_amdgcn_kernarg_segment_ptr(); asm volatile("" : "+s"(ap)); \
    int tid = threadIdx.x; asm volatile("" : "+v"(tid)); \
    const int lane = tid & 63, wave = __builtin_amdgcn_readfirstlane(tid >> 6); \
    const int G = gridDim.x, bx = blockIdx.x, gw = bx * 8 + wave, NGW = G * 8, gt = bx * 512 + tid, NGT = G * 512; \
    unsigned char* ws = ap->ws; float* out = ap->out; bf16_t* H = (bf16_t*)(ws + WS_H); \
    (void)lane; (void)gw; (void)NGW; (void)gt; (void)NGT; (void)out; (void)H; (void)bx; (void)G;
#define GRID_SYNC_CG() cg::this_grid().sync()
#define GRID_SYNC() do { CArgsP ap_ = (CArgsP)__builtin_amdgcn_kernarg_segment_ptr(); asm volatile("" : "+s"(ap_)); \
    XcdBarrier b_; b_.bar = (unsigned*)(ap_->ws + WS_CTL) + CW_BAR; b_.x = xb_xcc_id(); b_.st = (volatile LAS3 unsigned*)(lds3 + MISC_OFF); xcd_barrier(b_); } while (0)

#define SSQP(k) ((float*)(ws + WS_SSQ) + (size_t)(k) * TT)
template <int LAYER> DEVI void ffn_block(LAS3 unsigned char* lds3) {
    { PHASE_VARS
      for (int rep_ = 0; rep_ < (PROBE_GLU ? 2 : 1); ++rep_) if (PH(18)) { pg8::Gemm g{(const bf16_t*)(ws + WS_XBA), (const bf16_t*)(ws + (LAYER ? WS_W_GU1 : WS_W_GU0)), TT, 2 * FFH, 1024}; pg8::StaticOrder S; S.init(TT, 2 * FFH, G, bx);
        Epi<EM_GLU> E{(bf16_t*)(ws + WS_ACT), nullptr, nullptr, nullptr, nullptr, nullptr, nullptr, nullptr, SSQP(LAYER ? 3 : 1), nullptr, nullptr, nullptr};
        pg8::gemm_phase<Epi<EM_GLU>, pg8::StaticOrder, true, true>(lds3, g, S, E); } }
    GRID_SYNC();
    { PHASE_VARS
      if (PH(19)) { pg8::Gemm g{(const bf16_t*)(ws + WS_ACT), (const bf16_t*)(ws + (LAYER ? WS_W_D1 : WS_W_D0)), TT, 1024, FFH}; pg8::StaticOrder S; S.init(TT, 1024, G, bx);
        if constexpr (LAYER == 0) {
            Epi<EM_RES, true> E{nullptr, nullptr, nullptr, out, nullptr, nullptr, nullptr, nullptr, nullptr, SSQP(2), (bf16_t*)(ws + WS_XBB), ap->in[10]};
            pg8::gemm_phase<Epi<EM_RES, true>, pg8::StaticOrder, true, true>(lds3, g, S, E);
        } else {
            Epi<EM_RES> E{nullptr, nullptr, nullptr, out, nullptr, nullptr, nullptr, nullptr, nullptr, nullptr, nullptr, nullptr};
            pg8::gemm_phase<Epi<EM_RES>, pg8::StaticOrder, true, true>(lds3, g, S, E); } } }
}

__global__ void __launch_bounds__(512, 2) mega_fwd(Args a_unused) {
    extern __shared__ __attribute__((aligned(16))) unsigned char lds[];
    LAS3 unsigned char* lds3 = (LAS3 unsigned char*)lds;
    { if (threadIdx.x < 32) ((LAS3 unsigned*)(lds3 + MISC_OFF))[threadIdx.x] = 0u;
      __syncthreads();
      CArgsP ap0 = (CArgsP)__builtin_amdgcn_kernarg_segment_ptr();
      (void)xcd_barrier_post((unsigned*)(ap0->ws + WS_CTL) + CW_BAR, (volatile LAS3 unsigned*)(lds3 + MISC_OFF)); }
    { PHASE_VARS
      REP(0) if (PH(0)) p_fold(ap->in[3], ap->in[4], ap->in[6], (bf16_t*)(ws + WS_W_FT), (bf16_t*)(ws + WS_W_AB1) + (size_t)1536 * 1024, (float*)lds, gw, NGW, lane);
      REP(0) if (PH(1)) { p_dft((bf16_t*)(ws + WS_C4), (bf16_t*)(ws + WS_S4), 4096, 12, gt, NGT); p_dft((bf16_t*)(ws + WS_C2), (bf16_t*)(ws + WS_S2), 2048, 11, gt, NGT); }
      if (gt < 2048) { const int idx = gt >> 5, i = gt & 31; const float inv = powf(10000.f, -(float)(2 * i) * (1.f / 64.f)); const float ang = (float)idx * inv;
          ((float2*)(ws + WS_ROPE))[gt] = make_float2((float)cos((double)ang), (float)sin((double)ang)); }
      for (int i = gt; i < 3 * TT; i += NGT) SSQP(1)[i] = 0.f;
      REP(0) if (PH(2)) p_prep_fold(ap->in[0], ap->in[1], ap->in[2], (bf16_t*)(ws + WS_XBB), SSQP(0), (bf16_t*)((unsigned char*)out + OUT_HS), (bf16_t*)((unsigned char*)out + OUT_HD), (bf16_t*)(ws + WS_HM), gw, NGW, lane); }
    __syncthreads();
    { PHASE_VARS
      REP(3) if (PH(3)) { float* scr = (float*)(lds + wave * 16384);
      const float* win = ap->in[3];
      for (int it = gw; it < 11008; it += NGW) { int r = it;
          if (tr_mat<0>(r, win, 2080, 0, 1024, 256, (bf16_t*)(ws + WS_W_AB1), 0, 0.125f, scr, lane)) continue;
          if (tr_mat<0>(r, win, 2080, 256, 1024, 1280, (bf16_t*)(ws + WS_W_AB1), 256, 1.f, scr, lane)) continue;
          if (tr_mat<0>(r, ap->in[9], 1024, 0, 1024, 1024, (bf16_t*)(ws + WS_W_ABO), 0, 1.f, scr, lane)) continue;
          if (tr_mat<1>(r, ap->in[16], FFH, 0, 1024, FFH, (bf16_t*)(ws + WS_W_GU0), 0, 1.f, scr, lane)) continue;
          if (tr_mat<2>(r, ap->in[17], FFH, 0, 1024, FFH, (bf16_t*)(ws + WS_W_GU0), 0, 1.f, scr, lane)) continue;
          if (tr_mat<0>(r, ap->in[18], 1024, 0, FFH, 1024, (bf16_t*)(ws + WS_W_D0), 0, 1.f, scr, lane)) continue;
          if (tr_mat<0>(r, ap->in[11], 1536, 0, 1024, 1536, (bf16_t*)(ws + WS_W_QKV), 0, 1.f, scr, lane)) continue;
          if (tr_mat<0>(r, ap->in[14], 1024, 0, 1024, 1024, (bf16_t*)(ws + WS_W_CO), 0, 1.f, scr, lane)) continue;
          if (tr_mat<1>(r, ap->in[16] + (size_t)1024 * FFH, FFH, 0, 1024, FFH, (bf16_t*)(ws + WS_W_GU1), 0, 1.f, scr, lane)) continue;
          if (tr_mat<2>(r, ap->in[17] + (size_t)1024 * FFH, FFH, 0, 1024, FFH, (bf16_t*)(ws + WS_W_GU1), 0, 1.f, scr, lane)) continue;
          if (tr_mat<0>(r, ap->in[18] + (size_t)1024 * FFH, 1024, 0, FFH, 1024, (bf16_t*)(ws + WS_W_D1), 0, 1.f, scr, lane)) continue;
      } } }
    GRID_SYNC_CG();
    { PHASE_VARS
      REP(4) if (PH(4)) { pg8::Gemm g{(const bf16_t*)(ws + WS_XBB), (const bf16_t*)(ws + WS_W_AB1), TT, 2048, 1024}; RotOrder S; S.S.init(TT, 2048, G, bx);
        Epi<EM_AB1> E{(bf16_t*)(ws + WS_QKVR), nullptr, nullptr, (float*)(ws + WS_G), nullptr, nullptr, ap->in[5], ap->in[7], SSQP(0), nullptr, nullptr, nullptr};
        pg8::gemm_phase<Epi<EM_AB1>, RotOrder, true, true>(lds3, g, S, E); } }
    { PHASE_VARS
      REP(5) if (PH(5)) { pg8::Gemm g{(const bf16_t*)(ws + WS_W_FT), (const bf16_t*)((unsigned char*)out + OUT_HS), 1024, 2 * TF, 1024}; FoldOrder S{G, (bx + G / 2) % G};
        Epi<EM_AB1T> E{(bf16_t*)((unsigned char*)out + OUT_YTPC), (bf16_t*)((unsigned char*)out + OUT_YTSC), nullptr, nullptr, nullptr, nullptr, nullptr, nullptr, nullptr, nullptr, nullptr, nullptr};
        pg8::gemm_phase<Epi<EM_AB1T>, FoldOrder, true, true>(lds3, g, S, E); } }
    GRID_SYNC();
    { PHASE_VARS
      REP(6) if (PH(6)) { pg8::Gemm g{(const bf16_t*)(ws + WS_C4), (const bf16_t*)((unsigned char*)out + OUT_YTPC), 2048, 4096, 2048}; pg8::StaticOrder S; S.init(2048, 4096, G, bx);
        Epi<EM_FNETP> E{(bf16_t*)(ws + WS_PCP), nullptr, nullptr, nullptr, nullptr, nullptr, nullptr, nullptr, nullptr, nullptr, nullptr, nullptr};
        pg8::gemm_phase<Epi<EM_FNETP>, pg8::StaticOrder, true, true>(lds3, g, S, E); } }
    { PHASE_VARS
      REP(6) if (PH(6)) { pg8::Gemm g{(const bf16_t*)(ws + WS_S4), (const bf16_t*)((unsigned char*)out + OUT_YTPS), 2048, 4096, 2048}; pg8::StaticOrder S; S.init(2048, 4096, G, (bx + G / 2) % G);
        Epi<EM_FNETP> E{(bf16_t*)(ws + WS_PSP), nullptr, nullptr, nullptr, nullptr, nullptr, nullptr, nullptr, nullptr, nullptr, nullptr, nullptr};
        pg8::gemm_phase<Epi<EM_FNETP>, pg8::StaticOrder, true, true>(lds3, g, S, E); } }
    { PHASE_VARS
      REP(6) if (PH(7)) { pg8::Gemm g{(const bf16_t*)(ws + WS_C2), (const bf16_t*)((unsigned char*)out + OUT_YTSC), 1024, 4096, 1024}; pg8::StaticOrder S; S.init(1024, 4096, G, (bx + G / 2) % G);
        Epi<EM_FNETS> E{(bf16_t*)(ws + WS_PCS), nullptr, nullptr, nullptr, nullptr, nullptr, nullptr, nullptr, nullptr, nullptr, nullptr, nullptr};
        pg8::gemm_phase<Epi<EM_FNETS>, pg8::StaticOrder, true, true>(lds3, g, S, E); } }
    { PHASE_VARS
      REP(6) if (PH(7)) { pg8::Gemm g{(const bf16_t*)(ws + WS_S2), (const bf16_t*)((unsigned char*)out + OUT_YTSS), 1024, 4096, 1024}; pg8::StaticOrder S; S.init(1024, 4096, G, (bx + G / 4) % G);
        Epi<EM_FNETS> E{(bf16_t*)(ws + WS_PSS), nullptr, nullptr, nullptr, nullptr, nullptr, nullptr, nullptr, nullptr, nullptr, nullptr, nullptr};
        pg8::gemm_phase<Epi<EM_FNETS>, pg8::StaticOrder, true, true>(lds3, g, S, E); } }
    { PHASE_VARS
      REP(8) if (PH(8)) { const int half = G / 2;
        const bf16_t* QKVR = (const bf16_t*)(ws + WS_QKVR); const float* Gb = (const float*)(ws + WS_G); bf16_t* DST = (bf16_t*)((unsigned char*)out + OUT_DST); float* DEC = (float*)(ws + WS_DEC);
        const int first = bx < half ? bx : 1920 + bx - half, last = bx < half ? 1920 : 3072;
        GlaLd A; gla_load<false>(A, first, QKVR, Gb, DST, tid);
        for (int item = first; item < last; item += half) { GlaLd B; const int nx = item + half < last ? item + half : item;
            gla_load<false>(B, nx, QKVR, Gb, DST, tid);
            gla_a_item(A, item, DST, DEC, lds, tid, wave, lane); A = B; } }
      p_ymid((const bf16_t*)(ws + WS_HM), (const bf16_t*)(ws + WS_W_FT), (float*)(ws + WS_YMID), gw, NGW, lane); }
    GRID_SYNC();
    { PHASE_VARS
      if (PH(9)) for (int g2 = gt; g2 < 131072; g2 += NGT) p_scan((bf16_t*)((unsigned char*)out + OUT_DST), (const float*)(ws + WS_DEC), g2);
      p_fcombine((const bf16_t*)(ws + WS_PCP), (const bf16_t*)(ws + WS_PSP), (const float*)(ws + WS_YMID), H, 0, 4096, 11, gt, NGT);
      p_fcombine((const bf16_t*)(ws + WS_PCS), (const bf16_t*)(ws + WS_PSS), (const float*)(ws + WS_YMID) + 8 * 512, H, TP, 2048, 10, gt, NGT);
      p_fmid((const bf16_t*)((unsigned char*)out + OUT_YTPC), (const float*)(ws + WS_YMID), H, 0, 4096, gw, NGW, lane);
      p_fmid((const bf16_t*)((unsigned char*)out + OUT_YTSC), (const float*)(ws + WS_YMID) + 8 * 512, H, TP, 2048, gw, NGW, lane); }
    GRID_SYNC();
    { PHASE_VARS
      REP(10) if (PH(10)) { const bf16_t* QKVR = (const bf16_t*)(ws + WS_QKVR); const float* Gb = (const float*)(ws + WS_G); const bf16_t* DST = (const bf16_t*)((unsigned char*)out + OUT_DST);
        GlaLd A; gla_load<true>(A, bx, QKVR, Gb, DST, tid);
        for (int item = bx; item < 3072; item += G) { GlaLd B; const int nx = item + G < 3072 ? item + G : item;
            gla_load<true>(B, nx, QKVR, Gb, DST, tid);
            gla_c_item(A, item, QKVR, DST, ap->in[8], H, lds, tid, wave, lane); A = B; } } }
    GRID_SYNC();
    { PHASE_VARS
      if (PH(11)) { pg8::Gemm g{H, (const bf16_t*)(ws + WS_W_ABO), TT, 1024, 1024}; pg8::StaticOrder S; S.init(TT, 1024, G, bx);
        Epi<EM_RESIN, true> E{nullptr, nullptr, nullptr, out, ap->in[0], ap->in[1], nullptr, nullptr, nullptr, SSQP(1), (bf16_t*)(ws + WS_XBA), ap->in[15]};
        pg8::gemm_phase<Epi<EM_RESIN, true>, pg8::StaticOrder, true, true>(lds3, g, S, E); } }
    GRID_SYNC();
    ffn_block<0>(lds3);
    GRID_SYNC();
    { PHASE_VARS
      if (PH(13)) { pg8::Gemm g{(const bf16_t*)(ws + WS_XBB), (const bf16_t*)(ws + WS_W_QKV), TT, 1536, 1024}; pg8::StaticOrder S; S.init(TT, 1536, G, bx);
        Epi<EM_QKV> E{(bf16_t*)(ws + WS_Q), (bf16_t*)(ws + WS_K), (bf16_t*)(ws + WS_V), nullptr, nullptr, nullptr, nullptr, nullptr, SSQP(2), nullptr, nullptr, nullptr};
        pg8::gemm_phase<Epi<EM_QKV>, pg8::StaticOrder, true, true>(lds3, g, S, E); } }
    GRID_SYNC();
    { PHASE_VARS
      if (PH(14)) p_qkrope((bf16_t*)(ws + WS_Q), (bf16_t*)(ws + WS_K), ap->in[12], ap->in[13], (const float2*)(ws + WS_ROPE), gw, NGW, lane); }
    GRID_SYNC();
    { PHASE_VARS
      if (PH(15)) { const int vx = bx & 7, vi = bx >> 3;
        bf16_t* Qb = (bf16_t*)(ws + WS_Q); bf16_t* Kb = (bf16_t*)(ws + WS_K); bf16_t* Vb = (bf16_t*)(ws + WS_V); bf16_t* AO = (bf16_t*)(ws + WS_AO);
        for (int i6 = 0; i6 < (PROBE_ATTN ? 12 : 6); ++i6) { const int i = i6 % 6;
            int b, kvh, hq, qb, row0, seq;
            if (i < 4) { const int combo = vx * 2 + (i >> 1), u = (i & 1) * 32 + vi; b = combo >> 1; kvh = combo & 1; hq = kvh * 4 + (u >> 4); qb = u & 15; row0 = b * 4096; seq = 4096; }
            else { const int combo = vx * 2 + (i - 4), u = vi; b = combo >> 1; kvh = combo & 1; hq = kvh * 4 + (u >> 3); qb = u & 7; row0 = TP + b * 2048; seq = 2048; }
            attn::attn_dense_body<attn::bf16>(Qb + (size_t)(row0 + qb * 256) * 1024 + hq * 128, Kb + (size_t)row0 * 256 + kvh * 128, Vb + (size_t)row0 * 256 + kvh * 128,
                                              AO + (size_t)(row0 + qb * 256) * 1024 + hq * 128, seq, (char*)lds);
            __syncthreads();
        } } }
    GRID_SYNC();
    { PHASE_VARS
      if (PH(16)) { pg8::Gemm g{(const bf16_t*)(ws + WS_AO), (const bf16_t*)(ws + WS_W_CO), TT, 1024, 1024}; pg8::StaticOrder S; S.init(TT, 1024, G, bx);
        Epi<EM_RES, true> E{nullptr, nullptr, nullptr, out, nullptr, nullptr, nullptr, nullptr, nullptr, SSQP(3), (bf16_t*)(ws + WS_XBA), ap->in[15] + 1024};
        pg8::gemm_phase<Epi<EM_RES, true>, pg8::StaticOrder, true, true>(lds3, g, S, E); } }
    GRID_SYNC();
    ffn_block<1>(lds3);
}

extern "C" void kernel_launch(void* const* d_in, const int* in_sizes, int n_in, void* d_out, int out_size, void* d_ws, size_t ws_size, hipStream_t stream) {
    static int grid = 0;
    if (grid == 0) {
        int dev = 0, cus = 0, per_cu = 0;
        if (n_in != 19 || out_size != TT * DM || ws_size < WS_END) { fprintf(stderr, "kernel_launch: unexpected shapes: n_in %d out %d ws %zu (need %zu)\n", n_in, out_size, ws_size, (size_t)WS_END); grid = -1; return; }
        if (hipGetDevice(&dev) != hipSuccess || hipDeviceGetAttribute(&cus, hipDeviceAttributeMultiprocessorCount, dev) != hipSuccess) { fprintf(stderr, "kernel_launch: device query failed\n"); grid = -1; return; }
        if (hipFuncSetAttribute((const void*)mega_fwd, hipFuncAttributeMaxDynamicSharedMemorySize, LDS_BYTES) != hipSuccess) { fprintf(stderr, "kernel_launch: hipFuncSetAttribute failed\n"); grid = -1; return; }
        if (hipOccupancyMaxActiveBlocksPerMultiprocessor(&per_cu, (const void*)mega_fwd, 512, LDS_BYTES) != hipSuccess || per_cu < 1) fprintf(stderr, "kernel_launch: occupancy query reports %d blocks per CU\n", per_cu);
        (void)hipGetLastError();
        if (cus != 256) { fprintf(stderr, "kernel_launch: built for a 256-CU device, found %d\n", cus); grid = -1; return; }
        grid = 256;
    }
    if (grid < 0) return;
    if (hipMemsetAsync((char*)d_ws + WS_CTL, 0, CTL_BYTES, stream) != hipSuccess) { fprintf(stderr, "kernel_launch: memset failed\n"); return; }
    Args a{};
    for (int i = 0; i < 19; ++i) a.in[i] = (const float*)d_in[i];
    a.out = (float*)d_out; a.ws = (unsigned char*)d_ws;
    void* args[] = {&a};
    const hipError_t e = hipLaunchCooperativeKernel((const void*)mega_fwd, dim3(grid), dim3(512), args, LDS_BYTES, stream);
    if (e != hipSuccess) fprintf(stderr, "kernel_launch: cooperative launch failed: %s\n", hipGetErrorString(e));
}
```

```cpp
#include <hip/hip_runtime.h>
#include <hip/hip_cooperative_groups.h>
#include <cstdio>
#include <cstdint>
namespace cg = cooperative_groups;
#define DEVI __device__ __forceinline__
namespace pg8 {
#define PG8_LAS __attribute__((address_space(3)))
typedef unsigned short bf16_t;
typedef short bf16x8 __attribute__((ext_vector_type(8)));
typedef float f32x4 __attribute__((ext_vector_type(4)));
typedef unsigned u32x4 __attribute__((ext_vector_type(4)));
constexpr int BM = 256, BK = 64, HALF = 128, HTB = HALF * BK * 2  , STAGE_BYTES = 8 * HTB, NXCD = 8, WGM = 8;

__host__ __device__ __forceinline__ int lds_byte(int r, int c) { const int st = (r >> 4) * 2 + (c >> 5), rr = r & 15, cc = c & 31, ob = rr * 64 + cc * 2; return st * 1024 + (ob ^ (((ob >> 9) & 1) << 5)); }
__host__ __device__ __forceinline__ void stage_rc(int b, int& R, int& C) { const int st = b / 1024, sb = b % 1024, swz = sb ^ (((sb >> 9) & 1) << 5); R = (st >> 1) * 16 + swz / 64; C = (st & 1) * 32 + (swz % 64) / 2; }
__host__ __device__ __forceinline__ int perm32(int rho) { const int n = rho >> 4, i = rho & 15; return 8 * (i >> 2) + 4 * n + (i & 3); }

struct Unit { int pm, pn; };
struct Gemm { const bf16_t* A; const bf16_t* Bt; int M, N, K; };

struct StaticOrder {
    int nM, nN, nwg, G, c;
    __host__ __device__ void init(int M, int N, int G_, int c_) { nM = M / BM; nN = N / BM; nwg = nM * nN; G = G_; c = c_; }
    __host__ __device__ bool next(int i, Unit& u) const {
        const long L = (long)i * G + c; if (L >= nwg) return false;
        int wgid = (int)L; { const int q = nwg / NXCD, r = nwg % NXCD, xcd = wgid % NXCD, off = wgid / NXCD; wgid = (xcd < r ? xcd * (q + 1) : r * (q + 1) + (xcd - r) * q) + off; }
        const int nig = WGM * nN, gid = wgid / nig, fm = gid * WGM, gsz = (nM - fm) < WGM ? (nM - fm) : WGM;
        u.pm = fm + ((wgid % nig) % gsz); u.pn = (wgid % nig) / gsz; return true;
    }
    __device__ __forceinline__ void a_ready(const Unit&) const {}
    __device__ __forceinline__ void done(const Unit&) const {}
};

__device__ __forceinline__ unsigned cvt_pk_bf16(float lo, float hi) { unsigned r; asm volatile("v_cvt_pk_bf16_f32 %0, %1, %2" : "=v"(r) : "v"(lo), "v"(hi)); return r; }
template <class Epi, class Sched, bool ALIGN_EPI = false, bool SP2 = false>
__device__ __forceinline__ void gemm_phase(PG8_LAS unsigned char* lds, const Gemm g, const Sched& S, const Epi& E) {
    int tid_ = threadIdx.x; asm volatile("" : "+v"(tid_));
    const int tid = tid_, wid = __builtin_amdgcn_readfirstlane(tid >> 6), lane = tid & 63, wr = wid >> 2, wc = wid & 3, fr = lane & 15, fq = lane >> 4;
    const int K = g.K, nt = K / BK;
    unsigned voffA[2], voffB[2];
#pragma unroll
    for (int i = 0; i < 2; ++i) { int R, C; stage_rc(tid * 16 + i * 8192, R, C); const int Rb = Epi::PERM ? ((R & ~31) + perm32(R & 31)) : R;
        voffA[i] = (unsigned)(R * K + C) * 2u; voffB[i] = (unsigned)(Rb * K + C) * 2u; }
    const size_t kstep = (size_t)(BK * 2);
    const size_t hstep = (size_t)HALF * K * 2;
    const size_t tstep = 2 * hstep;
    const unsigned ldsw = (unsigned)wid * 1024u;
    const int aoff = lds_byte(wr * 64 + fr, fq * 8), boff = lds_byte(wc * 32 + fr, fq * 8);
#define PG8_SA(b, h) (((b) * 2 + (h)) * HTB)
#define PG8_SB(b, h) ((4 + (b) * 2 + (h)) * HTB)
#define PG8_STAGE(bufoff, gbase, voff) do { _Pragma("unroll") for (int _i = 0; _i < 2; ++_i) \
        __builtin_amdgcn_global_load_lds((const unsigned*)((const char*)(gbase) + (voff)[_i]), (PG8_LAS unsigned*)(lds + (bufoff) + ldsw + _i * 8192), 16, 0, 0); } while (0)
#define PG8_LDA(dst, b, h) do { _Pragma("unroll") for (int m = 0; m < 4; ++m) _Pragma("unroll") for (int k = 0; k < 2; ++k) dst[m][k] = *(const PG8_LAS bf16x8*)(lds + PG8_SA(b, h) + aoff + m * 2048 + k * 1024); } while (0)
#define PG8_LDB(dst, b, h) do { _Pragma("unroll") for (int n = 0; n < 2; ++n) _Pragma("unroll") for (int k = 0; k < 2; ++k) dst[n][k] = *(const PG8_LAS bf16x8*)(lds + PG8_SB(b, h) + boff + n * 2048 + k * 1024); } while (0)
#define PG8_MMA(ai, bj, At, Bt) do { __builtin_amdgcn_s_setprio(1); _Pragma("unroll") for (int m = 0; m < 4; ++m) _Pragma("unroll") for (int n = 0; n < 2; ++n) _Pragma("unroll") for (int k = 0; k < 2; ++k) \
        acc[ai][bj][m][n] = __builtin_amdgcn_mfma_f32_16x16x32_bf16(Bt[n][k], At[m][k], acc[ai][bj][m][n], 0, 0, 0); __builtin_amdgcn_s_setprio(0); } while (0)
#define PG8_WAIT_V(n) asm volatile("s_waitcnt vmcnt(" #n ")" ::: "memory")
#define PG8_WAIT_L(n) asm volatile("s_waitcnt lgkmcnt(" #n ")" ::: "memory")
#define PG8_BAR __builtin_amdgcn_s_barrier()
#define PG8_SCHED __builtin_amdgcn_sched_barrier(0)
    Unit cur, nxt; int ui = 0;
    if (!S.next(0, cur)) return;
    f32x4 acc[2][2][4][2];
#pragma unroll
    for (int a = 0; a < 2; ++a)
#pragma unroll
        for (int b = 0; b < 2; ++b)
#pragma unroll
            for (int m = 0; m < 4; ++m)
#pragma unroll
                for (int n = 0; n < 2; ++n) acc[a][b][m][n] = (f32x4){0.f, 0.f, 0.f, 0.f};
    bf16x8 At[4][2], B0[2][2], B1[2][2];
    const char* cA = (const char*)g.A + (size_t)cur.pm * tstep; const char* cB = (const char*)g.Bt + (size_t)cur.pn * tstep;
    S.a_ready(cur);
    if constexpr (SP2) {
        PG8_STAGE(PG8_SB(0, 0), cB, voffB); PG8_STAGE(PG8_SB(0, 1), cB + hstep, voffB); PG8_STAGE(PG8_SA(0, 0), cA, voffA); PG8_STAGE(PG8_SA(0, 1), cA + hstep, voffA);
        if (wr == 1) PG8_BAR;
        PG8_WAIT_V(2); PG8_BAR;
        PG8_STAGE(PG8_SB(1, 0), cB + kstep, voffB); PG8_STAGE(PG8_SA(1, 0), cA + kstep, voffA); PG8_STAGE(PG8_SB(1, 1), cB + hstep + kstep, voffB);
        PG8_WAIT_V(6); PG8_BAR;
    } else {
        PG8_STAGE(PG8_SB(0, 0), cB, voffB); PG8_STAGE(PG8_SA(0, 0), cA, voffA); PG8_STAGE(PG8_SB(0, 1), cB + hstep, voffB); PG8_STAGE(PG8_SA(0, 1), cA + hstep, voffA);
        if (wr == 1) PG8_BAR;
        PG8_WAIT_V(4); PG8_BAR;
        PG8_STAGE(PG8_SB(1, 0), cB + kstep, voffB); PG8_STAGE(PG8_SA(1, 0), cA + kstep, voffA); PG8_STAGE(PG8_SB(1, 1), cB + hstep + kstep, voffB);
        PG8_WAIT_V(6); PG8_BAR;
    }
    for (;;) {
        const bool has_next = S.next(ui + 1, nxt);
        const char* nA = has_next ? (const char*)g.A + (size_t)nxt.pm * tstep : cA; const char* nB = has_next ? (const char*)g.Bt + (size_t)nxt.pn * tstep : cB;
        for (int t = 0; t < nt; t += 2) {
            const bool last = (t == nt - 2);
            const char* a1 = cA + (size_t)(t + 1) * kstep;
            const char* a2 = last ? nA : cA + (size_t)(t + 2) * kstep; const char* b2 = last ? nB : cB + (size_t)(t + 2) * kstep;
            const char* a3 = a2 + kstep; const char* b3 = b2 + kstep;
            if (last && has_next) S.a_ready(nxt);
            if constexpr (SP2) {
            PG8_LDB(B0, 0, 0); PG8_LDB(B1, 0, 1); PG8_SCHED; PG8_LDA(At, 0, 0); PG8_STAGE(PG8_SA(1, 1), a1 + hstep, voffA);
            PG8_WAIT_V(8); PG8_WAIT_L(0); PG8_BAR; PG8_MMA(0, 0, At, B0); PG8_MMA(0, 1, At, B1); PG8_BAR; PG8_SCHED;
            PG8_LDA(At, 0, 1); PG8_STAGE(PG8_SB(0, 0), b2, voffB); PG8_STAGE(PG8_SB(0, 1), b2 + hstep, voffB); PG8_STAGE(PG8_SA(0, 0), a2, voffA);
            PG8_WAIT_V(8); PG8_WAIT_L(0); PG8_BAR; PG8_MMA(1, 0, At, B0); PG8_MMA(1, 1, At, B1); PG8_BAR; PG8_SCHED;
            PG8_LDB(B0, 1, 0); PG8_LDB(B1, 1, 1); PG8_SCHED; PG8_LDA(At, 1, 0); PG8_STAGE(PG8_SA(0, 1), a2 + hstep, voffA);
            PG8_WAIT_V(8); PG8_WAIT_L(0); PG8_BAR; PG8_MMA(0, 0, At, B0); PG8_MMA(0, 1, At, B1); PG8_BAR; PG8_SCHED;
            PG8_LDA(At, 1, 1); PG8_STAGE(PG8_SB(1, 0), b3, voffB); PG8_STAGE(PG8_SB(1, 1), b3 + hstep, voffB); PG8_STAGE(PG8_SA(1, 0), a3, voffA);
            PG8_WAIT_V(8); PG8_WAIT_L(0); PG8_BAR; PG8_MMA(1, 0, At, B0); PG8_MMA(1, 1, At, B1); PG8_BAR; PG8_SCHED;
            } else {
            PG8_LDB(B0, 0, 0); PG8_SCHED; PG8_LDA(At, 0, 0); PG8_STAGE(PG8_SA(1, 1), a1 + hstep, voffA);
            PG8_WAIT_L(8); PG8_BAR; PG8_WAIT_L(0); PG8_MMA(0, 0, At, B0); PG8_BAR; PG8_SCHED;
            PG8_LDB(B1, 0, 1); PG8_STAGE(PG8_SB(0, 0), b2, voffB);
            PG8_BAR; PG8_WAIT_L(0); PG8_MMA(0, 1, At, B1); PG8_BAR;
            PG8_LDA(At, 0, 1); PG8_STAGE(PG8_SA(0, 0), a2, voffA);
            PG8_BAR; PG8_WAIT_L(0); PG8_MMA(1, 0, At, B0); PG8_BAR; PG8_SCHED;
            PG8_STAGE(PG8_SB(0, 1), b2 + hstep, voffB);
            PG8_WAIT_V(6); PG8_BAR; PG8_MMA(1, 1, At, B1); PG8_BAR;
            PG8_LDB(B0, 1, 0); PG8_SCHED; PG8_LDA(At, 1, 0); PG8_STAGE(PG8_SA(0, 1), a2 + hstep, voffA);
            PG8_WAIT_L(8); PG8_BAR; PG8_WAIT_L(0); PG8_MMA(0, 0, At, B0); PG8_BAR; PG8_SCHED;
            PG8_LDB(B1, 1, 1); PG8_STAGE(PG8_SB(1, 0), b3, voffB);
            PG8_BAR; PG8_WAIT_L(0); PG8_MMA(0, 1, At, B1); PG8_BAR;
            PG8_LDA(At, 1, 1); PG8_STAGE(PG8_SA(1, 0), a3, voffA);
            PG8_BAR; PG8_WAIT_L(0); PG8_MMA(1, 0, At, B0); PG8_BAR; PG8_SCHED;
            PG8_STAGE(PG8_SB(1, 1), b3 + hstep, voffB);
            PG8_WAIT_V(6); PG8_BAR; PG8_MMA(1, 1, At, B1); PG8_BAR;
            }
        }
        if constexpr (ALIGN_EPI) { if (wr == 0) PG8_BAR; }
        if constexpr (!Epi::AFTER_DRAIN) { E(acc, cur, wr, wc, fr, fq); S.done(cur); }
        if (!has_next) break;
#pragma unroll
        for (int a = 0; a < 2; ++a)
#pragma unroll
            for (int b = 0; b < 2; ++b)
#pragma unroll
                for (int m = 0; m < 4; ++m)
#pragma unroll
                    for (int n = 0; n < 2; ++n) acc[a][b][m][n] = (f32x4){0.f, 0.f, 0.f, 0.f};
        cur = nxt; cA = nA; cB = nB; ++ui;
        if constexpr (ALIGN_EPI) { if (wr == 1) PG8_BAR; }
    }
    PG8_WAIT_V(0);
    if constexpr (!ALIGN_EPI) { if (wr == 0) PG8_BAR; }
    PG8_BAR;
    if constexpr (Epi::AFTER_DRAIN) { E.fused(acc, cur, wr, wc, fr, fq, lds, wid, lane); S.done(cur); }
#undef PG8_SA
#undef PG8_SB
#undef PG8_STAGE
#undef PG8_LDA
#undef PG8_LDB
#undef PG8_MMA
#undef PG8_WAIT_V
#undef PG8_WAIT_L
#undef PG8_BAR
#undef PG8_SCHED
}
}

typedef unsigned short bf16_t;
typedef short bf16x8 __attribute__((ext_vector_type(8)));
typedef float f32x4 __attribute__((ext_vector_type(4)));
typedef float f32x16 __attribute__((ext_vector_type(16)));
typedef unsigned u32x4 __attribute__((ext_vector_type(4)));
typedef unsigned u32x2 __attribute__((ext_vector_type(2)));
typedef float f32x2_t __attribute__((ext_vector_type(2)));
typedef __bf16 bf16x2_t __attribute__((ext_vector_type(2)));

constexpr int TP = 32768, TS = 16384, TT = TP + TS, DM = 1024, FFH = 2816, SP = 4096, SS = 2048;
constexpr float EPS = 1e-6f;
constexpr size_t MiB = 1u << 20;
constexpr size_t WS_CTL = 0, CTL_BYTES = 64 * 1024;
constexpr size_t WS_ROPE = 1 * MiB;
constexpr size_t WS_W_AB1 = 2 * MiB;
constexpr size_t WS_W_FT = 6 * MiB;
constexpr size_t WS_W_ABO = 8 * MiB;
constexpr size_t WS_W_GU0 = 10 * MiB;
constexpr size_t WS_W_D0 = 21 * MiB;
constexpr size_t WS_W_QKV = 27 * MiB;
constexpr size_t WS_W_CO = 30 * MiB;
constexpr size_t WS_W_GU1 = 32 * MiB;
constexpr size_t WS_W_D1 = 43 * MiB;
constexpr size_t WS_DEC = 49 * MiB;
constexpr size_t WS_C4 = 51 * MiB, WS_S4 = 59 * MiB;
constexpr size_t WS_C2 = 67 * MiB, WS_S2 = 69 * MiB;
constexpr size_t WS_HM = 1 * MiB + 64 * 1024;
constexpr size_t WS_YMID = 1 * MiB + 128 * 1024;
constexpr size_t WS_PCP = 91 * MiB, WS_PSP = 107 * MiB;
constexpr size_t WS_PCS = 123 * MiB, WS_PSS = 131 * MiB;
constexpr size_t WS_SSQ = 1 * MiB + 256 * 1024;
constexpr size_t WS_XBA = 51 * MiB;
constexpr size_t WS_XBB = 147 * MiB;
constexpr size_t WS_H = WS_XBB;
constexpr size_t WS_BIG = 243 * MiB;
constexpr size_t WS_QKVR = WS_BIG;
constexpr size_t WS_G = WS_BIG + 144 * MiB;
constexpr size_t WS_FOLDF = WS_BIG;
constexpr size_t WS_FOLDG = WS_BIG + 4 * MiB;
constexpr size_t WS_ACT = WS_BIG;
constexpr size_t WS_Q = WS_BIG, WS_K = WS_BIG + 96 * MiB, WS_V = WS_BIG + 120 * MiB, WS_AO = WS_BIG + 144 * MiB;
constexpr size_t WS_END = WS_BIG + 264 * MiB;
constexpr size_t OUT_YTPC = 0, OUT_YTPS = 16 * MiB, OUT_YTSC = 32 * MiB, OUT_YTSS = 40 * MiB, OUT_HS = 96 * MiB, OUT_HD = 144 * MiB, OUT_DST = 96 * MiB;
constexpr int TF = 24576, TFP = 16384;

DEVI float bf2f(bf16_t x) { return __uint_as_float(((unsigned)x) << 16); }
DEVI unsigned pk2(float lo, float hi) { f32x2_t v = {lo, hi}; bf16x2_t b = __builtin_convertvector(v, bf16x2_t); return __builtin_bit_cast(unsigned, b); }
DEVI bf16_t f2bf(float f) { return (bf16_t)(pk2(f, 0.f) & 0xffffu); }
DEVI u32x4 pk8(f32x4 a, f32x4 b) { u32x4 w; w.x = pk2(a[0], a[1]); w.y = pk2(a[2], a[3]); w.z = pk2(b[0], b[1]); w.w = pk2(b[2], b[3]); return w; }
DEVI float wave_sum(float v) {
#pragma unroll
    for (int o = 1; o < 64; o <<= 1) v += __shfl_xor(v, o);
    return v;
}
DEVI float logsig(float z) { return fminf(z, 0.f) - __logf(1.f + __expf(-fabsf(z))); }
DEVI float silu(float z) { return z * __builtin_amdgcn_rcpf(1.f + __expf(-z)); }

struct RotOrder { pg8::StaticOrder S;
    DEVI bool next(int i, pg8::Unit& u) const { if (!S.next(i, u)) return false; u.pn = (u.pn + ((u.pm >> 3) % 3)) & 7; return true; }
    DEVI void a_ready(const pg8::Unit&) const {}
    DEVI void done(const pg8::Unit&) const {} };
struct FoldOrder { int G, c;
    DEVI bool next(int i, pg8::Unit& u) const { const int L = i * G + c; if (L >= 384) return false; u.pm = L & 3; u.pn = (L >> 2) + (u.pm >> 1) * 96; return true; }
    DEVI void a_ready(const pg8::Unit&) const {}
    DEVI void done(const pg8::Unit&) const {} };
enum { EM_AB1, EM_AB1T, EM_FNETP, EM_FNETS, EM_RESIN, EM_RES, EM_GLU, EM_QKV };
template <int MODE, bool NEXT = false> struct Epi {
    static constexpr bool PERM = true, AFTER_DRAIN = false;
    bf16_t* O0; bf16_t* O1; bf16_t* O2; float* F0; const float* X0; const float* X1; const float* B0; const float* B1;
    const float* SQI; float* SQO; bf16_t* XBN; const float* GN;
    DEVI float rstd_of(int row) const { return rsqrtf(SQI[row] * (1.f / 1024.f) + EPS); }
    DEVI void operator()(const f32x4 (&acc)[2][2][4][2], const pg8::Unit& u, int wr, int wc, int fr, int fq) const {
        const int rbase = u.pm * 256 + wr * 64 + fr, cb = wc * 32 + 8 * fq;
        f32x4 ga[2][2];
        if constexpr (MODE == EM_AB1) { if (u.pn >= 6) { const float* bias = (u.pn - 6) ? B1 : B0;
#pragma unroll
            for (int bj = 0; bj < 2; ++bj) { ga[bj][0] = *(const f32x4*)(bias + bj * 128 + cb); ga[bj][1] = *(const f32x4*)(bias + bj * 128 + cb + 4); } } }
        float rsv[2][4];
        if constexpr (MODE == EM_AB1 || MODE == EM_GLU || MODE == EM_QKV) {
#pragma unroll
            for (int ai = 0; ai < 2; ++ai)
#pragma unroll
                for (int m = 0; m < 4; ++m) rsv[ai][m] = SQI[rbase + ai * 128 + m * 16];
#pragma unroll
            for (int ai = 0; ai < 2; ++ai)
#pragma unroll
                for (int m = 0; m < 4; ++m) rsv[ai][m] = rsqrtf(rsv[ai][m] * (1.f / 1024.f) + EPS);
        }
#pragma unroll
        for (int ai = 0; ai < 2; ++ai)
#pragma unroll
            for (int m = 0; m < 4; ++m) {
                const int row = rbase + ai * 128 + m * 16;
                float rs = 1.f, ssq = 0.f;
                if constexpr (MODE == EM_AB1 || MODE == EM_GLU || MODE == EM_QKV) rs = rsv[ai][m];
                if constexpr (MODE == EM_GLU) {
                    const f32x4 g0 = acc[ai][0][m][0] * rs, g1 = acc[ai][0][m][1] * rs, u0 = acc[ai][1][m][0] * rs, u1 = acc[ai][1][m][1] * rs;
                    f32x4 a, b;
#pragma unroll
                    for (int j = 0; j < 4; ++j) { a[j] = silu(g0[j]) * u0[j]; b[j] = silu(g1[j]) * u1[j]; }
                    *(u32x4*)(O0 + (size_t)row * FFH + u.pn * 128 + cb) = pk8(a, b);
                } else {
#pragma unroll
                    for (int bj = 0; bj < 2; ++bj) {
                        f32x4 v0 = acc[ai][bj][m][0] * rs, v1 = acc[ai][bj][m][1] * rs;
                        const int c = bj * 128 + cb;
                        if constexpr (MODE == EM_AB1) {
                            if (u.pn < 2) { *(u32x4*)(O0 + (size_t)u.pn * ((size_t)TT * 256) + (size_t)row * 256 + c) = pk8(v0, v1); }
                            else if (u.pn < 6) { *(u32x4*)(O0 + (size_t)(u.pn >> 1) * ((size_t)TT * 512) + (size_t)row * 512 + (u.pn & 1) * 256 + c) = pk8(v0, v1); }
                            else { const int dir = u.pn - 6;
                                const f32x4 b0 = ga[bj][0], b1 = ga[bj][1];
                                f32x4 a, b;
#pragma unroll
                                for (int j = 0; j < 4; ++j) { a[j] = logsig(v0[j] + b0[j]) * 0.0625f; b[j] = logsig(v1[j] + b1[j]) * 0.0625f; }
                                float* gp = F0 + (size_t)row * 512 + dir * 256 + c; *(f32x4*)gp = a; *(f32x4*)(gp + 4) = b; }
                        } else if constexpr (MODE == EM_AB1T) {
                            const int cc = row, part = cc >> 9, t0 = (u.pn - 96 * part) * 256;
                            bf16_t* dst;
                            if (t0 < TFP) { const int b = t0 >> 11, s = (t0 & 2047) + c; dst = O0 + (size_t)part * (4096 * 2048) + (size_t)(b * 512 + (cc & 511)) * 2048 + s; }
                            else { const int tt = t0 - TFP, b = tt >> 10, s = (tt & 1023) + c; dst = O1 + (size_t)part * (4096 * 1024) + (size_t)(b * 512 + (cc & 511)) * 1024 + s; }
                            *(u32x4*)dst = pk8(v0, v1);
                        } else if constexpr (MODE == EM_FNETP) {
                            *(u32x4*)(O0 + ((size_t)(u.pn >> 1) * 2048 + row) * 512 + (u.pn & 1) * 256 + c) = pk8(v0, v1);
                        } else if constexpr (MODE == EM_FNETS) {
                            *(u32x4*)(O0 + ((size_t)(u.pn >> 1) * 1024 + row) * 512 + (u.pn & 1) * 256 + c) = pk8(v0, v1);
                        } else if constexpr (MODE == EM_RESIN) {
                            const float* xp = (row < TP ? X0 + (size_t)row * 1024 : X1 + (size_t)(row - TP) * 1024) + u.pn * 256 + c;
                            const f32x4 x0 = *(const f32x4*)xp + v0, x1 = *(const f32x4*)(xp + 4) + v1;
                            ssq += (x0[0] * x0[0] + x0[1] * x0[1]) + (x0[2] * x0[2] + x0[3] * x0[3]) + (x1[0] * x1[0] + x1[1] * x1[1]) + (x1[2] * x1[2] + x1[3] * x1[3]);
                            *(u32x4*)(XBN + (size_t)row * 1024 + u.pn * 256 + c) = pk8(x0, x1);
                        } else if constexpr (MODE == EM_RES) {
                            bf16_t* rp = XBN + (size_t)row * 1024 + u.pn * 256 + c;
                            const u32x4 w = *(const u32x4*)rp;
                            f32x4 x0 = {__uint_as_float(w[0] << 16), __uint_as_float(w[0] & 0xffff0000u), __uint_as_float(w[1] << 16), __uint_as_float(w[1] & 0xffff0000u)};
                            f32x4 x1 = {__uint_as_float(w[2] << 16), __uint_as_float(w[2] & 0xffff0000u), __uint_as_float(w[3] << 16), __uint_as_float(w[3] & 0xffff0000u)};
                            x0 = x0 + v0; x1 = x1 + v1;
                            if constexpr (NEXT) { ssq += (x0[0] * x0[0] + x0[1] * x0[1]) + (x0[2] * x0[2] + x0[3] * x0[3]) + (x1[0] * x1[0] + x1[1] * x1[1]) + (x1[2] * x1[2] + x1[3] * x1[3]);
                                *(u32x4*)rp = pk8(x0, x1); }
                            else { float* op = F0 + (size_t)row * 1024 + u.pn * 256 + c; *(f32x4*)op = x0; *(f32x4*)(op + 4) = x1; }
                        } else if constexpr (MODE == EM_QKV) {
                            bf16_t* dst;
                            if (u.pn < 4) dst = O0 + (size_t)row * 1024 + u.pn * 256 + c;
                            else if (u.pn == 4) dst = O1 + (size_t)row * 256 + c;
                            else dst = O2 + (size_t)row * 256 + c;
                            *(u32x4*)dst = pk8(v0, v1);
                        }
                    }
                    if constexpr (MODE == EM_RESIN || (MODE == EM_RES && NEXT)) { ssq += __shfl_xor(ssq, 16); ssq += __shfl_xor(ssq, 32); if (fq == 0) atomicAdd(SQO + row, ssq); }
                }
            }
    }
};

DEVI void p_fold(const float* win, const float* upf, const float* upb, bf16_t* WFT, bf16_t* WG, float* tab, int gw, int NGW, int lane) {
    if (threadIdx.x < 128) tab[threadIdx.x] = cospif((float)threadIdx.x * (1.f / 64.f));
    __syncthreads();
    for (int it = gw; it < 1024 * 16; it += NGW) {
        const int k = it >> 4, cb = it & 15, cc = cb * 64 + lane, part = cc >> 9, g = (cc >> 7) & 3, l = cc & 127;
        const float* wr = win + (size_t)k * 2080 + 1568 + g * 128;
        const int sh = part ? 96 : 0;
        float acc = 0.f;
#pragma unroll 8
        for (int w = 0; w < 128; ++w) acc += wr[w] * tab[(w * l + sh) & 127];
        WFT[(size_t)cc * 1024 + k] = f2bf(acc);
    }
    for (int it = gw; it < 1024 * 8; it += NGW) {
        const int k = it >> 3, nb = it & 7, n = nb * 64 + lane, dir = n >> 8, nn = n & 255;
        const float* wr = win + (size_t)k * 2080 + 1536 + dir * 16;
        const float* up = dir ? upb : upf;
        float acc = 0.f;
#pragma unroll
        for (int r = 0; r < 16; ++r) acc += wr[r] * up[r * 256 + nn];
        WG[(size_t)n * 1024 + k] = f2bf(acc);
    }
    __syncthreads();
}
DEVI void p_dft(bf16_t* C, bf16_t* Sn, int S, int logS, int gt, int NGT) {
    const int lri = logS - 4;
    const long total = (long)(S / 2) << lri;
    const float nrm = rsqrtf((float)S * 128.f), xs = 2.f / (float)S;
    for (long it = gt; it < 2 * total; it += NGT) {
        const int part = it >= total; const long i2 = part ? it - total : it;
        const int k = (int)(i2 >> lri), s0 = (int)(i2 & ((1 << lri) - 1)) * 8;
        float v[8];
#pragma unroll
        for (int j = 0; j < 8; ++j) { const int idx = (k * (s0 + j)) & (S - 1); const float x = (float)idx * xs; v[j] = (part ? sinpif(x) : cospif(x)) * nrm; }
        u32x4 w; w.x = pk2(v[0], v[1]); w.y = pk2(v[2], v[3]); w.z = pk2(v[4], v[5]); w.w = pk2(v[6], v[7]);
        *(u32x4*)((part ? Sn : C) + (size_t)k * (S / 2) + s0) = w;
    }
}
DEVI void p_fcombine(const bf16_t* PC, const bf16_t* PS, const float* YM, bf16_t* MIX, int tokbase, int S, int logSH, int gt, int NGT) {
    const float nrm = rsqrtf((float)S * 128.f);
    const int total = 8 << (logSH + 6);
    for (int it0 = gt; it0 < total; it0 += 4 * NGT) {
        u32x4 pc[4], ps[4];
#pragma unroll
        for (int u = 0; u < 4; ++u) { const int it = it0 + u * NGT, ch = it & 63, k = (it >> 6) & ((1 << logSH) - 1), b = it >> (6 + logSH);
            pc[u] = *(const u32x4*)(PC + ((size_t)(b << logSH) + k) * 512 + ch * 8); ps[u] = *(const u32x4*)(PS + ((size_t)(b << logSH) + k) * 512 + ch * 8); }
#pragma unroll
        for (int u = 0; u < 4; ++u) { const int it = it0 + u * NGT, ch = it & 63, k = (it >> 6) & ((1 << logSH) - 1), b = it >> (6 + logSH);
            u32x4 lo, hi; const float sg = (k & 1) ? -nrm : nrm;
            const f32x4 m0 = *(const f32x4*)(YM + b * 512 + ch * 8), m1 = *(const f32x4*)(YM + b * 512 + ch * 8 + 4);
#pragma unroll
            for (int j = 0; j < 4; ++j) { const float c0 = __uint_as_float(pc[u][j] << 16), c1 = __uint_as_float(pc[u][j] & 0xffff0000u), s0 = __uint_as_float(ps[u][j] << 16), s1 = __uint_as_float(ps[u][j] & 0xffff0000u);
                const float e0 = sg * (j < 2 ? m0[2 * j] : m1[2 * j - 4]), e1 = sg * (j < 2 ? m0[2 * j + 1] : m1[2 * j - 3]);
                lo[j] = pk2(c0 - s0 + e0, c1 - s1 + e1); hi[j] = pk2(c0 + s0 + e0, c1 + s1 + e1); }
            *(u32x4*)(MIX + (size_t)(tokbase + b * S + k) * 1024 + 512 + ch * 8) = lo;
            if (k) *(u32x4*)(MIX + (size_t)(tokbase + b * S + S - k) * 1024 + 512 + ch * 8) = hi; }
    }
}
DEVI void p_fmid(const bf16_t* YC, const float* YM, bf16_t* MIX, int tokbase, int S, int gw, int NGW, int lane) {
    const float nrm = rsqrtf((float)S * 128.f); const int SH = S / 2;
    for (int r = gw; r < 4096; r += NGW) {
        const bf16_t* row = YC + (size_t)r * SH; float acc = 0.f;
        for (int s0 = lane * 8; s0 < SH; s0 += 512) { const u32x4 w = *(const u32x4*)(row + s0);
#pragma unroll
            for (int j = 0; j < 4; ++j) acc += __uint_as_float(w[j] << 16) - __uint_as_float(w[j] & 0xffff0000u); }
        acc = wave_sum(acc);
        if (lane == 0) MIX[(size_t)(tokbase + (r >> 9) * S + SH) * 1024 + 512 + (r & 511)] = f2bf((acc + YM[r]) * nrm);
    }
}
DEVI void p_ymid(const bf16_t* HM, const bf16_t* WFT, float* YM, int gw, int NGW, int lane) {
    for (int it = gw; it < 16 * 512; it += NGW) { const int q = it >> 9, c = it & 511;
        const u32x4 a0 = *(const u32x4*)(HM + q * 1024 + lane * 16), a1 = *(const u32x4*)(HM + q * 1024 + lane * 16 + 8);
        const u32x4 w0 = *(const u32x4*)(WFT + (size_t)c * 1024 + lane * 16), w1 = *(const u32x4*)(WFT + (size_t)c * 1024 + lane * 16 + 8);
        float acc = 0.f;
#pragma unroll
        for (int j = 0; j < 4; ++j) { acc += __uint_as_float(a0[j] << 16) * __uint_as_float(w0[j] << 16) + __uint_as_float(a0[j] & 0xffff0000u) * __uint_as_float(w0[j] & 0xffff0000u);
            acc += __uint_as_float(a1[j] << 16) * __uint_as_float(w1[j] << 16) + __uint_as_float(a1[j] & 0xffff0000u) * __uint_as_float(w1[j] & 0xffff0000u); }
        acc = wave_sum(acc);
        if (lane == 0) YM[it] = acc;
    }
}
DEVI void p_prep_fold(const float* x_p, const float* x_s, const float* gain, bf16_t* XB, float* SQ, bf16_t* HS, bf16_t* HD, bf16_t* HM, int gw, int NGW, int lane) {
    f32x4 gv[4];
#pragma unroll
    for (int j = 0; j < 4; ++j) gv[j] = *((const f32x4*)gain + lane + 64 * j);
    for (int it = gw; it < 8 * 2049 + 8 * 1025; it += NGW) {
        int q, j, S, tb, tfb;
        if (it < 8 * 2049) { q = it / 2049; j = it - q * 2049; S = 4096; tb = q * 4096; tfb = q * 2048; }
        else { const int i2 = it - 8 * 2049; q = i2 / 1025; j = i2 - q * 1025; S = 2048; tb = TP + q * 2048; tfb = TFP + q * 1024; q += 8; }
        const bool pair = j > 0 && j < S / 2;
        const int ra = tb + j, rb = pair ? tb + S - j : ra;
        const f32x4* xa = (const f32x4*)(ra < TP ? x_p + (size_t)ra * DM : x_s + (size_t)(ra - TP) * DM) + lane;
        const f32x4* xb = (const f32x4*)(rb < TP ? x_p + (size_t)rb * DM : x_s + (size_t)(rb - TP) * DM) + lane;
        f32x4 va[4], vb[4]; float sa = 0.f, sb = 0.f;
#pragma unroll
        for (int t = 0; t < 4; ++t) { va[t] = xa[64 * t]; vb[t] = xb[64 * t]; }
#pragma unroll
        for (int t = 0; t < 4; ++t) { sa += (va[t].x * va[t].x + va[t].y * va[t].y) + (va[t].z * va[t].z + va[t].w * va[t].w); sb += (vb[t].x * vb[t].x + vb[t].y * vb[t].y) + (vb[t].z * vb[t].z + vb[t].w * vb[t].w); }
        sa = wave_sum(sa); sb = wave_sum(sb);
        const float rsa = rsqrtf(sa * (1.f / DM) + EPS), rsb = pair ? rsqrtf(sb * (1.f / DM) + EPS) : 0.f;
        if (lane == 0) { SQ[ra] = sa; if (pair) SQ[rb] = sb; }
        u32x2* oa = (u32x2*)(XB + (size_t)ra * DM) + lane; u32x2* ob = (u32x2*)(XB + (size_t)rb * DM) + lane;
        u32x2* os = (u32x2*)((j == S / 2 ? HM + (size_t)q * DM : HS + (size_t)(tfb + j) * DM)) + lane; u32x2* od = (u32x2*)(HD + (size_t)(tfb + (j == S / 2 ? 0 : j)) * DM) + lane;
#pragma unroll
        for (int t = 0; t < 4; ++t) { const f32x4 ga = va[t] * gv[t], gb = vb[t] * gv[t];
            u32x2 w; w.x = pk2(ga.x, ga.y); w.y = pk2(ga.z, ga.w); oa[64 * t] = w;
            if (pair) { w.x = pk2(gb.x, gb.y); w.y = pk2(gb.z, gb.w); ob[64 * t] = w; }
            const f32x4 ha = ga * rsa, hb = gb * rsb;
            w.x = pk2(ha.x + hb.x, ha.y + hb.y); w.y = pk2(ha.z + hb.z, ha.w + hb.w); os[64 * t] = w;
            if (j != S / 2) { w.x = pk2(ha.x - hb.x, ha.y - hb.y); w.y = pk2(ha.z - hb.z, ha.w - hb.w); od[64 * t] = w; } }
    }
}
DEVI void p_norm(const float* src0, const float* src1, const float* gain, bf16_t* H, float* SQ, int gw, int NGW, int lane) {
    f32x4 gv[4];
#pragma unroll
    for (int j = 0; j < 4; ++j) gv[j] = *((const f32x4*)gain + lane + 64 * j);
    for (int m = gw; m < TT; m += NGW) {
        const f32x4* xr = (const f32x4*)(m < TP ? src0 + (size_t)m * DM : src1 + (size_t)(m - TP) * DM) + lane;
        f32x4 v[4]; float s = 0.f;
#pragma unroll
        for (int j = 0; j < 4; ++j) { v[j] = xr[64 * j]; s += (v[j].x * v[j].x + v[j].y * v[j].y) + (v[j].z * v[j].z + v[j].w * v[j].w); }
        const float rstd = 1.f; { const float tot = wave_sum(s); if (lane == 0) SQ[m] = tot; }
        u32x2* o8 = (u32x2*)(H + (size_t)m * DM) + lane;
#pragma unroll
        for (int j = 0; j < 4; ++j) { u32x2 w; w.x = pk2(v[j].x * rstd * gv[j].x, v[j].y * rstd * gv[j].y); w.y = pk2(v[j].z * rstd * gv[j].z, v[j].w * rstd * gv[j].w); o8[64 * j] = w; }
    }
}
DEVI void tr_item(const float* W, int ld, int col0, bf16_t* WT, int Kd, int drow0, float scale, const float* kg, float* scr, int k0, int n0, int lane) {
#pragma unroll 8
    for (int i = 0; i < 32; ++i) { const int kk = 2 * i + (lane >> 5); scr[kk * 33 + (lane & 31)] = W[(size_t)(k0 + kk) * ld + col0 + n0 + (lane & 31)] * (kg ? kg[k0 + kk] : 1.f); }
    asm volatile("s_waitcnt lgkmcnt(0)" ::: "memory");
    const int c = lane & 7;
#pragma unroll
    for (int j = 0; j < 4; ++j) { const int n = (lane >> 3) + 8 * j; const float* s = scr + (8 * c) * 33 + n;
        u32x4 o; o.x = pk2(s[0] * scale, s[33] * scale); o.y = pk2(s[66] * scale, s[99] * scale); o.z = pk2(s[132] * scale, s[165] * scale); o.w = pk2(s[198] * scale, s[231] * scale);
        *(u32x4*)(WT + (size_t)(drow0 + n) * Kd + k0 + 8 * c) = o; }
    asm volatile("s_waitcnt lgkmcnt(0)" ::: "memory");
}
template <int MAP> DEVI bool tr_mat(int& r, const float* W, int ld, int col0, int K, int ncols, bf16_t* WT, int drow, float scale, float* scr, int lane, const float* kg = nullptr) {
    const int nblk = ncols >> 5, cnt = (K >> 6) * nblk;
    if (r >= cnt) { r -= cnt; return false; }
    const int kb = r / nblk, nb = r - kb * nblk, n0 = nb * 32;
    int d0 = drow + n0;
    if (MAP == 1) d0 = (n0 >> 7) * 256 + (n0 & 127);
    if (MAP == 2) d0 = (n0 >> 7) * 256 + 128 + (n0 & 127);
    tr_item(W, ld, col0, WT, K, d0, scale, kg, scr, kb * 64, n0, lane);
    return true;
}

constexpr int GP = 144;
constexpr int L_QF = 0, L_QB = 9216, L_KF = 18432, L_KB = 27648, L_VT = 36864, L_ATF = 55296, L_ATB = 64512, L_SPF = 73728, L_SPB = 92160, L_SEG = 110592;
constexpr int L_KDF = 0, L_KDB = 9216;
DEVI int crow(int r, int hi) { return (r & 3) + 8 * (r >> 2) + 4 * hi; }
DEVI bf16x8 ldf(const unsigned char* base, int row, int ks, int hi) { return *(const bf16x8*)(base + row * GP + ks * 32 + hi * 16); }

#define LBAR() do { asm volatile("s_waitcnt lgkmcnt(0)" ::: "memory"); __builtin_amdgcn_s_barrier(); asm volatile("" ::: "memory"); } while (0)
struct GlaLd { float gf[8], gb[8]; bf16_t qh[8], kh[8], vh[16]; };
template <bool FULL> DEVI void gla_load(GlaLd& L, int item, const bf16_t* QKVR, const float* G, const bf16_t* DST, int tid) {
    const int n = item >> 2, h = item & 3, tok0 = n * 64, d = tid & 63, sg = tid >> 6, e = tid & 127, s4 = tid >> 7;
#pragma unroll
    for (int i = 0; i < 8; ++i) { const float* p = G + (size_t)(tok0 + 8 * sg + i) * 512 + h * 64 + d; L.gf[i] = p[0]; L.gb[i] = p[256]; }
#pragma unroll
    for (int i = 0; i < 8; ++i) { const bf16_t* tr = QKVR + (size_t)(tok0 + 8 * sg + i) * 256 + h * 64 + d; if (FULL) L.qh[i] = tr[0]; L.kh[i] = tr[(size_t)TT * 256]; }
#pragma unroll
    for (int i = 0; i < 16; ++i) L.vh[i] = QKVR[(size_t)TT * 512 + (size_t)(tok0 + 16 * s4 + i) * 512 + h * 128 + e];
}
DEVI void gla_prefix(const GlaLd& L, float* SEG, int tid, float (&bF)[8], float (&bB)[8], float& totF, float& totB) {
    const int d = tid & 63, sg = tid >> 6;
    bF[0] = L.gf[0];
#pragma unroll
    for (int i = 1; i < 8; ++i) bF[i] = bF[i - 1] + L.gf[i];
    bB[7] = L.gb[7];
#pragma unroll
    for (int i = 6; i >= 0; --i) bB[i] = bB[i + 1] + L.gb[i];
    SEG[sg * 64 + d] = bF[7]; SEG[512 + sg * 64 + d] = bB[0];
    LBAR();
    float offF = 0.f, offB = 0.f; totF = 0.f; totB = 0.f;
#pragma unroll
    for (int s = 0; s < 8; ++s) { const float a = SEG[s * 64 + d], b = SEG[512 + s * 64 + d]; totF += a; totB += b; if (s < sg) offF += a; if (s > sg) offB += b; }
#pragma unroll
    for (int i = 0; i < 8; ++i) { bF[i] += offF; bB[i] += offB; }
}
DEVI void gla_stage_vt(const GlaLd& L, unsigned char* VT, int tid) {
    const int e = tid & 127, s4 = tid >> 7;
    unsigned w[8];
#pragma unroll
    for (int i = 0; i < 8; ++i) w[i] = (unsigned)L.vh[2 * i] | ((unsigned)L.vh[2 * i + 1] << 16);
    u32x4 a = {w[0], w[1], w[2], w[3]}, b = {w[4], w[5], w[6], w[7]};
    *(u32x4*)(VT + e * GP + s4 * 32) = a; *(u32x4*)(VT + e * GP + s4 * 32 + 16) = b;
}
DEVI void gla_a_item(const GlaLd& L, int item, bf16_t* DST, float* DEC, unsigned char* lds, int tid, int wave, int lane) {
    const int d = tid & 63, sg = tid >> 6;
    float bF[8], bB[8], totF, totB;
    gla_prefix(L, (float*)(lds + L_SEG), tid, bF, bB, totF, totB);
    float kf[8], kb[8];
#pragma unroll
    for (int i = 0; i < 8; ++i) { const float kk = bf2f(L.kh[i]); kf[i] = kk * __expf(totF - bF[i]); kb[i] = kk * __expf(totB - bB[i]); }
    { u32x4 a = {pk2(kf[0], kf[1]), pk2(kf[2], kf[3]), pk2(kf[4], kf[5]), pk2(kf[6], kf[7])}, b = {pk2(kb[0], kb[1]), pk2(kb[2], kb[3]), pk2(kb[4], kb[5]), pk2(kb[6], kb[7])};
      *(u32x4*)(lds + L_KDF + d * GP + sg * 16) = a; *(u32x4*)(lds + L_KDB + d * GP + sg * 16) = b; }
    if (sg == 0) { DEC[(size_t)(item * 2) * 64 + d] = __expf(totF); DEC[(size_t)(item * 2 + 1) * 64 + d] = __expf(totB); }
    gla_stage_vt(L, lds + L_VT, tid);
    LBAR();
    { const int dir = wave >> 2, et = wave & 3, r32 = lane & 31, hi = lane >> 5;
      const unsigned char* KD = lds + (dir ? L_KDB : L_KDF);
      f32x16 c0 = {}, c1 = {};
#pragma unroll
      for (int ks = 0; ks < 4; ++ks) { const bf16x8 b = ldf(lds + L_VT, 32 * et + r32, ks, hi), a0 = ldf(KD, r32, ks, hi), a1 = ldf(KD, 32 + r32, ks, hi);
          c0 = __builtin_amdgcn_mfma_f32_32x32x16_bf16(a0, b, c0, 0, 0, 0); c1 = __builtin_amdgcn_mfma_f32_32x32x16_bf16(a1, b, c1, 0, 0, 0); }
      bf16_t* dst = DST + (size_t)(item * 2 + dir) * 8192 + (32 * et + r32) * 64 + 4 * hi;
#pragma unroll
      for (int q = 0; q < 4; ++q) { u32x2 w0 = {pk2(c0[4 * q], c0[4 * q + 1]), pk2(c0[4 * q + 2], c0[4 * q + 3])}, w1 = {pk2(c1[4 * q], c1[4 * q + 1]), pk2(c1[4 * q + 2], c1[4 * q + 3])};
          *(u32x2*)(dst + 8 * q) = w0; *(u32x2*)(dst + 32 + 8 * q) = w1; } }
    LBAR();
}
DEVI void p_scan(bf16_t* DST, const float* DEC, int gt) {
    const int combo = gt >> 10, el = gt & 1023, e = el >> 3, d0 = (el & 7) * 8;
    const int seq = combo >> 3, h = (combo >> 1) & 3, dir = combo & 1;
    const int nch = seq < 8 ? 64 : 32, n0 = seq < 8 ? seq * 64 : 512 + (seq - 8) * 32;
    float S[8];
#pragma unroll
    for (int j = 0; j < 8; ++j) S[j] = 0.f;
    for (int st0 = 0; st0 < nch; st0 += 8) {
        u32x4 ds[8]; f32x4 dc0[8], dc1[8];
#pragma unroll
        for (int u = 0; u < 8; ++u) { const int n = dir ? nch - 1 - (st0 + u) : st0 + u; const size_t item = (size_t)((n0 + n) * 4 + h) * 2 + dir;
            ds[u] = *(const u32x4*)(DST + item * 8192 + e * 64 + d0); dc0[u] = *(const f32x4*)(DEC + item * 64 + d0); dc1[u] = *(const f32x4*)(DEC + item * 64 + d0 + 4); }
#pragma unroll
        for (int u = 0; u < 8; ++u) { const int n = dir ? nch - 1 - (st0 + u) : st0 + u; const size_t item = (size_t)((n0 + n) * 4 + h) * 2 + dir;
            u32x4 w = {pk2(S[0], S[1]), pk2(S[2], S[3]), pk2(S[4], S[5]), pk2(S[6], S[7])};
            *(u32x4*)(DST + item * 8192 + e * 64 + d0) = w;
            S[0] = dc0[u][0] * S[0] + __uint_as_float(ds[u][0] << 16); S[1] = dc0[u][1] * S[1] + __uint_as_float(ds[u][0] & 0xffff0000u);
            S[2] = dc0[u][2] * S[2] + __uint_as_float(ds[u][1] << 16); S[3] = dc0[u][3] * S[3] + __uint_as_float(ds[u][1] & 0xffff0000u);
            S[4] = dc1[u][0] * S[4] + __uint_as_float(ds[u][2] << 16); S[5] = dc1[u][1] * S[5] + __uint_as_float(ds[u][2] & 0xffff0000u);
            S[6] = dc1[u][2] * S[6] + __uint_as_float(ds[u][3] << 16); S[7] = dc1[u][3] * S[7] + __uint_as_float(ds[u][3] & 0xffff0000u); }
    }
}
DEVI void gla_c_item(const GlaLd& L, int item, const bf16_t* QKVR, const bf16_t* DST, const float* outg, bf16_t* MIX, unsigned char* lds, int tid, int wave, int lane) {
    const int n = item >> 2, h = item & 3, tok0 = n * 64, d = tid & 63, sg = tid >> 6, r32 = lane & 31, hi = lane >> 5;
    u32x4 sp[4], rg0, rg1;
#pragma unroll
    for (int p = 0; p < 2; ++p) { const int row = (tid >> 3) + 64 * p, c = tid & 7;
        sp[2 * p] = *(const u32x4*)(DST + (size_t)(item * 2) * 8192 + row * 64 + c * 8); sp[2 * p + 1] = *(const u32x4*)(DST + (size_t)(item * 2 + 1) * 8192 + row * 64 + c * 8); }
    { const bf16_t* rp = QKVR + (size_t)TT * 1024 + (size_t)(tok0 + (tid >> 3)) * 512 + h * 128 + 16 * (tid & 7); rg0 = *(const u32x4*)rp; rg1 = *(const u32x4*)(rp + 8); }
    float bF[8], bB[8], totF, totB;
    gla_prefix(L, (float*)(lds + L_SEG), tid, bF, bB, totF, totB);
    bf16_t* QF = (bf16_t*)(lds + L_QF); bf16_t* QB = (bf16_t*)(lds + L_QB); bf16_t* KF = (bf16_t*)(lds + L_KF); bf16_t* KB = (bf16_t*)(lds + L_KB);
#pragma unroll
    for (int i = 0; i < 8; ++i) { const float qv = bf2f(L.qh[i]), kv = bf2f(L.kh[i]);
        const int o = (8 * sg + i) * (GP / 2) + d;
        QF[o] = f2bf(qv * __expf(bF[i])); KF[o] = f2bf(kv * __expf(-bF[i])); QB[o] = f2bf(qv * __expf(bB[i])); KB[o] = f2bf(kv * __expf(-bB[i])); }
    gla_stage_vt(L, lds + L_VT, tid);
#pragma unroll
    for (int p = 0; p < 2; ++p) { const int row = (tid >> 3) + 64 * p, c = tid & 7;
        *(u32x4*)(lds + L_SPF + row * GP + c * 16) = sp[2 * p]; *(u32x4*)(lds + L_SPB + row * GP + c * 16) = sp[2 * p + 1]; }
    LBAR();
    { const int dir = wave >> 2, it = (wave >> 1) & 1, jt = wave & 1;
      const unsigned char* Qd = lds + (dir ? L_QB : L_QF); const unsigned char* Kd = lds + (dir ? L_KB : L_KF);
      f32x16 c = {};
#pragma unroll
      for (int ks = 0; ks < 4; ++ks) c = __builtin_amdgcn_mfma_f32_32x32x16_bf16(ldf(Qd, 32 * it + r32, ks, hi), ldf(Kd, 32 * jt + r32, ks, hi), c, 0, 0, 0);
      bf16_t* AT = (bf16_t*)(lds + (dir ? L_ATB : L_ATF));
      const int j = 32 * jt + r32;
#pragma unroll
      for (int r = 0; r < 16; ++r) { const int i = 32 * it + crow(r, hi); const bool keep = dir ? (j >= i) : (j <= i); AT[i * (GP / 2) + j] = f2bf(keep ? c[r] : 0.f); } }
    LBAR();
    { const int it = wave >> 2, et = wave & 3;
      f32x16 o = {};
#pragma unroll
      for (int dir = 0; dir < 2; ++dir) {
          const unsigned char* AT = lds + (dir ? L_ATB : L_ATF); const unsigned char* Qd = lds + (dir ? L_QB : L_QF); const unsigned char* SPd = lds + (dir ? L_SPB : L_SPF);
#pragma unroll
          for (int ks = 0; ks < 4; ++ks) o = __builtin_amdgcn_mfma_f32_32x32x16_bf16(ldf(AT, 32 * it + r32, ks, hi), ldf(lds + L_VT, 32 * et + r32, ks, hi), o, 0, 0, 0);
#pragma unroll
          for (int ks = 0; ks < 4; ++ks) o = __builtin_amdgcn_mfma_f32_32x32x16_bf16(ldf(Qd, 32 * it + r32, ks, hi), ldf(SPd, 32 * et + r32, ks, hi), o, 0, 0, 0); }
      LBAR();
      float* OB = (float*)lds;
#pragma unroll
      for (int r = 0; r < 16; ++r) OB[(32 * it + crow(r, hi)) * 132 + 32 * et + r32] = o[r]; }
    LBAR();
    { const int i = tid >> 3, s8 = tid & 7; const float* OB = (const float*)lds + i * 132 + 16 * s8;
      f32x4 v[4]; float ss = 0.f;
#pragma unroll
      for (int q = 0; q < 4; ++q) { v[q] = *(const f32x4*)(OB + 4 * q); ss += (v[q].x * v[q].x + v[q].y * v[q].y) + (v[q].z * v[q].z + v[q].w * v[q].w); }
      ss += __shfl_xor(ss, 1); ss += __shfl_xor(ss, 2); ss += __shfl_xor(ss, 4);
      const float rstd = rsqrtf(ss * (1.f / 128.f) + EPS);
      const int tok = tok0 + i;
      const u32x4 r0 = rg0, r1 = rg1;
      float y[16];
#pragma unroll
      for (int q = 0; q < 4; ++q) { const f32x4 g = *(const f32x4*)(outg + 16 * s8 + 4 * q);
          const unsigned w0 = q < 2 ? r0[2 * q] : r1[2 * (q - 2)], w1 = q < 2 ? r0[2 * q + 1] : r1[2 * (q - 2) + 1];
          y[4 * q + 0] = v[q].x * rstd * g.x * silu(__uint_as_float(w0 << 16)); y[4 * q + 1] = v[q].y * rstd * g.y * silu(__uint_as_float(w0 & 0xffff0000u));
          y[4 * q + 2] = v[q].z * rstd * g.z * silu(__uint_as_float(w1 << 16)); y[4 * q + 3] = v[q].w * rstd * g.w * silu(__uint_as_float(w1 & 0xffff0000u)); }
      u32x4 a = {pk2(y[0], y[1]), pk2(y[2], y[3]), pk2(y[4], y[5]), pk2(y[6], y[7])}, b = {pk2(y[8], y[9]), pk2(y[10], y[11]), pk2(y[12], y[13]), pk2(y[14], y[15])};
      bf16_t* mp = MIX + (size_t)tok * 1024 + h * 128 + 16 * s8;
      *(u32x4*)mp = a; *(u32x4*)(mp + 8) = b; }
    LBAR();
}

DEVI void p_qkrope(bf16_t* Q, bf16_t* K, const float* qg, const float* kg, const float2* rope, int gw, int NGW, int lane) {
    const int i = lane & 31, hh = lane >> 5;
    float gq[4], gk[4];
#pragma unroll
    for (int j = 0; j < 4; ++j) { gq[j] = qg[32 * j + i]; gk[j] = kg[32 * j + i]; }
    for (int t0 = gw * 4; t0 < TT; t0 += NGW * 4) {
        bf16_t xr[4][5][4]; float2 rr[4], rc[4];
#pragma unroll
        for (int u = 0; u < 4; ++u) { const int t = t0 + u, s = t < TP ? (t & 4095) : ((t - TP) & 2047);
            rr[u] = rope[(s >> 6) * 32 + i]; rc[u] = rope[(s & 63) * 32 + i];
#pragma unroll
            for (int p = 0; p < 5; ++p) { const int slot = 2 * p + hh;
                const bf16_t* base = slot < 8 ? Q + (size_t)t * 1024 + slot * 128 : K + (size_t)t * 256 + (slot - 8) * 128;
#pragma unroll
                for (int j = 0; j < 4; ++j) xr[u][p][j] = base[32 * j + i]; } }
#pragma unroll
        for (int u = 0; u < 4; ++u) { const int t = t0 + u;
#pragma unroll
            for (int p = 0; p < 5; ++p) {
                const int slot = 2 * p + hh;
                bf16_t* base = slot < 8 ? Q + (size_t)t * 1024 + slot * 128 : K + (size_t)t * 256 + (slot - 8) * 128;
                float x[4]; float ss = 0.f;
#pragma unroll
                for (int j = 0; j < 4; ++j) { x[j] = bf2f(xr[u][p][j]); ss += x[j] * x[j]; }
                ss += __shfl_xor(ss, 1); ss += __shfl_xor(ss, 2); ss += __shfl_xor(ss, 4); ss += __shfl_xor(ss, 8); ss += __shfl_xor(ss, 16);
                const float rstd = rsqrtf(ss * (1.f / 128.f) + EPS);
#pragma unroll
                for (int j = 0; j < 4; ++j) x[j] *= rstd * (slot < 8 ? gq[j] : gk[j]);
                base[i] = f2bf(x[0] * rr[u].x - x[1] * rr[u].y); base[32 + i] = f2bf(x[1] * rr[u].x + x[0] * rr[u].y);
                base[64 + i] = f2bf(x[2] * rc[u].x - x[3] * rc[u].y); base[96 + i] = f2bf(x[3] * rc[u].x + x[2] * rc[u].y);
            } }
    }
}
namespace attn {
using bf16 = unsigned short;
constexpr int   D = 128, NW = 8, QBLK = 32, KVBLK = 64;
constexpr float SCALE = 0.088388347648318440f;
constexpr float THR = 8.f;
constexpr int SDEPTH = 2;
constexpr int LDQ = 1024, LDK = 256, LDO = 1024;
constexpr size_t SHM_V = KVBLK * D * 2, SHM_K = KVBLK * D * 2, SHM_ATTN = 2 * SHM_V + 2 * SHM_K + NW * 64 * 4;
using bf16x8 = __attribute__((ext_vector_type(8))) short;
using s16x4  = __attribute__((ext_vector_type(4))) short;
using f32x16 = __attribute__((ext_vector_type(16))) float;
using f32x8  = __attribute__((ext_vector_type(8))) float;
using u32x4  = __attribute__((ext_vector_type(4))) unsigned;
#define KSWZ(row, colB) ((row) * 256 + ((colB) ^ (((row) & 7) << 4)))
#define SBAR() __builtin_amdgcn_sched_barrier(0)
__device__ __forceinline__ int crow(int r, int hi) { return (r & 3) + 8 * (r >> 2) + 4 * hi; }
__device__ __forceinline__ unsigned cvtpk(float lo, float hi) {
  unsigned r; asm volatile("v_cvt_pk_bf16_f32 %0, %1, %2" : "=v"(r) : "v"(lo), "v"(hi)); return r;
}
template <typename TIn> struct Stage;
template <> struct Stage<bf16>  { using T = bf16x8;
  __device__ static __forceinline__ T ld8(const bf16* p) { return *reinterpret_cast<const bf16x8*>(p); }
  __device__ static __forceinline__ bf16x8 tobf(T x) { return x; } };
template <> struct Stage<float> { using T = f32x8;
  __device__ static __forceinline__ T ld8(const float* p) { return *reinterpret_cast<const f32x8*>(p); }
  __device__ static __forceinline__ bf16x8 tobf(T x) {
    u32x4 w = {cvtpk(x[0], x[1]), cvtpk(x[2], x[3]), cvtpk(x[4], x[5]), cvtpk(x[6], x[7])}; return *reinterpret_cast<bf16x8*>(&w); } };

__device__ __forceinline__ void partialSM(f32x16& p0, f32x16& p1, float& m_reg, float& mn, float& alpha) {
  constexpr float C = SCALE * 1.4426950408889634f;
  float pmax = p0[0]; for (int r = 1; r < 16; ++r) pmax = fmaxf(pmax, p0[r]); for (int r = 0; r < 16; ++r) pmax = fmaxf(pmax, p1[r]);
  { auto rr = __builtin_amdgcn_permlane32_swap(__float_as_uint(pmax), __float_as_uint(pmax), false, false);
    pmax = fmaxf(__uint_as_float(rr[0]), __uint_as_float(rr[1])); }
  if (__builtin_expect(__all(pmax - m_reg <= THR / SCALE), 1)) { mn = m_reg; alpha = 1.f; }
  else { mn = fmaxf(m_reg, pmax); alpha = __builtin_amdgcn_exp2f((m_reg - mn) * C); m_reg = mn; }
  float mnC = -mn * C;
  for (int r = 0; r < 16; ++r) p0[r] = fmaf(p0[r], C, mnC); for (int r = 0; r < 16; ++r) p1[r] = fmaf(p1[r], C, mnC);
  for (int r = 0; r < 16; ++r) p0[r] = __builtin_amdgcn_exp2f(p0[r]);
}
__device__ __forceinline__ void finishSM(f32x16& p0, f32x16& p1, float alpha, float& l_reg, bf16x8& pa0, bf16x8& pa1, bf16x8& pa2, bf16x8& pa3) {
  for (int r = 0; r < 16; ++r) p1[r] = __builtin_amdgcn_exp2f(p1[r]);
  float ps = 0; for (int r = 0; r < 16; ++r) ps += p0[r]; for (int r = 0; r < 16; ++r) ps += p1[r];
  { auto rr = __builtin_amdgcn_permlane32_swap(__float_as_uint(ps), __float_as_uint(ps), false, false);
    ps = __uint_as_float(rr[0]) + __uint_as_float(rr[1]); }
  l_reg = l_reg * alpha + ps;
#define PK4(P, BASE, OUT) do { unsigned a0 = cvtpk(P[BASE + 0], P[BASE + 1]), a1 = cvtpk(P[BASE + 2], P[BASE + 3]);   \
    unsigned b0 = cvtpk(P[BASE + 4], P[BASE + 5]), b1 = cvtpk(P[BASE + 6], P[BASE + 7]);                              \
    auto r0 = __builtin_amdgcn_permlane32_swap(a0, b0, false, false); auto r1 = __builtin_amdgcn_permlane32_swap(a1, b1, false, false); \
    u32x4 w = {r0[0], r1[0], r0[1], r1[1]}; OUT = *reinterpret_cast<bf16x8*>(&w); } while (0)
  PK4(p0, 0, pa0); PK4(p0, 8, pa1); PK4(p1, 0, pa2); PK4(p1, 8, pa3);
#undef PK4
}
__device__ __forceinline__ void qkt(f32x16& p0, f32x16& p1, const bf16* Ks, const bf16x8* qr, int r32, int hi) {
  p0 = f32x16{}; p1 = f32x16{};
  for (int d0 = 0; d0 < 8; ++d0) { int cb = (d0 * 16 + hi * 8) * 2;
    bf16x8 b0 = *reinterpret_cast<const bf16x8*>((const char*)Ks + KSWZ(r32, cb));
    bf16x8 b1 = *reinterpret_cast<const bf16x8*>((const char*)Ks + KSWZ(32 + r32, cb));
    p0 = __builtin_amdgcn_mfma_f32_32x32x16_bf16(b0, qr[d0], p0, 0, 0, 0);
    p1 = __builtin_amdgcn_mfma_f32_32x32x16_bf16(b1, qr[d0], p1, 0, 0, 0); }
}
__device__ __forceinline__ int v_st(int k, int c) { const int kk = (k & ~0xC) | ((k & 4) << 1) | ((k & 8) >> 1); return ((kk >> 3) * 4 + (c >> 5)) * 512 + ((kk & 7) * 32 + (c & 31)) * 2; }
__device__ __forceinline__ int v_rd_base(int lane) { return ((lane & 3) << 3) | (((lane >> 2) & 3) << 6) | (((lane >> 4) & 1) << 5) | (((lane >> 5) & 1) << 8); }
constexpr int v_rd_off(int d0, int ks, int half) { return d0 * 512 + ks * 4096 + half * 2048; }
template <int OFF> __device__ __forceinline__ s16x4 tr_read(int vb) {
  s16x4 r; asm volatile("ds_read_b64_tr_b16 %0, %1 offset:%2" : "=&v"(r) : "v"(vb), "i"(OFF) : "memory"); return r;
}
template <int D0> __device__ __forceinline__ void pv_one(f32x16& od, int vb, bf16x8 pa0, bf16x8 pa1, bf16x8 pa2, bf16x8 pa3) {
  const s16x4 l0 = tr_read<v_rd_off(D0, 0, 0)>(vb), h0 = tr_read<v_rd_off(D0, 0, 1)>(vb), l1 = tr_read<v_rd_off(D0, 1, 0)>(vb), h1 = tr_read<v_rd_off(D0, 1, 1)>(vb);
  const s16x4 l2 = tr_read<v_rd_off(D0, 2, 0)>(vb), h2 = tr_read<v_rd_off(D0, 2, 1)>(vb), l3 = tr_read<v_rd_off(D0, 3, 0)>(vb), h3 = tr_read<v_rd_off(D0, 3, 1)>(vb);
  asm volatile("s_waitcnt lgkmcnt(0)" ::: "memory"); SBAR();
#define PK(L, H) (bf16x8){L[0], L[1], L[2], L[3], H[0], H[1], H[2], H[3]}
  od = __builtin_amdgcn_mfma_f32_32x32x16_bf16(pa0, PK(l0, h0), od, 0, 0, 0);
  od = __builtin_amdgcn_mfma_f32_32x32x16_bf16(pa1, PK(l1, h1), od, 0, 0, 0);
  od = __builtin_amdgcn_mfma_f32_32x32x16_bf16(pa2, PK(l2, h2), od, 0, 0, 0);
  od = __builtin_amdgcn_mfma_f32_32x32x16_bf16(pa3, PK(l3, h3), od, 0, 0, 0);
#undef PK
}
__device__ __forceinline__ void pv_d0(f32x16* o, int vb, bf16x8 pa0, bf16x8 pa1, bf16x8 pa2, bf16x8 pa3) {
  pv_one<0>(o[0], vb, pa0, pa1, pa2, pa3); pv_one<1>(o[1], vb, pa0, pa1, pa2, pa3); pv_one<2>(o[2], vb, pa0, pa1, pa2, pa3); pv_one<3>(o[3], vb, pa0, pa1, pa2, pa3);
}

template <typename TQ>
__device__ __forceinline__ void attn_dense_body(const TQ* __restrict__ Qb, const bf16* __restrict__ Kh, const bf16* __restrict__ Vh,
                                                bf16* __restrict__ Ob, int seq, char* lds) {
  using St = Stage<bf16>; using SQ = Stage<TQ>;
  const int tid = threadIdx.x, wid = __builtin_amdgcn_readfirstlane(tid >> 6), lane = tid & 63, r32 = lane & 31, hi = lane >> 5;
  bf16* V_lds = (bf16*)lds; bf16* K_lds = (bf16*)(lds + 2 * SHM_V);
  float* ws = (float*)(lds + 2 * SHM_V + 2 * SHM_K) + wid * 64; float* li_l = ws; float* al_l = ws + 32;
  float m_reg = -1e30f, l_reg = 0; f32x16 o[4] = {}; bf16x8 qr[8];
  const TQ* Qw = Qb + (long)(wid * QBLK + r32) * LDQ + hi * 8;
#pragma unroll
  for (int d0 = 0; d0 < 8; ++d0) qr[d0] = SQ::tobf(SQ::ld8(Qw + d0 * 16));
  const int sr = tid >> 4, sc = (tid & 15) * 8, vst0 = v_st(sr, sc), vst1 = v_st(32 + sr, sc);
  const int vb0 = (int)(uintptr_t)V_lds + v_rd_base(lane);
  struct { typename St::T vs0, vs1, ks0, ks1; } sr_[SDEPTH];
#define SLOAD(i, k0) do { sr_[i].vs0 = St::ld8(&Vh[(long)((k0) + sr) * LDK + sc]); sr_[i].vs1 = St::ld8(&Vh[(long)((k0) + 32 + sr) * LDK + sc]); \
    sr_[i].ks0 = St::ld8(&Kh[(long)((k0) + sr) * LDK + sc]); sr_[i].ks1 = St::ld8(&Kh[(long)((k0) + 32 + sr) * LDK + sc]); } while (0)
#define SWRITE(b, i) do { *(bf16x8*)((char*)V_lds + (b) * SHM_V + vst0) = St::tobf(sr_[i].vs0);          \
    *(bf16x8*)((char*)V_lds + (b) * SHM_V + vst1) = St::tobf(sr_[i].vs1); int kc = sc * 2;               \
    *(bf16x8*)((char*)K_lds + (b) * SHM_K + KSWZ(sr, kc)) = St::tobf(sr_[i].ks0);                       \
    *(bf16x8*)((char*)K_lds + (b) * SHM_K + KSWZ(32 + sr, kc)) = St::tobf(sr_[i].ks1); } while (0)
#define SWAIT() do { if constexpr (SDEPTH == 2) asm volatile("s_waitcnt vmcnt(4)" ::: "memory"); else asm volatile("s_waitcnt vmcnt(0)" ::: "memory"); } while (0)
#define RESC(a) do { if (__any((a) < 1.f)) { if (hi == 0) al_l[r32] = (a); asm volatile("s_waitcnt lgkmcnt(0)" ::: "memory"); \
    for (int d = 0; d < 4; ++d) for (int r = 0; r < 16; ++r) o[d][r] *= al_l[crow(r, hi)]; } } while (0)
  f32x16 pA0, pA1, pB0, pB1; float mnA, mnB, alA, alB; bf16x8 pa0, pa1, pa2, pa3; const int NT = seq / KVBLK;
  constexpr int SE = 0, SO = SDEPTH - 1;
  SLOAD(SE, 0); asm volatile("s_waitcnt vmcnt(0)" ::: "memory"); SWRITE(0, SE); __syncthreads();
  qkt(pA0, pA1, K_lds, qr, r32, hi); partialSM(pA0, pA1, m_reg, mnA, alA);
  SLOAD(SO, KVBLK); if constexpr (SDEPTH == 2) { if (2 < NT) SLOAD(SE, 2 * KVBLK); }
  SWAIT(); SWRITE(1, SO); __syncthreads();
  for (int j = 1; j + 1 < NT; j += 2) {
    SBAR(); qkt(pB0, pB1, (bf16*)((char*)K_lds + SHM_K), qr, r32, hi);
    finishSM(pA0, pA1, alA, l_reg, pa0, pa1, pa2, pa3); SBAR();
    SLOAD(SO, (j + SDEPTH) * KVBLK); SBAR();
    pv_d0(o, vb0, pa0, pa1, pa2, pa3); partialSM(pB0, pB1, m_reg, mnB, alB);
    __syncthreads(); SWAIT(); SWRITE(0, SE);
    RESC(alB); __syncthreads();
    SBAR(); qkt(pA0, pA1, K_lds, qr, r32, hi);
    finishSM(pB0, pB1, alB, l_reg, pa0, pa1, pa2, pa3); SBAR();
    if (SDEPTH == 1 || j + 3 < NT) SLOAD(SE, (j + 1 + SDEPTH) * KVBLK); SBAR();
    pv_d0(o, vb0 + (int)SHM_V, pa0, pa1, pa2, pa3); partialSM(pA0, pA1, m_reg, mnA, alA);
    __syncthreads(); SWAIT(); SWRITE(1, SO);
    RESC(alA); __syncthreads();
  }
  SBAR(); qkt(pB0, pB1, (bf16*)((char*)K_lds + SHM_K), qr, r32, hi);
  finishSM(pA0, pA1, alA, l_reg, pa0, pa1, pa2, pa3); SBAR();
  pv_d0(o, vb0, pa0, pa1, pa2, pa3); partialSM(pB0, pB1, m_reg, mnB, alB);
  __syncthreads(); RESC(alB);
  finishSM(pB0, pB1, alB, l_reg, pa0, pa1, pa2, pa3); SBAR();
  pv_d0(o, vb0 + (int)SHM_V, pa0, pa1, pa2, pa3);
  if (hi == 0) li_l[r32] = l_reg; asm volatile("s_waitcnt lgkmcnt(0)" ::: "memory");
  float rli[16];
#pragma unroll
  for (int r = 0; r < 16; ++r) rli[r] = __builtin_amdgcn_rcpf(li_l[crow(r, hi)]);
  bf16* Ow = Ob + (long)(wid * QBLK) * LDO;
#pragma unroll
  for (int r = 0; r < 16; ++r) { int orow = crow(r, hi);
    for (int d0 = 0; d0 < 4; ++d0) Ow[(long)orow * LDO + d0 * 32 + r32] = (bf16)(cvtpk(o[d0][r] * rli[r], 0.f) & 0xffffu); }
#undef SLOAD
#undef SWRITE
#undef SWAIT
#undef RESC
}

#undef KSWZ
#undef SBAR
}

constexpr int LDS_BYTES = 135168;
struct Args { const float* in[19]; float* out; unsigned char* ws; };
#define LAS3 __attribute__((address_space(3)))

#define RLX_AGENT __ATOMIC_RELAXED, __HIP_MEMORY_SCOPE_AGENT
#define XB_TMO      128
#define XB_XCNT(j)  (256  + 64 * (j))
#define XB_XSUB(j)  (1280 + 64 * (j))
#define XB_XGEN(j)  (2304 + 64 * (j))
#define XB_TOP      3328
#define XB_TOPGEN   3392
#define XCD_BAR_WORDS 3456
#define XB_SPIN_CAP (1u << 18)

__device__ __forceinline__ unsigned xb_ld(unsigned* p)              { return __hip_atomic_load(p, __ATOMIC_RELAXED, __HIP_MEMORY_SCOPE_AGENT); }
__device__ __forceinline__ unsigned xb_add(unsigned* p, unsigned v) { return __hip_atomic_fetch_add(p, v, __ATOMIC_RELAXED, __HIP_MEMORY_SCOPE_AGENT); }
__device__ __forceinline__ unsigned xb_xcc_id() { return (unsigned)__builtin_amdgcn_s_getreg((3 << 11) | 20) & 0xFu; }
#define XB_SPIN(cond, bar) do { unsigned _sp = 0; while (cond) { __builtin_amdgcn_s_sleep(1); \
    if ((++_sp & 255u) == 0u) { if (xb_ld(&(bar)[XB_TMO])) break; if (_sp > XB_SPIN_CAP) { atomicAdd(&(bar)[XB_TMO], 1u); break; } } } } while (0)

struct XcdBarrier {
    unsigned* bar; unsigned x;
    volatile LAS3 unsigned* st;
};

__device__ __forceinline__ XcdBarrier xcd_barrier_post(unsigned* bar, volatile LAS3 unsigned* st) {
    XcdBarrier b; b.bar = bar; b.x = xb_xcc_id(); b.st = st;
    if (threadIdx.x == 0) (void)xb_add(&bar[XB_XCNT(b.x)], 1u);
    return b;
}
__device__ __forceinline__ void xcd_barrier_complete(unsigned* bar, unsigned x, unsigned& nloc, unsigned& nx) {
    const unsigned G = gridDim.x * gridDim.y * gridDim.z;
    unsigned sum, cnt, mine, sp = 0u;
    for (;;) {
        sum = 0u; cnt = 0u; mine = 0u;
#pragma unroll
        for (unsigned j = 0; j < 16; ++j) { const unsigned c = xb_ld(&bar[XB_XCNT(j)]); sum += c; cnt += (c > 0u) ? 1u : 0u; mine = (j == x) ? c : mine; }
        if (sum == G) break;
        __builtin_amdgcn_s_sleep(1);
        if ((++sp & 255u) == 0u) { if (xb_ld(&bar[XB_TMO])) break; if (sp > XB_SPIN_CAP) { atomicAdd(&bar[XB_TMO], 1u); break; } }
    }
    nloc = mine > 0u ? mine : 1u; nx = cnt > 0u ? cnt : 1u;
}

__device__ __forceinline__ void xcd_barrier(const XcdBarrier& b) {
    asm volatile("s_waitcnt vmcnt(0)" ::: "memory");
    __syncthreads();
    if (threadIdx.x == 0) {
        unsigned* bar = b.bar;
        __builtin_amdgcn_s_waitcnt(0);
        unsigned nloc = b.st[0], nx = b.st[1];
        if (nloc == 0u) { xcd_barrier_complete(bar, b.x, nloc, nx); b.st[0] = nloc; b.st[1] = nx; }
        const unsigned old = xb_add(&bar[XB_XSUB(b.x)], 1u);
        const unsigned gen = old / nloc;
        if (old + 1u == (gen + 1u) * nloc) {
            __builtin_amdgcn_fence(__ATOMIC_RELEASE, "agent");
            asm volatile("s_waitcnt vmcnt(0)" ::: "memory");
            const unsigned og = xb_add(&bar[XB_TOP], 1u);
            const unsigned tg = og / nx;
            if (og + 1u == (tg + 1u) * nx) xb_add(&bar[XB_TOPGEN], 1u);
            else XB_SPIN(xb_ld(&bar[XB_TOPGEN]) == tg, bar);
            __builtin_amdgcn_fence(__ATOMIC_ACQUIRE, "agent");
            xb_add(&bar[XB_XGEN(b.x)], 1u);
            asm volatile("s_waitcnt vmcnt(0)" ::: "memory");
        } else {
            XB_SPIN(xb_ld(&bar[XB_XGEN(b.x)]) == gen, bar);
            __builtin_amdgcn_fence(__ATOMIC_ACQUIRE, "agent");
            asm volatile("s_waitcnt vmcnt(0)" ::: "memory");
        }
    }
    __syncthreads();
}

constexpr int MISC_OFF = 131072;
constexpr int CW_BAR = 4096;
typedef const __attribute__((address_space(4))) Args* CArgsP;
#ifndef PHM
#define PHM 0xFFFFFFu
#endif
#ifndef PROBE_GLU
#define PROBE_GLU 0
#endif
#ifndef PROBE_MASK
#define PROBE_MASK 0u
#endif
#define REP(b) for (int rep__ = 0; rep__ < 1 + (int)((PROBE_MASK >> (b)) & 1u); ++rep__)
#ifndef PROBE_ATTN
#define PROBE_ATTN 0
#endif
#define PH(b) ((PHM >> (b)) & 1u)
#define PHASE_VARS \
    CArgsP ap = (CArgsP)__builtin_amdgcn_kernarg_segment_ptr(); asm volatile("" : "+s"(ap)); \
    int tid = threadIdx.x; asm volatile("" : "+v"(tid)); \
    const int lane = tid & 63, wave = __builtin_amdgcn_readfirstlane(tid >> 6); \
    const int G = gridDim.x, bx = blockIdx.x, gw = bx * 8 + wave, NGW = G * 8, gt = bx * 512 + tid, NGT = G * 512; \
    unsigned char* ws = ap->ws; float* out = ap->out; bf16_t* H = (bf16_t*)(ws + WS_H); \
    (void)lane; (void)gw; (void)NGW; (void)gt; (void)NGT; (void)out; (void)H; (void)bx; (void)G;
#define GRID_SYNC_CG() cg::this_grid().sync()
#define GRID_SYNC() do { CArgsP ap_ = (CArgsP)__builtin_amdgcn_kernarg_segment_ptr(); asm volatile("" : "+s"(ap_)); \
    XcdBarrier b_; b_.bar = (unsigned*)(ap_->ws + WS_CTL) + CW_BAR; b_.x = xb_xcc_id(); b_.st = (volatile LAS3 unsigned*)(lds3 + MISC_OFF); xcd_barrier(b_); } while (0)

#define SSQP(k) ((float*)(ws + WS_SSQ) + (size_t)(k) * TT)
template <int LAYER> DEVI void ffn_block(LAS3 unsigned char* lds3) {
    { PHASE_VARS
      for (int rep_ = 0; rep_ < (PROBE_GLU ? 2 : 1); ++rep_) if (PH(18)) { pg8::Gemm g{(const bf16_t*)(ws + WS_XBA), (const bf16_t*)(ws + (LAYER ? WS_W_GU1 : WS_W_GU0)), TT, 2 * FFH, 1024}; pg8::StaticOrder S; S.init(TT, 2 * FFH, G, bx);
        Epi<EM_GLU> E{(bf16_t*)(ws + WS_ACT), nullptr, nullptr, nullptr, nullptr, nullptr, nullptr, nullptr, SSQP(LAYER ? 3 : 1), nullptr, nullptr, nullptr};
        pg8::gemm_phase<Epi<EM_GLU>, pg8::StaticOrder, true, true>(lds3, g, S, E); } }
    GRID_SYNC();
    { PHASE_VARS
      if (PH(19)) { pg8::Gemm g{(const bf16_t*)(ws + WS_ACT), (const bf16_t*)(ws + (LAYER ? WS_W_D1 : WS_W_D0)), TT, 1024, FFH}; pg8::StaticOrder S; S.init(TT, 1024, G, bx);
        if constexpr (LAYER == 0) {
            Epi<EM_RES, true> E{nullptr, nullptr, nullptr, nullptr, nullptr, nullptr, nullptr, nullptr, nullptr, SSQP(2), (bf16_t*)(ws + WS_XBA), nullptr};
            pg8::gemm_phase<Epi<EM_RES, true>, pg8::StaticOrder, true, true>(lds3, g, S, E);
        } else {
            Epi<EM_RES> E{nullptr, nullptr, nullptr, out, nullptr, nullptr, nullptr, nullptr, nullptr, nullptr, (bf16_t*)(ws + WS_XBA), nullptr};
            pg8::gemm_phase<Epi<EM_RES>, pg8::StaticOrder, true, true>(lds3, g, S, E); } } }
}

__global__ void __launch_bounds__(512, 2) mega_fwd(Args a_unused) {
    extern __shared__ __attribute__((aligned(16))) unsigned char lds[];
    LAS3 unsigned char* lds3 = (LAS3 unsigned char*)lds;
    { if (threadIdx.x < 32) ((LAS3 unsigned*)(lds3 + MISC_OFF))[threadIdx.x] = 0u;
      __syncthreads();
      CArgsP ap0 = (CArgsP)__builtin_amdgcn_kernarg_segment_ptr();
      (void)xcd_barrier_post((unsigned*)(ap0->ws + WS_CTL) + CW_BAR, (volatile LAS3 unsigned*)(lds3 + MISC_OFF)); }
    { PHASE_VARS
      REP(0) if (PH(0)) p_fold(ap->in[3], ap->in[4], ap->in[6], (bf16_t*)(ws + WS_W_FT), (bf16_t*)(ws + WS_W_AB1) + (size_t)1536 * 1024, (float*)lds, gw, NGW, lane);
      REP(0) if (PH(1)) { p_dft((bf16_t*)(ws + WS_C4), (bf16_t*)(ws + WS_S4), 4096, 12, gt, NGT); p_dft((bf16_t*)(ws + WS_C2), (bf16_t*)(ws + WS_S2), 2048, 11, gt, NGT); }
      if (gt < 2048) { const int idx = gt >> 5, i = gt & 31; const float inv = powf(10000.f, -(float)(2 * i) * (1.f / 64.f)); const float ang = (float)idx * inv;
          ((float2*)(ws + WS_ROPE))[gt] = make_float2((float)cos((double)ang), (float)sin((double)ang)); }
      for (int i = gt; i < 3 * TT; i += NGT) SSQP(1)[i] = 0.f;
      REP(0) if (PH(2)) p_prep_fold(ap->in[0], ap->in[1], ap->in[2], (bf16_t*)(ws + WS_XBB), SSQP(0), (bf16_t*)((unsigned char*)out + OUT_HS), (bf16_t*)((unsigned char*)out + OUT_HD), (bf16_t*)(ws + WS_HM), gw, NGW, lane); }
    __syncthreads();
    { PHASE_VARS
      REP(3) if (PH(3)) { float* scr = (float*)(lds + wave * 16384);
      const float* win = ap->in[3];
      for (int it = gw; it < 11008; it += NGW) { int r = it;
          if (tr_mat<0>(r, win, 2080, 0, 1024, 256, (bf16_t*)(ws + WS_W_AB1), 0, 0.125f, scr, lane)) continue;
          if (tr_mat<0>(r, win, 2080, 256, 1024, 1280, (bf16_t*)(ws + WS_W_AB1), 256, 1.f, scr, lane)) continue;
          if (tr_mat<0>(r, ap->in[9], 1024, 0, 1024, 1024, (bf16_t*)(ws + WS_W_ABO), 0, 1.f, scr, lane)) continue;
          if (tr_mat<1>(r, ap->in[16], FFH, 0, 1024, FFH, (bf16_t*)(ws + WS_W_GU0), 0, 1.f, scr, lane, ap->in[15])) continue;
          if (tr_mat<2>(r, ap->in[17], FFH, 0, 1024, FFH, (bf16_t*)(ws + WS_W_GU0), 0, 1.f, scr, lane, ap->in[15])) continue;
          if (tr_mat<0>(r, ap->in[18], 1024, 0, FFH, 1024, (bf16_t*)(ws + WS_W_D0), 0, 1.f, scr, lane)) continue;
          if (tr_mat<0>(r, ap->in[11], 1536, 0, 1024, 1536, (bf16_t*)(ws + WS_W_QKV), 0, 1.f, scr, lane, ap->in[10])) continue;
          if (tr_mat<0>(r, ap->in[14], 1024, 0, 1024, 1024, (bf16_t*)(ws + WS_W_CO), 0, 1.f, scr, lane)) continue;
          if (tr_mat<1>(r, ap->in[16] + (size_t)1024 * FFH, FFH, 0, 1024, FFH, (bf16_t*)(ws + WS_W_GU1), 0, 1.f, scr, lane, ap->in[15] + 1024)) continue;
          if (tr_mat<2>(r, ap->in[17] + (size_t)1024 * FFH, FFH, 0, 1024, FFH, (bf16_t*)(ws + WS_W_GU1), 0, 1.f, scr, lane, ap->in[15] + 1024)) continue;
          if (tr_mat<0>(r, ap->in[18] + (size_t)1024 * FFH, 1024, 0, FFH, 1024, (bf16_t*)(ws + WS_W_D1), 0, 1.f, scr, lane)) continue;
      } } }
    GRID_SYNC_CG();
    { PHASE_VARS
      REP(4) if (PH(4)) { pg8::Gemm g{(const bf16_t*)(ws + WS_XBB), (const bf16_t*)(ws + WS_W_AB1), TT, 2048, 1024}; RotOrder S; S.S.init(TT, 2048, G, bx);
        Epi<EM_AB1> E{(bf16_t*)(ws + WS_QKVR), nullptr, nullptr, (float*)(ws + WS_G), nullptr, nullptr, ap->in[5], ap->in[7], SSQP(0), nullptr, nullptr, nullptr};
        pg8::gemm_phase<Epi<EM_AB1>, RotOrder, true, true>(lds3, g, S, E); } }
    { PHASE_VARS
      REP(5) if (PH(5)) { pg8::Gemm g{(const bf16_t*)(ws + WS_W_FT), (const bf16_t*)((unsigned char*)out + OUT_HS), 1024, 2 * TF, 1024}; FoldOrder S{G, (bx + G / 2) % G};
        Epi<EM_AB1T> E{(bf16_t*)((unsigned char*)out + OUT_YTPC), (bf16_t*)((unsigned char*)out + OUT_YTSC), nullptr, nullptr, nullptr, nullptr, nullptr, nullptr, nullptr, nullptr, nullptr, nullptr};
        pg8::gemm_phase<Epi<EM_AB1T>, FoldOrder, true, true>(lds3, g, S, E); } }
    GRID_SYNC();
    { PHASE_VARS
      REP(6) if (PH(6)) { pg8::Gemm g{(const bf16_t*)(ws + WS_C4), (const bf16_t*)((unsigned char*)out + OUT_YTPC), 2048, 4096, 2048}; pg8::StaticOrder S; S.init(2048, 4096, G, bx);
        Epi<EM_FNETP> E{(bf16_t*)(ws + WS_PCP), nullptr, nullptr, nullptr, nullptr, nullptr, nullptr, nullptr, nullptr, nullptr, nullptr, nullptr};
        pg8::gemm_phase<Epi<EM_FNETP>, pg8::StaticOrder, true, true>(lds3, g, S, E); } }
    { PHASE_VARS
      REP(6) if (PH(6)) { pg8::Gemm g{(const bf16_t*)(ws + WS_S4), (const bf16_t*)((unsigned char*)out + OUT_YTPS), 2048, 4096, 2048}; pg8::StaticOrder S; S.init(2048, 4096, G, (bx + G / 2) % G);
        Epi<EM_FNETP> E{(bf16_t*)(ws + WS_PSP), nullptr, nullptr, nullptr, nullptr, nullptr, nullptr, nullptr, nullptr, nullptr, nullptr, nullptr};
        pg8::gemm_phase<Epi<EM_FNETP>, pg8::StaticOrder, true, true>(lds3, g, S, E); } }
    { PHASE_VARS
      REP(6) if (PH(7)) { pg8::Gemm g{(const bf16_t*)(ws + WS_C2), (const bf16_t*)((unsigned char*)out + OUT_YTSC), 1024, 4096, 1024}; pg8::StaticOrder S; S.init(1024, 4096, G, (bx + G / 2) % G);
        Epi<EM_FNETS> E{(bf16_t*)(ws + WS_PCS), nullptr, nullptr, nullptr, nullptr, nullptr, nullptr, nullptr, nullptr, nullptr, nullptr, nullptr};
        pg8::gemm_phase<Epi<EM_FNETS>, pg8::StaticOrder, true, true>(lds3, g, S, E); } }
    { PHASE_VARS
      REP(6) if (PH(7)) { pg8::Gemm g{(const bf16_t*)(ws + WS_S2), (const bf16_t*)((unsigned char*)out + OUT_YTSS), 1024, 4096, 1024}; pg8::StaticOrder S; S.init(1024, 4096, G, (bx + G / 4) % G);
        Epi<EM_FNETS> E{(bf16_t*)(ws + WS_PSS), nullptr, nullptr, nullptr, nullptr, nullptr, nullptr, nullptr, nullptr, nullptr, nullptr, nullptr};
        pg8::gemm_phase<Epi<EM_FNETS>, pg8::StaticOrder, true, true>(lds3, g, S, E); } }
    { PHASE_VARS
      REP(8) if (PH(8)) { const int half = G / 2;
        const bf16_t* QKVR = (const bf16_t*)(ws + WS_QKVR); const float* Gb = (const float*)(ws + WS_G); bf16_t* DST = (bf16_t*)((unsigned char*)out + OUT_DST); float* DEC = (float*)(ws + WS_DEC);
        const int first = bx < half ? bx : 1920 + bx - half, last = bx < half ? 1920 : 3072;
        GlaLd A; gla_load<false>(A, first, QKVR, Gb, DST, tid);
        for (int item = first; item < last; item += half) { GlaLd B; const int nx = item + half < last ? item + half : item;
            gla_load<false>(B, nx, QKVR, Gb, DST, tid);
            gla_a_item(A, item, DST, DEC, lds, tid, wave, lane); A = B; } }
      p_ymid((const bf16_t*)(ws + WS_HM), (const bf16_t*)(ws + WS_W_FT), (float*)(ws + WS_YMID), gw, NGW, lane); }
    GRID_SYNC();
    { PHASE_VARS
      if (PH(9)) for (int g2 = gt; g2 < 131072; g2 += NGT) p_scan((bf16_t*)((unsigned char*)out + OUT_DST), (const float*)(ws + WS_DEC), g2);
      p_fcombine((const bf16_t*)(ws + WS_PCP), (const bf16_t*)(ws + WS_PSP), (const float*)(ws + WS_YMID), H, 0, 4096, 11, gt, NGT);
      p_fcombine((const bf16_t*)(ws + WS_PCS), (const bf16_t*)(ws + WS_PSS), (const float*)(ws + WS_YMID) + 8 * 512, H, TP, 2048, 10, gt, NGT);
      p_fmid((const bf16_t*)((unsigned char*)out + OUT_YTPC), (const float*)(ws + WS_YMID), H, 0, 4096, gw, NGW, lane);
      p_fmid((const bf16_t*)((unsigned char*)out + OUT_YTSC), (const float*)(ws + WS_YMID) + 8 * 512, H, TP, 2048, gw, NGW, lane); }
    GRID_SYNC();
    { PHASE_VARS
      REP(10) if (PH(10)) { const bf16_t* QKVR = (const bf16_t*)(ws + WS_QKVR); const float* Gb = (const float*)(ws + WS_G); const bf16_t* DST = (const bf16_t*)((unsigned char*)out + OUT_DST);
        GlaLd A; gla_load<true>(A, bx, QKVR, Gb, DST, tid);
        for (int item = bx; item < 3072; item += G) { GlaLd B; const int nx = item + G < 3072 ? item + G : item;
            gla_load<true>(B, nx, QKVR, Gb, DST, tid);
            gla_c_item(A, item, QKVR, DST, ap->in[8], H, lds, tid, wave, lane); A = B; } } }
    GRID_SYNC();
    { PHASE_VARS
      if (PH(11)) { pg8::Gemm g{H, (const bf16_t*)(ws + WS_W_ABO), TT, 1024, 1024}; pg8::StaticOrder S; S.init(TT, 1024, G, bx);
        Epi<EM_RESIN, true> E{nullptr, nullptr, nullptr, nullptr, ap->in[0], ap->in[1], nullptr, nullptr, nullptr, SSQP(1), (bf16_t*)(ws + WS_XBA), nullptr};
        pg8::gemm_phase<Epi<EM_RESIN, true>, pg8::StaticOrder, true, true>(lds3, g, S, E); } }
    GRID_SYNC();
    ffn_block<0>(lds3);
    GRID_SYNC();
    { PHASE_VARS
      if (PH(13)) { pg8::Gemm g{(const bf16_t*)(ws + WS_XBA), (const bf16_t*)(ws + WS_W_QKV), TT, 1536, 1024}; pg8::StaticOrder S; S.init(TT, 1536, G, bx);
        Epi<EM_QKV> E{(bf16_t*)(ws + WS_Q), (bf16_t*)(ws + WS_K), (bf16_t*)(ws + WS_V), nullptr, nullptr, nullptr, nullptr, nullptr, SSQP(2), nullptr, nullptr, nullptr};
        pg8::gemm_phase<Epi<EM_QKV>, pg8::StaticOrder, true, true>(lds3, g, S, E); } }
    GRID_SYNC();
    { PHASE_VARS
      if (PH(14)) p_qkrope((bf16_t*)(ws + WS_Q), (bf16_t*)(ws + WS_K), ap->in[12], ap->in[13], (const float2*)(ws + WS_ROPE), gw, NGW, lane); }
    GRID_SYNC();
    { PHASE_VARS
      if (PH(15)) { const int vx = bx & 7, vi = bx >> 3;
        bf16_t* Qb = (bf16_t*)(ws + WS_Q); bf16_t* Kb = (bf16_t*)(ws + WS_K); bf16_t* Vb = (bf16_t*)(ws + WS_V); bf16_t* AO = (bf16_t*)(ws + WS_AO);
        for (int i6 = 0; i6 < (PROBE_ATTN ? 12 : 6); ++i6) { const int i = i6 % 6;
            int b, kvh, hq, qb, row0, seq;
            if (i < 4) { const int combo = vx * 2 + (i >> 1), u = (i & 1) * 32 + vi; b = combo >> 1; kvh = combo & 1; hq = kvh * 4 + (u >> 4); qb = u & 15; row0 = b * 4096; seq = 4096; }
            else { const int combo = vx * 2 + (i - 4), u = vi; b = combo >> 1; kvh = combo & 1; hq = kvh * 4 + (u >> 3); qb = u & 7; row0 = TP + b * 2048; seq = 2048; }
            attn::attn_dense_body<attn::bf16>(Qb + (size_t)(row0 + qb * 256) * 1024 + hq * 128, Kb + (size_t)row0 * 256 + kvh * 128, Vb + (size_t)row0 * 256 + kvh * 128,
                                              AO + (size_t)(row0 + qb * 256) * 1024 + hq * 128, seq, (char*)lds);
            __syncthreads();
        } } }
    GRID_SYNC();
    { PHASE_VARS
      if (PH(16)) { pg8::Gemm g{(const bf16_t*)(ws + WS_AO), (const bf16_t*)(ws + WS_W_CO), TT, 1024, 1024}; pg8::StaticOrder S; S.init(TT, 1024, G, bx);
        Epi<EM_RES, true> E{nullptr, nullptr, nullptr, nullptr, nullptr, nullptr, nullptr, nullptr, nullptr, SSQP(3), (bf16_t*)(ws + WS_XBA), nullptr};
        pg8::gemm_phase<Epi<EM_RES, true>, pg8::StaticOrder, true, true>(lds3, g, S, E); } }
    GRID_SYNC();
    ffn_block<1>(lds3);
}

extern "C" void kernel_launch(void* const* d_in, const int* in_sizes, int n_in, void* d_out, int out_size, void* d_ws, size_t ws_size, hipStream_t stream) {
    static int grid = 0;
    if (grid == 0) {
        int dev = 0, cus = 0, per_cu = 0;
        if (n_in != 19 || out_size != TT * DM || ws_size < WS_END) { fprintf(stderr, "kernel_launch: unexpected shapes: n_in %d out %d ws %zu (need %zu)\n", n_in, out_size, ws_size, (size_t)WS_END); grid = -1; return; }
        if (hipGetDevice(&dev) != hipSuccess || hipDeviceGetAttribute(&cus, hipDeviceAttributeMultiprocessorCount, dev) != hipSuccess) { fprintf(stderr, "kernel_launch: device query failed\n"); grid = -1; return; }
        if (hipFuncSetAttribute((const void*)mega_fwd, hipFuncAttributeMaxDynamicSharedMemorySize, LDS_BYTES) != hipSuccess) { fprintf(stderr, "kernel_launch: hipFuncSetAttribute failed\n"); grid = -1; return; }
        if (hipOccupancyMaxActiveBlocksPerMultiprocessor(&per_cu, (const void*)mega_fwd, 512, LDS_BYTES) != hipSuccess || per_cu < 1) fprintf(stderr, "kernel_launch: occupancy query reports %d blocks per CU\n", per_cu);
        (void)hipGetLastError();
        if (cus != 256) { fprintf(stderr, "kernel_launch: built for a 256-CU device, found %d\n", cus); grid = -1; return; }
        grid = 256;
    }
    if (grid < 0) return;
    if (hipMemsetAsync((char*)d_ws + WS_CTL, 0, CTL_BYTES, stream) != hipSuccess) { fprintf(stderr, "kernel_launch: memset failed\n"); return; }
    Args a{};
    for (int i = 0; i < 19; ++i) a.in[i] = (const float*)d_in[i];
    a.out = (float*)d_out; a.ws = (unsigned char*)d_ws;
    void* args[] = {&a};
    const hipError_t e = hipLaunchCooperativeKernel((const void*)mega_fwd, dim3(grid), dim3(512), args, LDS_BYTES, stream);
    if (e != hipSuccess) fprintf(stderr, "kernel_launch: cooperative launch failed: %s\n", hipGetErrorString(e));
}
```

```cpp
#include <hip/hip_runtime.h>
#include <hip/hip_cooperative_groups.h>
#include <cstdio>
#include <cstdint>
namespace cg = cooperative_groups;
#define DEVI __device__ __forceinline__
namespace pg8 {
#define PG8_LAS __attribute__((address_space(3)))
typedef unsigned short bf16_t;
typedef short bf16x8 __attribute__((ext_vector_type(8)));
typedef float f32x4 __attribute__((ext_vector_type(4)));
typedef unsigned u32x4 __attribute__((ext_vector_type(4)));
constexpr int BM = 256, BK = 64, HALF = 128, HTB = HALF * BK * 2  , STAGE_BYTES = 8 * HTB, NXCD = 8, WGM = 8;

__host__ __device__ __forceinline__ int lds_byte(int r, int c) { const int st = (r >> 4) * 2 + (c >> 5), rr = r & 15, cc = c & 31, ob = rr * 64 + cc * 2; return st * 1024 + (ob ^ (((ob >> 9) & 1) << 5)); }
__host__ __device__ __forceinline__ void stage_rc(int b, int& R, int& C) { const int st = b / 1024, sb = b % 1024, swz = sb ^ (((sb >> 9) & 1) << 5); R = (st >> 1) * 16 + swz / 64; C = (st & 1) * 32 + (swz % 64) / 2; }
__host__ __device__ __forceinline__ int perm32(int rho) { const int n = rho >> 4, i = rho & 15; return 8 * (i >> 2) + 4 * n + (i & 3); }

struct Unit { int pm, pn; };
struct Gemm { const bf16_t* A; const bf16_t* Bt; int M, N, K; };

struct StaticOrder {
    int nM, nN, nwg, G, c;
    __host__ __device__ void init(int M, int N, int G_, int c_) { nM = M / BM; nN = N / BM; nwg = nM * nN; G = G_; c = c_; }
    __host__ __device__ bool next(int i, Unit& u) const {
        const long L = (long)i * G + c; if (L >= nwg) return false;
        int wgid = (int)L; { const int q = nwg / NXCD, r = nwg % NXCD, xcd = wgid % NXCD, off = wgid / NXCD; wgid = (xcd < r ? xcd * (q + 1) : r * (q + 1) + (xcd - r) * q) + off; }
        const int nig = WGM * nN, gid = wgid / nig, fm = gid * WGM, gsz = (nM - fm) < WGM ? (nM - fm) : WGM;
        u.pm = fm + ((wgid % nig) % gsz); u.pn = (wgid % nig) / gsz; return true;
    }
    __device__ __forceinline__ void a_ready(const Unit&) const {}
    __device__ __forceinline__ void done(const Unit&) const {}
};

__device__ __forceinline__ unsigned cvt_pk_bf16(float lo, float hi) { unsigned r; asm volatile("v_cvt_pk_bf16_f32 %0, %1, %2" : "=v"(r) : "v"(lo), "v"(hi)); return r; }
template <class Epi, class Sched, bool ALIGN_EPI = false, bool SP2 = false>
__device__ __forceinline__ void gemm_phase(PG8_LAS unsigned char* lds, const Gemm g, const Sched& S, const Epi& E) {
    int tid_ = threadIdx.x; asm volatile("" : "+v"(tid_));
    const int tid = tid_, wid = __builtin_amdgcn_readfirstlane(tid >> 6), lane = tid & 63, wr = wid >> 2, wc = wid & 3, fr = lane & 15, fq = lane >> 4;
    const int K = g.K, nt = K / BK;
    unsigned voffA[2], voffB[2];
#pragma unroll
    for (int i = 0; i < 2; ++i) { int R, C; stage_rc(tid * 16 + i * 8192, R, C); const int Rb = Epi::PERM ? ((R & ~31) + perm32(R & 31)) : R;
        voffA[i] = (unsigned)(R * K + C) * 2u; voffB[i] = (unsigned)(Rb * K + C) * 2u; }
    const size_t kstep = (size_t)(BK * 2);
    const size_t hstep = (size_t)HALF * K * 2;
    const size_t tstep = 2 * hstep;
    const unsigned ldsw = (unsigned)wid * 1024u;
    const int aoff = lds_byte(wr * 64 + fr, fq * 8), boff = lds_byte(wc * 32 + fr, fq * 8);
#define PG8_SA(b, h) (((b) * 2 + (h)) * HTB)
#define PG8_SB(b, h) ((4 + (b) * 2 + (h)) * HTB)
#define PG8_STAGE(bufoff, gbase, voff) do { _Pragma("unroll") for (int _i = 0; _i < 2; ++_i) \
        __builtin_amdgcn_global_load_lds((const unsigned*)((const char*)(gbase) + (voff)[_i]), (PG8_LAS unsigned*)(lds + (bufoff) + ldsw + _i * 8192), 16, 0, 0); } while (0)
#define PG8_LDA(dst, b, h) do { _Pragma("unroll") for (int m = 0; m < 4; ++m) _Pragma("unroll") for (int k = 0; k < 2; ++k) dst[m][k] = *(const PG8_LAS bf16x8*)(lds + PG8_SA(b, h) + aoff + m * 2048 + k * 1024); } while (0)
#define PG8_LDB(dst, b, h) do { _Pragma("unroll") for (int n = 0; n < 2; ++n) _Pragma("unroll") for (int k = 0; k < 2; ++k) dst[n][k] = *(const PG8_LAS bf16x8*)(lds + PG8_SB(b, h) + boff + n * 2048 + k * 1024); } while (0)
#define PG8_MMA(ai, bj, At, Bt) do { __builtin_amdgcn_s_setprio(1); _Pragma("unroll") for (int m = 0; m < 4; ++m) _Pragma("unroll") for (int n = 0; n < 2; ++n) _Pragma("unroll") for (int k = 0; k < 2; ++k) \
        acc[ai][bj][m][n] = __builtin_amdgcn_mfma_f32_16x16x32_bf16(Bt[n][k], At[m][k], acc[ai][bj][m][n], 0, 0, 0); __builtin_amdgcn_s_setprio(0); } while (0)
#define PG8_WAIT_V(n) asm volatile("s_waitcnt vmcnt(" #n ")" ::: "memory")
#define PG8_WAIT_L(n) asm volatile("s_waitcnt lgkmcnt(" #n ")" ::: "memory")
#define PG8_BAR __builtin_amdgcn_s_barrier()
#define PG8_SCHED __builtin_amdgcn_sched_barrier(0)
    Unit cur, nxt; int ui = 0;
    if (!S.next(0, cur)) return;
    f32x4 acc[2][2][4][2];
#pragma unroll
    for (int a = 0; a < 2; ++a)
#pragma unroll
        for (int b = 0; b < 2; ++b)
#pragma unroll
            for (int m = 0; m < 4; ++m)
#pragma unroll
                for (int n = 0; n < 2; ++n) acc[a][b][m][n] = (f32x4){0.f, 0.f, 0.f, 0.f};
    bf16x8 At[4][2], B0[2][2], B1[2][2];
    const char* cA = (const char*)g.A + (size_t)cur.pm * tstep; const char* cB = (const char*)g.Bt + (size_t)cur.pn * tstep;
    S.a_ready(cur);
    if constexpr (SP2) {
        PG8_STAGE(PG8_SB(0, 0), cB, voffB); PG8_STAGE(PG8_SB(0, 1), cB + hstep, voffB); PG8_STAGE(PG8_SA(0, 0), cA, voffA); PG8_STAGE(PG8_SA(0, 1), cA + hstep, voffA);
        if (wr == 1) PG8_BAR;
        PG8_WAIT_V(2); PG8_BAR;
        PG8_STAGE(PG8_SB(1, 0), cB + kstep, voffB); PG8_STAGE(PG8_SA(1, 0), cA + kstep, voffA); PG8_STAGE(PG8_SB(1, 1), cB + hstep + kstep, voffB);
        PG8_WAIT_V(6); PG8_BAR;
    } else {
        PG8_STAGE(PG8_SB(0, 0), cB, voffB); PG8_STAGE(PG8_SA(0, 0), cA, voffA); PG8_STAGE(PG8_SB(0, 1), cB + hstep, voffB); PG8_STAGE(PG8_SA(0, 1), cA + hstep, voffA);
        if (wr == 1) PG8_BAR;
        PG8_WAIT_V(4); PG8_BAR;
        PG8_STAGE(PG8_SB(1, 0), cB + kstep, voffB); PG8_STAGE(PG8_SA(1, 0), cA + kstep, voffA); PG8_STAGE(PG8_SB(1, 1), cB + hstep + kstep, voffB);
        PG8_WAIT_V(6); PG8_BAR;
    }
    for (;;) {
        const bool has_next = S.next(ui + 1, nxt);
        const char* nA = has_next ? (const char*)g.A + (size_t)nxt.pm * tstep : cA; const char* nB = has_next ? (const char*)g.Bt + (size_t)nxt.pn * tstep : cB;
        for (int t = 0; t < nt; t += 2) {
            const bool last = (t == nt - 2);
            const char* a1 = cA + (size_t)(t + 1) * kstep;
            const char* a2 = last ? nA : cA + (size_t)(t + 2) * kstep; const char* b2 = last ? nB : cB + (size_t)(t + 2) * kstep;
            const char* a3 = a2 + kstep; const char* b3 = b2 + kstep;
            if (last && has_next) S.a_ready(nxt);
            if constexpr (SP2) {
            PG8_LDB(B0, 0, 0); PG8_LDB(B1, 0, 1); PG8_SCHED; PG8_LDA(At, 0, 0); PG8_STAGE(PG8_SA(1, 1), a1 + hstep, voffA);
            PG8_WAIT_V(8); PG8_WAIT_L(0); PG8_BAR; PG8_MMA(0, 0, At, B0); PG8_MMA(0, 1, At, B1); PG8_BAR; PG8_SCHED;
            PG8_LDA(At, 0, 1); PG8_STAGE(PG8_SB(0, 0), b2, voffB); PG8_STAGE(PG8_SB(0, 1), b2 + hstep, voffB); PG8_STAGE(PG8_SA(0, 0), a2, voffA);
            PG8_WAIT_V(8); PG8_WAIT_L(0); PG8_BAR; PG8_MMA(1, 0, At, B0); PG8_MMA(1, 1, At, B1); PG8_BAR; PG8_SCHED;
            PG8_LDB(B0, 1, 0); PG8_LDB(B1, 1, 1); PG8_SCHED; PG8_LDA(At, 1, 0); PG8_STAGE(PG8_SA(0, 1), a2 + hstep, voffA);
            PG8_WAIT_V(8); PG8_WAIT_L(0); PG8_BAR; PG8_MMA(0, 0, At, B0); PG8_MMA(0, 1, At, B1); PG8_BAR; PG8_SCHED;
            PG8_LDA(At, 1, 1); PG8_STAGE(PG8_SB(1, 0), b3, voffB); PG8_STAGE(PG8_SB(1, 1), b3 + hstep, voffB); PG8_STAGE(PG8_SA(1, 0), a3, voffA);
            PG8_WAIT_V(8); PG8_WAIT_L(0); PG8_BAR; PG8_MMA(1, 0, At, B0); PG8_MMA(1, 1, At, B1); PG8_BAR; PG8_SCHED;
            } else {
            PG8_LDB(B0, 0, 0); PG8_SCHED; PG8_LDA(At, 0, 0); PG8_STAGE(PG8_SA(1, 1), a1 + hstep, voffA);
            PG8_WAIT_L(8); PG8_BAR; PG8_WAIT_L(0); PG8_MMA(0, 0, At, B0); PG8_BAR; PG8_SCHED;
            PG8_LDB(B1, 0, 1); PG8_STAGE(PG8_SB(0, 0), b2, voffB);
            PG8_BAR; PG8_WAIT_L(0); PG8_MMA(0, 1, At, B1); PG8_BAR;
            PG8_LDA(At, 0, 1); PG8_STAGE(PG8_SA(0, 0), a2, voffA);
            PG8_BAR; PG8_WAIT_L(0); PG8_MMA(1, 0, At, B0); PG8_BAR; PG8_SCHED;
            PG8_STAGE(PG8_SB(0, 1), b2 + hstep, voffB);
            PG8_WAIT_V(6); PG8_BAR; PG8_MMA(1, 1, At, B1); PG8_BAR;
            PG8_LDB(B0, 1, 0); PG8_SCHED; PG8_LDA(At, 1, 0); PG8_STAGE(PG8_SA(0, 1), a2 + hstep, voffA);
            PG8_WAIT_L(8); PG8_BAR; PG8_WAIT_L(0); PG8_MMA(0, 0, At, B0); PG8_BAR; PG8_SCHED;
            PG8_LDB(B1, 1, 1); PG8_STAGE(PG8_SB(1, 0), b3, voffB);
            PG8_BAR; PG8_WAIT_L(0); PG8_MMA(0, 1, At, B1); PG8_BAR;
            PG8_LDA(At, 1, 1); PG8_STAGE(PG8_SA(1, 0), a3, voffA);
            PG8_BAR; PG8_WAIT_L(0); PG8_MMA(1, 0, At, B0); PG8_BAR; PG8_SCHED;
            PG8_STAGE(PG8_SB(1, 1), b3 + hstep, voffB);
            PG8_WAIT_V(6); PG8_BAR; PG8_MMA(1, 1, At, B1); PG8_BAR;
            }
        }
        if constexpr (ALIGN_EPI) { if (wr == 0) PG8_BAR; }
        if constexpr (!Epi::AFTER_DRAIN) { E(acc, cur, wr, wc, fr, fq); S.done(cur); }
        if (!has_next) break;
#pragma unroll
        for (int a = 0; a < 2; ++a)
#pragma unroll
            for (int b = 0; b < 2; ++b)
#pragma unroll
                for (int m = 0; m < 4; ++m)
#pragma unroll
                    for (int n = 0; n < 2; ++n) acc[a][b][m][n] = (f32x4){0.f, 0.f, 0.f, 0.f};
        cur = nxt; cA = nA; cB = nB; ++ui;
        if constexpr (ALIGN_EPI) { if (wr == 1) PG8_BAR; }
    }
    PG8_WAIT_V(0);
    if constexpr (!ALIGN_EPI) { if (wr == 0) PG8_BAR; }
    PG8_BAR;
    if constexpr (Epi::AFTER_DRAIN) { E.fused(acc, cur, wr, wc, fr, fq, lds, wid, lane); S.done(cur); }
#undef PG8_SA
#undef PG8_SB
#undef PG8_STAGE
#undef PG8_LDA
#undef PG8_LDB
#undef PG8_MMA
#undef PG8_WAIT_V
#undef PG8_WAIT_L
#undef PG8_BAR
#undef PG8_SCHED
}
}

typedef unsigned short bf16_t;
typedef short bf16x8 __attribute__((ext_vector_type(8)));
typedef float f32x4 __attribute__((ext_vector_type(4)));
typedef float f32x16 __attribute__((ext_vector_type(16)));
typedef unsigned u32x4 __attribute__((ext_vector_type(4)));
typedef unsigned u32x2 __attribute__((ext_vector_type(2)));
typedef float f32x2_t __attribute__((ext_vector_type(2)));
typedef __bf16 bf16x2_t __attribute__((ext_vector_type(2)));

constexpr int TP = 32768, TS = 16384, TT = TP + TS, DM = 1024, FFH = 2816, SP = 4096, SS = 2048;
constexpr float EPS = 1e-6f;
constexpr size_t MiB = 1u << 20;
constexpr size_t WS_CTL = 0, CTL_BYTES = 64 * 1024;
constexpr size_t WS_ROPE = 1 * MiB;
constexpr size_t WS_W_AB1 = 2 * MiB;
constexpr size_t WS_W_FT = 6 * MiB;
constexpr size_t WS_W_ABO = 8 * MiB;
constexpr size_t WS_W_GU0 = 10 * MiB;
constexpr size_t WS_W_D0 = 21 * MiB;
constexpr size_t WS_W_QKV = 27 * MiB;
constexpr size_t WS_W_CO = 30 * MiB;
constexpr size_t WS_W_GU1 = 32 * MiB;
constexpr size_t WS_W_D1 = 43 * MiB;
constexpr size_t WS_DEC = 49 * MiB;
constexpr size_t WS_C4 = 51 * MiB, WS_S4 = 59 * MiB;
constexpr size_t WS_C2 = 67 * MiB, WS_S2 = 69 * MiB;
constexpr size_t WS_HM = 1 * MiB + 64 * 1024;
constexpr size_t WS_YMID = 1 * MiB + 128 * 1024;
constexpr size_t WS_PCP = 91 * MiB, WS_PSP = 107 * MiB;
constexpr size_t WS_PCS = 123 * MiB, WS_PSS = 131 * MiB;
constexpr size_t WS_SSQ = 1 * MiB + 256 * 1024;
constexpr size_t WS_XBA = 51 * MiB;
constexpr size_t WS_XBB = 147 * MiB;
constexpr size_t WS_H = WS_XBB;
constexpr size_t WS_BIG = 243 * MiB;
constexpr size_t WS_QKVR = WS_BIG;
constexpr size_t WS_G = WS_BIG + 144 * MiB;
constexpr size_t WS_FOLDF = WS_BIG;
constexpr size_t WS_FOLDG = WS_BIG + 4 * MiB;
constexpr size_t WS_ACT = WS_BIG;
constexpr size_t WS_Q = WS_BIG, WS_K = WS_BIG + 96 * MiB, WS_V = WS_BIG + 120 * MiB, WS_AO = WS_BIG + 144 * MiB;
constexpr size_t WS_END = WS_BIG + 264 * MiB;
constexpr size_t OUT_YTPC = 0, OUT_YTPS = 16 * MiB, OUT_YTSC = 32 * MiB, OUT_YTSS = 40 * MiB, OUT_HS = 96 * MiB, OUT_HD = 144 * MiB, OUT_DST = 96 * MiB;
constexpr int TF = 24576, TFP = 16384;

DEVI float bf2f(bf16_t x) { return __uint_as_float(((unsigned)x) << 16); }
DEVI unsigned pk2(float lo, float hi) { f32x2_t v = {lo, hi}; bf16x2_t b = __builtin_convertvector(v, bf16x2_t); return __builtin_bit_cast(unsigned, b); }
DEVI bf16_t f2bf(float f) { return (bf16_t)(pk2(f, 0.f) & 0xffffu); }
DEVI u32x4 pk8(f32x4 a, f32x4 b) { u32x4 w; w.x = pk2(a[0], a[1]); w.y = pk2(a[2], a[3]); w.z = pk2(b[0], b[1]); w.w = pk2(b[2], b[3]); return w; }
DEVI float wave_sum(float v) {
#pragma unroll
    for (int o = 1; o < 64; o <<= 1) v += __shfl_xor(v, o);
    return v;
}
DEVI float logsig(float z) { return fminf(z, 0.f) - __logf(1.f + __expf(-fabsf(z))); }
DEVI float silu(float z) { return z * __builtin_amdgcn_rcpf(1.f + __expf(-z)); }

struct RotOrder { pg8::StaticOrder S;
    DEVI bool next(int i, pg8::Unit& u) const { if (!S.next(i, u)) return false; u.pn = (u.pn + ((u.pm >> 3) % 3)) & 7; return true; }
    DEVI void a_ready(const pg8::Unit&) const {}
    DEVI void done(const pg8::Unit&) const {} };
struct FoldOrder { int G, c;
    DEVI bool next(int i, pg8::Unit& u) const { const int L = i * G + c; if (L >= 384) return false; u.pm = L & 3; u.pn = (L >> 2) + (u.pm >> 1) * 96; return true; }
    DEVI void a_ready(const pg8::Unit&) const {}
    DEVI void done(const pg8::Unit&) const {} };
enum { EM_AB1, EM_AB1T, EM_FNETP, EM_FNETS, EM_RESIN, EM_RES, EM_GLU, EM_QKV };
template <int MODE, bool NEXT = false> struct Epi {
    static constexpr bool PERM = true, AFTER_DRAIN = false;
    bf16_t* O0; bf16_t* O1; bf16_t* O2; float* F0; const float* X0; const float* X1; const float* B0; const float* B1;
    const float* SQI; float* SQO; bf16_t* XBN; const float* GN;
    DEVI float rstd_of(int row) const { return rsqrtf(SQI[row] * (1.f / 1024.f) + EPS); }
    DEVI void operator()(const f32x4 (&acc)[2][2][4][2], const pg8::Unit& u, int wr, int wc, int fr, int fq) const {
        const int rbase = u.pm * 256 + wr * 64 + fr, cb = wc * 32 + 8 * fq;
        f32x4 ga[2][2];
        if constexpr (MODE == EM_AB1) { if (u.pn >= 6) { const float* bias = (u.pn - 6) ? B1 : B0;
#pragma unroll
            for (int bj = 0; bj < 2; ++bj) { ga[bj][0] = *(const f32x4*)(bias + bj * 128 + cb); ga[bj][1] = *(const f32x4*)(bias + bj * 128 + cb + 4); } } }
        float rsv[2][4];
        if constexpr (MODE == EM_AB1 || MODE == EM_GLU || MODE == EM_QKV) {
#pragma unroll
            for (int ai = 0; ai < 2; ++ai)
#pragma unroll
                for (int m = 0; m < 4; ++m) rsv[ai][m] = SQI[rbase + ai * 128 + m * 16];
#pragma unroll
            for (int ai = 0; ai < 2; ++ai)
#pragma unroll
                for (int m = 0; m < 4; ++m) rsv[ai][m] = rsqrtf(rsv[ai][m] * (1.f / 1024.f) + EPS);
        }
#pragma unroll
        for (int ai = 0; ai < 2; ++ai)
#pragma unroll
            for (int m = 0; m < 4; ++m) {
                const int row = rbase + ai * 128 + m * 16;
                float rs = 1.f, ssq = 0.f;
                if constexpr (MODE == EM_AB1 || MODE == EM_GLU || MODE == EM_QKV) rs = rsv[ai][m];
                if constexpr (MODE == EM_GLU) {
                    const f32x4 g0 = acc[ai][0][m][0] * rs, g1 = acc[ai][0][m][1] * rs, u0 = acc[ai][1][m][0] * rs, u1 = acc[ai][1][m][1] * rs;
                    f32x4 a, b;
#pragma unroll
                    for (int j = 0; j < 4; ++j) { a[j] = silu(g0[j]) * u0[j]; b[j] = silu(g1[j]) * u1[j]; }
                    __builtin_nontemporal_store(pk8(a, b), (u32x4*)(O0 + (size_t)row * FFH + u.pn * 128 + cb));
                } else {
#pragma unroll
                    for (int bj = 0; bj < 2; ++bj) {
                        f32x4 v0 = acc[ai][bj][m][0] * rs, v1 = acc[ai][bj][m][1] * rs;
                        const int c = bj * 128 + cb;
                        if constexpr (MODE == EM_AB1) {
                            if (u.pn < 2) { __builtin_nontemporal_store(pk8(v0, v1), (u32x4*)(O0 + (size_t)u.pn * ((size_t)TT * 256) + (size_t)row * 256 + c)); }
                            else if (u.pn < 6) { __builtin_nontemporal_store(pk8(v0, v1), (u32x4*)(O0 + (size_t)(u.pn >> 1) * ((size_t)TT * 512) + (size_t)row * 512 + (u.pn & 1) * 256 + c)); }
                            else { const int dir = u.pn - 6;
                                const f32x4 b0 = ga[bj][0], b1 = ga[bj][1];
                                f32x4 a, b;
#pragma unroll
                                for (int j = 0; j < 4; ++j) { a[j] = logsig(v0[j] + b0[j]) * 0.0625f; b[j] = logsig(v1[j] + b1[j]) * 0.0625f; }
                                float* gp = F0 + (size_t)row * 512 + dir * 256 + c; __builtin_nontemporal_store(a, (f32x4*)gp); __builtin_nontemporal_store(b, (f32x4*)(gp + 4)); }
                        } else if constexpr (MODE == EM_AB1T) {
                            const int cc = row, part = cc >> 9, t0 = (u.pn - 96 * part) * 256;
                            bf16_t* dst;
                            if (t0 < TFP) { const int b = t0 >> 11, s = (t0 & 2047) + c; dst = O0 + (size_t)part * (4096 * 2048) + (size_t)(b * 512 + (cc & 511)) * 2048 + s; }
                            else { const int tt = t0 - TFP, b = tt >> 10, s = (tt & 1023) + c; dst = O1 + (size_t)part * (4096 * 1024) + (size_t)(b * 512 + (cc & 511)) * 1024 + s; }
                            __builtin_nontemporal_store(pk8(v0, v1), (u32x4*)dst);
                        } else if constexpr (MODE == EM_FNETP) {
                            __builtin_nontemporal_store(pk8(v0, v1), (u32x4*)(O0 + ((size_t)(u.pn >> 1) * 2048 + row) * 512 + (u.pn & 1) * 256 + c));
                        } else if constexpr (MODE == EM_FNETS) {
                            __builtin_nontemporal_store(pk8(v0, v1), (u32x4*)(O0 + ((size_t)(u.pn >> 1) * 1024 + row) * 512 + (u.pn & 1) * 256 + c));
                        } else if constexpr (MODE == EM_RESIN) {
                            const float* xp = (row < TP ? X0 + (size_t)row * 1024 : X1 + (size_t)(row - TP) * 1024) + u.pn * 256 + c;
                            const f32x4 x0 = *(const f32x4*)xp + v0, x1 = *(const f32x4*)(xp + 4) + v1;
                            ssq += (x0[0] * x0[0] + x0[1] * x0[1]) + (x0[2] * x0[2] + x0[3] * x0[3]) + (x1[0] * x1[0] + x1[1] * x1[1]) + (x1[2] * x1[2] + x1[3] * x1[3]);
                            __builtin_nontemporal_store(pk8(x0, x1), (u32x4*)(XBN + (size_t)row * 1024 + u.pn * 256 + c));
                        } else if constexpr (MODE == EM_RES) {
                            bf16_t* rp = XBN + (size_t)row * 1024 + u.pn * 256 + c;
                            const u32x4 w = *(const u32x4*)rp;
                            f32x4 x0 = {__uint_as_float(w[0] << 16), __uint_as_float(w[0] & 0xffff0000u), __uint_as_float(w[1] << 16), __uint_as_float(w[1] & 0xffff0000u)};
                            f32x4 x1 = {__uint_as_float(w[2] << 16), __uint_as_float(w[2] & 0xffff0000u), __uint_as_float(w[3] << 16), __uint_as_float(w[3] & 0xffff0000u)};
                            x0 = x0 + v0; x1 = x1 + v1;
                            if constexpr (NEXT) { ssq += (x0[0] * x0[0] + x0[1] * x0[1]) + (x0[2] * x0[2] + x0[3] * x0[3]) + (x1[0] * x1[0] + x1[1] * x1[1]) + (x1[2] * x1[2] + x1[3] * x1[3]);
                                __builtin_nontemporal_store(pk8(x0, x1), (u32x4*)rp); }
                            else { float* op = F0 + (size_t)row * 1024 + u.pn * 256 + c; __builtin_nontemporal_store(x0, (f32x4*)op); __builtin_nontemporal_store(x1, (f32x4*)(op + 4)); }
                        } else if constexpr (MODE == EM_QKV) {
                            bf16_t* dst;
                            if (u.pn < 4) dst = O0 + (size_t)row * 1024 + u.pn * 256 + c;
                            else if (u.pn == 4) dst = O1 + (size_t)row * 256 + c;
                            else dst = O2 + (size_t)row * 256 + c;
                            *(u32x4*)dst = pk8(v0, v1);
                        }
                    }
                    if constexpr (MODE == EM_RESIN || (MODE == EM_RES && NEXT)) { ssq += __shfl_xor(ssq, 16); ssq += __shfl_xor(ssq, 32); if (fq == 0) atomicAdd(SQO + row, ssq); }
                }
            }
    }
};

DEVI void p_fold(const float* win, const float* upf, const float* upb, bf16_t* WFT, bf16_t* WG, float* tab, int gw, int NGW, int lane) {
    if (threadIdx.x < 128) tab[threadIdx.x] = cospif((float)threadIdx.x * (1.f / 64.f));
    __syncthreads();
    for (int it = gw; it < 1024 * 16; it += NGW) {
        const int k = it >> 4, cb = it & 15, cc = cb * 64 + lane, part = cc >> 9, g = (cc >> 7) & 3, l = cc & 127;
        const float* wr = win + (size_t)k * 2080 + 1568 + g * 128;
        const int sh = part ? 96 : 0;
        float acc = 0.f;
#pragma unroll 8
        for (int w = 0; w < 128; ++w) acc += wr[w] * tab[(w * l + sh) & 127];
        WFT[(size_t)cc * 1024 + k] = f2bf(acc);
    }
    for (int it = gw; it < 1024 * 8; it += NGW) {
        const int k = it >> 3, nb = it & 7, n = nb * 64 + lane, dir = n >> 8, nn = n & 255;
        const float* wr = win + (size_t)k * 2080 + 1536 + dir * 16;
        const float* up = dir ? upb : upf;
        float acc = 0.f;
#pragma unroll
        for (int r = 0; r < 16; ++r) acc += wr[r] * up[r * 256 + nn];
        WG[(size_t)n * 1024 + k] = f2bf(acc);
    }
    __syncthreads();
}
DEVI void p_dft(bf16_t* C, bf16_t* Sn, int S, int logS, int gt, int NGT) {
    const int lri = logS - 4;
    const long total = (long)(S / 2) << lri;
    const float nrm = rsqrtf((float)S * 128.f), xs = 2.f / (float)S;
    for (long it = gt; it < 2 * total; it += NGT) {
        const int part = it >= total; const long i2 = part ? it - total : it;
        const int k = (int)(i2 >> lri), s0 = (int)(i2 & ((1 << lri) - 1)) * 8;
        float v[8];
#pragma unroll
        for (int j = 0; j < 8; ++j) { const int idx = (k * (s0 + j)) & (S - 1); const float x = (float)idx * xs; v[j] = (part ? sinpif(x) : cospif(x)) * nrm; }
        u32x4 w; w.x = pk2(v[0], v[1]); w.y = pk2(v[2], v[3]); w.z = pk2(v[4], v[5]); w.w = pk2(v[6], v[7]);
        *(u32x4*)((part ? Sn : C) + (size_t)k * (S / 2) + s0) = w;
    }
}
DEVI void p_fcombine(const bf16_t* PC, const bf16_t* PS, const float* YM, bf16_t* MIX, int tokbase, int S, int logSH, int gt, int NGT) {
    const float nrm = rsqrtf((float)S * 128.f);
    const int total = 8 << (logSH + 6);
    for (int it0 = gt; it0 < total; it0 += 4 * NGT) {
        u32x4 pc[4], ps[4];
#pragma unroll
        for (int u = 0; u < 4; ++u) { const int it = it0 + u * NGT, ch = it & 63, k = (it >> 6) & ((1 << logSH) - 1), b = it >> (6 + logSH);
            pc[u] = *(const u32x4*)(PC + ((size_t)(b << logSH) + k) * 512 + ch * 8); ps[u] = *(const u32x4*)(PS + ((size_t)(b << logSH) + k) * 512 + ch * 8); }
#pragma unroll
        for (int u = 0; u < 4; ++u) { const int it = it0 + u * NGT, ch = it & 63, k = (it >> 6) & ((1 << logSH) - 1), b = it >> (6 + logSH);
            u32x4 lo, hi; const float sg = (k & 1) ? -nrm : nrm;
            const f32x4 m0 = *(const f32x4*)(YM + b * 512 + ch * 8), m1 = *(const f32x4*)(YM + b * 512 + ch * 8 + 4);
#pragma unroll
            for (int j = 0; j < 4; ++j) { const float c0 = __uint_as_float(pc[u][j] << 16), c1 = __uint_as_float(pc[u][j] & 0xffff0000u), s0 = __uint_as_float(ps[u][j] << 16), s1 = __uint_as_float(ps[u][j] & 0xffff0000u);
                const float e0 = sg * (j < 2 ? m0[2 * j] : m1[2 * j - 4]), e1 = sg * (j < 2 ? m0[2 * j + 1] : m1[2 * j - 3]);
                lo[j] = pk2(c0 - s0 + e0, c1 - s1 + e1); hi[j] = pk2(c0 + s0 + e0, c1 + s1 + e1); }
            *(u32x4*)(MIX + (size_t)(tokbase + b * S + k) * 1024 + 512 + ch * 8) = lo;
            if (k) *(u32x4*)(MIX + (size_t)(tokbase + b * S + S - k) * 1024 + 512 + ch * 8) = hi; }
    }
}
DEVI void p_fmid(const bf16_t* YC, const float* YM, bf16_t* MIX, int tokbase, int S, int gw, int NGW, int lane) {
    const float nrm = rsqrtf((float)S * 128.f); const int SH = S / 2;
    for (int r = gw; r < 4096; r += NGW) {
        const bf16_t* row = YC + (size_t)r * SH; float acc = 0.f;
        for (int s0 = lane * 8; s0 < SH; s0 += 512) { const u32x4 w = *(const u32x4*)(row + s0);
#pragma unroll
            for (int j = 0; j < 4; ++j) acc += __uint_as_float(w[j] << 16) - __uint_as_float(w[j] & 0xffff0000u); }
        acc = wave_sum(acc);
        if (lane == 0) MIX[(size_t)(tokbase + (r >> 9) * S + SH) * 1024 + 512 + (r & 511)] = f2bf((acc + YM[r]) * nrm);
    }
}
DEVI void p_ymid(const bf16_t* HM, const bf16_t* WFT, float* YM, int gw, int NGW, int lane) {
    for (int it = gw; it < 16 * 512; it += NGW) { const int q = it >> 9, c = it & 511;
        const u32x4 a0 = *(const u32x4*)(HM + q * 1024 + lane * 16), a1 = *(const u32x4*)(HM + q * 1024 + lane * 16 + 8);
        const u32x4 w0 = *(const u32x4*)(WFT + (size_t)c * 1024 + lane * 16), w1 = *(const u32x4*)(WFT + (size_t)c * 1024 + lane * 16 + 8);
        float acc = 0.f;
#pragma unroll
        for (int j = 0; j < 4; ++j) { acc += __uint_as_float(a0[j] << 16) * __uint_as_float(w0[j] << 16) + __uint_as_float(a0[j] & 0xffff0000u) * __uint_as_float(w0[j] & 0xffff0000u);
            acc += __uint_as_float(a1[j] << 16) * __uint_as_float(w1[j] << 16) + __uint_as_float(a1[j] & 0xffff0000u) * __uint_as_float(w1[j] & 0xffff0000u); }
        acc = wave_sum(acc);
        if (lane == 0) YM[it] = acc;
    }
}
DEVI void p_prep_fold(const float* x_p, const float* x_s, const float* gain, bf16_t* XB, float* SQ, bf16_t* HS, bf16_t* HD, bf16_t* HM, int gw, int NGW, int lane) {
    f32x4 gv[4];
#pragma unroll
    for (int j = 0; j < 4; ++j) gv[j] = *((const f32x4*)gain + lane + 64 * j);
    for (int it = gw; it < 8 * 2049 + 8 * 1025; it += NGW) {
        int q, j, S, tb, tfb;
        if (it < 8 * 2049) { q = it / 2049; j = it - q * 2049; S = 4096; tb = q * 4096; tfb = q * 2048; }
        else { const int i2 = it - 8 * 2049; q = i2 / 1025; j = i2 - q * 1025; S = 2048; tb = TP + q * 2048; tfb = TFP + q * 1024; q += 8; }
        const bool pair = j > 0 && j < S / 2;
        const int ra = tb + j, rb = pair ? tb + S - j : ra;
        const f32x4* xa = (const f32x4*)(ra < TP ? x_p + (size_t)ra * DM : x_s + (size_t)(ra - TP) * DM) + lane;
        const f32x4* xb = (const f32x4*)(rb < TP ? x_p + (size_t)rb * DM : x_s + (size_t)(rb - TP) * DM) + lane;
        f32x4 va[4], vb[4]; float sa = 0.f, sb = 0.f;
#pragma unroll
        for (int t = 0; t < 4; ++t) { va[t] = xa[64 * t]; vb[t] = xb[64 * t]; }
#pragma unroll
        for (int t = 0; t < 4; ++t) { sa += (va[t].x * va[t].x + va[t].y * va[t].y) + (va[t].z * va[t].z + va[t].w * va[t].w); sb += (vb[t].x * vb[t].x + vb[t].y * vb[t].y) + (vb[t].z * vb[t].z + vb[t].w * vb[t].w); }
        sa = wave_sum(sa); sb = wave_sum(sb);
        const float rsa = rsqrtf(sa * (1.f / DM) + EPS), rsb = pair ? rsqrtf(sb * (1.f / DM) + EPS) : 0.f;
        if (lane == 0) { SQ[ra] = sa; if (pair) SQ[rb] = sb; }
        u32x2* oa = (u32x2*)(XB + (size_t)ra * DM) + lane; u32x2* ob = (u32x2*)(XB + (size_t)rb * DM) + lane;
        u32x2* os = (u32x2*)((j == S / 2 ? HM + (size_t)q * DM : HS + (size_t)(tfb + j) * DM)) + lane; u32x2* od = (u32x2*)(HD + (size_t)(tfb + (j == S / 2 ? 0 : j)) * DM) + lane;
#pragma unroll
        for (int t = 0; t < 4; ++t) { const f32x4 ga = va[t] * gv[t], gb = vb[t] * gv[t];
            u32x2 w; w.x = pk2(ga.x, ga.y); w.y = pk2(ga.z, ga.w); oa[64 * t] = w;
            if (pair) { w.x = pk2(gb.x, gb.y); w.y = pk2(gb.z, gb.w); ob[64 * t] = w; }
            const f32x4 ha = ga * rsa, hb = gb * rsb;
            w.x = pk2(ha.x + hb.x, ha.y + hb.y); w.y = pk2(ha.z + hb.z, ha.w + hb.w); os[64 * t] = w;
            if (j != S / 2) { w.x = pk2(ha.x - hb.x, ha.y - hb.y); w.y = pk2(ha.z - hb.z, ha.w - hb.w); od[64 * t] = w; } }
    }
}
DEVI void p_norm(const float* src0, const float* src1, const float* gain, bf16_t* H, float* SQ, int gw, int NGW, int lane) {
    f32x4 gv[4];
#pragma unroll
    for (int j = 0; j < 4; ++j) gv[j] = *((const f32x4*)gain + lane + 64 * j);
    for (int m = gw; m < TT; m += NGW) {
        const f32x4* xr = (const f32x4*)(m < TP ? src0 + (size_t)m * DM : src1 + (size_t)(m - TP) * DM) + lane;
        f32x4 v[4]; float s = 0.f;
#pragma unroll
        for (int j = 0; j < 4; ++j) { v[j] = xr[64 * j]; s += (v[j].x * v[j].x + v[j].y * v[j].y) + (v[j].z * v[j].z + v[j].w * v[j].w); }
        const float rstd = 1.f; { const float tot = wave_sum(s); if (lane == 0) SQ[m] = tot; }
        u32x2* o8 = (u32x2*)(H + (size_t)m * DM) + lane;
#pragma unroll
        for (int j = 0; j < 4; ++j) { u32x2 w; w.x = pk2(v[j].x * rstd * gv[j].x, v[j].y * rstd * gv[j].y); w.y = pk2(v[j].z * rstd * gv[j].z, v[j].w * rstd * gv[j].w); o8[64 * j] = w; }
    }
}
DEVI void tr_item(const float* W, int ld, int col0, bf16_t* WT, int Kd, int drow0, float scale, const float* kg, float* scr, int k0, int n0, int lane) {
#pragma unroll 8
    for (int i = 0; i < 32; ++i) { const int kk = 2 * i + (lane >> 5); scr[kk * 33 + (lane & 31)] = W[(size_t)(k0 + kk) * ld + col0 + n0 + (lane & 31)] * (kg ? kg[k0 + kk] : 1.f); }
    asm volatile("s_waitcnt lgkmcnt(0)" ::: "memory");
    const int c = lane & 7;
#pragma unroll
    for (int j = 0; j < 4; ++j) { const int n = (lane >> 3) + 8 * j; const float* s = scr + (8 * c) * 33 + n;
        u32x4 o; o.x = pk2(s[0] * scale, s[33] * scale); o.y = pk2(s[66] * scale, s[99] * scale); o.z = pk2(s[132] * scale, s[165] * scale); o.w = pk2(s[198] * scale, s[231] * scale);
        *(u32x4*)(WT + (size_t)(drow0 + n) * Kd + k0 + 8 * c) = o; }
    asm volatile("s_waitcnt lgkmcnt(0)" ::: "memory");
}
template <int MAP> DEVI bool tr_mat(int& r, const float* W, int ld, int col0, int K, int ncols, bf16_t* WT, int drow, float scale, float* scr, int lane, const float* kg = nullptr) {
    const int nblk = ncols >> 5, cnt = (K >> 6) * nblk;
    if (r >= cnt) { r -= cnt; return false; }
    const int kb = r / nblk, nb = r - kb * nblk, n0 = nb * 32;
    int d0 = drow + n0;
    if (MAP == 1) d0 = (n0 >> 7) * 256 + (n0 & 127);
    if (MAP == 2) d0 = (n0 >> 7) * 256 + 128 + (n0 & 127);
    tr_item(W, ld, col0, WT, K, d0, scale, kg, scr, kb * 64, n0, lane);
    return true;
}

constexpr int GP = 144;
constexpr int L_QF = 0, L_QB = 9216, L_KF = 18432, L_KB = 27648, L_VT = 36864, L_ATF = 55296, L_ATB = 64512, L_SPF = 73728, L_SPB = 92160, L_SEG = 110592;
constexpr int L_KDF = 0, L_KDB = 9216;
DEVI int crow(int r, int hi) { return (r & 3) + 8 * (r >> 2) + 4 * hi; }
DEVI bf16x8 ldf(const unsigned char* base, int row, int ks, int hi) { return *(const bf16x8*)(base + row * GP + ks * 32 + hi * 16); }

#define LBAR() do { asm volatile("s_waitcnt lgkmcnt(0)" ::: "memory"); __builtin_amdgcn_s_barrier(); asm volatile("" ::: "memory"); } while (0)
struct GlaLd { float gf[8], gb[8]; bf16_t qh[8], kh[8], vh[16]; };
template <bool FULL> DEVI void gla_load(GlaLd& L, int item, const bf16_t* QKVR, const float* G, const bf16_t* DST, int tid) {
    const int n = item >> 2, h = item & 3, tok0 = n * 64, d = tid & 63, sg = tid >> 6, e = tid & 127, s4 = tid >> 7;
#pragma unroll
    for (int i = 0; i < 8; ++i) { const float* p = G + (size_t)(tok0 + 8 * sg + i) * 512 + h * 64 + d; L.gf[i] = p[0]; L.gb[i] = p[256]; }
#pragma unroll
    for (int i = 0; i < 8; ++i) { const bf16_t* tr = QKVR + (size_t)(tok0 + 8 * sg + i) * 256 + h * 64 + d; if (FULL) L.qh[i] = tr[0]; L.kh[i] = tr[(size_t)TT * 256]; }
#pragma unroll
    for (int i = 0; i < 16; ++i) L.vh[i] = QKVR[(size_t)TT * 512 + (size_t)(tok0 + 16 * s4 + i) * 512 + h * 128 + e];
}
DEVI void gla_prefix(const GlaLd& L, float* SEG, int tid, float (&bF)[8], float (&bB)[8], float& totF, float& totB) {
    const int d = tid & 63, sg = tid >> 6;
    bF[0] = L.gf[0];
#pragma unroll
    for (int i = 1; i < 8; ++i) bF[i] = bF[i - 1] + L.gf[i];
    bB[7] = L.gb[7];
#pragma unroll
    for (int i = 6; i >= 0; --i) bB[i] = bB[i + 1] + L.gb[i];
    SEG[sg * 64 + d] = bF[7]; SEG[512 + sg * 64 + d] = bB[0];
    LBAR();
    float offF = 0.f, offB = 0.f; totF = 0.f; totB = 0.f;
#pragma unroll
    for (int s = 0; s < 8; ++s) { const float a = SEG[s * 64 + d], b = SEG[512 + s * 64 + d]; totF += a; totB += b; if (s < sg) offF += a; if (s > sg) offB += b; }
#pragma unroll
    for (int i = 0; i < 8; ++i) { bF[i] += offF; bB[i] += offB; }
}
DEVI void gla_stage_vt(const GlaLd& L, unsigned char* VT, int tid) {
    const int e = tid & 127, s4 = tid >> 7;
    unsigned w[8];
#pragma unroll
    for (int i = 0; i < 8; ++i) w[i] = (unsigned)L.vh[2 * i] | ((unsigned)L.vh[2 * i + 1] << 16);
    u32x4 a = {w[0], w[1], w[2], w[3]}, b = {w[4], w[5], w[6], w[7]};
    *(u32x4*)(VT + e * GP + s4 * 32) = a; *(u32x4*)(VT + e * GP + s4 * 32 + 16) = b;
}
DEVI void gla_a_item(const GlaLd& L, int item, bf16_t* DST, float* DEC, unsigned char* lds, int tid, int wave, int lane) {
    const int d = tid & 63, sg = tid >> 6;
    float bF[8], bB[8], totF, totB;
    gla_prefix(L, (float*)(lds + L_SEG), tid, bF, bB, totF, totB);
    float kf[8], kb[8];
#pragma unroll
    for (int i = 0; i < 8; ++i) { const float kk = bf2f(L.kh[i]); kf[i] = kk * __expf(totF - bF[i]); kb[i] = kk * __expf(totB - bB[i]); }
    { u32x4 a = {pk2(kf[0], kf[1]), pk2(kf[2], kf[3]), pk2(kf[4], kf[5]), pk2(kf[6], kf[7])}, b = {pk2(kb[0], kb[1]), pk2(kb[2], kb[3]), pk2(kb[4], kb[5]), pk2(kb[6], kb[7])};
      *(u32x4*)(lds + L_KDF + d * GP + sg * 16) = a; *(u32x4*)(lds + L_KDB + d * GP + sg * 16) = b; }
    if (sg == 0) { DEC[(size_t)(item * 2) * 64 + d] = __expf(totF); DEC[(size_t)(item * 2 + 1) * 64 + d] = __expf(totB); }
    gla_stage_vt(L, lds + L_VT, tid);
    LBAR();
    { const int dir = wave >> 2, et = wave & 3, r32 = lane & 31, hi = lane >> 5;
      const unsigned char* KD = lds + (dir ? L_KDB : L_KDF);
      f32x16 c0 = {}, c1 = {};
#pragma unroll
      for (int ks = 0; ks < 4; ++ks) { const bf16x8 b = ldf(lds + L_VT, 32 * et + r32, ks, hi), a0 = ldf(KD, r32, ks, hi), a1 = ldf(KD, 32 + r32, ks, hi);
          c0 = __builtin_amdgcn_mfma_f32_32x32x16_bf16(a0, b, c0, 0, 0, 0); c1 = __builtin_amdgcn_mfma_f32_32x32x16_bf16(a1, b, c1, 0, 0, 0); }
      bf16_t* dst = DST + (size_t)(item * 2 + dir) * 8192 + (32 * et + r32) * 64 + 4 * hi;
#pragma unroll
      for (int q = 0; q < 4; ++q) { u32x2 w0 = {pk2(c0[4 * q], c0[4 * q + 1]), pk2(c0[4 * q + 2], c0[4 * q + 3])}, w1 = {pk2(c1[4 * q], c1[4 * q + 1]), pk2(c1[4 * q + 2], c1[4 * q + 3])};
          *(u32x2*)(dst + 8 * q) = w0; *(u32x2*)(dst + 32 + 8 * q) = w1; } }
    LBAR();
}
DEVI void p_scan(bf16_t* DST, const float* DEC, int gt) {
    const int combo = gt >> 10, el = gt & 1023, e = el >> 3, d0 = (el & 7) * 8;
    const int seq = combo >> 3, h = (combo >> 1) & 3, dir = combo & 1;
    const int nch = seq < 8 ? 64 : 32, n0 = seq < 8 ? seq * 64 : 512 + (seq - 8) * 32;
    float S[8];
#pragma unroll
    for (int j = 0; j < 8; ++j) S[j] = 0.f;
    for (int st0 = 0; st0 < nch; st0 += 8) {
        u32x4 ds[8]; f32x4 dc0[8], dc1[8];
#pragma unroll
        for (int u = 0; u < 8; ++u) { const int n = dir ? nch - 1 - (st0 + u) : st0 + u; const size_t item = (size_t)((n0 + n) * 4 + h) * 2 + dir;
            ds[u] = *(const u32x4*)(DST + item * 8192 + e * 64 + d0); dc0[u] = *(const f32x4*)(DEC + item * 64 + d0); dc1[u] = *(const f32x4*)(DEC + item * 64 + d0 + 4); }
#pragma unroll
        for (int u = 0; u < 8; ++u) { const int n = dir ? nch - 1 - (st0 + u) : st0 + u; const size_t item = (size_t)((n0 + n) * 4 + h) * 2 + dir;
            u32x4 w = {pk2(S[0], S[1]), pk2(S[2], S[3]), pk2(S[4], S[5]), pk2(S[6], S[7])};
            *(u32x4*)(DST + item * 8192 + e * 64 + d0) = w;
            S[0] = dc0[u][0] * S[0] + __uint_as_float(ds[u][0] << 16); S[1] = dc0[u][1] * S[1] + __uint_as_float(ds[u][0] & 0xffff0000u);
            S[2] = dc0[u][2] * S[2] + __uint_as_float(ds[u][1] << 16); S[3] = dc0[u][3] * S[3] + __uint_as_float(ds[u][1] & 0xffff0000u);
            S[4] = dc1[u][0] * S[4] + __uint_as_float(ds[u][2] << 16); S[5] = dc1[u][1] * S[5] + __uint_as_float(ds[u][2] & 0xffff0000u);
            S[6] = dc1[u][2] * S[6] + __uint_as_float(ds[u][3] << 16); S[7] = dc1[u][3] * S[7] + __uint_as_float(ds[u][3] & 0xffff0000u); }
    }
}
DEVI void gla_c_item(const GlaLd& L, int item, const bf16_t* QKVR, const bf16_t* DST, const float* outg, bf16_t* MIX, unsigned char* lds, int tid, int wave, int lane) {
    const int n = item >> 2, h = item & 3, tok0 = n * 64, d = tid & 63, sg = tid >> 6, r32 = lane & 31, hi = lane >> 5;
    u32x4 sp[4], rg0, rg1;
#pragma unroll
    for (int p = 0; p < 2; ++p) { const int row = (tid >> 3) + 64 * p, c = tid & 7;
        sp[2 * p] = *(const u32x4*)(DST + (size_t)(item * 2) * 8192 + row * 64 + c * 8); sp[2 * p + 1] = *(const u32x4*)(DST + (size_t)(item * 2 + 1) * 8192 + row * 64 + c * 8); }
    { const bf16_t* rp = QKVR + (size_t)TT * 1024 + (size_t)(tok0 + (tid >> 3)) * 512 + h * 128 + 16 * (tid & 7); rg0 = *(const u32x4*)rp; rg1 = *(const u32x4*)(rp + 8); }
    float bF[8], bB[8], totF, totB;
    gla_prefix(L, (float*)(lds + L_SEG), tid, bF, bB, totF, totB);
    bf16_t* QF = (bf16_t*)(lds + L_QF); bf16_t* QB = (bf16_t*)(lds + L_QB); bf16_t* KF = (bf16_t*)(lds + L_KF); bf16_t* KB = (bf16_t*)(lds + L_KB);
#pragma unroll
    for (int i = 0; i < 8; ++i) { const float qv = bf2f(L.qh[i]), kv = bf2f(L.kh[i]);
        const int o = (8 * sg + i) * (GP / 2) + d;
        QF[o] = f2bf(qv * __expf(bF[i])); KF[o] = f2bf(kv * __expf(-bF[i])); QB[o] = f2bf(qv * __expf(bB[i])); KB[o] = f2bf(kv * __expf(-bB[i])); }
    gla_stage_vt(L, lds + L_VT, tid);
#pragma unroll
    for (int p = 0; p < 2; ++p) { const int row = (tid >> 3) + 64 * p, c = tid & 7;
        *(u32x4*)(lds + L_SPF + row * GP + c * 16) = sp[2 * p]; *(u32x4*)(lds + L_SPB + row * GP + c * 16) = sp[2 * p + 1]; }
    LBAR();
    { const int dir = wave >> 2, it = (wave >> 1) & 1, jt = wave & 1;
      const unsigned char* Qd = lds + (dir ? L_QB : L_QF); const unsigned char* Kd = lds + (dir ? L_KB : L_KF);
      f32x16 c = {};
#pragma unroll
      for (int ks = 0; ks < 4; ++ks) c = __builtin_amdgcn_mfma_f32_32x32x16_bf16(ldf(Qd, 32 * it + r32, ks, hi), ldf(Kd, 32 * jt + r32, ks, hi), c, 0, 0, 0);
      bf16_t* AT = (bf16_t*)(lds + (dir ? L_ATB : L_ATF));
      const int j = 32 * jt + r32;
#pragma unroll
      for (int r = 0; r < 16; ++r) { const int i = 32 * it + crow(r, hi); const bool keep = dir ? (j >= i) : (j <= i); AT[i * (GP / 2) + j] = f2bf(keep ? c[r] : 0.f); } }
    LBAR();
    { const int it = wave >> 2, et = wave & 3;
      f32x16 o = {};
#pragma unroll
      for (int dir = 0; dir < 2; ++dir) {
          const unsigned char* AT = lds + (dir ? L_ATB : L_ATF); const unsigned char* Qd = lds + (dir ? L_QB : L_QF); const unsigned char* SPd = lds + (dir ? L_SPB : L_SPF);
#pragma unroll
          for (int ks = 0; ks < 4; ++ks) o = __builtin_amdgcn_mfma_f32_32x32x16_bf16(ldf(AT, 32 * it + r32, ks, hi), ldf(lds + L_VT, 32 * et + r32, ks, hi), o, 0, 0, 0);
#pragma unroll
          for (int ks = 0; ks < 4; ++ks) o = __builtin_amdgcn_mfma_f32_32x32x16_bf16(ldf(Qd, 32 * it + r32, ks, hi), ldf(SPd, 32 * et + r32, ks, hi), o, 0, 0, 0); }
      LBAR();
      float* OB = (float*)lds;
#pragma unroll
      for (int r = 0; r < 16; ++r) OB[(32 * it + crow(r, hi)) * 132 + 32 * et + r32] = o[r]; }
    LBAR();
    { const int i = tid >> 3, s8 = tid & 7; const float* OB = (const float*)lds + i * 132 + 16 * s8;
      f32x4 v[4]; float ss = 0.f;
#pragma unroll
      for (int q = 0; q < 4; ++q) { v[q] = *(const f32x4*)(OB + 4 * q); ss += (v[q].x * v[q].x + v[q].y * v[q].y) + (v[q].z * v[q].z + v[q].w * v[q].w); }
      ss += __shfl_xor(ss, 1); ss += __shfl_xor(ss, 2); ss += __shfl_xor(ss, 4);
      const float rstd = rsqrtf(ss * (1.f / 128.f) + EPS);
      const int tok = tok0 + i;
      const u32x4 r0 = rg0, r1 = rg1;
      float y[16];
#pragma unroll
      for (int q = 0; q < 4; ++q) { const f32x4 g = *(const f32x4*)(outg + 16 * s8 + 4 * q);
          const unsigned w0 = q < 2 ? r0[2 * q] : r1[2 * (q - 2)], w1 = q < 2 ? r0[2 * q + 1] : r1[2 * (q - 2) + 1];
          y[4 * q + 0] = v[q].x * rstd * g.x * silu(__uint_as_float(w0 << 16)); y[4 * q + 1] = v[q].y * rstd * g.y * silu(__uint_as_float(w0 & 0xffff0000u));
          y[4 * q + 2] = v[q].z * rstd * g.z * silu(__uint_as_float(w1 << 16)); y[4 * q + 3] = v[q].w * rstd * g.w * silu(__uint_as_float(w1 & 0xffff0000u)); }
      u32x4 a = {pk2(y[0], y[1]), pk2(y[2], y[3]), pk2(y[4], y[5]), pk2(y[6], y[7])}, b = {pk2(y[8], y[9]), pk2(y[10], y[11]), pk2(y[12], y[13]), pk2(y[14], y[15])};
      bf16_t* mp = MIX + (size_t)tok * 1024 + h * 128 + 16 * s8;
      *(u32x4*)mp = a; *(u32x4*)(mp + 8) = b; }
    LBAR();
}

DEVI void p_qkrope(bf16_t* Q, bf16_t* K, const float* qg, const float* kg, const float2* rope, int gw, int NGW, int lane) {
    const int i = lane & 31, hh = lane >> 5;
    float gq[4], gk[4];
#pragma unroll
    for (int j = 0; j < 4; ++j) { gq[j] = qg[32 * j + i]; gk[j] = kg[32 * j + i]; }
    for (int t0 = gw * 4; t0 < TT; t0 += NGW * 4) {
        bf16_t xr[4][5][4]; float2 rr[4], rc[4];
#pragma unroll
        for (int u = 0; u < 4; ++u) { const int t = t0 + u, s = t < TP ? (t & 4095) : ((t - TP) & 2047);
            rr[u] = rope[(s >> 6) * 32 + i]; rc[u] = rope[(s & 63) * 32 + i];
#pragma unroll
            for (int p = 0; p < 5; ++p) { const int slot = 2 * p + hh;
                const bf16_t* base = slot < 8 ? Q + (size_t)t * 1024 + slot * 128 : K + (size_t)t * 256 + (slot - 8) * 128;
#pragma unroll
                for (int j = 0; j < 4; ++j) xr[u][p][j] = base[32 * j + i]; } }
#pragma unroll
        for (int u = 0; u < 4; ++u) { const int t = t0 + u;
#pragma unroll
            for (int p = 0; p < 5; ++p) {
                const int slot = 2 * p + hh;
                bf16_t* base = slot < 8 ? Q + (size_t)t * 1024 + slot * 128 : K + (size_t)t * 256 + (slot - 8) * 128;
                float x[4]; float ss = 0.f;
#pragma unroll
                for (int j = 0; j < 4; ++j) { x[j] = bf2f(xr[u][p][j]); ss += x[j] * x[j]; }
                ss += __shfl_xor(ss, 1); ss += __shfl_xor(ss, 2); ss += __shfl_xor(ss, 4); ss += __shfl_xor(ss, 8); ss += __shfl_xor(ss, 16);
                const float rstd = rsqrtf(ss * (1.f / 128.f) + EPS);
#pragma unroll
                for (int j = 0; j < 4; ++j) x[j] *= rstd * (slot < 8 ? gq[j] : gk[j]);
                base[i] = f2bf(x[0] * rr[u].x - x[1] * rr[u].y); base[32 + i] = f2bf(x[1] * rr[u].x + x[0] * rr[u].y);
                base[64 + i] = f2bf(x[2] * rc[u].x - x[3] * rc[u].y); base[96 + i] = f2bf(x[3] * rc[u].x + x[2] * rc[u].y);
            } }
    }
}
namespace attn {
using bf16 = unsigned short;
constexpr int   D = 128, NW = 8, QBLK = 32, KVBLK = 64;
constexpr float SCALE = 0.088388347648318440f;
constexpr float THR = 8.f;
constexpr int SDEPTH = 2;
constexpr int LDQ = 1024, LDK = 256, LDO = 1024;
constexpr size_t SHM_V = KVBLK * D * 2, SHM_K = KVBLK * D * 2, SHM_ATTN = 2 * SHM_V + 2 * SHM_K + NW * 64 * 4;
using bf16x8 = __attribute__((ext_vector_type(8))) short;
using s16x4  = __attribute__((ext_vector_type(4))) short;
using f32x16 = __attribute__((ext_vector_type(16))) float;
using f32x8  = __attribute__((ext_vector_type(8))) float;
using u32x4  = __attribute__((ext_vector_type(4))) unsigned;
#define KSWZ(row, colB) ((row) * 256 + ((colB) ^ (((row) & 7) << 4)))
#define SBAR() __builtin_amdgcn_sched_barrier(0)
__device__ __forceinline__ int crow(int r, int hi) { return (r & 3) + 8 * (r >> 2) + 4 * hi; }
__device__ __forceinline__ unsigned cvtpk(float lo, float hi) {
  unsigned r; asm volatile("v_cvt_pk_bf16_f32 %0, %1, %2" : "=v"(r) : "v"(lo), "v"(hi)); return r;
}
template <typename TIn> struct Stage;
template <> struct Stage<bf16>  { using T = bf16x8;
  __device__ static __forceinline__ T ld8(const bf16* p) { return *reinterpret_cast<const bf16x8*>(p); }
  __device__ static __forceinline__ bf16x8 tobf(T x) { return x; } };
template <> struct Stage<float> { using T = f32x8;
  __device__ static __forceinline__ T ld8(const float* p) { return *reinterpret_cast<const f32x8*>(p); }
  __device__ static __forceinline__ bf16x8 tobf(T x) {
    u32x4 w = {cvtpk(x[0], x[1]), cvtpk(x[2], x[3]), cvtpk(x[4], x[5]), cvtpk(x[6], x[7])}; return *reinterpret_cast<bf16x8*>(&w); } };

__device__ __forceinline__ void partialSM(f32x16& p0, f32x16& p1, float& m_reg, float& mn, float& alpha) {
  constexpr float C = SCALE * 1.4426950408889634f;
  float pmax = p0[0]; for (int r = 1; r < 16; ++r) pmax = fmaxf(pmax, p0[r]); for (int r = 0; r < 16; ++r) pmax = fmaxf(pmax, p1[r]);
  { auto rr = __builtin_amdgcn_permlane32_swap(__float_as_uint(pmax), __float_as_uint(pmax), false, false);
    pmax = fmaxf(__uint_as_float(rr[0]), __uint_as_float(rr[1])); }
  if (__builtin_expect(__all(pmax - m_reg <= THR / SCALE), 1)) { mn = m_reg; alpha = 1.f; }
  else { mn = fmaxf(m_reg, pmax); alpha = __builtin_amdgcn_exp2f((m_reg - mn) * C); m_reg = mn; }
  float mnC = -mn * C;
  for (int r = 0; r < 16; ++r) p0[r] = fmaf(p0[r], C, mnC); for (int r = 0; r < 16; ++r) p1[r] = fmaf(p1[r], C, mnC);
  for (int r = 0; r < 16; ++r) p0[r] = __builtin_amdgcn_exp2f(p0[r]);
}
__device__ __forceinline__ void finishSM(f32x16& p0, f32x16& p1, float alpha, float& l_reg, bf16x8& pa0, bf16x8& pa1, bf16x8& pa2, bf16x8& pa3) {
  for (int r = 0; r < 16; ++r) p1[r] = __builtin_amdgcn_exp2f(p1[r]);
  float ps = 0; for (int r = 0; r < 16; ++r) ps += p0[r]; for (int r = 0; r < 16; ++r) ps += p1[r];
  { auto rr = __builtin_amdgcn_permlane32_swap(__float_as_uint(ps), __float_as_uint(ps), false, false);
    ps = __uint_as_float(rr[0]) + __uint_as_float(rr[1]); }
  l_reg = l_reg * alpha + ps;
#define PK4(P, BASE, OUT) do { unsigned a0 = cvtpk(P[BASE + 0], P[BASE + 1]), a1 = cvtpk(P[BASE + 2], P[BASE + 3]);   \
    unsigned b0 = cvtpk(P[BASE + 4], P[BASE + 5]), b1 = cvtpk(P[BASE + 6], P[BASE + 7]);                              \
    auto r0 = __builtin_amdgcn_permlane32_swap(a0, b0, false, false); auto r1 = __builtin_amdgcn_permlane32_swap(a1, b1, false, false); \
    u32x4 w = {r0[0], r1[0], r0[1], r1[1]}; OUT = *reinterpret_cast<bf16x8*>(&w); } while (0)
  PK4(p0, 0, pa0); PK4(p0, 8, pa1); PK4(p1, 0, pa2); PK4(p1, 8, pa3);
#undef PK4
}
__device__ __forceinline__ void qkt(f32x16& p0, f32x16& p1, const bf16* Ks, const bf16x8* qr, int r32, int hi) {
  p0 = f32x16{}; p1 = f32x16{};
  for (int d0 = 0; d0 < 8; ++d0) { int cb = (d0 * 16 + hi * 8) * 2;
    bf16x8 b0 = *reinterpret_cast<const bf16x8*>((const char*)Ks + KSWZ(r32, cb));
    bf16x8 b1 = *reinterpret_cast<const bf16x8*>((const char*)Ks + KSWZ(32 + r32, cb));
    p0 = __builtin_amdgcn_mfma_f32_32x32x16_bf16(b0, qr[d0], p0, 0, 0, 0);
    p1 = __builtin_amdgcn_mfma_f32_32x32x16_bf16(b1, qr[d0], p1, 0, 0, 0); }
}
__device__ __forceinline__ int v_st(int k, int c) { const int kk = (k & ~0xC) | ((k & 4) << 1) | ((k & 8) >> 1); return ((kk >> 3) * 4 + (c >> 5)) * 512 + ((kk & 7) * 32 + (c & 31)) * 2; }
__device__ __forceinline__ int v_rd_base(int lane) { return ((lane & 3) << 3) | (((lane >> 2) & 3) << 6) | (((lane >> 4) & 1) << 5) | (((lane >> 5) & 1) << 8); }
constexpr int v_rd_off(int d0, int ks, int half) { return d0 * 512 + ks * 4096 + half * 2048; }
template <int OFF> __device__ __forceinline__ s16x4 tr_read(int vb) {
  s16x4 r; asm volatile("ds_read_b64_tr_b16 %0, %1 offset:%2" : "=&v"(r) : "v"(vb), "i"(OFF) : "memory"); return r;
}
template <int D0> __device__ __forceinline__ void pv_one(f32x16& od, int vb, bf16x8 pa0, bf16x8 pa1, bf16x8 pa2, bf16x8 pa3) {
  const s16x4 l0 = tr_read<v_rd_off(D0, 0, 0)>(vb), h0 = tr_read<v_rd_off(D0, 0, 1)>(vb), l1 = tr_read<v_rd_off(D0, 1, 0)>(vb), h1 = tr_read<v_rd_off(D0, 1, 1)>(vb);
  const s16x4 l2 = tr_read<v_rd_off(D0, 2, 0)>(vb), h2 = tr_read<v_rd_off(D0, 2, 1)>(vb), l3 = tr_read<v_rd_off(D0, 3, 0)>(vb), h3 = tr_read<v_rd_off(D0, 3, 1)>(vb);
  asm volatile("s_waitcnt lgkmcnt(0)" ::: "memory"); SBAR();
#define PK(L, H) (bf16x8){L[0], L[1], L[2], L[3], H[0], H[1], H[2], H[3]}
  od = __builtin_amdgcn_mfma_f32_32x32x16_bf16(pa0, PK(l0, h0), od, 0, 0, 0);
  od = __builtin_amdgcn_mfma_f32_32x32x16_bf16(pa1, PK(l1, h1), od, 0, 0, 0);
  od = __builtin_amdgcn_mfma_f32_32x32x16_bf16(pa2, PK(l2, h2), od, 0, 0, 0);
  od = __builtin_amdgcn_mfma_f32_32x32x16_bf16(pa3, PK(l3, h3), od, 0, 0, 0);
#undef PK
}
__device__ __forceinline__ void pv_d0(f32x16* o, int vb, bf16x8 pa0, bf16x8 pa1, bf16x8 pa2, bf16x8 pa3) {
  pv_one<0>(o[0], vb, pa0, pa1, pa2, pa3); pv_one<1>(o[1], vb, pa0, pa1, pa2, pa3); pv_one<2>(o[2], vb, pa0, pa1, pa2, pa3); pv_one<3>(o[3], vb, pa0, pa1, pa2, pa3);
}

template <typename TQ>
__device__ __forceinline__ void attn_dense_body(const TQ* __restrict__ Qb, const bf16* __restrict__ Kh, const bf16* __restrict__ Vh,
                                                bf16* __restrict__ Ob, int seq, char* lds) {
  using St = Stage<bf16>; using SQ = Stage<TQ>;
  const int tid = threadIdx.x, wid = __builtin_amdgcn_readfirstlane(tid >> 6), lane = tid & 63, r32 = lane & 31, hi = lane >> 5;
  bf16* V_lds = (bf16*)lds; bf16* K_lds = (bf16*)(lds + 2 * SHM_V);
  float* ws = (float*)(lds + 2 * SHM_V + 2 * SHM_K) + wid * 64; float* li_l = ws; float* al_l = ws + 32;
  float m_reg = -1e30f, l_reg = 0; f32x16 o[4] = {}; bf16x8 qr[8];
  const TQ* Qw = Qb + (long)(wid * QBLK + r32) * LDQ + hi * 8;
#pragma unroll
  for (int d0 = 0; d0 < 8; ++d0) qr[d0] = SQ::tobf(SQ::ld8(Qw + d0 * 16));
  const int sr = tid >> 4, sc = (tid & 15) * 8, vst0 = v_st(sr, sc), vst1 = v_st(32 + sr, sc);
  const int vb0 = (int)(uintptr_t)V_lds + v_rd_base(lane);
  struct { typename St::T vs0, vs1, ks0, ks1; } sr_[SDEPTH];
#define SLOAD(i, k0) do { sr_[i].vs0 = St::ld8(&Vh[(long)((k0) + sr) * LDK + sc]); sr_[i].vs1 = St::ld8(&Vh[(long)((k0) + 32 + sr) * LDK + sc]); \
    sr_[i].ks0 = St::ld8(&Kh[(long)((k0) + sr) * LDK + sc]); sr_[i].ks1 = St::ld8(&Kh[(long)((k0) + 32 + sr) * LDK + sc]); } while (0)
#define SWRITE(b, i) do { *(bf16x8*)((char*)V_lds + (b) * SHM_V + vst0) = St::tobf(sr_[i].vs0);          \
    *(bf16x8*)((char*)V_lds + (b) * SHM_V + vst1) = St::tobf(sr_[i].vs1); int kc = sc * 2;               \
    *(bf16x8*)((char*)K_lds + (b) * SHM_K + KSWZ(sr, kc)) = St::tobf(sr_[i].ks0);                       \
    *(bf16x8*)((char*)K_lds + (b) * SHM_K + KSWZ(32 + sr, kc)) = St::tobf(sr_[i].ks1); } while (0)
#define SWAIT() do { if constexpr (SDEPTH == 2) asm volatile("s_waitcnt vmcnt(4)" ::: "memory"); else asm volatile("s_waitcnt vmcnt(0)" ::: "memory"); } while (0)
#define RESC(a) do { if (__any((a) < 1.f)) { if (hi == 0) al_l[r32] = (a); asm volatile("s_waitcnt lgkmcnt(0)" ::: "memory"); \
    for (int d = 0; d < 4; ++d) for (int r = 0; r < 16; ++r) o[d][r] *= al_l[crow(r, hi)]; } } while (0)
  f32x16 pA0, pA1, pB0, pB1; float mnA, mnB, alA, alB; bf16x8 pa0, pa1, pa2, pa3; const int NT = seq / KVBLK;
  constexpr int SE = 0, SO = SDEPTH - 1;
  SLOAD(SE, 0); asm volatile("s_waitcnt vmcnt(0)" ::: "memory"); SWRITE(0, SE); __syncthreads();
  qkt(pA0, pA1, K_lds, qr, r32, hi); partialSM(pA0, pA1, m_reg, mnA, alA);
  SLOAD(SO, KVBLK); if constexpr (SDEPTH == 2) { if (2 < NT) SLOAD(SE, 2 * KVBLK); }
  SWAIT(); SWRITE(1, SO); __syncthreads();
  for (int j = 1; j + 1 < NT; j += 2) {
    SBAR(); qkt(pB0, pB1, (bf16*)((char*)K_lds + SHM_K), qr, r32, hi);
    finishSM(pA0, pA1, alA, l_reg, pa0, pa1, pa2, pa3); SBAR();
    SLOAD(SO, (j + SDEPTH) * KVBLK); SBAR();
    pv_d0(o, vb0, pa0, pa1, pa2, pa3); partialSM(pB0, pB1, m_reg, mnB, alB);
    __syncthreads(); SWAIT(); SWRITE(0, SE);
    RESC(alB); __syncthreads();
    SBAR(); qkt(pA0, pA1, K_lds, qr, r32, hi);
    finishSM(pB0, pB1, alB, l_reg, pa0, pa1, pa2, pa3); SBAR();
    if (SDEPTH == 1 || j + 3 < NT) SLOAD(SE, (j + 1 + SDEPTH) * KVBLK); SBAR();
    pv_d0(o, vb0 + (int)SHM_V, pa0, pa1, pa2, pa3); partialSM(pA0, pA1, m_reg, mnA, alA);
    __syncthreads(); SWAIT(); SWRITE(1, SO);
    RESC(alA); __syncthreads();
  }
  SBAR(); qkt(pB0, pB1, (bf16*)((char*)K_lds + SHM_K), qr, r32, hi);
  finishSM(pA0, pA1, alA, l_reg, pa0, pa1, pa2, pa3); SBAR();
  pv_d0(o, vb0, pa0, pa1, pa2, pa3); partialSM(pB0, pB1, m_reg, mnB, alB);
  __syncthreads(); RESC(alB);
  finishSM(pB0, pB1, alB, l_reg, pa0, pa1, pa2, pa3); SBAR();
  pv_d0(o, vb0 + (int)SHM_V, pa0, pa1, pa2, pa3);
  if (hi == 0) li_l[r32] = l_reg; asm volatile("s_waitcnt lgkmcnt(0)" ::: "memory");
  float rli[16];
#pragma unroll
  for (int r = 0; r < 16; ++r) rli[r] = __builtin_amdgcn_rcpf(li_l[crow(r, hi)]);
  bf16* Ow = Ob + (long)(wid * QBLK) * LDO;
#pragma unroll
  for (int r = 0; r < 16; ++r) { int orow = crow(r, hi);
    for (int d0 = 0; d0 < 4; ++d0) Ow[(long)orow * LDO + d0 * 32 + r32] = (bf16)(cvtpk(o[d0][r] * rli[r], 0.f) & 0xffffu); }
#undef SLOAD
#undef SWRITE
#undef SWAIT
#undef RESC
}

#undef KSWZ
#undef SBAR
}

constexpr int LDS_BYTES = 135168;
struct Args { const float* in[19]; float* out; unsigned char* ws; };
#define LAS3 __attribute__((address_space(3)))

#define RLX_AGENT __ATOMIC_RELAXED, __HIP_MEMORY_SCOPE_AGENT
#define XB_TMO      128
#define XB_XCNT(j)  (256  + 64 * (j))
#define XB_XSUB(j)  (1280 + 64 * (j))
#define XB_XGEN(j)  (2304 + 64 * (j))
#define XB_TOP      3328
#define XB_TOPGEN   3392
#define XCD_BAR_WORDS 3456
#define XB_SPIN_CAP (1u << 18)

__device__ __forceinline__ unsigned xb_ld(unsigned* p)              { return __hip_atomic_load(p, __ATOMIC_RELAXED, __HIP_MEMORY_SCOPE_AGENT); }
__device__ __forceinline__ unsigned xb_add(unsigned* p, unsigned v) { return __hip_atomic_fetch_add(p, v, __ATOMIC_RELAXED, __HIP_MEMORY_SCOPE_AGENT); }
__device__ __forceinline__ unsigned xb_xcc_id() { return (unsigned)__builtin_amdgcn_s_getreg((3 << 11) | 20) & 0xFu; }
#define XB_SPIN(cond, bar) do { unsigned _sp = 0; while (cond) { __builtin_amdgcn_s_sleep(1); \
    if ((++_sp & 255u) == 0u) { if (xb_ld(&(bar)[XB_TMO])) break; if (_sp > XB_SPIN_CAP) { atomicAdd(&(bar)[XB_TMO], 1u); break; } } } } while (0)

struct XcdBarrier {
    unsigned* bar; unsigned x;
    volatile LAS3 unsigned* st;
};

__device__ __forceinline__ XcdBarrier xcd_barrier_post(unsigned* bar, volatile LAS3 unsigned* st) {
    XcdBarrier b; b.bar = bar; b.x = xb_xcc_id(); b.st = st;
    if (threadIdx.x == 0) (void)xb_add(&bar[XB_XCNT(b.x)], 1u);
    return b;
}
__device__ __forceinline__ void xcd_barrier_complete(unsigned* bar, unsigned x, unsigned& nloc, unsigned& nx) {
    const unsigned G = gridDim.x * gridDim.y * gridDim.z;
    unsigned sum, cnt, mine, sp = 0u;
    for (;;) {
        sum = 0u; cnt = 0u; mine = 0u;
#pragma unroll
        for (unsigned j = 0; j < 16; ++j) { const unsigned c = xb_ld(&bar[XB_XCNT(j)]); sum += c; cnt += (c > 0u) ? 1u : 0u; mine = (j == x) ? c : mine; }
        if (sum == G) break;
        __builtin_amdgcn_s_sleep(1);
        if ((++sp & 255u) == 0u) { if (xb_ld(&bar[XB_TMO])) break; if (sp > XB_SPIN_CAP) { atomicAdd(&bar[XB_TMO], 1u); break; } }
    }
    nloc = mine > 0u ? mine : 1u; nx = cnt > 0u ? cnt : 1u;
}

__device__ __forceinline__ void xcd_barrier(const XcdBarrier& b) {
    asm volatile("s_waitcnt vmcnt(0)" ::: "memory");
    __syncthreads();
    if (threadIdx.x == 0) {
        unsigned* bar = b.bar;
        __builtin_amdgcn_s_waitcnt(0);
        unsigned nloc = b.st[0], nx = b.st[1];
        if (nloc == 0u) { xcd_barrier_complete(bar, b.x, nloc, nx); b.st[0] = nloc; b.st[1] = nx; }
        const unsigned old = xb_add(&bar[XB_XSUB(b.x)], 1u);
        const unsigned gen = old / nloc;
        if (old + 1u == (gen + 1u) * nloc) {
            __builtin_amdgcn_fence(__ATOMIC_RELEASE, "agent");
            asm volatile("s_waitcnt vmcnt(0)" ::: "memory");
            const unsigned og = xb_add(&bar[XB_TOP], 1u);
            const unsigned tg = og / nx;
            if (og + 1u == (tg + 1u) * nx) xb_add(&bar[XB_TOPGEN], 1u);
            else XB_SPIN(xb_ld(&bar[XB_TOPGEN]) == tg, bar);
            __builtin_amdgcn_fence(__ATOMIC_ACQUIRE, "agent");
            xb_add(&bar[XB_XGEN(b.x)], 1u);
            asm volatile("s_waitcnt vmcnt(0)" ::: "memory");
        } else {
            XB_SPIN(xb_ld(&bar[XB_XGEN(b.x)]) == gen, bar);
            __builtin_amdgcn_fence(__ATOMIC_ACQUIRE, "agent");
            asm volatile("s_waitcnt vmcnt(0)" ::: "memory");
        }
    }
    __syncthreads();
}

constexpr int MISC_OFF = 131072;
constexpr int CW_BAR = 4096;
typedef const __attribute__((address_space(4))) Args* CArgsP;
#ifndef PHM
#define PHM 0xFFFFFFu
#endif
#ifndef PROBE_GLU
#define PROBE_GLU 0
#endif
#ifndef PROBE_MASK
#define PROBE_MASK 0u
#endif
#define REP(b) for (int rep__ = 0; rep__ < 1 + (int)((PROBE_MASK >> (b)) & 1u); ++rep__)
#ifndef PROBE_ATTN
#define PROBE_ATTN 0
#endif
#define PH(b) ((PHM >> (b)) & 1u)
#define PHASE_VARS \
    CArgsP ap = (CArgsP)__builtin_amdgcn_kernarg_segment_ptr(); asm volatile("" : "+s"(ap)); \
    int tid = threadIdx.x; asm volatile("" : "+v"(tid)); \
    const int lane = tid & 63, wave = __builtin_amdgcn_readfirstlane(tid >> 6); \
    const int G = gridDim.x, bx = blockIdx.x, gw = bx * 8 + wave, NGW = G * 8, gt = bx * 512 + tid, NGT = G * 512; \
    unsigned char* ws = ap->ws; float* out = ap->out; bf16_t* H = (bf16_t*)(ws + WS_H); \
    (void)lane; (void)gw; (void)NGW; (void)gt; (void)NGT; (void)out; (void)H; (void)bx; (void)G;
#define GRID_SYNC_CG() cg::this_grid().sync()
#define GRID_SYNC() do { CArgsP ap_ = (CArgsP)__builtin_amdgcn_kernarg_segment_ptr(); asm volatile("" : "+s"(ap_)); \
    XcdBarrier b_; b_.bar = (unsigned*)(ap_->ws + WS_CTL) + CW_BAR; b_.x = xb_xcc_id(); b_.st = (volatile LAS3 unsigned*)(lds3 + MISC_OFF); xcd_barrier(b_); } while (0)

#define SSQP(k) ((float*)(ws + WS_SSQ) + (size_t)(k) * TT)
template <int LAYER> DEVI void ffn_block(LAS3 unsigned char* lds3) {
    { PHASE_VARS
      for (int rep_ = 0; rep_ < (PROBE_GLU ? 2 : 1); ++rep_) if (PH(18)) { pg8::Gemm g{(const bf16_t*)(ws + WS_XBA), (const bf16_t*)(ws + (LAYER ? WS_W_GU1 : WS_W_GU0)), TT, 2 * FFH, 1024}; pg8::StaticOrder S; S.init(TT, 2 * FFH, G, bx);
        Epi<EM_GLU> E{(bf16_t*)(ws + WS_ACT), nullptr, nullptr, nullptr, nullptr, nullptr, nullptr, nullptr, SSQP(LAYER ? 3 : 1), nullptr, nullptr, nullptr};
        pg8::gemm_phase<Epi<EM_GLU>, pg8::StaticOrder, true, true>(lds3, g, S, E); } }
    GRID_SYNC();
    { PHASE_VARS
      if (PH(19)) { pg8::Gemm g{(const bf16_t*)(ws + WS_ACT), (const bf16_t*)(ws + (LAYER ? WS_W_D1 : WS_W_D0)), TT, 1024, FFH}; pg8::StaticOrder S; S.init(TT, 1024, G, bx);
        if constexpr (LAYER == 0) {
            Epi<EM_RES, true> E{nullptr, nullptr, nullptr, nullptr, nullptr, nullptr, nullptr, nullptr, nullptr, SSQP(2), (bf16_t*)(ws + WS_XBA), nullptr};
            pg8::gemm_phase<Epi<EM_RES, true>, pg8::StaticOrder, true, true>(lds3, g, S, E);
        } else {
            Epi<EM_RES> E{nullptr, nullptr, nullptr, out, nullptr, nullptr, nullptr, nullptr, nullptr, nullptr, (bf16_t*)(ws + WS_XBA), nullptr};
            pg8::gemm_phase<Epi<EM_RES>, pg8::StaticOrder, true, true>(lds3, g, S, E); } } }
}

__global__ void __launch_bounds__(512, 2) mega_fwd(Args a_unused) {
    extern __shared__ __attribute__((aligned(16))) unsigned char lds[];
    LAS3 unsigned char* lds3 = (LAS3 unsigned char*)lds;
    { if (threadIdx.x < 32) ((LAS3 unsigned*)(lds3 + MISC_OFF))[threadIdx.x] = 0u;
      __syncthreads();
      CArgsP ap0 = (CArgsP)__builtin_amdgcn_kernarg_segment_ptr();
      (void)xcd_barrier_post((unsigned*)(ap0->ws + WS_CTL) + CW_BAR, (volatile LAS3 unsigned*)(lds3 + MISC_OFF)); }
    { PHASE_VARS
      REP(0) if (PH(0)) p_fold(ap->in[3], ap->in[4], ap->in[6], (bf16_t*)(ws + WS_W_FT), (bf16_t*)(ws + WS_W_AB1) + (size_t)1536 * 1024, (float*)lds, gw, NGW, lane);
      REP(0) if (PH(1)) { p_dft((bf16_t*)(ws + WS_C4), (bf16_t*)(ws + WS_S4), 4096, 12, gt, NGT); p_dft((bf16_t*)(ws + WS_C2), (bf16_t*)(ws + WS_S2), 2048, 11, gt, NGT); }
      if (gt < 2048) { const int idx = gt >> 5, i = gt & 31; const float inv = powf(10000.f, -(float)(2 * i) * (1.f / 64.f)); const float ang = (float)idx * inv;
          ((float2*)(ws + WS_ROPE))[gt] = make_float2((float)cos((double)ang), (float)sin((double)ang)); }
      for (int i = gt; i < 3 * TT; i += NGT) SSQP(1)[i] = 0.f;
      REP(0) if (PH(2)) p_prep_fold(ap->in[0], ap->in[1], ap->in[2], (bf16_t*)(ws + WS_XBB), SSQP(0), (bf16_t*)((unsigned char*)out + OUT_HS), (bf16_t*)((unsigned char*)out + OUT_HD), (bf16_t*)(ws + WS_HM), gw, NGW, lane); }
    __syncthreads();
    { PHASE_VARS
      REP(3) if (PH(3)) { float* scr = (float*)(lds + wave * 16384);
      const float* win = ap->in[3];
      for (int it = gw; it < 11008; it += NGW) { int r = it;
          if (tr_mat<0>(r, win, 2080, 0, 1024, 256, (bf16_t*)(ws + WS_W_AB1), 0, 0.125f, scr, lane)) continue;
          if (tr_mat<0>(r, win, 2080, 256, 1024, 1280, (bf16_t*)(ws + WS_W_AB1), 256, 1.f, scr, lane)) continue;
          if (tr_mat<0>(r, ap->in[9], 1024, 0, 1024, 1024, (bf16_t*)(ws + WS_W_ABO), 0, 1.f, scr, lane)) continue;
          if (tr_mat<1>(r, ap->in[16], FFH, 0, 1024, FFH, (bf16_t*)(ws + WS_W_GU0), 0, 1.f, scr, lane, ap->in[15])) continue;
          if (tr_mat<2>(r, ap->in[17], FFH, 0, 1024, FFH, (bf16_t*)(ws + WS_W_GU0), 0, 1.f, scr, lane, ap->in[15])) continue;
          if (tr_mat<0>(r, ap->in[18], 1024, 0, FFH, 1024, (bf16_t*)(ws + WS_W_D0), 0, 1.f, scr, lane)) continue;
          if (tr_mat<0>(r, ap->in[11], 1536, 0, 1024, 1536, (bf16_t*)(ws + WS_W_QKV), 0, 1.f, scr, lane, ap->in[10])) continue;
          if (tr_mat<0>(r, ap->in[14], 1024, 0, 1024, 1024, (bf16_t*)(ws + WS_W_CO), 0, 1.f, scr, lane)) continue;
          if (tr_mat<1>(r, ap->in[16] + (size_t)1024 * FFH, FFH, 0, 1024, FFH, (bf16_t*)(ws + WS_W_GU1), 0, 1.f, scr, lane, ap->in[15] + 1024)) continue;
          if (tr_mat<2>(r, ap->in[17] + (size_t)1024 * FFH, FFH, 0, 1024, FFH, (bf16_t*)(ws + WS_W_GU1), 0, 1.f, scr, lane, ap->in[15] + 1024)) continue;
          if (tr_mat<0>(r, ap->in[18] + (size_t)1024 * FFH, 1024, 0, FFH, 1024, (bf16_t*)(ws + WS_W_D1), 0, 1.f, scr, lane)) continue;
      } } }
    GRID_SYNC_CG();
    { PHASE_VARS
      REP(4) if (PH(4)) { pg8::Gemm g{(const bf16_t*)(ws + WS_XBB), (const bf16_t*)(ws + WS_W_AB1), TT, 2048, 1024}; RotOrder S; S.S.init(TT, 2048, G, bx);
        Epi<EM_AB1> E{(bf16_t*)(ws + WS_QKVR), nullptr, nullptr, (float*)(ws + WS_G), nullptr, nullptr, ap->in[5], ap->in[7], SSQP(0), nullptr, nullptr, nullptr};
        pg8::gemm_phase<Epi<EM_AB1>, RotOrder, true, true>(lds3, g, S, E); } }
    { PHASE_VARS
      REP(5) if (PH(5)) { pg8::Gemm g{(const bf16_t*)(ws + WS_W_FT), (const bf16_t*)((unsigned char*)out + OUT_HS), 1024, 2 * TF, 1024}; FoldOrder S{G, (bx + G / 2) % G};
        Epi<EM_AB1T> E{(bf16_t*)((unsigned char*)out + OUT_YTPC), (bf16_t*)((unsigned char*)out + OUT_YTSC), nullptr, nullptr, nullptr, nullptr, nullptr, nullptr, nullptr, nullptr, nullptr, nullptr};
        pg8::gemm_phase<Epi<EM_AB1T>, FoldOrder, true, true>(lds3, g, S, E); } }
    GRID_SYNC();
    { PHASE_VARS
      REP(6) if (PH(6)) { pg8::Gemm g{(const bf16_t*)(ws + WS_C4), (const bf16_t*)((unsigned char*)out + OUT_YTPC), 2048, 4096, 2048}; pg8::StaticOrder S; S.init(2048, 4096, G, bx);
        Epi<EM_FNETP> E{(bf16_t*)(ws + WS_PCP), nullptr, nullptr, nullptr, nullptr, nullptr, nullptr, nullptr, nullptr, nullptr, nullptr, nullptr};
        pg8::gemm_phase<Epi<EM_FNETP>, pg8::StaticOrder, true, true>(lds3, g, S, E); } }
    { PHASE_VARS
      REP(6) if (PH(6)) { pg8::Gemm g{(const bf16_t*)(ws + WS_S4), (const bf16_t*)((unsigned char*)out + OUT_YTPS), 2048, 4096, 2048}; pg8::StaticOrder S; S.init(2048, 4096, G, (bx + G / 2) % G);
        Epi<EM_FNETP> E{(bf16_t*)(ws + WS_PSP), nullptr, nullptr, nullptr, nullptr, nullptr, nullptr, nullptr, nullptr, nullptr, nullptr, nullptr};
        pg8::gemm_phase<Epi<EM_FNETP>, pg8::StaticOrder, true, true>(lds3, g, S, E); } }
    { PHASE_VARS
      REP(6) if (PH(7)) { pg8::Gemm g{(const bf16_t*)(ws + WS_C2), (const bf16_t*)((unsigned char*)out + OUT_YTSC), 1024, 4096, 1024}; pg8::StaticOrder S; S.init(1024, 4096, G, (bx + G / 2) % G);
        Epi<EM_FNETS> E{(bf16_t*)(ws + WS_PCS), nullptr, nullptr, nullptr, nullptr, nullptr, nullptr, nullptr, nullptr, nullptr, nullptr, nullptr};
        pg8::gemm_phase<Epi<EM_FNETS>, pg8::StaticOrder, true, true>(lds3, g, S, E); } }
    { PHASE_VARS
      REP(6) if (PH(7)) { pg8::Gemm g{(const bf16_t*)(ws + WS_S2), (const bf16_t*)((unsigned char*)out + OUT_YTSS), 1024, 4096, 1024}; pg8::StaticOrder S; S.init(1024, 4096, G, (bx + G / 4) % G);
        Epi<EM_FNETS> E{(bf16_t*)(ws + WS_PSS), nullptr, nullptr, nullptr, nullptr, nullptr, nullptr, nullptr, nullptr, nullptr, nullptr, nullptr};
        pg8::gemm_phase<Epi<EM_FNETS>, pg8::StaticOrder, true, true>(lds3, g, S, E); } }
    { PHASE_VARS
      REP(8) if (PH(8)) { const int half = G / 2;
        const bf16_t* QKVR = (const bf16_t*)(ws + WS_QKVR); const float* Gb = (const float*)(ws + WS_G); bf16_t* DST = (bf16_t*)((unsigned char*)out + OUT_DST); float* DEC = (float*)(ws + WS_DEC);
        const int first = bx < half ? bx : 1920 + bx - half, last = bx < half ? 1920 : 3072;
        GlaLd A; gla_load<false>(A, first, QKVR, Gb, DST, tid);
        for (int item = first; item < last; item += half) { GlaLd B; const int nx = item + half < last ? item + half : item;
            gla_load<false>(B, nx, QKVR, Gb, DST, tid);
            gla_a_item(A, item, DST, DEC, lds, tid, wave, lane); A = B; } }
      p_ymid((const bf16_t*)(ws + WS_HM), (const bf16_t*)(ws + WS_W_FT), (float*)(ws + WS_YMID), gw, NGW, lane); }
    GRID_SYNC();
    { PHASE_VARS
      if (PH(9)) for (int g2 = gt; g2 < 131072; g2 += NGT) p_scan((bf16_t*)((unsigned char*)out + OUT_DST), (const float*)(ws + WS_DEC), g2);
      p_fcombine((const bf16_t*)(ws + WS_PCP), (const bf16_t*)(ws + WS_PSP), (const float*)(ws + WS_YMID), H, 0, 4096, 11, gt, NGT);
      p_fcombine((const bf16_t*)(ws + WS_PCS), (const bf16_t*)(ws + WS_PSS), (const float*)(ws + WS_YMID) + 8 * 512, H, TP, 2048, 10, gt, NGT);
      p_fmid((const bf16_t*)((unsigned char*)out + OUT_YTPC), (const float*)(ws + WS_YMID), H, 0, 4096, gw, NGW, lane);
      p_fmid((const bf16_t*)((unsigned char*)out + OUT_YTSC), (const float*)(ws + WS_YMID) + 8 * 512, H, TP, 2048, gw, NGW, lane); }
    GRID_SYNC();
    { PHASE_VARS
      REP(10) if (PH(10)) { const bf16_t* QKVR = (const bf16_t*)(ws + WS_QKVR); const float* Gb = (const float*)(ws + WS_G); const bf16_t* DST = (const bf16_t*)((unsigned char*)out + OUT_DST);
        GlaLd A; gla_load<true>(A, bx, QKVR, Gb, DST, tid);
        for (int item = bx; item < 3072; item += G) { GlaLd B; const int nx = item + G < 3072 ? item + G : item;
            gla_load<true>(B, nx, QKVR, Gb, DST, tid);
            gla_c_item(A, item, QKVR, DST, ap->in[8], H, lds, tid, wave, lane); A = B; } } }
    GRID_SYNC();
    { PHASE_VARS
      if (PH(11)) { pg8::Gemm g{H, (const bf16_t*)(ws + WS_W_ABO), TT, 1024, 1024}; pg8::StaticOrder S; S.init(TT, 1024, G, bx);
        Epi<EM_RESIN, true> E{nullptr, nullptr, nullptr, nullptr, ap->in[0], ap->in[1], nullptr, nullptr, nullptr, SSQP(1), (bf16_t*)(ws + WS_XBA), nullptr};
        pg8::gemm_phase<Epi<EM_RESIN, true>, pg8::StaticOrder, true, true>(lds3, g, S, E); } }
    GRID_SYNC();
    ffn_block<0>(lds3);
    GRID_SYNC();
    { PHASE_VARS
      if (PH(13)) { pg8::Gemm g{(const bf16_t*)(ws + WS_XBA), (const bf16_t*)(ws + WS_W_QKV), TT, 1536, 1024}; pg8::StaticOrder S; S.init(TT, 1536, G, bx);
        Epi<EM_QKV> E{(bf16_t*)(ws + WS_Q), (bf16_t*)(ws + WS_K), (bf16_t*)(ws + WS_V), nullptr, nullptr, nullptr, nullptr, nullptr, SSQP(2), nullptr, nullptr, nullptr};
        pg8::gemm_phase<Epi<EM_QKV>, pg8::StaticOrder, true, true>(lds3, g, S, E); } }
    GRID_SYNC();
    { PHASE_VARS
      if (PH(14)) p_qkrope((bf16_t*)(ws + WS_Q), (bf16_t*)(ws + WS_K), ap->in[12], ap->in[13], (const float2*)(ws + WS_ROPE), gw, NGW, lane); }
    GRID_SYNC();
    { PHASE_VARS
      if (PH(15)) { const int vx = bx & 7, vi = bx >> 3;
        bf16_t* Qb = (bf16_t*)(ws + WS_Q); bf16_t* Kb = (bf16_t*)(ws + WS_K); bf16_t* Vb = (bf16_t*)(ws + WS_V); bf16_t* AO = (bf16_t*)(ws + WS_AO);
        for (int i6 = 0; i6 < (PROBE_ATTN ? 12 : 6); ++i6) { const int i = i6 % 6;
            int b, kvh, hq, qb, row0, seq;
            if (i < 4) { const int combo = vx * 2 + (i >> 1), u = (i & 1) * 32 + vi; b = combo >> 1; kvh = combo & 1; hq = kvh * 4 + (u >> 4); qb = u & 15; row0 = b * 4096; seq = 4096; }
            else { const int combo = vx * 2 + (i - 4), u = vi; b = combo >> 1; kvh = combo & 1; hq = kvh * 4 + (u >> 3); qb = u & 7; row0 = TP + b * 2048; seq = 2048; }
            attn::attn_dense_body<attn::bf16>(Qb + (size_t)(row0 + qb * 256) * 1024 + hq * 128, Kb + (size_t)row0 * 256 + kvh * 128, Vb + (size_t)row0 * 256 + kvh * 128,
                                              AO + (size_t)(row0 + qb * 256) * 1024 + hq * 128, seq, (char*)lds);
            __syncthreads();
        } } }
    GRID_SYNC();
    { PHASE_VARS
      if (PH(16)) { pg8::Gemm g{(const bf16_t*)(ws + WS_AO), (const bf16_t*)(ws + WS_W_CO), TT, 1024, 1024}; pg8::StaticOrder S; S.init(TT, 1024, G, bx);
        Epi<EM_RES, true> E{nullptr, nullptr, nullptr, nullptr, nullptr, nullptr, nullptr, nullptr, nullptr, SSQP(3), (bf16_t*)(ws + WS_XBA), nullptr};
        pg8::gemm_phase<Epi<EM_RES, true>, pg8::StaticOrder, true, true>(lds3, g, S, E); } }
    GRID_SYNC();
    ffn_block<1>(lds3);
}

extern "C" void kernel_launch(void* const* d_in, const int* in_sizes, int n_in, void* d_out, int out_size, void* d_ws, size_t ws_size, hipStream_t stream) {
    static int grid = 0;
    if (grid == 0) {
        int dev = 0, cus = 0, per_cu = 0;
        if (n_in != 19 || out_size != TT * DM || ws_size < WS_END) { fprintf(stderr, "kernel_launch: unexpected shapes: n_in %d out %d ws %zu (need %zu)\n", n_in, out_size, ws_size, (size_t)WS_END); grid = -1; return; }
        if (hipGetDevice(&dev) != hipSuccess || hipDeviceGetAttribute(&cus, hipDeviceAttributeMultiprocessorCount, dev) != hipSuccess) { fprintf(stderr, "kernel_launch: device query failed\n"); grid = -1; return; }
        if (hipFuncSetAttribute((const void*)mega_fwd, hipFuncAttributeMaxDynamicSharedMemorySize, LDS_BYTES) != hipSuccess) { fprintf(stderr, "kernel_launch: hipFuncSetAttribute failed\n"); grid = -1; return; }
        if (hipOccupancyMaxActiveBlocksPerMultiprocessor(&per_cu, (const void*)mega_fwd, 512, LDS_BYTES) != hipSuccess || per_cu < 1) fprintf(stderr, "kernel_launch: occupancy query reports %d blocks per CU\n", per_cu);
        (void)hipGetLastError();
        if (cus != 256) { fprintf(stderr, "kernel_launch: built for a 256-CU device, found %d\n", cus); grid = -1; return; }
        grid = 256;
    }
    if (grid < 0) return;
    if (hipMemsetAsync((char*)d_ws + WS_CTL, 0, CTL_BYTES, stream) != hipSuccess) { fprintf(stderr, "kernel_launch: memset failed\n"); return; }
    Args a{};
    for (int i = 0; i < 19; ++i) a.in[i] = (const float*)d_in[i];
    a.out = (float*)d_out; a.ws = (unsigned char*)d_ws;
    void* args[] = {&a};
    const hipError_t e = hipLaunchCooperativeKernel((const void*)mega_fwd, dim3(grid), dim3(512), args, LDS_BYTES, stream);
    if (e != hipSuccess) fprintf(stderr, "kernel_launch: cooperative launch failed: %s\n", hipGetErrorString(e));
}
```

```cpp
#include <hip/hip_runtime.h>
#include <hip/hip_cooperative_groups.h>
#include <cstdio>
#include <cstdint>
namespace cg = cooperative_groups;
#define DEVI __device__ __forceinline__
namespace pg8 {
#define PG8_LAS __attribute__((address_space(3)))
typedef unsigned short bf16_t;
typedef short bf16x8 __attribute__((ext_vector_type(8)));
typedef float f32x4 __attribute__((ext_vector_type(4)));
typedef unsigned u32x4 __attribute__((ext_vector_type(4)));
constexpr int BM = 256, BK = 64, HALF = 128, HTB = HALF * BK * 2  , STAGE_BYTES = 8 * HTB, NXCD = 8, WGM = 8;

__host__ __device__ __forceinline__ int lds_byte(int r, int c) { const int st = (r >> 4) * 2 + (c >> 5), rr = r & 15, cc = c & 31, ob = rr * 64 + cc * 2; return st * 1024 + (ob ^ (((ob >> 9) & 1) << 5)); }
__host__ __device__ __forceinline__ void stage_rc(int b, int& R, int& C) { const int st = b / 1024, sb = b % 1024, swz = sb ^ (((sb >> 9) & 1) << 5); R = (st >> 1) * 16 + swz / 64; C = (st & 1) * 32 + (swz % 64) / 2; }
__host__ __device__ __forceinline__ int perm32(int rho) { const int n = rho >> 4, i = rho & 15; return 8 * (i >> 2) + 4 * n + (i & 3); }

struct Unit { int pm, pn; };
struct Gemm { const bf16_t* A; const bf16_t* Bt; int M, N, K; };

struct StaticOrder {
    int nM, nN, nwg, G, c;
    __host__ __device__ void init(int M, int N, int G_, int c_) { nM = M / BM; nN = N / BM; nwg = nM * nN; G = G_; c = c_; }
    __host__ __device__ bool next(int i, Unit& u) const {
        const long L = (long)i * G + c; if (L >= nwg) return false;
        int wgid = (int)L; { const int q = nwg / NXCD, r = nwg % NXCD, xcd = wgid % NXCD, off = wgid / NXCD; wgid = (xcd < r ? xcd * (q + 1) : r * (q + 1) + (xcd - r) * q) + off; }
        const int nig = WGM * nN, gid = wgid / nig, fm = gid * WGM, gsz = (nM - fm) < WGM ? (nM - fm) : WGM;
        u.pm = fm + ((wgid % nig) % gsz); u.pn = (wgid % nig) / gsz; return true;
    }
    __device__ __forceinline__ void a_ready(const Unit&) const {}
    __device__ __forceinline__ void done(const Unit&) const {}
};

__device__ __forceinline__ unsigned cvt_pk_bf16(float lo, float hi) { unsigned r; asm volatile("v_cvt_pk_bf16_f32 %0, %1, %2" : "=v"(r) : "v"(lo), "v"(hi)); return r; }
template <class Epi, class Sched, bool ALIGN_EPI = false, bool SP2 = false>
__device__ __forceinline__ void gemm_phase(PG8_LAS unsigned char* lds, const Gemm g, const Sched& S, const Epi& E) {
    int tid_ = threadIdx.x; asm volatile("" : "+v"(tid_));
    const int tid = tid_, wid = __builtin_amdgcn_readfirstlane(tid >> 6), lane = tid & 63, wr = wid >> 2, wc = wid & 3, fr = lane & 15, fq = lane >> 4;
    const int K = g.K, nt = K / BK;
    unsigned voffA[2], voffB[2];
#pragma unroll
    for (int i = 0; i < 2; ++i) { int R, C; stage_rc(tid * 16 + i * 8192, R, C); const int Rb = Epi::PERM ? ((R & ~31) + perm32(R & 31)) : R;
        voffA[i] = (unsigned)(R * K + C) * 2u; voffB[i] = (unsigned)(Rb * K + C) * 2u; }
    const size_t kstep = (size_t)(BK * 2);
    const size_t hstep = (size_t)HALF * K * 2;
    const size_t tstep = 2 * hstep;
    const unsigned ldsw = (unsigned)wid * 1024u;
    const int aoff = lds_byte(wr * 64 + fr, fq * 8), boff = lds_byte(wc * 32 + fr, fq * 8);
#define PG8_SA(b, h) (((b) * 2 + (h)) * HTB)
#define PG8_SB(b, h) ((4 + (b) * 2 + (h)) * HTB)
#define PG8_STAGE(bufoff, gbase, voff) do { _Pragma("unroll") for (int _i = 0; _i < 2; ++_i) \
        __builtin_amdgcn_global_load_lds((const unsigned*)((const char*)(gbase) + (voff)[_i]), (PG8_LAS unsigned*)(lds + (bufoff) + ldsw + _i * 8192), 16, 0, 0); } while (0)
#define PG8_LDA(dst, b, h) do { _Pragma("unroll") for (int m = 0; m < 4; ++m) _Pragma("unroll") for (int k = 0; k < 2; ++k) dst[m][k] = *(const PG8_LAS bf16x8*)(lds + PG8_SA(b, h) + aoff + m * 2048 + k * 1024); } while (0)
#define PG8_LDB(dst, b, h) do { _Pragma("unroll") for (int n = 0; n < 2; ++n) _Pragma("unroll") for (int k = 0; k < 2; ++k) dst[n][k] = *(const PG8_LAS bf16x8*)(lds + PG8_SB(b, h) + boff + n * 2048 + k * 1024); } while (0)
#define PG8_MMA(ai, bj, At, Bt) do { __builtin_amdgcn_s_setprio(1); _Pragma("unroll") for (int m = 0; m < 4; ++m) _Pragma("unroll") for (int n = 0; n < 2; ++n) _Pragma("unroll") for (int k = 0; k < 2; ++k) \
        acc[ai][bj][m][n] = __builtin_amdgcn_mfma_f32_16x16x32_bf16(Bt[n][k], At[m][k], acc[ai][bj][m][n], 0, 0, 0); __builtin_amdgcn_s_setprio(0); } while (0)
#define PG8_WAIT_V(n) asm volatile("s_waitcnt vmcnt(" #n ")" ::: "memory")
#define PG8_WAIT_L(n) asm volatile("s_waitcnt lgkmcnt(" #n ")" ::: "memory")
#define PG8_BAR __builtin_amdgcn_s_barrier()
#define PG8_SCHED __builtin_amdgcn_sched_barrier(0)
    Unit cur, nxt; int ui = 0;
    if (!S.next(0, cur)) return;
    f32x4 acc[2][2][4][2];
#pragma unroll
    for (int a = 0; a < 2; ++a)
#pragma unroll
        for (int b = 0; b < 2; ++b)
#pragma unroll
            for (int m = 0; m < 4; ++m)
#pragma unroll
                for (int n = 0; n < 2; ++n) acc[a][b][m][n] = (f32x4){0.f, 0.f, 0.f, 0.f};
    bf16x8 At[4][2], B0[2][2], B1[2][2];
    const char* cA = (const char*)g.A + (size_t)cur.pm * tstep; const char* cB = (const char*)g.Bt + (size_t)cur.pn * tstep;
    S.a_ready(cur);
    if constexpr (SP2) {
        PG8_STAGE(PG8_SB(0, 0), cB, voffB); PG8_STAGE(PG8_SB(0, 1), cB + hstep, voffB); PG8_STAGE(PG8_SA(0, 0), cA, voffA); PG8_STAGE(PG8_SA(0, 1), cA + hstep, voffA);
        if (wr == 1) PG8_BAR;
        PG8_WAIT_V(2); PG8_BAR;
        PG8_STAGE(PG8_SB(1, 0), cB + kstep, voffB); PG8_STAGE(PG8_SA(1, 0), cA + kstep, voffA); PG8_STAGE(PG8_SB(1, 1), cB + hstep + kstep, voffB);
        PG8_WAIT_V(6); PG8_BAR;
    } else {
        PG8_STAGE(PG8_SB(0, 0), cB, voffB); PG8_STAGE(PG8_SA(0, 0), cA, voffA); PG8_STAGE(PG8_SB(0, 1), cB + hstep, voffB); PG8_STAGE(PG8_SA(0, 1), cA + hstep, voffA);
        if (wr == 1) PG8_BAR;
        PG8_WAIT_V(4); PG8_BAR;
        PG8_STAGE(PG8_SB(1, 0), cB + kstep, voffB); PG8_STAGE(PG8_SA(1, 0), cA + kstep, voffA); PG8_STAGE(PG8_SB(1, 1), cB + hstep + kstep, voffB);
        PG8_WAIT_V(6); PG8_BAR;
    }
    for (;;) {
        const bool has_next = S.next(ui + 1, nxt);
        const char* nA = has_next ? (const char*)g.A + (size_t)nxt.pm * tstep : cA; const char* nB = has_next ? (const char*)g.Bt + (size_t)nxt.pn * tstep : cB;
        for (int t = 0; t < nt; t += 2) {
            const bool last = (t == nt - 2);
            const char* a1 = cA + (size_t)(t + 1) * kstep;
            const char* a2 = last ? nA : cA + (size_t)(t + 2) * kstep; const char* b2 = last ? nB : cB + (size_t)(t + 2) * kstep;
            const char* a3 = a2 + kstep; const char* b3 = b2 + kstep;
            if (last && has_next) S.a_ready(nxt);
            if constexpr (SP2) {
            PG8_LDB(B0, 0, 0); PG8_LDB(B1, 0, 1); PG8_SCHED; PG8_LDA(At, 0, 0); PG8_STAGE(PG8_SA(1, 1), a1 + hstep, voffA);
            PG8_WAIT_V(8); PG8_WAIT_L(0); PG8_BAR; PG8_MMA(0, 0, At, B0); PG8_MMA(0, 1, At, B1); PG8_BAR; PG8_SCHED;
            PG8_LDA(At, 0, 1); PG8_STAGE(PG8_SB(0, 0), b2, voffB); PG8_STAGE(PG8_SB(0, 1), b2 + hstep, voffB); PG8_STAGE(PG8_SA(0, 0), a2, voffA);
            PG8_WAIT_V(8); PG8_WAIT_L(0); PG8_BAR; PG8_MMA(1, 0, At, B0); PG8_MMA(1, 1, At, B1); PG8_BAR; PG8_SCHED;
            PG8_LDB(B0, 1, 0); PG8_LDB(B1, 1, 1); PG8_SCHED; PG8_LDA(At, 1, 0); PG8_STAGE(PG8_SA(0, 1), a2 + hstep, voffA);
            PG8_WAIT_V(8); PG8_WAIT_L(0); PG8_BAR; PG8_MMA(0, 0, At, B0); PG8_MMA(0, 1, At, B1); PG8_BAR; PG8_SCHED;
            PG8_LDA(At, 1, 1); PG8_STAGE(PG8_SB(1, 0), b3, voffB); PG8_STAGE(PG8_SB(1, 1), b3 + hstep, voffB); PG8_STAGE(PG8_SA(1, 0), a3, voffA);
            PG8_WAIT_V(8); PG8_WAIT_L(0); PG8_BAR; PG8_MMA(1, 0, At, B0); PG8_MMA(1, 1, At, B1); PG8_BAR; PG8_SCHED;
            } else {
            PG8_LDB(B0, 0, 0); PG8_SCHED; PG8_LDA(At, 0, 0); PG8_STAGE(PG8_SA(1, 1), a1 + hstep, voffA);
            PG8_WAIT_L(8); PG8_BAR; PG8_WAIT_L(0); PG8_MMA(0, 0, At, B0); PG8_BAR; PG8_SCHED;
            PG8_LDB(B1, 0, 1); PG8_STAGE(PG8_SB(0, 0), b2, voffB);
            PG8_BAR; PG8_WAIT_L(0); PG8_MMA(0, 1, At, B1); PG8_BAR;
            PG8_LDA(At, 0, 1); PG8_STAGE(PG8_SA(0, 0), a2, voffA);
            PG8_BAR; PG8_WAIT_L(0); PG8_MMA(1, 0, At, B0); PG8_BAR; PG8_SCHED;
            PG8_STAGE(PG8_SB(0, 1), b2 + hstep, voffB);
            PG8_WAIT_V(6); PG8_BAR; PG8_MMA(1, 1, At, B1); PG8_BAR;
            PG8_LDB(B0, 1, 0); PG8_SCHED; PG8_LDA(At, 1, 0); PG8_STAGE(PG8_SA(0, 1), a2 + hstep, voffA);
            PG8_WAIT_L(8); PG8_BAR; PG8_WAIT_L(0); PG8_MMA(0, 0, At, B0); PG8_BAR; PG8_SCHED;
            PG8_LDB(B1, 1, 1); PG8_STAGE(PG8_SB(1, 0), b3, voffB);
            PG8_BAR; PG8_WAIT_L(0); PG8_MMA(0, 1, At, B1); PG8_BAR;
            PG8_LDA(At, 1, 1); PG8_STAGE(PG8_SA(1, 0), a3, voffA);
            PG8_BAR; PG8_WAIT_L(0); PG8_MMA(1, 0, At, B0); PG8_BAR; PG8_SCHED;
            PG8_STAGE(PG8_SB(1, 1), b3 + hstep, voffB);
            PG8_WAIT_V(6); PG8_BAR; PG8_MMA(1, 1, At, B1); PG8_BAR;
            }
        }
        if constexpr (ALIGN_EPI) { if (wr == 0) PG8_BAR; }
        if constexpr (!Epi::AFTER_DRAIN) { E(acc, cur, wr, wc, fr, fq); S.done(cur); }
        if (!has_next) break;
#pragma unroll
        for (int a = 0; a < 2; ++a)
#pragma unroll
            for (int b = 0; b < 2; ++b)
#pragma unroll
                for (int m = 0; m < 4; ++m)
#pragma unroll
                    for (int n = 0; n < 2; ++n) acc[a][b][m][n] = (f32x4){0.f, 0.f, 0.f, 0.f};
        cur = nxt; cA = nA; cB = nB; ++ui;
        if constexpr (ALIGN_EPI) { if (wr == 1) PG8_BAR; }
    }
    PG8_WAIT_V(0);
    if constexpr (!ALIGN_EPI) { if (wr == 0) PG8_BAR; }
    PG8_BAR;
    if constexpr (Epi::AFTER_DRAIN) { E.fused(acc, cur, wr, wc, fr, fq, lds, wid, lane); S.done(cur); }
#undef PG8_SA
#undef PG8_SB
#undef PG8_STAGE
#undef PG8_LDA
#undef PG8_LDB
#undef PG8_MMA
#undef PG8_WAIT_V
#undef PG8_WAIT_L
#undef PG8_BAR
#undef PG8_SCHED
}
}

typedef unsigned short bf16_t;
typedef short bf16x8 __attribute__((ext_vector_type(8)));
typedef float f32x4 __attribute__((ext_vector_type(4)));
typedef float f32x16 __attribute__((ext_vector_type(16)));
typedef unsigned u32x4 __attribute__((ext_vector_type(4)));
typedef unsigned u32x2 __attribute__((ext_vector_type(2)));
typedef float f32x2_t __attribute__((ext_vector_type(2)));
typedef __bf16 bf16x2_t __attribute__((ext_vector_type(2)));

constexpr int TP = 32768, TS = 16384, TT = TP + TS, DM = 1024, FFH = 2816, SP = 4096, SS = 2048;
constexpr float EPS = 1e-6f;
constexpr size_t MiB = 1u << 20;
constexpr size_t WS_CTL = 0, CTL_BYTES = 64 * 1024;
constexpr size_t WS_ROPE = 1 * MiB;
constexpr size_t WS_W_AB1 = 2 * MiB;
constexpr size_t WS_W_FT = 6 * MiB;
constexpr size_t WS_W_ABO = 8 * MiB;
constexpr size_t WS_W_GU0 = 10 * MiB;
constexpr size_t WS_W_D0 = 21 * MiB;
constexpr size_t WS_W_QKV = 27 * MiB;
constexpr size_t WS_W_CO = 30 * MiB;
constexpr size_t WS_W_GU1 = 32 * MiB;
constexpr size_t WS_W_D1 = 43 * MiB;
constexpr size_t WS_DEC = 49 * MiB;
constexpr size_t WS_C4 = 435 * MiB, WS_S4 = 443 * MiB;
constexpr size_t WS_C2 = 451 * MiB, WS_S2 = 453 * MiB;
constexpr size_t WS_HM = 1 * MiB + 64 * 1024;
constexpr size_t WS_YMID = 1 * MiB + 128 * 1024;
constexpr size_t OUT_PCP = 48 * MiB, OUT_PSP = 64 * MiB;
constexpr size_t OUT_PCS = 80 * MiB, OUT_PSS = 88 * MiB;
constexpr size_t WS_SSQ = 1 * MiB + 256 * 1024;
constexpr size_t WS_XBA = 51 * MiB;
constexpr size_t WS_XBB = 147 * MiB;
constexpr size_t WS_H = WS_XBB;
constexpr size_t WS_BIG = 243 * MiB;
constexpr size_t WS_QKVR = WS_BIG;
constexpr size_t WS_G = WS_BIG + 144 * MiB;
constexpr size_t WS_FOLDF = WS_BIG;
constexpr size_t WS_FOLDG = WS_BIG + 4 * MiB;
constexpr size_t WS_ACT = WS_BIG;
constexpr size_t WS_Q = WS_BIG, WS_K = WS_BIG + 96 * MiB, WS_V = WS_BIG + 120 * MiB, WS_AO = WS_BIG + 144 * MiB;
constexpr size_t WS_END = WS_BIG + 264 * MiB;
constexpr size_t OUT_YTPC = 0, OUT_YTPS = 16 * MiB, OUT_YTSC = 32 * MiB, OUT_YTSS = 40 * MiB, OUT_HS = 96 * MiB, OUT_HD = 144 * MiB, OUT_DST = 96 * MiB;
constexpr int TF = 24576, TFP = 16384;

DEVI float bf2f(bf16_t x) { return __uint_as_float(((unsigned)x) << 16); }
DEVI unsigned pk2(float lo, float hi) { f32x2_t v = {lo, hi}; bf16x2_t b = __builtin_convertvector(v, bf16x2_t); return __builtin_bit_cast(unsigned, b); }
DEVI bf16_t f2bf(float f) { return (bf16_t)(pk2(f, 0.f) & 0xffffu); }
DEVI u32x4 pk8(f32x4 a, f32x4 b) { u32x4 w; w.x = pk2(a[0], a[1]); w.y = pk2(a[2], a[3]); w.z = pk2(b[0], b[1]); w.w = pk2(b[2], b[3]); return w; }
DEVI float wave_sum(float v) {
#pragma unroll
    for (int o = 1; o < 64; o <<= 1) v += __shfl_xor(v, o);
    return v;
}
DEVI float logsig(float z) { return fminf(z, 0.f) - __logf(1.f + __expf(-fabsf(z))); }
DEVI float silu(float z) { return z * __builtin_amdgcn_rcpf(1.f + __expf(-z)); }

struct RotOrder { pg8::StaticOrder S;
    DEVI bool next(int i, pg8::Unit& u) const { if (!S.next(i, u)) return false; u.pn = (u.pn + ((u.pm >> 3) % 3)) & 7; return true; }
    DEVI void a_ready(const pg8::Unit&) const {}
    DEVI void done(const pg8::Unit&) const {} };
struct FoldOrder { int G, c;
    DEVI bool next(int i, pg8::Unit& u) const { const int L = i * G + c; if (L >= 384) return false; u.pm = L & 3; u.pn = (L >> 2) + (u.pm >> 1) * 96; return true; }
    DEVI void a_ready(const pg8::Unit&) const {}
    DEVI void done(const pg8::Unit&) const {} };
enum { EM_AB1, EM_AB1T, EM_FNETP, EM_FNETS, EM_RESIN, EM_RES, EM_GLU, EM_QKV };
template <int MODE, bool NEXT = false> struct Epi {
    static constexpr bool PERM = true, AFTER_DRAIN = false;
    bf16_t* O0; bf16_t* O1; bf16_t* O2; float* F0; const float* X0; const float* X1; const float* B0; const float* B1;
    const float* SQI; float* SQO; bf16_t* XBN; const float* GN;
    DEVI float rstd_of(int row) const { return rsqrtf(SQI[row] * (1.f / 1024.f) + EPS); }
    DEVI void operator()(const f32x4 (&acc)[2][2][4][2], const pg8::Unit& u, int wr, int wc, int fr, int fq) const {
        const int rbase = u.pm * 256 + wr * 64 + fr, cb = wc * 32 + 8 * fq;
        f32x4 ga[2][2];
        if constexpr (MODE == EM_AB1) { if (u.pn >= 6) { const float* bias = (u.pn - 6) ? B1 : B0;
#pragma unroll
            for (int bj = 0; bj < 2; ++bj) { ga[bj][0] = *(const f32x4*)(bias + bj * 128 + cb); ga[bj][1] = *(const f32x4*)(bias + bj * 128 + cb + 4); } } }
        float rsv[2][4];
        if constexpr (MODE == EM_AB1 || MODE == EM_GLU || MODE == EM_QKV) {
#pragma unroll
            for (int ai = 0; ai < 2; ++ai)
#pragma unroll
                for (int m = 0; m < 4; ++m) rsv[ai][m] = SQI[rbase + ai * 128 + m * 16];
#pragma unroll
            for (int ai = 0; ai < 2; ++ai)
#pragma unroll
                for (int m = 0; m < 4; ++m) rsv[ai][m] = rsqrtf(rsv[ai][m] * (1.f / 1024.f) + EPS);
        }
#pragma unroll
        for (int ai = 0; ai < 2; ++ai)
#pragma unroll
            for (int m = 0; m < 4; ++m) {
                const int row = rbase + ai * 128 + m * 16;
                float rs = 1.f, ssq = 0.f;
                if constexpr (MODE == EM_AB1 || MODE == EM_GLU || MODE == EM_QKV) rs = rsv[ai][m];
                if constexpr (MODE == EM_GLU) {
                    const f32x4 g0 = acc[ai][0][m][0] * rs, g1 = acc[ai][0][m][1] * rs, u0 = acc[ai][1][m][0] * rs, u1 = acc[ai][1][m][1] * rs;
                    f32x4 a, b;
#pragma unroll
                    for (int j = 0; j < 4; ++j) { a[j] = silu(g0[j]) * u0[j]; b[j] = silu(g1[j]) * u1[j]; }
                    __builtin_nontemporal_store(pk8(a, b), (u32x4*)(O0 + (size_t)row * FFH + u.pn * 128 + cb));
                } else {
#pragma unroll
                    for (int bj = 0; bj < 2; ++bj) {
                        f32x4 v0 = acc[ai][bj][m][0] * rs, v1 = acc[ai][bj][m][1] * rs;
                        const int c = bj * 128 + cb;
                        if constexpr (MODE == EM_AB1) {
                            if (u.pn < 2) { __builtin_nontemporal_store(pk8(v0, v1), (u32x4*)(O0 + (size_t)u.pn * ((size_t)TT * 256) + (size_t)row * 256 + c)); }
                            else if (u.pn < 6) { __builtin_nontemporal_store(pk8(v0, v1), (u32x4*)(O0 + (size_t)(u.pn >> 1) * ((size_t)TT * 512) + (size_t)row * 512 + (u.pn & 1) * 256 + c)); }
                            else { const int dir = u.pn - 6;
                                const f32x4 b0 = ga[bj][0], b1 = ga[bj][1];
                                f32x4 a, b;
#pragma unroll
                                for (int j = 0; j < 4; ++j) { a[j] = logsig(v0[j] + b0[j]) * 0.0625f; b[j] = logsig(v1[j] + b1[j]) * 0.0625f; }
                                __builtin_nontemporal_store(pk8(a, b), (u32x4*)(O1 + (size_t)row * 512 + dir * 256 + c)); }
                        } else if constexpr (MODE == EM_AB1T) {
                            const int cc = row, part = cc >> 9, t0 = (u.pn - 96 * part) * 256;
                            bf16_t* dst;
                            if (t0 < TFP) { const int b = t0 >> 11, s = (t0 & 2047) + c; dst = O0 + (size_t)part * (4096 * 2048) + (size_t)(b * 512 + (cc & 511)) * 2048 + s; }
                            else { const int tt = t0 - TFP, b = tt >> 10, s = (tt & 1023) + c; dst = O1 + (size_t)part * (4096 * 1024) + (size_t)(b * 512 + (cc & 511)) * 1024 + s; }
                            __builtin_nontemporal_store(pk8(v0, v1), (u32x4*)dst);
                        } else if constexpr (MODE == EM_FNETP) {
                            __builtin_nontemporal_store(pk8(v0, v1), (u32x4*)(O0 + ((size_t)(u.pn >> 1) * 2048 + row) * 512 + (u.pn & 1) * 256 + c));
                        } else if constexpr (MODE == EM_FNETS) {
                            __builtin_nontemporal_store(pk8(v0, v1), (u32x4*)(O0 + ((size_t)(u.pn >> 1) * 1024 + row) * 512 + (u.pn & 1) * 256 + c));
                        } else if constexpr (MODE == EM_RESIN) {
                            const float* xp = (row < TP ? X0 + (size_t)row * 1024 : X1 + (size_t)(row - TP) * 1024) + u.pn * 256 + c;
                            const f32x4 x0 = *(const f32x4*)xp + v0, x1 = *(const f32x4*)(xp + 4) + v1;
                            ssq += (x0[0] * x0[0] + x0[1] * x0[1]) + (x0[2] * x0[2] + x0[3] * x0[3]) + (x1[0] * x1[0] + x1[1] * x1[1]) + (x1[2] * x1[2] + x1[3] * x1[3]);
                            __builtin_nontemporal_store(pk8(x0, x1), (u32x4*)(XBN + (size_t)row * 1024 + u.pn * 256 + c));
                        } else if constexpr (MODE == EM_RES) {
                            bf16_t* rp = XBN + (size_t)row * 1024 + u.pn * 256 + c;
                            const u32x4 w = *(const u32x4*)rp;
                            f32x4 x0 = {__uint_as_float(w[0] << 16), __uint_as_float(w[0] & 0xffff0000u), __uint_as_float(w[1] << 16), __uint_as_float(w[1] & 0xffff0000u)};
                            f32x4 x1 = {__uint_as_float(w[2] << 16), __uint_as_float(w[2] & 0xffff0000u), __uint_as_float(w[3] << 16), __uint_as_float(w[3] & 0xffff0000u)};
                            x0 = x0 + v0; x1 = x1 + v1;
                            if constexpr (NEXT) { ssq += (x0[0] * x0[0] + x0[1] * x0[1]) + (x0[2] * x0[2] + x0[3] * x0[3]) + (x1[0] * x1[0] + x1[1] * x1[1]) + (x1[2] * x1[2] + x1[3] * x1[3]);
                                __builtin_nontemporal_store(pk8(x0, x1), (u32x4*)rp); }
                            else { float* op = F0 + (size_t)row * 1024 + u.pn * 256 + c; __builtin_nontemporal_store(x0, (f32x4*)op); __builtin_nontemporal_store(x1, (f32x4*)(op + 4)); }
                        } else if constexpr (MODE == EM_QKV) {
                            bf16_t* dst;
                            if (u.pn < 4) dst = O0 + (size_t)row * 1024 + u.pn * 256 + c;
                            else if (u.pn == 4) dst = O1 + (size_t)row * 256 + c;
                            else dst = O2 + (size_t)row * 256 + c;
                            *(u32x4*)dst = pk8(v0, v1);
                        }
                    }
                    if constexpr (MODE == EM_RESIN || (MODE == EM_RES && NEXT)) { ssq += __shfl_xor(ssq, 16); ssq += __shfl_xor(ssq, 32); if (fq == 0) atomicAdd(SQO + row, ssq); }
                }
            }
    }
};

DEVI void p_fold(const float* win, const float* upf, const float* upb, const float* g0, bf16_t* WFT, bf16_t* WG, float* tab, int gw, int NGW, int lane) {
    if (threadIdx.x < 128) tab[threadIdx.x] = cospif((float)threadIdx.x * (1.f / 64.f));
    __syncthreads();
    for (int it = gw; it < 1024 * 16; it += NGW) {
        const int k = it >> 4, cb = it & 15, cc = cb * 64 + lane, part = cc >> 9, g = (cc >> 7) & 3, l = cc & 127;
        const float* wr = win + (size_t)k * 2080 + 1568 + g * 128;
        const int sh = part ? 96 : 0;
        float acc = 0.f;
#pragma unroll 8
        for (int w = 0; w < 128; ++w) acc += wr[w] * tab[(w * l + sh) & 127];
        WFT[(size_t)cc * 1024 + k] = f2bf(acc);
    }
    for (int it = gw; it < 1024 * 8; it += NGW) {
        const int k = it >> 3, nb = it & 7, n = nb * 64 + lane, dir = n >> 8, nn = n & 255;
        const float* wr = win + (size_t)k * 2080 + 1536 + dir * 16;
        const float* up = dir ? upb : upf;
        float acc = 0.f;
#pragma unroll
        for (int r = 0; r < 16; ++r) acc += wr[r] * up[r * 256 + nn];
        WG[(size_t)n * 1024 + k] = f2bf(acc * g0[k]);
    }
    __syncthreads();
}
DEVI void p_dft(bf16_t* C, bf16_t* Sn, int S, int logS, int gt, int NGT) {
    const int lri = logS - 4;
    const long total = (long)(S / 2) << lri;
    const float nrm = rsqrtf((float)S * 128.f), xs = 2.f / (float)S;
    for (long it = gt; it < 2 * total; it += NGT) {
        const int part = it >= total; const long i2 = part ? it - total : it;
        const int k = (int)(i2 >> lri), s0 = (int)(i2 & ((1 << lri) - 1)) * 8;
        float v[8];
#pragma unroll
        for (int j = 0; j < 8; ++j) { const int idx = (k * (s0 + j)) & (S - 1); const float x = (float)idx * xs; v[j] = (part ? sinpif(x) : cospif(x)) * nrm; }
        u32x4 w; w.x = pk2(v[0], v[1]); w.y = pk2(v[2], v[3]); w.z = pk2(v[4], v[5]); w.w = pk2(v[6], v[7]);
        *(u32x4*)((part ? Sn : C) + (size_t)k * (S / 2) + s0) = w;
    }
}
DEVI void p_fcombine(const bf16_t* PC, const bf16_t* PS, const float* YM, bf16_t* MIX, int tokbase, int S, int logSH, int gt, int NGT) {
    const float nrm = rsqrtf((float)S * 128.f);
    const int total = 8 << (logSH + 6);
    for (int it0 = gt; it0 < total; it0 += 4 * NGT) {
        u32x4 pc[4], ps[4];
#pragma unroll
        for (int u = 0; u < 4; ++u) { const int it = it0 + u * NGT, ch = it & 63, k = (it >> 6) & ((1 << logSH) - 1), b = it >> (6 + logSH);
            pc[u] = *(const u32x4*)(PC + ((size_t)(b << logSH) + k) * 512 + ch * 8); ps[u] = *(const u32x4*)(PS + ((size_t)(b << logSH) + k) * 512 + ch * 8); }
#pragma unroll
        for (int u = 0; u < 4; ++u) { const int it = it0 + u * NGT, ch = it & 63, k = (it >> 6) & ((1 << logSH) - 1), b = it >> (6 + logSH);
            u32x4 lo, hi; const float sg = (k & 1) ? -nrm : nrm;
            const f32x4 m0 = *(const f32x4*)(YM + b * 512 + ch * 8), m1 = *(const f32x4*)(YM + b * 512 + ch * 8 + 4);
#pragma unroll
            for (int j = 0; j < 4; ++j) { const float c0 = __uint_as_float(pc[u][j] << 16), c1 = __uint_as_float(pc[u][j] & 0xffff0000u), s0 = __uint_as_float(ps[u][j] << 16), s1 = __uint_as_float(ps[u][j] & 0xffff0000u);
                const float e0 = sg * (j < 2 ? m0[2 * j] : m1[2 * j - 4]), e1 = sg * (j < 2 ? m0[2 * j + 1] : m1[2 * j - 3]);
                lo[j] = pk2(c0 - s0 + e0, c1 - s1 + e1); hi[j] = pk2(c0 + s0 + e0, c1 + s1 + e1); }
            *(u32x4*)(MIX + (size_t)(tokbase + b * S + k) * 1024 + 512 + ch * 8) = lo;
            if (k) *(u32x4*)(MIX + (size_t)(tokbase + b * S + S - k) * 1024 + 512 + ch * 8) = hi; }
    }
}
DEVI void p_fmid(const bf16_t* YC, const float* YM, bf16_t* MIX, int tokbase, int S, int gw, int NGW, int lane) {
    const float nrm = rsqrtf((float)S * 128.f); const int SH = S / 2;
    for (int r = gw; r < 4096; r += NGW) {
        const bf16_t* row = YC + (size_t)r * SH; float acc = 0.f;
        for (int s0 = lane * 8; s0 < SH; s0 += 512) { const u32x4 w = *(const u32x4*)(row + s0);
#pragma unroll
            for (int j = 0; j < 4; ++j) acc += __uint_as_float(w[j] << 16) - __uint_as_float(w[j] & 0xffff0000u); }
        acc = wave_sum(acc);
        if (lane == 0) MIX[(size_t)(tokbase + (r >> 9) * S + SH) * 1024 + 512 + (r & 511)] = f2bf((acc + YM[r]) * nrm);
    }
}
DEVI void p_ymid(const bf16_t* HM, const bf16_t* WFT, float* YM, int gw, int NGW, int lane) {
    for (int it = gw; it < 16 * 512; it += NGW) { const int q = it >> 9, c = it & 511;
        const u32x4 a0 = *(const u32x4*)(HM + q * 1024 + lane * 16), a1 = *(const u32x4*)(HM + q * 1024 + lane * 16 + 8);
        const u32x4 w0 = *(const u32x4*)(WFT + (size_t)c * 1024 + lane * 16), w1 = *(const u32x4*)(WFT + (size_t)c * 1024 + lane * 16 + 8);
        float acc = 0.f;
#pragma unroll
        for (int j = 0; j < 4; ++j) { acc += __uint_as_float(a0[j] << 16) * __uint_as_float(w0[j] << 16) + __uint_as_float(a0[j] & 0xffff0000u) * __uint_as_float(w0[j] & 0xffff0000u);
            acc += __uint_as_float(a1[j] << 16) * __uint_as_float(w1[j] << 16) + __uint_as_float(a1[j] & 0xffff0000u) * __uint_as_float(w1[j] & 0xffff0000u); }
        acc = wave_sum(acc);
        if (lane == 0) YM[it] = acc;
    }
}
DEVI void p_prep_fold(const float* x_p, const float* x_s, const float* gain, bf16_t* XB, float* SQ, bf16_t* HS, bf16_t* HD, bf16_t* HM, int gw, int NGW, int lane) {
    f32x4 gv[4];
#pragma unroll
    for (int j = 0; j < 4; ++j) gv[j] = *((const f32x4*)gain + lane + 64 * j);
    for (int it = gw; it < 8 * 2049 + 8 * 1025; it += NGW) {
        int q, j, S, tb, tfb;
        if (it < 8 * 2049) { q = it / 2049; j = it - q * 2049; S = 4096; tb = q * 4096; tfb = q * 2048; }
        else { const int i2 = it - 8 * 2049; q = i2 / 1025; j = i2 - q * 1025; S = 2048; tb = TP + q * 2048; tfb = TFP + q * 1024; q += 8; }
        const bool pair = j > 0 && j < S / 2;
        const int ra = tb + j, rb = pair ? tb + S - j : ra;
        const f32x4* xa = (const f32x4*)(ra < TP ? x_p + (size_t)ra * DM : x_s + (size_t)(ra - TP) * DM) + lane;
        const f32x4* xb = (const f32x4*)(rb < TP ? x_p + (size_t)rb * DM : x_s + (size_t)(rb - TP) * DM) + lane;
        f32x4 va[4], vb[4]; float sa = 0.f, sb = 0.f;
#pragma unroll
        for (int t = 0; t < 4; ++t) { va[t] = xa[64 * t]; vb[t] = xb[64 * t]; }
#pragma unroll
        for (int t = 0; t < 4; ++t) { sa += (va[t].x * va[t].x + va[t].y * va[t].y) + (va[t].z * va[t].z + va[t].w * va[t].w); sb += (vb[t].x * vb[t].x + vb[t].y * vb[t].y) + (vb[t].z * vb[t].z + vb[t].w * vb[t].w); }
        sa = wave_sum(sa); sb = wave_sum(sb);
        const float rsa = rsqrtf(sa * (1.f / DM) + EPS), rsb = pair ? rsqrtf(sb * (1.f / DM) + EPS) : 0.f;
        if (lane == 0) { SQ[ra] = sa; if (pair) SQ[rb] = sb; }
        u32x2* oa = (u32x2*)(XB + (size_t)ra * DM) + lane; u32x2* ob = (u32x2*)(XB + (size_t)rb * DM) + lane;
        u32x2* os = (u32x2*)((j == S / 2 ? HM + (size_t)q * DM : HS + (size_t)(tfb + j) * DM)) + lane; u32x2* od = (u32x2*)(HD + (size_t)(tfb + (j == S / 2 ? 0 : j)) * DM) + lane;
#pragma unroll
        for (int t = 0; t < 4; ++t) { const f32x4 ga = va[t] * gv[t], gb = vb[t] * gv[t];
            u32x2 w; w.x = pk2(va[t].x, va[t].y); w.y = pk2(va[t].z, va[t].w); oa[64 * t] = w;
            if (pair) { w.x = pk2(vb[t].x, vb[t].y); w.y = pk2(vb[t].z, vb[t].w); ob[64 * t] = w; }
            const f32x4 ha = ga * rsa, hb = gb * rsb;
            w.x = pk2(ha.x + hb.x, ha.y + hb.y); w.y = pk2(ha.z + hb.z, ha.w + hb.w); os[64 * t] = w;
            if (j != S / 2) { w.x = pk2(ha.x - hb.x, ha.y - hb.y); w.y = pk2(ha.z - hb.z, ha.w - hb.w); od[64 * t] = w; } }
    }
}
DEVI void p_norm(const float* src0, const float* src1, const float* gain, bf16_t* H, float* SQ, int gw, int NGW, int lane) {
    f32x4 gv[4];
#pragma unroll
    for (int j = 0; j < 4; ++j) gv[j] = *((const f32x4*)gain + lane + 64 * j);
    for (int m = gw; m < TT; m += NGW) {
        const f32x4* xr = (const f32x4*)(m < TP ? src0 + (size_t)m * DM : src1 + (size_t)(m - TP) * DM) + lane;
        f32x4 v[4]; float s = 0.f;
#pragma unroll
        for (int j = 0; j < 4; ++j) { v[j] = xr[64 * j]; s += (v[j].x * v[j].x + v[j].y * v[j].y) + (v[j].z * v[j].z + v[j].w * v[j].w); }
        const float rstd = 1.f; { const float tot = wave_sum(s); if (lane == 0) SQ[m] = tot; }
        u32x2* o8 = (u32x2*)(H + (size_t)m * DM) + lane;
#pragma unroll
        for (int j = 0; j < 4; ++j) { u32x2 w; w.x = pk2(v[j].x * rstd * gv[j].x, v[j].y * rstd * gv[j].y); w.y = pk2(v[j].z * rstd * gv[j].z, v[j].w * rstd * gv[j].w); o8[64 * j] = w; }
    }
}
DEVI void tr_item(const float* W, int ld, int col0, bf16_t* WT, int Kd, int drow0, float scale, const float* kg, float* scr, int k0, int n0, int lane) {
#pragma unroll 8
    for (int i = 0; i < 32; ++i) { const int kk = 2 * i + (lane >> 5); scr[kk * 33 + (lane & 31)] = W[(size_t)(k0 + kk) * ld + col0 + n0 + (lane & 31)] * (kg ? kg[k0 + kk] : 1.f); }
    asm volatile("s_waitcnt lgkmcnt(0)" ::: "memory");
    const int c = lane & 7;
#pragma unroll
    for (int j = 0; j < 4; ++j) { const int n = (lane >> 3) + 8 * j; const float* s = scr + (8 * c) * 33 + n;
        u32x4 o; o.x = pk2(s[0] * scale, s[33] * scale); o.y = pk2(s[66] * scale, s[99] * scale); o.z = pk2(s[132] * scale, s[165] * scale); o.w = pk2(s[198] * scale, s[231] * scale);
        *(u32x4*)(WT + (size_t)(drow0 + n) * Kd + k0 + 8 * c) = o; }
    asm volatile("s_waitcnt lgkmcnt(0)" ::: "memory");
}
template <int MAP> DEVI bool tr_mat(int& r, const float* W, int ld, int col0, int K, int ncols, bf16_t* WT, int drow, float scale, float* scr, int lane, const float* kg = nullptr) {
    const int nblk = ncols >> 5, cnt = (K >> 6) * nblk;
    if (r >= cnt) { r -= cnt; return false; }
    const int kb = r / nblk, nb = r - kb * nblk, n0 = nb * 32;
    int d0 = drow + n0;
    if (MAP == 1) d0 = (n0 >> 7) * 256 + (n0 & 127);
    if (MAP == 2) d0 = (n0 >> 7) * 256 + 128 + (n0 & 127);
    tr_item(W, ld, col0, WT, K, d0, scale, kg, scr, kb * 64, n0, lane);
    return true;
}

constexpr int GP = 144;
constexpr int L_QF = 0, L_QB = 9216, L_KF = 18432, L_KB = 27648, L_VT = 36864, L_ATF = 55296, L_ATB = 64512, L_SPF = 73728, L_SPB = 92160, L_SEG = 110592;
constexpr int L_KDF = 0, L_KDB = 9216;
DEVI int crow(int r, int hi) { return (r & 3) + 8 * (r >> 2) + 4 * hi; }
DEVI bf16x8 ldf(const unsigned char* base, int row, int ks, int hi) { return *(const bf16x8*)(base + row * GP + ks * 32 + hi * 16); }

#define LBAR() do { asm volatile("s_waitcnt lgkmcnt(0)" ::: "memory"); __builtin_amdgcn_s_barrier(); asm volatile("" ::: "memory"); } while (0)
struct GlaLd { bf16_t gf[8], gb[8], qh[8], kh[8], vh[16]; };
template <bool FULL> DEVI void gla_load(GlaLd& L, int item, const bf16_t* QKVR, const bf16_t* G, const bf16_t* DST, int tid) {
    const int n = item >> 2, h = item & 3, tok0 = n * 64, d = tid & 63, sg = tid >> 6, e = tid & 127, s4 = tid >> 7;
#pragma unroll
    for (int i = 0; i < 8; ++i) { const bf16_t* p = G + (size_t)(tok0 + 8 * sg + i) * 512 + h * 64 + d; L.gf[i] = p[0]; L.gb[i] = p[256]; }
#pragma unroll
    for (int i = 0; i < 8; ++i) { const bf16_t* tr = QKVR + (size_t)(tok0 + 8 * sg + i) * 256 + h * 64 + d; if (FULL) L.qh[i] = tr[0]; L.kh[i] = tr[(size_t)TT * 256]; }
#pragma unroll
    for (int i = 0; i < 16; ++i) L.vh[i] = QKVR[(size_t)TT * 512 + (size_t)(tok0 + 16 * s4 + i) * 512 + h * 128 + e];
}
DEVI void gla_prefix(const GlaLd& L, float* SEG, int tid, float (&bF)[8], float (&bB)[8], float& totF, float& totB) {
    const int d = tid & 63, sg = tid >> 6;
    bF[0] = bf2f(L.gf[0]);
#pragma unroll
    for (int i = 1; i < 8; ++i) bF[i] = bF[i - 1] + bf2f(L.gf[i]);
    bB[7] = bf2f(L.gb[7]);
#pragma unroll
    for (int i = 6; i >= 0; --i) bB[i] = bB[i + 1] + bf2f(L.gb[i]);
    SEG[sg * 64 + d] = bF[7]; SEG[512 + sg * 64 + d] = bB[0];
    LBAR();
    float offF = 0.f, offB = 0.f; totF = 0.f; totB = 0.f;
#pragma unroll
    for (int s = 0; s < 8; ++s) { const float a = SEG[s * 64 + d], b = SEG[512 + s * 64 + d]; totF += a; totB += b; if (s < sg) offF += a; if (s > sg) offB += b; }
#pragma unroll
    for (int i = 0; i < 8; ++i) { bF[i] += offF; bB[i] += offB; }
}
DEVI void gla_stage_vt(const GlaLd& L, unsigned char* VT, int tid) {
    const int e = tid & 127, s4 = tid >> 7;
    unsigned w[8];
#pragma unroll
    for (int i = 0; i < 8; ++i) w[i] = (unsigned)L.vh[2 * i] | ((unsigned)L.vh[2 * i + 1] << 16);
    u32x4 a = {w[0], w[1], w[2], w[3]}, b = {w[4], w[5], w[6], w[7]};
    *(u32x4*)(VT + e * GP + s4 * 32) = a; *(u32x4*)(VT + e * GP + s4 * 32 + 16) = b;
}
DEVI void gla_a_item(const GlaLd& L, int item, bf16_t* DST, float* DEC, unsigned char* lds, int tid, int wave, int lane) {
    const int d = tid & 63, sg = tid >> 6;
    float bF[8], bB[8], totF, totB;
    gla_prefix(L, (float*)(lds + L_SEG), tid, bF, bB, totF, totB);
    float kf[8], kb[8];
#pragma unroll
    for (int i = 0; i < 8; ++i) { const float kk = bf2f(L.kh[i]); kf[i] = kk * __expf(totF - bF[i]); kb[i] = kk * __expf(totB - bB[i]); }
    { u32x4 a = {pk2(kf[0], kf[1]), pk2(kf[2], kf[3]), pk2(kf[4], kf[5]), pk2(kf[6], kf[7])}, b = {pk2(kb[0], kb[1]), pk2(kb[2], kb[3]), pk2(kb[4], kb[5]), pk2(kb[6], kb[7])};
      *(u32x4*)(lds + L_KDF + d * GP + sg * 16) = a; *(u32x4*)(lds + L_KDB + d * GP + sg * 16) = b; }
    if (sg == 0) { DEC[(size_t)(item * 2) * 64 + d] = __expf(totF); DEC[(size_t)(item * 2 + 1) * 64 + d] = __expf(totB); }
    gla_stage_vt(L, lds + L_VT, tid);
    LBAR();
    { const int dir = wave >> 2, et = wave & 3, r32 = lane & 31, hi = lane >> 5;
      const unsigned char* KD = lds + (dir ? L_KDB : L_KDF);
      f32x16 c0 = {}, c1 = {};
#pragma unroll
      for (int ks = 0; ks < 4; ++ks) { const bf16x8 b = ldf(lds + L_VT, 32 * et + r32, ks, hi), a0 = ldf(KD, r32, ks, hi), a1 = ldf(KD, 32 + r32, ks, hi);
          c0 = __builtin_amdgcn_mfma_f32_32x32x16_bf16(a0, b, c0, 0, 0, 0); c1 = __builtin_amdgcn_mfma_f32_32x32x16_bf16(a1, b, c1, 0, 0, 0); }
      bf16_t* dst = DST + (size_t)(item * 2 + dir) * 8192 + (32 * et + r32) * 64 + 4 * hi;
#pragma unroll
      for (int q = 0; q < 4; ++q) { u32x2 w0 = {pk2(c0[4 * q], c0[4 * q + 1]), pk2(c0[4 * q + 2], c0[4 * q + 3])}, w1 = {pk2(c1[4 * q], c1[4 * q + 1]), pk2(c1[4 * q + 2], c1[4 * q + 3])};
          *(u32x2*)(dst + 8 * q) = w0; *(u32x2*)(dst + 32 + 8 * q) = w1; } }
    LBAR();
}
DEVI void p_scan(bf16_t* DST, const float* DEC, int gt) {
    const int combo = gt >> 10, el = gt & 1023, e = el >> 3, d0 = (el & 7) * 8;
    const int seq = combo >> 3, h = (combo >> 1) & 3, dir = combo & 1;
    const int nch = seq < 8 ? 64 : 32, n0 = seq < 8 ? seq * 64 : 512 + (seq - 8) * 32;
    float S[8];
#pragma unroll
    for (int j = 0; j < 8; ++j) S[j] = 0.f;
    for (int st0 = 0; st0 < nch; st0 += 8) {
        u32x4 ds[8]; f32x4 dc0[8], dc1[8];
#pragma unroll
        for (int u = 0; u < 8; ++u) { const int n = dir ? nch - 1 - (st0 + u) : st0 + u; const size_t item = (size_t)((n0 + n) * 4 + h) * 2 + dir;
            ds[u] = *(const u32x4*)(DST + item * 8192 + e * 64 + d0); dc0[u] = *(const f32x4*)(DEC + item * 64 + d0); dc1[u] = *(const f32x4*)(DEC + item * 64 + d0 + 4); }
#pragma unroll
        for (int u = 0; u < 8; ++u) { const int n = dir ? nch - 1 - (st0 + u) : st0 + u; const size_t item = (size_t)((n0 + n) * 4 + h) * 2 + dir;
            u32x4 w = {pk2(S[0], S[1]), pk2(S[2], S[3]), pk2(S[4], S[5]), pk2(S[6], S[7])};
            *(u32x4*)(DST + item * 8192 + e * 64 + d0) = w;
            S[0] = dc0[u][0] * S[0] + __uint_as_float(ds[u][0] << 16); S[1] = dc0[u][1] * S[1] + __uint_as_float(ds[u][0] & 0xffff0000u);
            S[2] = dc0[u][2] * S[2] + __uint_as_float(ds[u][1] << 16); S[3] = dc0[u][3] * S[3] + __uint_as_float(ds[u][1] & 0xffff0000u);
            S[4] = dc1[u][0] * S[4] + __uint_as_float(ds[u][2] << 16); S[5] = dc1[u][1] * S[5] + __uint_as_float(ds[u][2] & 0xffff0000u);
            S[6] = dc1[u][2] * S[6] + __uint_as_float(ds[u][3] << 16); S[7] = dc1[u][3] * S[7] + __uint_as_float(ds[u][3] & 0xffff0000u); }
    }
}
DEVI void gla_c_item(const GlaLd& L, int item, const bf16_t* QKVR, const bf16_t* DST, const float* outg, bf16_t* MIX, unsigned char* lds, int tid, int wave, int lane) {
    const int n = item >> 2, h = item & 3, tok0 = n * 64, d = tid & 63, sg = tid >> 6, r32 = lane & 31, hi = lane >> 5;
    u32x4 sp[4], rg0, rg1;
#pragma unroll
    for (int p = 0; p < 2; ++p) { const int row = (tid >> 3) + 64 * p, c = tid & 7;
        sp[2 * p] = *(const u32x4*)(DST + (size_t)(item * 2) * 8192 + row * 64 + c * 8); sp[2 * p + 1] = *(const u32x4*)(DST + (size_t)(item * 2 + 1) * 8192 + row * 64 + c * 8); }
    { const bf16_t* rp = QKVR + (size_t)TT * 1024 + (size_t)(tok0 + (tid >> 3)) * 512 + h * 128 + 16 * (tid & 7); rg0 = *(const u32x4*)rp; rg1 = *(const u32x4*)(rp + 8); }
    float bF[8], bB[8], totF, totB;
    gla_prefix(L, (float*)(lds + L_SEG), tid, bF, bB, totF, totB);
    bf16_t* QF = (bf16_t*)(lds + L_QF); bf16_t* QB = (bf16_t*)(lds + L_QB); bf16_t* KF = (bf16_t*)(lds + L_KF); bf16_t* KB = (bf16_t*)(lds + L_KB);
#pragma unroll
    for (int i = 0; i < 8; ++i) { const float qv = bf2f(L.qh[i]), kv = bf2f(L.kh[i]);
        const int o = (8 * sg + i) * (GP / 2) + d;
        QF[o] = f2bf(qv * __expf(bF[i])); KF[o] = f2bf(kv * __expf(-bF[i])); QB[o] = f2bf(qv * __expf(bB[i])); KB[o] = f2bf(kv * __expf(-bB[i])); }
    gla_stage_vt(L, lds + L_VT, tid);
#pragma unroll
    for (int p = 0; p < 2; ++p) { const int row = (tid >> 3) + 64 * p, c = tid & 7;
        *(u32x4*)(lds + L_SPF + row * GP + c * 16) = sp[2 * p]; *(u32x4*)(lds + L_SPB + row * GP + c * 16) = sp[2 * p + 1]; }
    LBAR();
    { const int dir = wave >> 2, it = (wave >> 1) & 1, jt = wave & 1;
      const unsigned char* Qd = lds + (dir ? L_QB : L_QF); const unsigned char* Kd = lds + (dir ? L_KB : L_KF);
      f32x16 c = {};
#pragma unroll
      for (int ks = 0; ks < 4; ++ks) c = __builtin_amdgcn_mfma_f32_32x32x16_bf16(ldf(Qd, 32 * it + r32, ks, hi), ldf(Kd, 32 * jt + r32, ks, hi), c, 0, 0, 0);
      bf16_t* AT = (bf16_t*)(lds + (dir ? L_ATB : L_ATF));
      const int j = 32 * jt + r32;
#pragma unroll
      for (int r = 0; r < 16; ++r) { const int i = 32 * it + crow(r, hi); const bool keep = dir ? (j >= i) : (j <= i); AT[i * (GP / 2) + j] = f2bf(keep ? c[r] : 0.f); } }
    LBAR();
    { const int it = wave >> 2, et = wave & 3;
      f32x16 o = {};
#pragma unroll
      for (int dir = 0; dir < 2; ++dir) {
          const unsigned char* AT = lds + (dir ? L_ATB : L_ATF); const unsigned char* Qd = lds + (dir ? L_QB : L_QF); const unsigned char* SPd = lds + (dir ? L_SPB : L_SPF);
#pragma unroll
          for (int ks = 0; ks < 4; ++ks) o = __builtin_amdgcn_mfma_f32_32x32x16_bf16(ldf(AT, 32 * it + r32, ks, hi), ldf(lds + L_VT, 32 * et + r32, ks, hi), o, 0, 0, 0);
#pragma unroll
          for (int ks = 0; ks < 4; ++ks) o = __builtin_amdgcn_mfma_f32_32x32x16_bf16(ldf(Qd, 32 * it + r32, ks, hi), ldf(SPd, 32 * et + r32, ks, hi), o, 0, 0, 0); }
      LBAR();
      float* OB = (float*)lds;
#pragma unroll
      for (int r = 0; r < 16; ++r) OB[(32 * it + crow(r, hi)) * 132 + 32 * et + r32] = o[r]; }
    LBAR();
    { const int i = tid >> 3, s8 = tid & 7; const float* OB = (const float*)lds + i * 132 + 16 * s8;
      f32x4 v[4]; float ss = 0.f;
#pragma unroll
      for (int q = 0; q < 4; ++q) { v[q] = *(const f32x4*)(OB + 4 * q); ss += (v[q].x * v[q].x + v[q].y * v[q].y) + (v[q].z * v[q].z + v[q].w * v[q].w); }
      ss += __shfl_xor(ss, 1); ss += __shfl_xor(ss, 2); ss += __shfl_xor(ss, 4);
      const float rstd = rsqrtf(ss * (1.f / 128.f) + EPS);
      const int tok = tok0 + i;
      const u32x4 r0 = rg0, r1 = rg1;
      float y[16];
#pragma unroll
      for (int q = 0; q < 4; ++q) { const f32x4 g = *(const f32x4*)(outg + 16 * s8 + 4 * q);
          const unsigned w0 = q < 2 ? r0[2 * q] : r1[2 * (q - 2)], w1 = q < 2 ? r0[2 * q + 1] : r1[2 * (q - 2) + 1];
          y[4 * q + 0] = v[q].x * rstd * g.x * silu(__uint_as_float(w0 << 16)); y[4 * q + 1] = v[q].y * rstd * g.y * silu(__uint_as_float(w0 & 0xffff0000u));
          y[4 * q + 2] = v[q].z * rstd * g.z * silu(__uint_as_float(w1 << 16)); y[4 * q + 3] = v[q].w * rstd * g.w * silu(__uint_as_float(w1 & 0xffff0000u)); }
      u32x4 a = {pk2(y[0], y[1]), pk2(y[2], y[3]), pk2(y[4], y[5]), pk2(y[6], y[7])}, b = {pk2(y[8], y[9]), pk2(y[10], y[11]), pk2(y[12], y[13]), pk2(y[14], y[15])};
      bf16_t* mp = MIX + (size_t)tok * 1024 + h * 128 + 16 * s8;
      *(u32x4*)mp = a; *(u32x4*)(mp + 8) = b; }
    LBAR();
}

DEVI void p_qkrope(bf16_t* Q, bf16_t* K, const float* qg, const float* kg, const float2* rope, int gw, int NGW, int lane) {
    const int i = lane & 31, hh = lane >> 5;
    float gq[4], gk[4];
#pragma unroll
    for (int j = 0; j < 4; ++j) { gq[j] = qg[32 * j + i]; gk[j] = kg[32 * j + i]; }
    for (int t0 = gw * 4; t0 < TT; t0 += NGW * 4) {
        bf16_t xr[4][5][4]; float2 rr[4], rc[4];
#pragma unroll
        for (int u = 0; u < 4; ++u) { const int t = t0 + u, s = t < TP ? (t & 4095) : ((t - TP) & 2047);
            rr[u] = rope[(s >> 6) * 32 + i]; rc[u] = rope[(s & 63) * 32 + i];
#pragma unroll
            for (int p = 0; p < 5; ++p) { const int slot = 2 * p + hh;
                const bf16_t* base = slot < 8 ? Q + (size_t)t * 1024 + slot * 128 : K + (size_t)t * 256 + (slot - 8) * 128;
#pragma unroll
                for (int j = 0; j < 4; ++j) xr[u][p][j] = base[32 * j + i]; } }
#pragma unroll
        for (int u = 0; u < 4; ++u) { const int t = t0 + u;
#pragma unroll
            for (int p = 0; p < 5; ++p) {
                const int slot = 2 * p + hh;
                bf16_t* base = slot < 8 ? Q + (size_t)t * 1024 + slot * 128 : K + (size_t)t * 256 + (slot - 8) * 128;
                float x[4]; float ss = 0.f;
#pragma unroll
                for (int j = 0; j < 4; ++j) { x[j] = bf2f(xr[u][p][j]); ss += x[j] * x[j]; }
                ss += __shfl_xor(ss, 1); ss += __shfl_xor(ss, 2); ss += __shfl_xor(ss, 4); ss += __shfl_xor(ss, 8); ss += __shfl_xor(ss, 16);
                const float rstd = rsqrtf(ss * (1.f / 128.f) + EPS);
#pragma unroll
                for (int j = 0; j < 4; ++j) x[j] *= rstd * (slot < 8 ? gq[j] : gk[j]);
                base[i] = f2bf(x[0] * rr[u].x - x[1] * rr[u].y); base[32 + i] = f2bf(x[1] * rr[u].x + x[0] * rr[u].y);
                base[64 + i] = f2bf(x[2] * rc[u].x - x[3] * rc[u].y); base[96 + i] = f2bf(x[3] * rc[u].x + x[2] * rc[u].y);
            } }
    }
}
namespace attn {
using bf16 = unsigned short;
constexpr int   D = 128, NW = 8, QBLK = 32, KVBLK = 64;
constexpr float SCALE = 0.088388347648318440f;
constexpr float THR = 8.f;
constexpr int SDEPTH = 2;
constexpr int LDQ = 1024, LDK = 256, LDO = 1024;
constexpr size_t SHM_V = KVBLK * D * 2, SHM_K = KVBLK * D * 2, SHM_ATTN = 2 * SHM_V + 2 * SHM_K + NW * 64 * 4;
using bf16x8 = __attribute__((ext_vector_type(8))) short;
using s16x4  = __attribute__((ext_vector_type(4))) short;
using f32x16 = __attribute__((ext_vector_type(16))) float;
using f32x8  = __attribute__((ext_vector_type(8))) float;
using u32x4  = __attribute__((ext_vector_type(4))) unsigned;
#define KSWZ(row, colB) ((row) * 256 + ((colB) ^ (((row) & 7) << 4)))
#define SBAR() __builtin_amdgcn_sched_barrier(0)
__device__ __forceinline__ int crow(int r, int hi) { return (r & 3) + 8 * (r >> 2) + 4 * hi; }
__device__ __forceinline__ unsigned cvtpk(float lo, float hi) {
  unsigned r; asm volatile("v_cvt_pk_bf16_f32 %0, %1, %2" : "=v"(r) : "v"(lo), "v"(hi)); return r;
}
template <typename TIn> struct Stage;
template <> struct Stage<bf16>  { using T = bf16x8;
  __device__ static __forceinline__ T ld8(const bf16* p) { return *reinterpret_cast<const bf16x8*>(p); }
  __device__ static __forceinline__ bf16x8 tobf(T x) { return x; } };
template <> struct Stage<float> { using T = f32x8;
  __device__ static __forceinline__ T ld8(const float* p) { return *reinterpret_cast<const f32x8*>(p); }
  __device__ static __forceinline__ bf16x8 tobf(T x) {
    u32x4 w = {cvtpk(x[0], x[1]), cvtpk(x[2], x[3]), cvtpk(x[4], x[5]), cvtpk(x[6], x[7])}; return *reinterpret_cast<bf16x8*>(&w); } };

__device__ __forceinline__ void partialSM(f32x16& p0, f32x16& p1, float& m_reg, float& mn, float& alpha) {
  constexpr float C = SCALE * 1.4426950408889634f;
  float pmax = p0[0]; for (int r = 1; r < 16; ++r) pmax = fmaxf(pmax, p0[r]); for (int r = 0; r < 16; ++r) pmax = fmaxf(pmax, p1[r]);
  { auto rr = __builtin_amdgcn_permlane32_swap(__float_as_uint(pmax), __float_as_uint(pmax), false, false);
    pmax = fmaxf(__uint_as_float(rr[0]), __uint_as_float(rr[1])); }
  if (__builtin_expect(__all(pmax - m_reg <= THR / SCALE), 1)) { mn = m_reg; alpha = 1.f; }
  else { mn = fmaxf(m_reg, pmax); alpha = __builtin_amdgcn_exp2f((m_reg - mn) * C); m_reg = mn; }
  float mnC = -mn * C;
  for (int r = 0; r < 16; ++r) p0[r] = fmaf(p0[r], C, mnC); for (int r = 0; r < 16; ++r) p1[r] = fmaf(p1[r], C, mnC);
  for (int r = 0; r < 16; ++r) p0[r] = __builtin_amdgcn_exp2f(p0[r]);
}
__device__ __forceinline__ void finishSM(f32x16& p0, f32x16& p1, float alpha, float& l_reg, bf16x8& pa0, bf16x8& pa1, bf16x8& pa2, bf16x8& pa3) {
  for (int r = 0; r < 16; ++r) p1[r] = __builtin_amdgcn_exp2f(p1[r]);
  float ps = 0; for (int r = 0; r < 16; ++r) ps += p0[r]; for (int r = 0; r < 16; ++r) ps += p1[r];
  { auto rr = __builtin_amdgcn_permlane32_swap(__float_as_uint(ps), __float_as_uint(ps), false, false);
    ps = __uint_as_float(rr[0]) + __uint_as_float(rr[1]); }
  l_reg = l_reg * alpha + ps;
#define PK4(P, BASE, OUT) do { unsigned a0 = cvtpk(P[BASE + 0], P[BASE + 1]), a1 = cvtpk(P[BASE + 2], P[BASE + 3]);   \
    unsigned b0 = cvtpk(P[BASE + 4], P[BASE + 5]), b1 = cvtpk(P[BASE + 6], P[BASE + 7]);                              \
    auto r0 = __builtin_amdgcn_permlane32_swap(a0, b0, false, false); auto r1 = __builtin_amdgcn_permlane32_swap(a1, b1, false, false); \
    u32x4 w = {r0[0], r1[0], r0[1], r1[1]}; OUT = *reinterpret_cast<bf16x8*>(&w); } while (0)
  PK4(p0, 0, pa0); PK4(p0, 8, pa1); PK4(p1, 0, pa2); PK4(p1, 8, pa3);
#undef PK4
}
__device__ __forceinline__ void qkt(f32x16& p0, f32x16& p1, const bf16* Ks, const bf16x8* qr, int r32, int hi) {
  p0 = f32x16{}; p1 = f32x16{};
  for (int d0 = 0; d0 < 8; ++d0) { int cb = (d0 * 16 + hi * 8) * 2;
    bf16x8 b0 = *reinterpret_cast<const bf16x8*>((const char*)Ks + KSWZ(r32, cb));
    bf16x8 b1 = *reinterpret_cast<const bf16x8*>((const char*)Ks + KSWZ(32 + r32, cb));
    p0 = __builtin_amdgcn_mfma_f32_32x32x16_bf16(b0, qr[d0], p0, 0, 0, 0);
    p1 = __builtin_amdgcn_mfma_f32_32x32x16_bf16(b1, qr[d0], p1, 0, 0, 0); }
}
__device__ __forceinline__ int v_st(int k, int c) { const int kk = (k & ~0xC) | ((k & 4) << 1) | ((k & 8) >> 1); return ((kk >> 3) * 4 + (c >> 5)) * 512 + ((kk & 7) * 32 + (c & 31)) * 2; }
__device__ __forceinline__ int v_rd_base(int lane) { return ((lane & 3) << 3) | (((lane >> 2) & 3) << 6) | (((lane >> 4) & 1) << 5) | (((lane >> 5) & 1) << 8); }
constexpr int v_rd_off(int d0, int ks, int half) { return d0 * 512 + ks * 4096 + half * 2048; }
template <int OFF> __device__ __forceinline__ s16x4 tr_read(int vb) {
  s16x4 r; asm volatile("ds_read_b64_tr_b16 %0, %1 offset:%2" : "=&v"(r) : "v"(vb), "i"(OFF) : "memory"); return r;
}
template <int D0> __device__ __forceinline__ void pv_one(f32x16& od, int vb, bf16x8 pa0, bf16x8 pa1, bf16x8 pa2, bf16x8 pa3) {
  const s16x4 l0 = tr_read<v_rd_off(D0, 0, 0)>(vb), h0 = tr_read<v_rd_off(D0, 0, 1)>(vb), l1 = tr_read<v_rd_off(D0, 1, 0)>(vb), h1 = tr_read<v_rd_off(D0, 1, 1)>(vb);
  const s16x4 l2 = tr_read<v_rd_off(D0, 2, 0)>(vb), h2 = tr_read<v_rd_off(D0, 2, 1)>(vb), l3 = tr_read<v_rd_off(D0, 3, 0)>(vb), h3 = tr_read<v_rd_off(D0, 3, 1)>(vb);
  asm volatile("s_waitcnt lgkmcnt(0)" ::: "memory"); SBAR();
#define PK(L, H) (bf16x8){L[0], L[1], L[2], L[3], H[0], H[1], H[2], H[3]}
  od = __builtin_amdgcn_mfma_f32_32x32x16_bf16(pa0, PK(l0, h0), od, 0, 0, 0);
  od = __builtin_amdgcn_mfma_f32_32x32x16_bf16(pa1, PK(l1, h1), od, 0, 0, 0);
  od = __builtin_amdgcn_mfma_f32_32x32x16_bf16(pa2, PK(l2, h2), od, 0, 0, 0);
  od = __builtin_amdgcn_mfma_f32_32x32x16_bf16(pa3, PK(l3, h3), od, 0, 0, 0);
#undef PK
}
__device__ __forceinline__ void pv_d0(f32x16* o, int vb, bf16x8 pa0, bf16x8 pa1, bf16x8 pa2, bf16x8 pa3) {
  pv_one<0>(o[0], vb, pa0, pa1, pa2, pa3); pv_one<1>(o[1], vb, pa0, pa1, pa2, pa3); pv_one<2>(o[2], vb, pa0, pa1, pa2, pa3); pv_one<3>(o[3], vb, pa0, pa1, pa2, pa3);
}

template <typename TQ>
__device__ __forceinline__ void attn_dense_body(const TQ* __restrict__ Qb, const bf16* __restrict__ Kh, const bf16* __restrict__ Vh,
                                                bf16* __restrict__ Ob, int seq, char* lds) {
  using St = Stage<bf16>; using SQ = Stage<TQ>;
  const int tid = threadIdx.x, wid = __builtin_amdgcn_readfirstlane(tid >> 6), lane = tid & 63, r32 = lane & 31, hi = lane >> 5;
  bf16* V_lds = (bf16*)lds; bf16* K_lds = (bf16*)(lds + 2 * SHM_V);
  float* ws = (float*)(lds + 2 * SHM_V + 2 * SHM_K) + wid * 64; float* li_l = ws; float* al_l = ws + 32;
  float m_reg = -1e30f, l_reg = 0; f32x16 o[4] = {}; bf16x8 qr[8];
  const TQ* Qw = Qb + (long)(wid * QBLK + r32) * LDQ + hi * 8;
#pragma unroll
  for (int d0 = 0; d0 < 8; ++d0) qr[d0] = SQ::tobf(SQ::ld8(Qw + d0 * 16));
  const int sr = tid >> 4, sc = (tid & 15) * 8, vst0 = v_st(sr, sc), vst1 = v_st(32 + sr, sc);
  const int vb0 = (int)(uintptr_t)V_lds + v_rd_base(lane);
  struct { typename St::T vs0, vs1, ks0, ks1; } sr_[SDEPTH];
#define SLOAD(i, k0) do { sr_[i].vs0 = St::ld8(&Vh[(long)((k0) + sr) * LDK + sc]); sr_[i].vs1 = St::ld8(&Vh[(long)((k0) + 32 + sr) * LDK + sc]); \
    sr_[i].ks0 = St::ld8(&Kh[(long)((k0) + sr) * LDK + sc]); sr_[i].ks1 = St::ld8(&Kh[(long)((k0) + 32 + sr) * LDK + sc]); } while (0)
#define SWRITE(b, i) do { *(bf16x8*)((char*)V_lds + (b) * SHM_V + vst0) = St::tobf(sr_[i].vs0);          \
    *(bf16x8*)((char*)V_lds + (b) * SHM_V + vst1) = St::tobf(sr_[i].vs1); int kc = sc * 2;               \
    *(bf16x8*)((char*)K_lds + (b) * SHM_K + KSWZ(sr, kc)) = St::tobf(sr_[i].ks0);                       \
    *(bf16x8*)((char*)K_lds + (b) * SHM_K + KSWZ(32 + sr, kc)) = St::tobf(sr_[i].ks1); } while (0)
#define SWAIT() do { if constexpr (SDEPTH == 2) asm volatile("s_waitcnt vmcnt(4)" ::: "memory"); else asm volatile("s_waitcnt vmcnt(0)" ::: "memory"); } while (0)
#define RESC(a) do { if (__any((a) < 1.f)) { if (hi == 0) al_l[r32] = (a); asm volatile("s_waitcnt lgkmcnt(0)" ::: "memory"); \
    for (int d = 0; d < 4; ++d) for (int r = 0; r < 16; ++r) o[d][r] *= al_l[crow(r, hi)]; } } while (0)
  f32x16 pA0, pA1, pB0, pB1; float mnA, mnB, alA, alB; bf16x8 pa0, pa1, pa2, pa3; const int NT = seq / KVBLK;
  constexpr int SE = 0, SO = SDEPTH - 1;
  SLOAD(SE, 0); asm volatile("s_waitcnt vmcnt(0)" ::: "memory"); SWRITE(0, SE); __syncthreads();
  qkt(pA0, pA1, K_lds, qr, r32, hi); partialSM(pA0, pA1, m_reg, mnA, alA);
  SLOAD(SO, KVBLK); if constexpr (SDEPTH == 2) { if (2 < NT) SLOAD(SE, 2 * KVBLK); }
  SWAIT(); SWRITE(1, SO); __syncthreads();
  for (int j = 1; j + 1 < NT; j += 2) {
    SBAR(); qkt(pB0, pB1, (bf16*)((char*)K_lds + SHM_K), qr, r32, hi);
    finishSM(pA0, pA1, alA, l_reg, pa0, pa1, pa2, pa3); SBAR();
    SLOAD(SO, (j + SDEPTH) * KVBLK); SBAR();
    pv_d0(o, vb0, pa0, pa1, pa2, pa3); partialSM(pB0, pB1, m_reg, mnB, alB);
    __syncthreads(); SWAIT(); SWRITE(0, SE);
    RESC(alB); __syncthreads();
    SBAR(); qkt(pA0, pA1, K_lds, qr, r32, hi);
    finishSM(pB0, pB1, alB, l_reg, pa0, pa1, pa2, pa3); SBAR();
    if (SDEPTH == 1 || j + 3 < NT) SLOAD(SE, (j + 1 + SDEPTH) * KVBLK); SBAR();
    pv_d0(o, vb0 + (int)SHM_V, pa0, pa1, pa2, pa3); partialSM(pA0, pA1, m_reg, mnA, alA);
    __syncthreads(); SWAIT(); SWRITE(1, SO);
    RESC(alA); __syncthreads();
  }
  SBAR(); qkt(pB0, pB1, (bf16*)((char*)K_lds + SHM_K), qr, r32, hi);
  finishSM(pA0, pA1, alA, l_reg, pa0, pa1, pa2, pa3); SBAR();
  pv_d0(o, vb0, pa0, pa1, pa2, pa3); partialSM(pB0, pB1, m_reg, mnB, alB);
  __syncthreads(); RESC(alB);
  finishSM(pB0, pB1, alB, l_reg, pa0, pa1, pa2, pa3); SBAR();
  pv_d0(o, vb0 + (int)SHM_V, pa0, pa1, pa2, pa3);
  if (hi == 0) li_l[r32] = l_reg; asm volatile("s_waitcnt lgkmcnt(0)" ::: "memory");
  float rli[16];
#pragma unroll
  for (int r = 0; r < 16; ++r) rli[r] = __builtin_amdgcn_rcpf(li_l[crow(r, hi)]);
  bf16* Ow = Ob + (long)(wid * QBLK) * LDO;
#pragma unroll
  for (int r = 0; r < 16; ++r) { int orow = crow(r, hi);
    for (int d0 = 0; d0 < 4; ++d0) Ow[(long)orow * LDO + d0 * 32 + r32] = (bf16)(cvtpk(o[d0][r] * rli[r], 0.f) & 0xffffu); }
#undef SLOAD
#undef SWRITE
#undef SWAIT
#undef RESC
}

#undef KSWZ
#undef SBAR
}

constexpr int LDS_BYTES = 135168;
struct Args { const float* in[19]; float* out; unsigned char* ws; };
#define LAS3 __attribute__((address_space(3)))

#define RLX_AGENT __ATOMIC_RELAXED, __HIP_MEMORY_SCOPE_AGENT
#define XB_TMO      128
#define XB_XCNT(j)  (256  + 64 * (j))
#define XB_XSUB(j)  (1280 + 64 * (j))
#define XB_XGEN(j)  (2304 + 64 * (j))
#define XB_TOP      3328
#define XB_TOPGEN   3392
#define XCD_BAR_WORDS 3456
#define XB_SPIN_CAP (1u << 18)

__device__ __forceinline__ unsigned xb_ld(unsigned* p)              { return __hip_atomic_load(p, __ATOMIC_RELAXED, __HIP_MEMORY_SCOPE_AGENT); }
__device__ __forceinline__ unsigned xb_add(unsigned* p, unsigned v) { return __hip_atomic_fetch_add(p, v, __ATOMIC_RELAXED, __HIP_MEMORY_SCOPE_AGENT); }
__device__ __forceinline__ unsigned xb_xcc_id() { return (unsigned)__builtin_amdgcn_s_getreg((3 << 11) | 20) & 0xFu; }
#define XB_SPIN(cond, bar) do { unsigned _sp = 0; while (cond) { __builtin_amdgcn_s_sleep(1); \
    if ((++_sp & 255u) == 0u) { if (xb_ld(&(bar)[XB_TMO])) break; if (_sp > XB_SPIN_CAP) { atomicAdd(&(bar)[XB_TMO], 1u); break; } } } } while (0)

struct XcdBarrier {
    unsigned* bar; unsigned x;
    volatile LAS3 unsigned* st;
};

__device__ __forceinline__ XcdBarrier xcd_barrier_post(unsigned* bar, volatile LAS3 unsigned* st) {
    XcdBarrier b; b.bar = bar; b.x = xb_xcc_id(); b.st = st;
    if (threadIdx.x == 0) (void)xb_add(&bar[XB_XCNT(b.x)], 1u);
    return b;
}
__device__ __forceinline__ void xcd_barrier_complete(unsigned* bar, unsigned x, unsigned& nloc, unsigned& nx) {
    const unsigned G = gridDim.x * gridDim.y * gridDim.z;
    unsigned sum, cnt, mine, sp = 0u;
    for (;;) {
        sum = 0u; cnt = 0u; mine = 0u;
#pragma unroll
        for (unsigned j = 0; j < 16; ++j) { const unsigned c = xb_ld(&bar[XB_XCNT(j)]); sum += c; cnt += (c > 0u) ? 1u : 0u; mine = (j == x) ? c : mine; }
        if (sum == G) break;
        __builtin_amdgcn_s_sleep(1);
        if ((++sp & 255u) == 0u) { if (xb_ld(&bar[XB_TMO])) break; if (sp > XB_SPIN_CAP) { atomicAdd(&bar[XB_TMO], 1u); break; } }
    }
    nloc = mine > 0u ? mine : 1u; nx = cnt > 0u ? cnt : 1u;
}

__device__ __forceinline__ void xcd_barrier(const XcdBarrier& b) {
    asm volatile("s_waitcnt vmcnt(0)" ::: "memory");
    __syncthreads();
    if (threadIdx.x == 0) {
        unsigned* bar = b.bar;
        __builtin_amdgcn_s_waitcnt(0);
        unsigned nloc = b.st[0], nx = b.st[1];
        if (nloc == 0u) { xcd_barrier_complete(bar, b.x, nloc, nx); b.st[0] = nloc; b.st[1] = nx; }
        const unsigned old = xb_add(&bar[XB_XSUB(b.x)], 1u);
        const unsigned gen = old / nloc;
        if (old + 1u == (gen + 1u) * nloc) {
            __builtin_amdgcn_fence(__ATOMIC_RELEASE, "agent");
            asm volatile("s_waitcnt vmcnt(0)" ::: "memory");
            const unsigned og = xb_add(&bar[XB_TOP], 1u);
            const unsigned tg = og / nx;
            if (og + 1u == (tg + 1u) * nx) xb_add(&bar[XB_TOPGEN], 1u);
            else XB_SPIN(xb_ld(&bar[XB_TOPGEN]) == tg, bar);
            __builtin_amdgcn_fence(__ATOMIC_ACQUIRE, "agent");
            xb_add(&bar[XB_XGEN(b.x)], 1u);
            asm volatile("s_waitcnt vmcnt(0)" ::: "memory");
        } else {
            XB_SPIN(xb_ld(&bar[XB_XGEN(b.x)]) == gen, bar);
            __builtin_amdgcn_fence(__ATOMIC_ACQUIRE, "agent");
            asm volatile("s_waitcnt vmcnt(0)" ::: "memory");
        }
    }
    __syncthreads();
}

constexpr int MISC_OFF = 131072;
constexpr int CW_BAR = 4096;
typedef const __attribute__((address_space(4))) Args* CArgsP;
#ifndef PHM
#define PHM 0xFFFFFFu
#endif
#ifndef PROBE_GLU
#define PROBE_GLU 0
#endif
#ifndef PROBE_MASK
#define PROBE_MASK 0u
#endif
#define REP(b) for (int rep__ = 0; rep__ < 1 + (int)((PROBE_MASK >> (b)) & 1u); ++rep__)
#ifndef PROBE_ATTN
#define PROBE_ATTN 0
#endif
#define PH(b) ((PHM >> (b)) & 1u)
#define PHASE_VARS \
    CArgsP ap = (CArgsP)__builtin_amdgcn_kernarg_segment_ptr(); asm volatile("" : "+s"(ap)); \
    int tid = threadIdx.x; asm volatile("" : "+v"(tid)); \
    const int lane = tid & 63, wave = __builtin_amdgcn_readfirstlane(tid >> 6); \
    const int G = gridDim.x, bx = blockIdx.x, gw = bx * 8 + wave, NGW = G * 8, gt = bx * 512 + tid, NGT = G * 512; \
    unsigned char* ws = ap->ws; float* out = ap->out; bf16_t* H = (bf16_t*)(ws + WS_H); \
    (void)lane; (void)gw; (void)NGW; (void)gt; (void)NGT; (void)out; (void)H; (void)bx; (void)G;
#define GRID_SYNC_CG() cg::this_grid().sync()
#define GRID_SYNC() do { CArgsP ap_ = (CArgsP)__builtin_amdgcn_kernarg_segment_ptr(); asm volatile("" : "+s"(ap_)); \
    XcdBarrier b_; b_.bar = (unsigned*)(ap_->ws + WS_CTL) + CW_BAR; b_.x = xb_xcc_id(); b_.st = (volatile LAS3 unsigned*)(lds3 + MISC_OFF); xcd_barrier(b_); } while (0)

#define SSQP(k) ((float*)(ws + WS_SSQ) + (size_t)(k) * TT)
template <int LAYER> DEVI void ffn_block(LAS3 unsigned char* lds3) {
    { PHASE_VARS
      for (int rep_ = 0; rep_ < (PROBE_GLU ? 2 : 1); ++rep_) if (PH(18)) { pg8::Gemm g{(const bf16_t*)(ws + WS_XBA), (const bf16_t*)(ws + (LAYER ? WS_W_GU1 : WS_W_GU0)), TT, 2 * FFH, 1024}; pg8::StaticOrder S; S.init(TT, 2 * FFH, G, bx);
        Epi<EM_GLU> E{(bf16_t*)(ws + WS_ACT), nullptr, nullptr, nullptr, nullptr, nullptr, nullptr, nullptr, SSQP(LAYER ? 3 : 1), nullptr, nullptr, nullptr};
        pg8::gemm_phase<Epi<EM_GLU>, pg8::StaticOrder, true, true>(lds3, g, S, E); } }
    GRID_SYNC();
    { PHASE_VARS
      if (PH(19)) { pg8::Gemm g{(const bf16_t*)(ws + WS_ACT), (const bf16_t*)(ws + (LAYER ? WS_W_D1 : WS_W_D0)), TT, 1024, FFH}; pg8::StaticOrder S; S.init(TT, 1024, G, bx);
        if constexpr (LAYER == 0) {
            Epi<EM_RES, true> E{nullptr, nullptr, nullptr, nullptr, nullptr, nullptr, nullptr, nullptr, nullptr, SSQP(2), (bf16_t*)(ws + WS_XBA), nullptr};
            pg8::gemm_phase<Epi<EM_RES, true>, pg8::StaticOrder, true, true>(lds3, g, S, E);
        } else {
            Epi<EM_RES> E{nullptr, nullptr, nullptr, out, nullptr, nullptr, nullptr, nullptr, nullptr, nullptr, (bf16_t*)(ws + WS_XBA), nullptr};
            pg8::gemm_phase<Epi<EM_RES>, pg8::StaticOrder, true, true>(lds3, g, S, E); } } }
}

__global__ void __launch_bounds__(512, 2) mega_fwd(Args a_unused) {
    extern __shared__ __attribute__((aligned(16))) unsigned char lds[];
    LAS3 unsigned char* lds3 = (LAS3 unsigned char*)lds;
    { if (threadIdx.x < 32) ((LAS3 unsigned*)(lds3 + MISC_OFF))[threadIdx.x] = 0u;
      __syncthreads();
      CArgsP ap0 = (CArgsP)__builtin_amdgcn_kernarg_segment_ptr();
      (void)xcd_barrier_post((unsigned*)(ap0->ws + WS_CTL) + CW_BAR, (volatile LAS3 unsigned*)(lds3 + MISC_OFF)); }
    { PHASE_VARS
      REP(0) if (PH(0)) p_fold(ap->in[3], ap->in[4], ap->in[6], ap->in[2], (bf16_t*)(ws + WS_W_FT), (bf16_t*)(ws + WS_W_AB1) + (size_t)1536 * 1024, (float*)lds, gw, NGW, lane);
      REP(0) if (PH(1)) { p_dft((bf16_t*)(ws + WS_C4), (bf16_t*)(ws + WS_S4), 4096, 12, gt, NGT); p_dft((bf16_t*)(ws + WS_C2), (bf16_t*)(ws + WS_S2), 2048, 11, gt, NGT); }
      if (gt < 2048) { const int idx = gt >> 5, i = gt & 31; const float inv = powf(10000.f, -(float)(2 * i) * (1.f / 64.f)); const float ang = (float)idx * inv;
          ((float2*)(ws + WS_ROPE))[gt] = make_float2((float)cos((double)ang), (float)sin((double)ang)); }
      for (int i = gt; i < 3 * TT; i += NGT) SSQP(1)[i] = 0.f;
      REP(0) if (PH(2)) p_prep_fold(ap->in[0], ap->in[1], ap->in[2], (bf16_t*)(ws + WS_XBA), SSQP(0), (bf16_t*)((unsigned char*)out + OUT_HS), (bf16_t*)((unsigned char*)out + OUT_HD), (bf16_t*)(ws + WS_HM), gw, NGW, lane); }
    __syncthreads();
    { PHASE_VARS
      REP(3) if (PH(3)) { float* scr = (float*)(lds + wave * 16384);
      const float* win = ap->in[3];
      for (int it = gw; it < 11008; it += NGW) { int r = it;
          if (tr_mat<0>(r, win, 2080, 0, 1024, 256, (bf16_t*)(ws + WS_W_AB1), 0, 0.125f, scr, lane, ap->in[2])) continue;
          if (tr_mat<0>(r, win, 2080, 256, 1024, 1280, (bf16_t*)(ws + WS_W_AB1), 256, 1.f, scr, lane, ap->in[2])) continue;
          if (tr_mat<0>(r, ap->in[9], 1024, 0, 1024, 1024, (bf16_t*)(ws + WS_W_ABO), 0, 1.f, scr, lane)) continue;
          if (tr_mat<1>(r, ap->in[16], FFH, 0, 1024, FFH, (bf16_t*)(ws + WS_W_GU0), 0, 1.f, scr, lane, ap->in[15])) continue;
          if (tr_mat<2>(r, ap->in[17], FFH, 0, 1024, FFH, (bf16_t*)(ws + WS_W_GU0), 0, 1.f, scr, lane, ap->in[15])) continue;
          if (tr_mat<0>(r, ap->in[18], 1024, 0, FFH, 1024, (bf16_t*)(ws + WS_W_D0), 0, 1.f, scr, lane)) continue;
          if (tr_mat<0>(r, ap->in[11], 1536, 0, 1024, 1536, (bf16_t*)(ws + WS_W_QKV), 0, 1.f, scr, lane, ap->in[10])) continue;
          if (tr_mat<0>(r, ap->in[14], 1024, 0, 1024, 1024, (bf16_t*)(ws + WS_W_CO), 0, 1.f, scr, lane)) continue;
          if (tr_mat<1>(r, ap->in[16] + (size_t)1024 * FFH, FFH, 0, 1024, FFH, (bf16_t*)(ws + WS_W_GU1), 0, 1.f, scr, lane, ap->in[15] + 1024)) continue;
          if (tr_mat<2>(r, ap->in[17] + (size_t)1024 * FFH, FFH, 0, 1024, FFH, (bf16_t*)(ws + WS_W_GU1), 0, 1.f, scr, lane, ap->in[15] + 1024)) continue;
          if (tr_mat<0>(r, ap->in[18] + (size_t)1024 * FFH, 1024, 0, FFH, 1024, (bf16_t*)(ws + WS_W_D1), 0, 1.f, scr, lane)) continue;
      } } }
    GRID_SYNC_CG();
    { PHASE_VARS
      REP(4) if (PH(4)) { pg8::Gemm g{(const bf16_t*)(ws + WS_XBA), (const bf16_t*)(ws + WS_W_AB1), TT, 2048, 1024}; RotOrder S; S.S.init(TT, 2048, G, bx);
        Epi<EM_AB1> E{(bf16_t*)(ws + WS_QKVR), (bf16_t*)(ws + WS_G), nullptr, nullptr, nullptr, nullptr, ap->in[5], ap->in[7], SSQP(0), nullptr, nullptr, nullptr};
        pg8::gemm_phase<Epi<EM_AB1>, RotOrder, true, true>(lds3, g, S, E); } }
    { PHASE_VARS
      REP(5) if (PH(5)) { pg8::Gemm g{(const bf16_t*)(ws + WS_W_FT), (const bf16_t*)((unsigned char*)out + OUT_HS), 1024, 2 * TF, 1024}; FoldOrder S{G, (bx + G / 2) % G};
        Epi<EM_AB1T> E{(bf16_t*)((unsigned char*)out + OUT_YTPC), (bf16_t*)((unsigned char*)out + OUT_YTSC), nullptr, nullptr, nullptr, nullptr, nullptr, nullptr, nullptr, nullptr, nullptr, nullptr};
        pg8::gemm_phase<Epi<EM_AB1T>, FoldOrder, true, true>(lds3, g, S, E); } }
    GRID_SYNC();
    { PHASE_VARS
      REP(6) if (PH(6)) { pg8::Gemm g{(const bf16_t*)(ws + WS_C4), (const bf16_t*)((unsigned char*)out + OUT_YTPC), 2048, 4096, 2048}; pg8::StaticOrder S; S.init(2048, 4096, G, bx);
        Epi<EM_FNETP> E{(bf16_t*)((unsigned char*)out + OUT_PCP), nullptr, nullptr, nullptr, nullptr, nullptr, nullptr, nullptr, nullptr, nullptr, nullptr, nullptr};
        pg8::gemm_phase<Epi<EM_FNETP>, pg8::StaticOrder, true, true>(lds3, g, S, E); } }
    { PHASE_VARS
      REP(6) if (PH(6)) { pg8::Gemm g{(const bf16_t*)(ws + WS_S4), (const bf16_t*)((unsigned char*)out + OUT_YTPS), 2048, 4096, 2048}; pg8::StaticOrder S; S.init(2048, 4096, G, (bx + G / 2) % G);
        Epi<EM_FNETP> E{(bf16_t*)((unsigned char*)out + OUT_PSP), nullptr, nullptr, nullptr, nullptr, nullptr, nullptr, nullptr, nullptr, nullptr, nullptr, nullptr};
        pg8::gemm_phase<Epi<EM_FNETP>, pg8::StaticOrder, true, true>(lds3, g, S, E); } }
    { PHASE_VARS
      REP(6) if (PH(7)) { pg8::Gemm g{(const bf16_t*)(ws + WS_C2), (const bf16_t*)((unsigned char*)out + OUT_YTSC), 1024, 4096, 1024}; pg8::StaticOrder S; S.init(1024, 4096, G, (bx + G / 2) % G);
        Epi<EM_FNETS> E{(bf16_t*)((unsigned char*)out + OUT_PCS), nullptr, nullptr, nullptr, nullptr, nullptr, nullptr, nullptr, nullptr, nullptr, nullptr, nullptr};
        pg8::gemm_phase<Epi<EM_FNETS>, pg8::StaticOrder, true, true>(lds3, g, S, E); } }
    { PHASE_VARS
      REP(6) if (PH(7)) { pg8::Gemm g{(const bf16_t*)(ws + WS_S2), (const bf16_t*)((unsigned char*)out + OUT_YTSS), 1024, 4096, 1024}; pg8::StaticOrder S; S.init(1024, 4096, G, (bx + G / 4) % G);
        Epi<EM_FNETS> E{(bf16_t*)((unsigned char*)out + OUT_PSS), nullptr, nullptr, nullptr, nullptr, nullptr, nullptr, nullptr, nullptr, nullptr, nullptr, nullptr};
        pg8::gemm_phase<Epi<EM_FNETS>, pg8::StaticOrder, true, true>(lds3, g, S, E); } }
    { PHASE_VARS
      REP(8) if (PH(8)) { const int half = G / 2;
        const bf16_t* QKVR = (const bf16_t*)(ws + WS_QKVR); const bf16_t* Gb = (const bf16_t*)(ws + WS_G); bf16_t* DST = (bf16_t*)((unsigned char*)out + OUT_DST); float* DEC = (float*)(ws + WS_DEC);
        const int first = bx < half ? bx : 1920 + bx - half, last = bx < half ? 1920 : 3072;
        GlaLd A; gla_load<false>(A, first, QKVR, Gb, DST, tid);
        for (int item = first; item < last; item += half) { GlaLd B; const int nx = item + half < last ? item + half : item;
            gla_load<false>(B, nx, QKVR, Gb, DST, tid);
            gla_a_item(A, item, DST, DEC, lds, tid, wave, lane); A = B; } }
      p_ymid((const bf16_t*)(ws + WS_HM), (const bf16_t*)(ws + WS_W_FT), (float*)(ws + WS_YMID), gw, NGW, lane); }
    GRID_SYNC();
    { PHASE_VARS
      if (PH(9)) for (int g2 = gt; g2 < 131072; g2 += NGT) p_scan((bf16_t*)((unsigned char*)out + OUT_DST), (const float*)(ws + WS_DEC), g2);
      p_fcombine((const bf16_t*)((unsigned char*)out + OUT_PCP), (const bf16_t*)((unsigned char*)out + OUT_PSP), (const float*)(ws + WS_YMID), H, 0, 4096, 11, gt, NGT);
      p_fcombine((const bf16_t*)((unsigned char*)out + OUT_PCS), (const bf16_t*)((unsigned char*)out + OUT_PSS), (const float*)(ws + WS_YMID) + 8 * 512, H, TP, 2048, 10, gt, NGT);
      p_fmid((const bf16_t*)((unsigned char*)out + OUT_YTPC), (const float*)(ws + WS_YMID), H, 0, 4096, gw, NGW, lane);
      p_fmid((const bf16_t*)((unsigned char*)out + OUT_YTSC), (const float*)(ws + WS_YMID) + 8 * 512, H, TP, 2048, gw, NGW, lane); }
    GRID_SYNC();
    { PHASE_VARS
      REP(10) if (PH(10)) { const bf16_t* QKVR = (const bf16_t*)(ws + WS_QKVR); const bf16_t* Gb = (const bf16_t*)(ws + WS_G); const bf16_t* DST = (const bf16_t*)((unsigned char*)out + OUT_DST);
        GlaLd A; gla_load<true>(A, bx, QKVR, Gb, DST, tid);
        for (int item = bx; item < 3072; item += G) { GlaLd B; const int nx = item + G < 3072 ? item + G : item;
            gla_load<true>(B, nx, QKVR, Gb, DST, tid);
            gla_c_item(A, item, QKVR, DST, ap->in[8], H, lds, tid, wave, lane); A = B; } } }
    GRID_SYNC();
    { PHASE_VARS
      if (PH(11)) { pg8::Gemm g{H, (const bf16_t*)(ws + WS_W_ABO), TT, 1024, 1024}; pg8::StaticOrder S; S.init(TT, 1024, G, bx);
        Epi<EM_RES, true> E{nullptr, nullptr, nullptr, nullptr, nullptr, nullptr, nullptr, nullptr, nullptr, SSQP(1), (bf16_t*)(ws + WS_XBA), nullptr};
        pg8::gemm_phase<Epi<EM_RES, true>, pg8::StaticOrder, true, true>(lds3, g, S, E); } }
    GRID_SYNC();
    ffn_block<0>(lds3);
    GRID_SYNC();
    { PHASE_VARS
      if (PH(13)) { pg8::Gemm g{(const bf16_t*)(ws + WS_XBA), (const bf16_t*)(ws + WS_W_QKV), TT, 1536, 1024}; pg8::StaticOrder S; S.init(TT, 1536, G, bx);
        Epi<EM_QKV> E{(bf16_t*)(ws + WS_Q), (bf16_t*)(ws + WS_K), (bf16_t*)(ws + WS_V), nullptr, nullptr, nullptr, nullptr, nullptr, SSQP(2), nullptr, nullptr, nullptr};
        pg8::gemm_phase<Epi<EM_QKV>, pg8::StaticOrder, true, true>(lds3, g, S, E); } }
    GRID_SYNC();
    { PHASE_VARS
      if (PH(14)) p_qkrope((bf16_t*)(ws + WS_Q), (bf16_t*)(ws + WS_K), ap->in[12], ap->in[13], (const float2*)(ws + WS_ROPE), gw, NGW, lane); }
    GRID_SYNC();
    { PHASE_VARS
      if (PH(15)) { const int vx = bx & 7, vi = bx >> 3;
        bf16_t* Qb = (bf16_t*)(ws + WS_Q); bf16_t* Kb = (bf16_t*)(ws + WS_K); bf16_t* Vb = (bf16_t*)(ws + WS_V); bf16_t* AO = (bf16_t*)(ws + WS_AO);
        for (int i6 = 0; i6 < (PROBE_ATTN ? 12 : 6); ++i6) { const int i = i6 % 6;
            int b, kvh, hq, qb, row0, seq;
            if (i < 4) { const int combo = vx * 2 + (i >> 1), u = (i & 1) * 32 + vi; b = combo >> 1; kvh = combo & 1; hq = kvh * 4 + (u >> 4); qb = u & 15; row0 = b * 4096; seq = 4096; }
            else { const int combo = vx * 2 + (i - 4), u = vi; b = combo >> 1; kvh = combo & 1; hq = kvh * 4 + (u >> 3); qb = u & 7; row0 = TP + b * 2048; seq = 2048; }
            attn::attn_dense_body<attn::bf16>(Qb + (size_t)(row0 + qb * 256) * 1024 + hq * 128, Kb + (size_t)row0 * 256 + kvh * 128, Vb + (size_t)row0 * 256 + kvh * 128,
                                              AO + (size_t)(row0 + qb * 256) * 1024 + hq * 128, seq, (char*)lds);
            __syncthreads();
        } } }
    GRID_SYNC();
    { PHASE_VARS
      if (PH(16)) { pg8::Gemm g{(const bf16_t*)(ws + WS_AO), (const bf16_t*)(ws + WS_W_CO), TT, 1024, 1024}; pg8::StaticOrder S; S.init(TT, 1024, G, bx);
        Epi<EM_RES, true> E{nullptr, nullptr, nullptr, nullptr, nullptr, nullptr, nullptr, nullptr, nullptr, SSQP(3), (bf16_t*)(ws + WS_XBA), nullptr};
        pg8::gemm_phase<Epi<EM_RES, true>, pg8::StaticOrder, true, true>(lds3, g, S, E); } }
    GRID_SYNC();
    ffn_block<1>(lds3);
}

extern "C" void kernel_launch(void* const* d_in, const int* in_sizes, int n_in, void* d_out, int out_size, void* d_ws, size_t ws_size, hipStream_t stream) {
    static int grid = 0;
    if (grid == 0) {
        int dev = 0, cus = 0, per_cu = 0;
        if (n_in != 19 || out_size != TT * DM || ws_size < WS_END) { fprintf(stderr, "kernel_launch: unexpected shapes: n_in %d out %d ws %zu (need %zu)\n", n_in, out_size, ws_size, (size_t)WS_END); grid = -1; return; }
        if (hipGetDevice(&dev) != hipSuccess || hipDeviceGetAttribute(&cus, hipDeviceAttributeMultiprocessorCount, dev) != hipSuccess) { fprintf(stderr, "kernel_launch: device query failed\n"); grid = -1; return; }
        if (hipFuncSetAttribute((const void*)mega_fwd, hipFuncAttributeMaxDynamicSharedMemorySize, LDS_BYTES) != hipSuccess) { fprintf(stderr, "kernel_launch: hipFuncSetAttribute failed\n"); grid = -1; return; }
        if (hipOccupancyMaxActiveBlocksPerMultiprocessor(&per_cu, (const void*)mega_fwd, 512, LDS_BYTES) != hipSuccess || per_cu < 1) fprintf(stderr, "kernel_launch: occupancy query reports %d blocks per CU\n", per_cu);
        (void)hipGetLastError();
        if (cus != 256) { fprintf(stderr, "kernel_launch: built for a 256-CU device, found %d\n", cus); grid = -1; return; }
        grid = 256;
    }
    if (grid < 0) return;
    if (hipMemsetAsync((char*)d_ws + WS_CTL, 0, CTL_BYTES, stream) != hipSuccess) { fprintf(stderr, "kernel_launch: memset failed\n"); return; }
    Args a{};
    for (int i = 0; i < 19; ++i) a.in[i] = (const float*)d_in[i];
    a.out = (float*)d_out; a.ws = (unsigned char*)d_ws;
    void* args[] = {&a};
    const hipError_t e = hipLaunchCooperativeKernel((const void*)mega_fwd, dim3(grid), dim3(512), args, LDS_BYTES, stream);
    if (e != hipSuccess) fprintf(stderr, "kernel_launch: cooperative launch failed: %s\n", hipGetErrorString(e));
}
```
